# Optimizing an MI355X kernel written in HIP

```python
import math
import jax, jax.numpy as jnp
from jax import lax
import numpy as np

D_MODEL = 1024
BATCH = 2
SEQ = 16384
DEPTH = 2

EPS = 1e-6
N_MEM = 256
HEAD_DIM = 64
X_HEADS = 4
X_WIDTH = X_HEADS * HEAD_DIM
MIX_WIDTH = D_MODEL
TM_WIDTH = MIX_WIDTH - X_WIDTH
LRU_WIDTH = TM_WIDTH
LRU_BLOCKS = 4
LRU_BLOCK = LRU_WIDTH // LRU_BLOCKS
CONV_WIDTH = 4
LRU_C = 8.0
LRU_IN = 2 * LRU_WIDTH + X_WIDTH
DSA_HEADS = TM_WIDTH // HEAD_DIM
DSA_V_DIM = 128
IDX_HEADS = 4
IDX_DIM = 64
TOPK_MAX = 256
Q_BLOCK = 128
DSA_SIZES = (DSA_HEADS * HEAD_DIM, HEAD_DIM, DSA_V_DIM, IDX_HEADS * IDX_DIM, IDX_DIM, IDX_HEADS, X_WIDTH)
DSA_IN = int(sum(DSA_SIZES))
DSA_SPLITS = tuple(int(c) for c in np.cumsum(DSA_SIZES)[:-1])
REL_BUCKETS = 32
REL_MAX_DIST = 128
N_GROUPS = 4
EXPERTS_PER_GROUP = 8
N_EXPERTS = N_GROUPS * EXPERTS_PER_GROUP
TOP_K_IN_GROUP = 2
D_EXPERT = 512
MOE_BLOCK = 128
N_LRU_LAYERS = (DEPTH + 1) // 2
N_DSA_LAYERS = DEPTH // 2

kernel_name = "hybrid_rglru_dsa_memxattn_hmoe"


def rms_norm(x, g):
    xf = x.astype(jnp.float32)
    y = xf * lax.rsqrt(jnp.mean(xf * xf, axis=-1, keepdims=True) + EPS)
    return (y * g.astype(jnp.float32)).astype(x.dtype)


def rms_unit(x):
    xf = x.astype(jnp.float32)
    return (xf * lax.rsqrt(jnp.mean(xf * xf, axis=-1, keepdims=True) + EPS)).astype(x.dtype)


def t5_bucket(dist):
    max_exact = REL_BUCKETS // 2
    d = jnp.maximum(dist, 0)
    df = jnp.maximum(d, 1).astype(jnp.float32)
    large = max_exact + (jnp.log(df / max_exact) / math.log(REL_MAX_DIST / max_exact)
                         * (REL_BUCKETS - max_exact)).astype(jnp.int32)
    large = jnp.minimum(large, REL_BUCKETS - 1)
    return jnp.where(d < max_exact, d, large)


def memory_kv(mem, g, w):
    B, M, _ = mem.shape
    k, v = jnp.split(rms_norm(mem, g) @ w, 2, axis=-1)
    return k.reshape(B, M, X_HEADS, HEAD_DIM), v.reshape(B, M, X_HEADS, HEAD_DIM)


def memory_cross_attention(xq, mk, mv, gq, gk):
    B, S, _ = xq.shape
    q = rms_norm(xq.reshape(B, S, X_HEADS, HEAD_DIM), gq)
    k = rms_norm(mk, gk)
    logits = jnp.einsum('bshd,bmhd->bhsm', q, k).astype(jnp.float32) * HEAD_DIM ** -0.5
    p = jax.nn.softmax(logits, axis=-1).astype(mv.dtype)
    return jnp.einsum('bhsm,bmhd->bshd', p, mv).reshape(B, S, X_WIDTH)


def causal_depthwise_conv(x, w, b):
    S = x.shape[1]
    xp = jnp.pad(x, ((0, 0), (CONV_WIDTH - 1, 0), (0, 0)))
    out = b
    for k in range(CONV_WIDTH):
        out = out + xp[:, k:k + S] * w[k]
    return out


def rglru(x, w_a, b_a, w_x, b_x, lam):
    B, S, _ = x.shape
    xf = x.astype(jnp.float32)
    xb = xf.reshape(B, S, LRU_BLOCKS, LRU_BLOCK)
    r = jax.nn.sigmoid(jnp.einsum('bsni,nij->bsnj', xb, w_a.astype(jnp.float32)).reshape(B, S, LRU_WIDTH) + b_a)
    i = jax.nn.sigmoid(jnp.einsum('bsni,nij->bsnj', xb, w_x.astype(jnp.float32)).reshape(B, S, LRU_WIDTH) + b_x)
    log_a = -LRU_C * r * jax.nn.softplus(-lam.astype(jnp.float32))
    a = jnp.exp(log_a)
    u = jnp.sqrt(-jnp.expm1(2.0 * log_a)) * (i * xf)

    def combine(left, right):
        a1, b1 = left
        a2, b2 = right
        return a1 * a2, a2 * b1 + b2

    _, h = lax.associative_scan(combine, (a, u), axis=1)
    return h.astype(x.dtype)


def rglru_mixer(hn, mk, mv, w_in, conv_w, conv_b, w_a, b_a, w_x, b_x, lam, xq_g, xk_g):
    proj = hn @ w_in
    xs, gate, xq = jnp.split(proj, [LRU_WIDTH, 2 * LRU_WIDTH], axis=-1)
    xs = causal_depthwise_conv(xs, conv_w, conv_b)
    y = rglru(xs, w_a, b_a, w_x, b_x, lam) * jax.nn.gelu(gate)
    xo = memory_cross_attention(xq, mk, mv, xq_g, xk_g)
    return jnp.concatenate([y, xo], axis=-1)


def dsa_mixer(hn, mk, mv, w_in, q_g, k_g, w_uv, rel_bias, xq_g, xk_g):
    B, S, _ = hn.shape
    proj = hn @ w_in
    q, k, v, qi, ki, wi, xq = jnp.split(proj, DSA_SPLITS, axis=-1)
    q = rms_norm(q.reshape(B, S, DSA_HEADS, HEAD_DIM), q_g)
    k = rms_norm(k, k_g)
    qi = qi.reshape(B, S, IDX_HEADS, IDX_DIM)
    ki = rms_unit(ki)
    wi = wi * IDX_HEADS ** -0.5
    topk = min(TOPK_MAX, S // 4)
    n_blk = S // Q_BLOCK
    key_pos = jnp.arange(S, dtype=jnp.int32)

    def to_blocks(a):
        return jnp.swapaxes(a.reshape(B, n_blk, Q_BLOCK, *a.shape[2:]), 0, 1)

    def block_fn(args):
        qb, qib, wib, blk = args
        t = blk * Q_BLOCK + jnp.arange(Q_BLOCK, dtype=jnp.int32)
        dots = jnp.einsum('bqhd,bsd->bqhs', qib, ki).astype(jnp.float32) * IDX_DIM ** -0.5
        score = jnp.einsum('bqh,bqhs->bqs', wib.astype(jnp.float32), jax.nn.relu(dots))
        score = jnp.where((key_pos[None, :] <= t[:, None])[None], score, -jnp.inf)
        _, sel = lax.top_k(score, topk)
        k_sel = jax.vmap(lambda kk, ii: kk[ii])(k, sel)
        v_sel = jax.vmap(lambda vv, ii: vv[ii])(v, sel)
        dist = t[None, :, None] - sel
        bias = jnp.swapaxes(rel_bias[t5_bucket(dist)], -1, -2)
        logits = jnp.einsum('bqhd,bqkd->bqhk', qb, k_sel).astype(jnp.float32) * HEAD_DIM ** -0.5
        logits = logits + bias.astype(jnp.float32)
        logits = jnp.where((dist >= 0)[:, :, None, :], logits, -jnp.inf)
        p = jax.nn.softmax(logits, axis=-1).astype(v.dtype)
        o = jnp.einsum('bqhk,bqkc->bqhc', p, v_sel)
        return jnp.einsum('bqhc,hcd->bqhd', o, w_uv).reshape(B, Q_BLOCK, DSA_HEADS * HEAD_DIM)

    out = lax.map(block_fn, (to_blocks(q), to_blocks(qi), to_blocks(wi), jnp.arange(n_blk, dtype=jnp.int32)))
    y = jnp.swapaxes(out, 0, 1).reshape(B, S, DSA_HEADS * HEAD_DIM)
    xo = memory_cross_attention(xq, mk, mv, xq_g, xk_g)
    return jnp.concatenate([y, xo], axis=-1)


def grouped_swiglu(xt, eid, w_gate, w_up, w_down):
    N, D = xt.shape
    A = eid.shape[0]
    counts = jnp.bincount(eid, length=N_EXPERTS)
    padded = (counts + MOE_BLOCK - 1) // MOE_BLOCK * MOE_BLOCK
    seg_end = jnp.cumsum(padded)
    pad_start = seg_end - padded
    start = jnp.cumsum(counts) - counts
    order = jnp.argsort(eid)
    eid_sorted = eid[order]
    dest_sorted = (pad_start[eid_sorted] + jnp.arange(A) - start[eid_sorted]).astype(jnp.int32)
    dest = jnp.zeros((A,), jnp.int32).at[order].set(dest_sorted)
    n_blocks = -(-A // MOE_BLOCK) + N_EXPERTS
    P = n_blocks * MOE_BLOCK
    tok = jnp.arange(A, dtype=jnp.int32) // TOP_K_IN_GROUP
    buf = jnp.zeros((P, D), xt.dtype).at[dest].set(xt[tok])
    block_eid = jnp.minimum(jnp.searchsorted(seg_end, jnp.arange(n_blocks) * MOE_BLOCK, side='right'),
                            N_EXPERTS - 1)

    def expert_block(args):
        xb, e = args
        return (jax.nn.silu(xb @ w_gate[e]) * (xb @ w_up[e])) @ w_down[e]

    out = lax.map(expert_block, (buf.reshape(n_blocks, MOE_BLOCK, D), block_eid))
    return out.reshape(P, D)[dest]


def hier_moe(h, w_grp, b_grp, w_rt, b_rt, w_gate, w_up, w_down):
    B, S, D = h.shape
    xt = h.reshape(B * S, D)
    N = xt.shape[0]
    p_grp = jax.nn.softmax((xt @ w_grp).astype(jnp.float32) + b_grp, axis=-1)
    p_g, g_sel = lax.top_k(p_grp, 1)
    e_logits = ((xt @ w_rt).astype(jnp.float32) + b_rt).reshape(N, N_GROUPS, EXPERTS_PER_GROUP)
    e_logits = jnp.take_along_axis(e_logits, g_sel[:, :, None], axis=1)[:, 0]
    p_e = jax.nn.softmax(e_logits, axis=-1)
    v2, e_sel = lax.top_k(p_e, TOP_K_IN_GROUP)
    gate = p_g * v2 / jnp.sum(v2, axis=-1, keepdims=True)
    eid = (g_sel * EXPERTS_PER_GROUP + e_sel).reshape(-1).astype(jnp.int32)
    y = grouped_swiglu(xt, eid, w_gate, w_up, w_down).reshape(N, TOP_K_IN_GROUP, D)
    out = jnp.sum(y * gate[..., None].astype(y.dtype), axis=1)
    return out.reshape(B, S, D)


def setup_inputs(seed: int = 0) -> dict:
    key = jax.random.key(seed)
    ks = iter(jax.random.split(key, 40))
    f32 = jnp.float32

    def nrm(shape, scale):
        return jax.random.normal(next(ks), shape, f32) * scale

    def gain(shape):
        return 1.0 + nrm(shape, 0.02)

    NL, ND = N_LRU_LAYERS, N_DSA_LAYERS
    x = nrm((BATCH, SEQ, D_MODEL), 1.0)
    mem = nrm((BATCH, N_MEM, D_MODEL), 1.0)
    norm_mix = gain((DEPTH, D_MODEL))
    norm_ffn = gain((DEPTH, D_MODEL))
    mem_norm = gain((DEPTH, D_MODEL))
    w_mem_kv = nrm((DEPTH, D_MODEL, 2 * X_WIDTH), D_MODEL ** -0.5)
    xq_norm = gain((DEPTH, HEAD_DIM))
    xk_norm = gain((DEPTH, HEAD_DIM))
    w_out = nrm((DEPTH, MIX_WIDTH, D_MODEL), MIX_WIDTH ** -0.5)
    lru_w_in = nrm((NL, D_MODEL, LRU_IN), D_MODEL ** -0.5)
    lru_conv_w = nrm((NL, CONV_WIDTH, LRU_WIDTH), CONV_WIDTH ** -0.5)
    lru_conv_b = nrm((NL, LRU_WIDTH), 0.01)
    lru_w_a = nrm((NL, LRU_BLOCKS, LRU_BLOCK, LRU_BLOCK), LRU_BLOCK ** -0.5)
    lru_b_a = nrm((NL, LRU_WIDTH), 0.01)
    lru_w_x = nrm((NL, LRU_BLOCKS, LRU_BLOCK, LRU_BLOCK), LRU_BLOCK ** -0.5)
    lru_b_x = nrm((NL, LRU_WIDTH), 0.01)
    a0 = jax.random.uniform(next(ks), (NL, LRU_WIDTH), f32, 0.9, 0.999)
    p = a0 ** (1.0 / LRU_C)
    lru_lambda = jnp.log(p) - jnp.log1p(-p)
    dsa_w_in = nrm((ND, D_MODEL, DSA_IN), D_MODEL ** -0.5)
    dsa_q_norm = gain((ND, HEAD_DIM))
    dsa_k_norm = gain((ND, HEAD_DIM))
    dsa_w_uv = nrm((ND, DSA_HEADS, DSA_V_DIM, HEAD_DIM), DSA_V_DIM ** -0.5)
    rel_bias = nrm((REL_BUCKETS, DSA_HEADS), 0.5)
    moe_w_group = nrm((DEPTH, D_MODEL, N_GROUPS), D_MODEL ** -0.5)
    moe_b_group = nrm((DEPTH, N_GROUPS), 0.01)
    moe_w_router = nrm((DEPTH, D_MODEL, N_EXPERTS), D_MODEL ** -0.5)
    moe_b_router = nrm((DEPTH, N_EXPERTS), 0.01)
    moe_w_gate = nrm((DEPTH, N_EXPERTS, D_MODEL, D_EXPERT), D_MODEL ** -0.5)
    moe_w_up = nrm((DEPTH, N_EXPERTS, D_MODEL, D_EXPERT), D_MODEL ** -0.5)
    moe_w_down = nrm((DEPTH, N_EXPERTS, D_EXPERT, D_MODEL), D_EXPERT ** -0.5)
    return {"x": x, "mem": mem, "norm_mix": norm_mix, "norm_ffn": norm_ffn, "mem_norm": mem_norm,
            "w_mem_kv": w_mem_kv, "xq_norm": xq_norm, "xk_norm": xk_norm, "w_out": w_out,
            "lru_w_in": lru_w_in, "lru_conv_w": lru_conv_w, "lru_conv_b": lru_conv_b,
            "lru_w_a": lru_w_a, "lru_b_a": lru_b_a, "lru_w_x": lru_w_x, "lru_b_x": lru_b_x,
            "lru_lambda": lru_lambda, "dsa_w_in": dsa_w_in, "dsa_q_norm": dsa_q_norm,
            "dsa_k_norm": dsa_k_norm, "dsa_w_uv": dsa_w_uv, "rel_bias": rel_bias,
            "moe_w_group": moe_w_group, "moe_b_group": moe_b_group, "moe_w_router": moe_w_router,
            "moe_b_router": moe_b_router, "moe_w_gate": moe_w_gate, "moe_w_up": moe_w_up,
            "moe_w_down": moe_w_down}


def reference(x, mem, norm_mix, norm_ffn, mem_norm, w_mem_kv, xq_norm, xk_norm, w_out,
              lru_w_in, lru_conv_w, lru_conv_b, lru_w_a, lru_b_a, lru_w_x, lru_b_x, lru_lambda,
              dsa_w_in, dsa_q_norm, dsa_k_norm, dsa_w_uv, rel_bias,
              moe_w_group, moe_b_group, moe_w_router, moe_b_router, moe_w_gate, moe_w_up, moe_w_down):
    for i in range(DEPTH):
        j = i // 2
        mk, mv = memory_kv(mem, mem_norm[i], w_mem_kv[i])
        hn = rms_norm(x, norm_mix[i])
        if i % 2 == 0:
            mixed = rglru_mixer(hn, mk, mv, lru_w_in[j], lru_conv_w[j], lru_conv_b[j], lru_w_a[j],
                                lru_b_a[j], lru_w_x[j], lru_b_x[j], lru_lambda[j], xq_norm[i], xk_norm[i])
        else:
            mixed = dsa_mixer(hn, mk, mv, dsa_w_in[j], dsa_q_norm[j], dsa_k_norm[j], dsa_w_uv[j],
                              rel_bias, xq_norm[i], xk_norm[i])
        x = x + mixed @ w_out[i]
        x = x + hier_moe(rms_norm(x, norm_ffn[i]), moe_w_group[i], moe_b_group[i], moe_w_router[i],
                         moe_b_router[i], moe_w_gate[i], moe_w_up[i], moe_w_down[i])
    return x
```

```cpp
#include <hip/hip_runtime.h>
#include <cstdio>
#include <cstdint>
namespace pg8 {
#define PG8_LAS __attribute__((address_space(3)))
typedef unsigned short bf16_t;
typedef short bf16x8 __attribute__((ext_vector_type(8)));
typedef float f32x4 __attribute__((ext_vector_type(4)));
typedef float f32x2 __attribute__((ext_vector_type(2)));
typedef unsigned u32x4 __attribute__((ext_vector_type(4)));
constexpr int BM = 256, BK = 64, HALF = 128, HTB = HALF * BK * 2  , STAGE_BYTES = 8 * HTB, NXCD = 8, WGM = 8;

__host__ __device__ __forceinline__ int lds_byte(int r, int c) { const int st = (r >> 4) * 2 + (c >> 5), rr = r & 15, cc = c & 31, ob = rr * 64 + cc * 2; return st * 1024 + (ob ^ (((ob >> 9) & 1) << 5)); }
__host__ __device__ __forceinline__ void stage_rc(int b, int& R, int& C) { const int st = b / 1024, sb = b % 1024, swz = sb ^ (((sb >> 9) & 1) << 5); R = (st >> 1) * 16 + swz / 64; C = (st & 1) * 32 + (swz % 64) / 2; }
__host__ __device__ __forceinline__ int perm32(int rho) { const int n = rho >> 4, i = rho & 15; return 8 * (i >> 2) + 4 * n + (i & 3); }

struct Unit { int pm, pn; size_t boff; };
struct Gemm { const bf16_t* A; const bf16_t* Bt; int lda, ldb, K; };

struct StaticOrder {
    int nM, nN, nwg, G, c;
    __host__ __device__ void init(int nM_, int nN_, int G_, int c_) { nM = nM_; nN = nN_; nwg = nM * nN; G = G_; c = c_; }
    __host__ __device__ bool next(int i, Unit& u) const {
        const long L = (long)i * G + c; if (L >= nwg) return false;
        int wgid = (int)L; { const int q = nwg / NXCD, r = nwg % NXCD, xcd = wgid % NXCD, off = wgid / NXCD; wgid = (xcd < r ? xcd * (q + 1) : r * (q + 1) + (xcd - r) * q) + off; }
        const int nig = WGM * nN, gid = wgid / nig, fm = gid * WGM, gsz = (nM - fm) < WGM ? (nM - fm) : WGM;
        u.pm = fm + ((wgid % nig) % gsz); u.pn = (wgid % nig) / gsz; u.boff = 0; return true;
    }
    __device__ __forceinline__ void a_ready(const Unit&) const {}
    __device__ __forceinline__ void done(const Unit&) const {}
};
struct GroupedOrder : StaticOrder {
    const int* te; size_t estride;
    __device__ bool next(int i, Unit& u) const { if (!StaticOrder::next(i, u)) return false; u.boff = (size_t)te[u.pm] * estride; return true; }
};

__device__ __forceinline__ unsigned cvt_pk_bf16(float lo, float hi) { unsigned r; asm volatile("v_cvt_pk_bf16_f32 %0, %1, %2" : "=v"(r) : "v"(lo), "v"(hi)); return r; }
__device__ __forceinline__ float bf_lo(unsigned w) { return __uint_as_float(w << 16); }
__device__ __forceinline__ float bf_hi(unsigned w) { return __uint_as_float(w & 0xffff0000u); }
__device__ __forceinline__ float sigmoidf_(float v) { return __builtin_amdgcn_rcpf(1.0f + __expf(-v)); }
__device__ __forceinline__ float gelu_tanh(float v) { const float z = 1.5957691216057308f * (v + 0.044715f * v * v * v); return v * sigmoidf_(z); }

template <bool GELU> struct EpiBf16 {
    static constexpr bool PERM = true, AFTER_DRAIN = false;
    bf16_t* O; int ldc; int gelu_lo, gelu_hi;
    __device__ __forceinline__ void operator()(const f32x4 (&acc)[2][2][4][2], const Unit& u, int wr, int wc, int fr, int fq) const {
        const int row0 = u.pm * BM + wr * 64 + fr, col0 = u.pn * BM + wc * 32 + 8 * fq;
        const bool act = GELU && (u.pn >= gelu_lo && u.pn < gelu_hi);
#pragma unroll
        for (int ai = 0; ai < 2; ++ai)
#pragma unroll
            for (int m = 0; m < 4; ++m) { bf16_t* rowp = O + (size_t)(row0 + ai * HALF + m * 16) * ldc + col0;
#pragma unroll
                for (int bj = 0; bj < 2; ++bj) { f32x4 v0 = acc[ai][bj][m][0], v1 = acc[ai][bj][m][1];
                    if (act) {
#pragma unroll
                        for (int j = 0; j < 4; ++j) { v0[j] = gelu_tanh(v0[j]); v1[j] = gelu_tanh(v1[j]); } }
                    u32x4 w; w.x = cvt_pk_bf16(v0[0], v0[1]); w.y = cvt_pk_bf16(v0[2], v0[3]); w.z = cvt_pk_bf16(v1[0], v1[1]); w.w = cvt_pk_bf16(v1[2], v1[3]);
                    *(u32x4*)(rowp + bj * HALF) = w; } }
    }
};
struct EpiSwiglu {
    static constexpr bool PERM = true, AFTER_DRAIN = false;
    bf16_t* O; int ldc;
    __device__ __forceinline__ void operator()(const f32x4 (&acc)[2][2][4][2], const Unit& u, int wr, int wc, int fr, int fq) const {
        const int row0 = u.pm * BM + wr * 64 + fr, col0 = u.pn * HALF + wc * 32 + 8 * fq;
#pragma unroll
        for (int ai = 0; ai < 2; ++ai)
#pragma unroll
            for (int m = 0; m < 4; ++m) { bf16_t* rowp = O + (size_t)(row0 + ai * HALF + m * 16) * ldc + col0;
                f32x4 v0, v1;
#pragma unroll
                for (int j = 0; j < 4; ++j) { const float g0 = acc[ai][0][m][0][j], g1 = acc[ai][0][m][1][j];
                    v0[j] = g0 * sigmoidf_(g0) * acc[ai][1][m][0][j]; v1[j] = g1 * sigmoidf_(g1) * acc[ai][1][m][1][j]; }
                u32x4 w; w.x = cvt_pk_bf16(v0[0], v0[1]); w.y = cvt_pk_bf16(v0[2], v0[3]); w.z = cvt_pk_bf16(v1[0], v1[1]); w.w = cvt_pk_bf16(v1[2], v1[3]);
                *(u32x4*)rowp = w; }
    }
};
struct EpiLruGate {
    static constexpr bool PERM = true, AFTER_DRAIN = false;
    bf16_t* LA; bf16_t* U; const bf16_t* XS; int ldc; const float* b_a; const float* b_x; const float* lam;
    __device__ __forceinline__ void operator()(const f32x4 (&acc)[2][2][4][2], const Unit& u, int wr, int wc, int fr, int fq) const {
        const int row0 = u.pm * BM + wr * 64 + fr, ch0 = u.pn * HALF + wc * 32 + 8 * fq;
        float ba[8], bx[8], sp8[8];
#pragma unroll
        for (int j = 0; j < 8; ++j) { ba[j] = b_a[ch0 + j]; bx[j] = b_x[ch0 + j]; const float l = lam[ch0 + j];
            sp8[j] = 8.0f * ((l > 15.f) ? __expf(-l) : __logf(1.0f + __expf(-l))); }
#pragma unroll
        for (int ai = 0; ai < 2; ++ai)
#pragma unroll
            for (int m = 0; m < 4; ++m) { const size_t off = (size_t)(row0 + ai * HALF + m * 16) * ldc + ch0;
                const u32x4 xw = *(const u32x4*)(XS + off);
                float xv[8] = {bf_lo(xw.x), bf_hi(xw.x), bf_lo(xw.y), bf_hi(xw.y), bf_lo(xw.z), bf_hi(xw.z), bf_lo(xw.w), bf_hi(xw.w)};
                float la[8], uu[8];
#pragma unroll
                for (int j = 0; j < 8; ++j) { const float rp = acc[ai][0][m][j >> 2][j & 3] + ba[j], ip = acc[ai][1][m][j >> 2][j & 3] + bx[j];
                    const float r = sigmoidf_(rp), ig = sigmoidf_(ip);
                    const float l = -sp8[j] * r; const float t = 2.0f * l;
                    const float om = (t > -0.02f) ? -t * (1.0f + t * (0.5f + t * (0.16666667f + t * 0.041666667f))) : 1.0f - __expf(t);
                    la[j] = l; uu[j] = sqrtf(om) * ig * xv[j]; }
                u32x4 w; w.x = cvt_pk_bf16(la[0], la[1]); w.y = cvt_pk_bf16(la[2], la[3]); w.z = cvt_pk_bf16(la[4], la[5]); w.w = cvt_pk_bf16(la[6], la[7]);
                *(u32x4*)(LA + off) = w;
                u32x4 w2; w2.x = cvt_pk_bf16(uu[0], uu[1]); w2.y = cvt_pk_bf16(uu[2], uu[3]); w2.z = cvt_pk_bf16(uu[4], uu[5]); w2.w = cvt_pk_bf16(uu[6], uu[7]);
                *(u32x4*)(U + off) = w2; __builtin_amdgcn_sched_barrier(0); }
    }
};
struct EpiResF32 {
    static constexpr bool PERM = false, AFTER_DRAIN = false;
    float* C; const float* R; int ldc;
    __device__ __forceinline__ void operator()(const f32x4 (&acc)[2][2][4][2], const Unit& u, int wr, int wc, int fr, int fq) const {
        const int row0 = u.pm * BM + wr * 64 + fr, col0 = u.pn * BM + wc * 32 + 4 * fq;
#pragma unroll
        for (int ai = 0; ai < 2; ++ai)
#pragma unroll
            for (int m = 0; m < 4; ++m) { const size_t ro = (size_t)(row0 + ai * HALF + m * 16) * ldc + col0;
#pragma unroll
                for (int bj = 0; bj < 2; ++bj)
#pragma unroll
                    for (int n = 0; n < 2; ++n) { const f32x4 r = *(const f32x4*)(R + ro + bj * HALF + n * 16); *(f32x4*)(C + ro + bj * HALF + n * 16) = r + acc[ai][bj][m][n]; }  __builtin_amdgcn_sched_barrier(0); }
    }
};
struct EpiLogits {
    static constexpr bool PERM = false, AFTER_DRAIN = false;
    float* C;
    __device__ __forceinline__ void operator()(const f32x4 (&acc)[2][2][4][2], const Unit& u, int wr, int wc, int fr, int fq) const {
        if (wc >= 2 || u.pn != 0) return;
        const int row0 = u.pm * BM + wr * 64 + fr, col0 = wc * 32 + 4 * fq;
#pragma unroll
        for (int ai = 0; ai < 2; ++ai)
#pragma unroll
            for (int m = 0; m < 4; ++m) { float* rowp = C + (size_t)(row0 + ai * HALF + m * 16) * 64 + col0;
#pragma unroll
                for (int n = 0; n < 2; ++n) *(f32x4*)(rowp + n * 16) = acc[ai][0][m][n]; }
    }
};
template <class Epi, class Sched, bool ALIGN_EPI = false, bool SP2 = false>
__device__ __forceinline__ void gemm_phase(PG8_LAS unsigned char* lds, const Gemm g, const Sched& S, const Epi& E) {
    int tid_ = threadIdx.x; asm volatile("" : "+v"(tid_));
    const int tid = tid_, wid = __builtin_amdgcn_readfirstlane(tid >> 6), lane = tid & 63, wr = wid >> 2, wc = wid & 3, fr = lane & 15, fq = lane >> 4;
    const int K = g.K, nt = K / BK;
    unsigned voffA[2], voffB[2];
#pragma unroll
    for (int i = 0; i < 2; ++i) { int R, C; stage_rc(tid * 16 + i * 8192, R, C); const int Rb = Epi::PERM ? ((R & ~31) + perm32(R & 31)) : R;
        voffA[i] = (unsigned)(R * g.lda + C) * 2u; voffB[i] = (unsigned)(Rb * g.ldb + C) * 2u; }
    const size_t kstep = (size_t)(BK * 2);
    const size_t hsA = (size_t)HALF * g.lda * 2, hsB = (size_t)HALF * g.ldb * 2;
    const size_t tsA = 2 * hsA, tsB = 2 * hsB;
    const unsigned ldsw = (unsigned)wid * 1024u;
    const int aoff = lds_byte(wr * 64 + fr, fq * 8), boff = lds_byte(wc * 32 + fr, fq * 8);
#define PG8_SA(b, h) (((b) * 2 + (h)) * HTB)
#define PG8_SB(b, h) ((4 + (b) * 2 + (h)) * HTB)
#define PG8_STAGE(bufoff, gbase, voff) do { _Pragma("unroll") for (int _i = 0; _i < 2; ++_i) \
        __builtin_amdgcn_global_load_lds((const unsigned*)((const char*)(gbase) + (voff)[_i]), (PG8_LAS unsigned*)(lds + (bufoff) + ldsw + _i * 8192), 16, 0, 0); } while (0)
#define PG8_LDA(dst, b, h) do { _Pragma("unroll") for (int m = 0; m < 4; ++m) _Pragma("unroll") for (int k = 0; k < 2; ++k) dst[m][k] = *(const PG8_LAS bf16x8*)(lds + PG8_SA(b, h) + aoff + m * 2048 + k * 1024); } while (0)
#define PG8_LDB(dst, b, h) do { _Pragma("unroll") for (int n = 0; n < 2; ++n) _Pragma("unroll") for (int k = 0; k < 2; ++k) dst[n][k] = *(const PG8_LAS bf16x8*)(lds + PG8_SB(b, h) + boff + n * 2048 + k * 1024); } while (0)
#define PG8_MMA(ai, bj, At, Bt) do { __builtin_amdgcn_s_setprio(1); _Pragma("unroll") for (int m = 0; m < 4; ++m) _Pragma("unroll") for (int n = 0; n < 2; ++n) _Pragma("unroll") for (int k = 0; k < 2; ++k) \
        acc[ai][bj][m][n] = __builtin_amdgcn_mfma_f32_16x16x32_bf16(Bt[n][k], At[m][k], acc[ai][bj][m][n], 0, 0, 0); __builtin_amdgcn_s_setprio(0); } while (0)
#define PG8_WAIT_V(n) asm volatile("s_waitcnt vmcnt(" #n ")" ::: "memory")
#define PG8_WAIT_L(n) asm volatile("s_waitcnt lgkmcnt(" #n ")" ::: "memory")
#define PG8_BAR __builtin_amdgcn_s_barrier()
#define PG8_SCHED __builtin_amdgcn_sched_barrier(0)
    Unit cur, nxt; int ui = 0;
    if (!S.next(0, cur)) return;
    f32x4 acc[2][2][4][2];
#pragma unroll
    for (int a = 0; a < 2; ++a)
#pragma unroll
        for (int b = 0; b < 2; ++b)
#pragma unroll
            for (int m = 0; m < 4; ++m)
#pragma unroll
                for (int n = 0; n < 2; ++n) acc[a][b][m][n] = (f32x4){0.f, 0.f, 0.f, 0.f};
    bf16x8 At[4][2], B0[2][2], B1[2][2];
    const char* cA = (const char*)g.A + (size_t)cur.pm * tsA; const char* cB = (const char*)g.Bt + cur.boff + (size_t)cur.pn * tsB;
    S.a_ready(cur);
    if constexpr (SP2) {
        PG8_STAGE(PG8_SB(0, 0), cB, voffB); PG8_STAGE(PG8_SB(0, 1), cB + hsB, voffB); PG8_STAGE(PG8_SA(0, 0), cA, voffA); PG8_STAGE(PG8_SA(0, 1), cA + hsA, voffA);
        if (wr == 1) PG8_BAR;
        PG8_WAIT_V(2); PG8_BAR;
        PG8_STAGE(PG8_SB(1, 0), cB + kstep, voffB); PG8_STAGE(PG8_SA(1, 0), cA + kstep, voffA); PG8_STAGE(PG8_SB(1, 1), cB + hsB + kstep, voffB);
        PG8_WAIT_V(6); PG8_BAR;
    } else {
        PG8_STAGE(PG8_SB(0, 0), cB, voffB); PG8_STAGE(PG8_SA(0, 0), cA, voffA); PG8_STAGE(PG8_SB(0, 1), cB + hsB, voffB); PG8_STAGE(PG8_SA(0, 1), cA + hsA, voffA);
        if (wr == 1) PG8_BAR;
        PG8_WAIT_V(4); PG8_BAR;
        PG8_STAGE(PG8_SB(1, 0), cB + kstep, voffB); PG8_STAGE(PG8_SA(1, 0), cA + kstep, voffA); PG8_STAGE(PG8_SB(1, 1), cB + hsB + kstep, voffB);
        PG8_WAIT_V(6); PG8_BAR;
    }
    for (;;) {
        const bool has_next = S.next(ui + 1, nxt);
        const char* nA = has_next ? (const char*)g.A + (size_t)nxt.pm * tsA : cA; const char* nB = has_next ? (const char*)g.Bt + nxt.boff + (size_t)nxt.pn * tsB : cB;
        for (int t = 0; t < nt; t += 2) {
            const bool last = (t == nt - 2);
            const char* a1 = cA + (size_t)(t + 1) * kstep;
            const char* a2 = last ? nA : cA + (size_t)(t + 2) * kstep; const char* b2 = last ? nB : cB + (size_t)(t + 2) * kstep;
            const char* a3 = a2 + kstep; const char* b3 = b2 + kstep;
            if (last && has_next) S.a_ready(nxt);
            if constexpr (SP2) {
            PG8_LDB(B0, 0, 0); PG8_LDB(B1, 0, 1); PG8_SCHED; PG8_LDA(At, 0, 0); PG8_STAGE(PG8_SA(1, 1), a1 + hsA, voffA);
            PG8_WAIT_V(8); PG8_WAIT_L(0); PG8_BAR; PG8_MMA(0, 0, At, B0); PG8_MMA(0, 1, At, B1); PG8_BAR; PG8_SCHED;
            PG8_LDA(At, 0, 1); PG8_STAGE(PG8_SB(0, 0), b2, voffB); PG8_STAGE(PG8_SB(0, 1), b2 + hsB, voffB); PG8_STAGE(PG8_SA(0, 0), a2, voffA);
            PG8_WAIT_V(8); PG8_WAIT_L(0); PG8_BAR; PG8_MMA(1, 0, At, B0); PG8_MMA(1, 1, At, B1); PG8_BAR; PG8_SCHED;
            PG8_LDB(B0, 1, 0); PG8_LDB(B1, 1, 1); PG8_SCHED; PG8_LDA(At, 1, 0); PG8_STAGE(PG8_SA(0, 1), a2 + hsA, voffA);
            PG8_WAIT_V(8); PG8_WAIT_L(0); PG8_BAR; PG8_MMA(0, 0, At, B0); PG8_MMA(0, 1, At, B1); PG8_BAR; PG8_SCHED;
            PG8_LDA(At, 1, 1); PG8_STAGE(PG8_SB(1, 0), b3, voffB); PG8_STAGE(PG8_SB(1, 1), b3 + hsB, voffB); PG8_STAGE(PG8_SA(1, 0), a3, voffA);
            PG8_WAIT_V(8); PG8_WAIT_L(0); PG8_BAR; PG8_MMA(1, 0, At, B0); PG8_MMA(1, 1, At, B1); PG8_BAR; PG8_SCHED;
            } else {
            PG8_LDB(B0, 0, 0); PG8_SCHED; PG8_LDA(At, 0, 0); PG8_STAGE(PG8_SA(1, 1), a1 + hsA, voffA);
            PG8_WAIT_L(8); PG8_BAR; PG8_WAIT_L(0); PG8_MMA(0, 0, At, B0); PG8_BAR; PG8_SCHED;
            PG8_LDB(B1, 0, 1); PG8_STAGE(PG8_SB(0, 0), b2, voffB);
            PG8_BAR; PG8_WAIT_L(0); PG8_MMA(0, 1, At, B1); PG8_BAR;
            PG8_LDA(At, 0, 1); PG8_STAGE(PG8_SA(0, 0), a2, voffA);
            PG8_BAR; PG8_WAIT_L(0); PG8_MMA(1, 0, At, B0); PG8_BAR; PG8_SCHED;
            PG8_STAGE(PG8_SB(0, 1), b2 + hsB, voffB);
            PG8_WAIT_V(6); PG8_BAR; PG8_MMA(1, 1, At, B1); PG8_BAR;
            PG8_LDB(B0, 1, 0); PG8_SCHED; PG8_LDA(At, 1, 0); PG8_STAGE(PG8_SA(0, 1), a2 + hsA, voffA);
            PG8_WAIT_L(8); PG8_BAR; PG8_WAIT_L(0); PG8_MMA(0, 0, At, B0); PG8_BAR; PG8_SCHED;
            PG8_LDB(B1, 1, 1); PG8_STAGE(PG8_SB(1, 0), b3, voffB);
            PG8_BAR; PG8_WAIT_L(0); PG8_MMA(0, 1, At, B1); PG8_BAR;
            PG8_LDA(At, 1, 1); PG8_STAGE(PG8_SA(1, 0), a3, voffA);
            PG8_BAR; PG8_WAIT_L(0); PG8_MMA(1, 0, At, B0); PG8_BAR; PG8_SCHED;
            PG8_STAGE(PG8_SB(1, 1), b3 + hsB, voffB);
            PG8_WAIT_V(6); PG8_BAR; PG8_MMA(1, 1, At, B1); PG8_BAR;
            }
        }
        if constexpr (ALIGN_EPI) { if (wr == 0) PG8_BAR; }
        if constexpr (!Epi::AFTER_DRAIN) { E(acc, cur, wr, wc, fr, fq); S.done(cur); }
        if (!has_next) break;
#pragma unroll
        for (int a = 0; a < 2; ++a)
#pragma unroll
            for (int b = 0; b < 2; ++b)
#pragma unroll
                for (int m = 0; m < 4; ++m)
#pragma unroll
                    for (int n = 0; n < 2; ++n) acc[a][b][m][n] = (f32x4){0.f, 0.f, 0.f, 0.f};
        cur = nxt; cA = nA; cB = nB; ++ui;
        if constexpr (ALIGN_EPI) { if (wr == 1) PG8_BAR; }
    }
    PG8_WAIT_V(0);
    if constexpr (!ALIGN_EPI) { if (wr == 0) PG8_BAR; }
    PG8_BAR;
    if constexpr (Epi::AFTER_DRAIN) { E.fused(acc, cur, wr, wc, fr, fq, lds, wid, lane); S.done(cur); }
#undef PG8_SA
#undef PG8_SB
#undef PG8_STAGE
#undef PG8_LDA
#undef PG8_LDB
#undef PG8_MMA
#undef PG8_WAIT_V
#undef PG8_WAIT_L
#undef PG8_BAR
#undef PG8_SCHED
}
}

constexpr int NTOK = 32768, SEQ = 16384, DM = 1024;
constexpr float EPS = 1e-6f;
constexpr size_t MiB = 1u << 20;
constexpr size_t WS_CTL = 0, CTL_ZERO_BYTES = 1 * MiB;
constexpr size_t WS_WB = 1 * MiB;
constexpr size_t WB_MKV = WS_WB + 0 * MiB;
constexpr size_t WB_MEMN = WS_WB + 1 * MiB;
constexpr size_t WB_MKVO = WS_WB + 2 * MiB;
constexpr size_t WB_WR = WS_WB + 3 * MiB;
constexpr size_t WB_WIN = WS_WB + 4 * MiB;
constexpr size_t WB_WGT = WS_WB + 8 * MiB;
constexpr size_t WB_WOUT = WS_WB + 11 * MiB;
constexpr size_t WB_WGU = WS_WB + 16 * MiB;
constexpr size_t WB_WD = WS_WB + 80 * MiB;
constexpr size_t WS_HN = WS_WB + 112 * MiB;
constexpr size_t WS_AR = WS_HN + 64 * MiB;
constexpr size_t AR_PROJ = WS_AR;
constexpr size_t AR_XSC = WS_AR + 112 * MiB;
constexpr size_t AR_LA = WS_AR + 160 * MiB;
constexpr size_t AR_UU = WS_AR + 208 * MiB;
constexpr size_t AR_MIXL = WS_AR + 256 * MiB;
constexpr size_t AR_SA = WS_AR + 320 * MiB;
constexpr size_t AR_SH = WS_AR + 322 * MiB;
constexpr size_t AR_CARRY = WS_AR + 324 * MiB;
constexpr size_t AR_KN = WS_AR + 96 * MiB;
constexpr size_t AR_KIN = WS_AR + 100 * MiB;
constexpr size_t AR_QIW = WS_AR + 104 * MiB;
constexpr size_t AR_WI = WS_AR + 120 * MiB;
constexpr size_t AR_SEL = WS_AR + 121 * MiB;
constexpr size_t AR_MIXD = WS_AR + 160 * MiB;
constexpr size_t AR_XS = WS_AR;
constexpr size_t AR_ACT = WS_AR + 144 * MiB;
constexpr size_t AR_LOG = WS_AR + 216 * MiB;
constexpr size_t AR_EID = WS_AR + 224 * MiB;
constexpr size_t AR_GATE = WS_AR + 225 * MiB;
constexpr size_t AR_DEST = WS_AR + 226 * MiB;
constexpr size_t WS_END = WS_AR + 328 * MiB;
constexpr int CW_TMO = 0, CW_CODE = 1;
constexpr int CW_CNT = 256, CW_CUR = 320, CW_NT = 384, CW_LSTRIDE = 256;
constexpr int CW_TE = 1024, CW_TE_STRIDE = 512;
constexpr int CW_BAR = 4096;
constexpr int LDS_BYTES = 159744, MISC_OFF = 155648;

#define GAS __attribute__((address_space(1)))
#define LAS __attribute__((address_space(3)))
#define DI __device__ __forceinline__
typedef unsigned short bf16;
typedef unsigned v4u __attribute__((ext_vector_type(4)));
typedef unsigned v2u __attribute__((ext_vector_type(2)));
typedef int v4i __attribute__((ext_vector_type(4)));
typedef float f32x4 __attribute__((ext_vector_type(4)));
typedef float f32x16 __attribute__((ext_vector_type(16)));
typedef short bf16x8 __attribute__((ext_vector_type(8)));
typedef GAS unsigned gu32;
#define RLX_AGENT __ATOMIC_RELAXED, __HIP_MEMORY_SCOPE_AGENT
#define LDS_WAIT() asm volatile("s_waitcnt lgkmcnt(0)" ::: "memory")
DI unsigned f2bf(float f) { unsigned u = __builtin_bit_cast(unsigned, f); return (u + 0x7fffu + ((u >> 16) & 1u)) >> 16; }
DI unsigned pk2(float lo, float hi) { return f2bf(lo) | (f2bf(hi) << 16); }
DI float bflo(unsigned w) { return __uint_as_float(w << 16); }
DI float bfhi(unsigned w) { return __uint_as_float(w & 0xffff0000u); }
DI void unpack8(const v4u w, float (&f)[8]) { f[0] = bflo(w.x); f[1] = bfhi(w.x); f[2] = bflo(w.y); f[3] = bfhi(w.y); f[4] = bflo(w.z); f[5] = bfhi(w.z); f[6] = bflo(w.w); f[7] = bfhi(w.w); }
DI v4u pack8(const float (&f)[8]) { v4u w; w.x = pk2(f[0], f[1]); w.y = pk2(f[2], f[3]); w.z = pk2(f[4], f[5]); w.w = pk2(f[6], f[7]); return w; }
DI unsigned lds_add(LAS unsigned* p, unsigned v) { return __hip_atomic_fetch_add(p, v, __ATOMIC_RELAXED, __HIP_MEMORY_SCOPE_WORKGROUP); }
DI float wave_sum(float v) {
#pragma unroll
    for (int o = 1; o < 64; o <<= 1) v += __shfl_xor(v, o);
    return v;
}

#define XB_TMO      128
#define XB_XCNT(j)  (256  + 64 * (j))
#define XB_XSUB(j)  (1280 + 64 * (j))
#define XB_XGEN(j)  (2304 + 64 * (j))
#define XB_TOP      3328
#define XB_TOPGEN   3392
#define XCD_BAR_WORDS 3456
#define XB_SPIN_CAP (1u << 22)
DI unsigned xb_ld(unsigned* p)              { return __hip_atomic_load(p, __ATOMIC_RELAXED, __HIP_MEMORY_SCOPE_AGENT); }
DI unsigned xb_add(unsigned* p, unsigned v) { return __hip_atomic_fetch_add(p, v, __ATOMIC_RELAXED, __HIP_MEMORY_SCOPE_AGENT); }
DI unsigned xb_xcc_id() { return (unsigned)__builtin_amdgcn_s_getreg((3 << 11) | 20) & 0xFu; }
#define XB_SPIN(cond, bar) do { unsigned _sp = 0; while (cond) { __builtin_amdgcn_s_sleep(1); \
    if ((++_sp & 255u) == 0u) { if (xb_ld(&(bar)[XB_TMO])) break; if (_sp > XB_SPIN_CAP) { atomicAdd(&(bar)[XB_TMO], 1u); break; } } } } while (0)
struct XcdBarrier { unsigned* bar; unsigned x; volatile LAS unsigned* st; };
DI XcdBarrier xcd_barrier_post(unsigned* bar, volatile LAS unsigned* st) {
    XcdBarrier b; b.bar = bar; b.x = xb_xcc_id(); b.st = st;
    if (threadIdx.x == 0) (void)xb_add(&bar[XB_XCNT(b.x)], 1u);
    return b;
}
DI void xcd_barrier_complete(unsigned* bar, unsigned x, unsigned& nloc, unsigned& nx) {
    const unsigned G = gridDim.x * gridDim.y * gridDim.z;
    unsigned sum, cnt, mine, sp = 0u;
    for (;;) {
        sum = 0u; cnt = 0u; mine = 0u;
#pragma unroll
        for (unsigned j = 0; j < 16; ++j) { const unsigned c = xb_ld(&bar[XB_XCNT(j)]); sum += c; cnt += (c > 0u) ? 1u : 0u; mine = (j == x) ? c : mine; }
        if (sum == G) break;
        __builtin_amdgcn_s_sleep(1);
        if ((++sp & 255u) == 0u) { if (xb_ld(&bar[XB_TMO])) break; if (sp > XB_SPIN_CAP) { atomicAdd(&bar[XB_TMO], 1u); break; } }
    }
    nloc = mine > 0u ? mine : 1u; nx = cnt > 0u ? cnt : 1u;
}
DI void xcd_barrier(const XcdBarrier& b) {
    asm volatile("s_waitcnt vmcnt(0)" ::: "memory");
    __syncthreads();
    if (threadIdx.x == 0) {
        unsigned* bar = b.bar;
        __builtin_amdgcn_s_waitcnt(0);
        unsigned nloc = b.st[0], nx = b.st[1];
        if (nloc == 0u) { xcd_barrier_complete(bar, b.x, nloc, nx); b.st[0] = nloc; b.st[1] = nx; }
        const unsigned old = xb_add(&bar[XB_XSUB(b.x)], 1u);
        const unsigned gen = old / nloc;
        if (old + 1u == (gen + 1u) * nloc) {
            __builtin_amdgcn_fence(__ATOMIC_RELEASE, "agent");
            asm volatile("s_waitcnt vmcnt(0)" ::: "memory");
            const unsigned og = xb_add(&bar[XB_TOP], 1u);
            const unsigned tg = og / nx;
            if (og + 1u == (tg + 1u) * nx) xb_add(&bar[XB_TOPGEN], 1u);
            else XB_SPIN(xb_ld(&bar[XB_TOPGEN]) == tg, bar);
            __builtin_amdgcn_fence(__ATOMIC_ACQUIRE, "agent");
            xb_add(&bar[XB_XGEN(b.x)], 1u);
            asm volatile("s_waitcnt vmcnt(0)" ::: "memory");
        } else {
            XB_SPIN(xb_ld(&bar[XB_XGEN(b.x)]) == gen, bar);
            __builtin_amdgcn_fence(__ATOMIC_ACQUIRE, "agent");
            asm volatile("s_waitcnt vmcnt(0)" ::: "memory");
        }
    }
    __syncthreads();
}

struct Params { const float* in[29]; float* out; unsigned char* ws; };
struct PV { unsigned char* ws; float* out; LAS unsigned long long* tab; };
DI const float* pin(const PV& P, int i) { const unsigned long long v = P.tab[i]; const unsigned lo = __builtin_amdgcn_readfirstlane((unsigned)v), hi = __builtin_amdgcn_readfirstlane((unsigned)(v >> 32)); return (const float*)(((unsigned long long)hi << 32) | lo); }
struct Ctx { LAS unsigned char* lds; int tid, lane, wave, G, blk, gw, NGW; };
DI Ctx relaunder(const Ctx& c0) { Ctx c = c0; int t = threadIdx.x; asm volatile("" : "+v"(t)); c.tid = t; c.lane = t & 63; c.wave = __builtin_amdgcn_readfirstlane(t >> 6); c.gw = c.blk * 8 + c.wave; return c; }
enum { I_X = 0, I_MEM, I_NORM_MIX, I_NORM_FFN, I_MEM_NORM, I_W_MEM_KV, I_XQ_NORM, I_XK_NORM, I_W_OUT, I_LRU_W_IN, I_LRU_CONV_W, I_LRU_CONV_B, I_LRU_W_A, I_LRU_B_A,
       I_LRU_W_X, I_LRU_B_X, I_LRU_LAMBDA, I_DSA_W_IN, I_DSA_Q_NORM, I_DSA_K_NORM, I_DSA_W_UV, I_REL_BIAS, I_MOE_W_GROUP, I_MOE_B_GROUP, I_MOE_W_ROUTER, I_MOE_B_ROUTER,
       I_MOE_W_GATE, I_MOE_W_UP, I_MOE_W_DOWN };

DI void tr_tile(const float* __restrict__ W, int ldw, bf16* __restrict__ WT, int ldk, LAS unsigned* scr, int lane) {
    const int m = lane & 15, q = lane >> 4;
#pragma unroll
    for (int i = 0; i < 8; ++i) {
        const int kk = 8 * i + 2 * q;
        const f32x4 v0 = *(const f32x4*)(W + (size_t)kk * ldw + 4 * m);
        const f32x4 v1 = *(const f32x4*)(W + (size_t)(kk + 1) * ldw + 4 * m);
        const int sw = 4 * (i ^ (m & 7)) + q;
        scr[(4 * m + 0) * 32 + sw] = pk2(v0.x, v1.x);
        scr[(4 * m + 1) * 32 + sw] = pk2(v0.y, v1.y);
        scr[(4 * m + 2) * 32 + sw] = pk2(v0.z, v1.z);
        scr[(4 * m + 3) * 32 + sw] = pk2(v0.w, v1.w);
    }
    LDS_WAIT();
#pragma unroll
    for (int r = 0; r < 8; ++r) {
        const int n = 8 * r + (lane >> 3), c = lane & 7;
        const v4u o = *(const LAS v4u*)(scr + n * 32 + 4 * (c ^ ((n >> 2) & 7)));
        *(v4u*)(WT + (size_t)n * ldk + 8 * c) = o;
    }
    LDS_WAIT();
}
DI void rms_row(const float* __restrict__ xrow, const float* __restrict__ g, bf16* __restrict__ orow, int lane, f32x4 (&v)[4]) {
    const f32x4* xr = (const f32x4*)xrow + lane; const f32x4* gr = (const f32x4*)g + lane;
    float s = 0.f;
#pragma unroll
    for (int j = 0; j < 4; ++j) { v[j] = xr[64 * j]; s += (v[j].x * v[j].x + v[j].y * v[j].y) + (v[j].z * v[j].z + v[j].w * v[j].w); }
    const float r = 1.0f / sqrtf(wave_sum(s) * (1.0f / 1024.0f) + EPS);
    v2u* o8 = (v2u*)orow + lane;
#pragma unroll
    for (int j = 0; j < 4; ++j) { const f32x4 gg = gr[64 * j]; v[j] = v[j] * r * gg; v2u o; o.x = pk2(v[j].x, v[j].y); o.y = pk2(v[j].z, v[j].w); o8[64 * j] = o; }
}
struct TrJob { const float* src; bf16* dst; int ldw, ldk, nN, items; };
template <int layer> DI void phase_prep(const Ctx& c0, const PV& P) {
    const Ctx c = relaunder(c0);
    unsigned char* ws = P.ws;
    LAS unsigned* scr = (LAS unsigned*)(c.lds + c.wave * 8192);
    LAS TrJob* jobs = (LAS TrJob*)(c.lds + 65536);
    LAS int* njp = (LAS int*)(c.lds + 65536 + 512);
    LAS f32x4* wiw = (LAS f32x4*)(c.lds + 69632);
    if (c.tid == 0) {
        int nj = 0;
#define ADDJOB(S_, D_, K_, N_, LDW_, LDK_) do { jobs[nj].src = (S_); jobs[nj].dst = (D_); jobs[nj].ldw = (LDW_); jobs[nj].ldk = (LDK_); jobs[nj].nN = (N_) / 64; jobs[nj].items = ((K_) / 64) * ((N_) / 64); ++nj; } while (0)
        ADDJOB(pin(P, I_W_MEM_KV) + (size_t)layer * 1024 * 512, (bf16*)(ws + WB_MKV), 1024, 512, 512, 1024);
        if (layer == 0) {
            ADDJOB(pin(P, I_LRU_W_IN), (bf16*)(ws + WB_WIN), 1024, 1792, 1792, 1024);
            ADDJOB(pin(P, I_W_OUT), (bf16*)(ws + WB_WOUT), 1024, 1024, 1024, 1024);
        } else {
            ADDJOB(pin(P, I_DSA_W_IN), (bf16*)(ws + WB_WIN), 1024, 1280, 1540, 1024);
            ADDJOB(pin(P, I_DSA_W_IN) + 1284, (bf16*)(ws + WB_WIN) + (size_t)1280 * 1024, 1024, 256, 1540, 1024);
            ADDJOB(pin(P, I_W_OUT) + (size_t)1024 * 1024 + (size_t)768 * 1024, (bf16*)(ws + WB_WOUT) + 1536, 256, 1024, 1024, 1792);
        }
#undef ADDJOB
        *njp = nj;
    }
    if (layer == 1) { for (int k = c.tid; k < 1024; k += 512) wiw[k] = *(const f32x4*)(pin(P, I_DSA_W_IN) + (size_t)k * 1540 + 1280); }
    __syncthreads();
    {
        const float* xin = (layer == 0) ? pin(P, I_X) : P.out;
        const float* g = pin(P, I_NORM_MIX) + layer * 1024;
        bf16* HN = (bf16*)(ws + WS_HN); float* WI = (float*)(ws + AR_WI);
        for (int r = c.gw; r < NTOK; r += c.NGW) {
            f32x4 v[4]; rms_row(xin + (size_t)r * 1024, g, HN + (size_t)r * 1024, c.lane, v);
            if (layer == 1) {
                f32x4 a = {0.f, 0.f, 0.f, 0.f};
#pragma unroll
                for (int j = 0; j < 4; ++j) { const int k0 = 4 * (c.lane + 64 * j); a += v[j].x * wiw[k0] + v[j].y * wiw[k0 + 1] + v[j].z * wiw[k0 + 2] + v[j].w * wiw[k0 + 3]; }
                a.x = wave_sum(a.x); a.y = wave_sum(a.y); a.z = wave_sum(a.z); a.w = wave_sum(a.w);
                if (c.lane == 0) *(f32x4*)(WI + (size_t)r * 4) = a * 0.5f;
            }
        }
        const float* gm = pin(P, I_MEM_NORM) + layer * 1024; bf16* MEMN = (bf16*)(ws + WB_MEMN);
        for (int r = c.gw; r < 512; r += c.NGW) { f32x4 v[4]; rms_row(pin(P, I_MEM) + (size_t)r * 1024, gm, MEMN + (size_t)r * 1024, c.lane, v); }
    }
    {
        const int nj = *njp; int gen_total = 0;
        for (int j = 0; j < nj; ++j) gen_total += jobs[j].items;
        const int total = gen_total + 3 * 32 * 128;
        const float* wg = pin(P, I_MOE_W_GATE) + (size_t)layer * 32 * 1024 * 512;
        const float* wu = pin(P, I_MOE_W_UP) + (size_t)layer * 32 * 1024 * 512;
        const float* wd = pin(P, I_MOE_W_DOWN) + (size_t)layer * 32 * 512 * 1024;
        bf16* WGU = (bf16*)(ws + WB_WGU); bf16* WD = (bf16*)(ws + WB_WD);
        for (int it = c.gw; it < total; it += c.NGW) {
            const float* src; bf16* dst; int ldw, ldk;
            if (it < gen_total) {
                int r = it, j = 0;
                while (r >= jobs[j].items) { r -= jobs[j].items; ++j; }
                const int nN = jobs[j].nN, kb = r / nN, nb = r % nN;
                ldw = jobs[j].ldw; ldk = jobs[j].ldk;
                src = jobs[j].src + (size_t)kb * 64 * ldw + nb * 64; dst = jobs[j].dst + (size_t)nb * 64 * ldk + kb * 64;
            } else {
                const int r = it - gen_total, type = r >> 12, e = (r >> 7) & 31, ti = r & 127;
                if (type < 2) { const int kb = ti >> 3, nb = ti & 7; ldw = 512; ldk = 1024;
                    src = (type == 0 ? wg : wu) + (size_t)e * 1024 * 512 + (size_t)kb * 64 * 512 + nb * 64;
                    const int drow = 256 * (nb >> 1) + 64 * (nb & 1) + 128 * type;
                    dst = WGU + (size_t)e * 1024 * 1024 + (size_t)drow * 1024 + kb * 64;
                } else { const int kb = ti >> 4, nb = ti & 15; ldw = 1024; ldk = 512;
                    src = wd + (size_t)e * 512 * 1024 + (size_t)kb * 64 * 1024 + nb * 64;
                    dst = WD + (size_t)e * 1024 * 512 + (size_t)nb * 64 * 512 + kb * 64; }
            }
            tr_tile(src, ldw, dst, ldk, scr, c.lane);
        }
    }
    const int gtid = c.blk * 512 + c.tid, nthr = c.G * 512;
    {
        const float* wgr = pin(P, I_MOE_W_GROUP) + (size_t)layer * 1024 * 4; const float* wrt = pin(P, I_MOE_W_ROUTER) + (size_t)layer * 1024 * 32;
        bf16* WR = (bf16*)(ws + WB_WR);
        for (int i = gtid; i < 256 * 128; i += nthr) { const int row = i >> 7, k8 = i & 127; float f[8];
#pragma unroll
            for (int kk = 0; kk < 8; ++kk) { const int k = 8 * k8 + kk; f[kk] = row < 4 ? wgr[k * 4 + row] : (row < 36 ? wrt[k * 32 + (row - 4)] : 0.f); }
            *(v4u*)(WR + (size_t)row * 1024 + 8 * k8) = pack8(f); }
    }
    if (layer == 0) {
        bf16* WGT = (bf16*)(ws + WB_WGT);
        for (int i = gtid; i < 1536 * 96; i += nthr) { const int rho = i / 96, k8 = i % 96; const int pn = rho >> 8, bj = (rho >> 7) & 1, j = rho & 127, ch = 128 * pn + j, blkc = ch / 192, cc = ch % 192;
            const float* src = (bj ? pin(P, I_LRU_W_X) : pin(P, I_LRU_W_A)) + (size_t)blkc * 192 * 192; float f[8];
            const int k0 = 8 * k8; const bool in = (k0 / 192) == blkc;
#pragma unroll
            for (int kk = 0; kk < 8; ++kk) f[kk] = in ? src[((k0 + kk) % 192) * 192 + cc] : 0.f;
            *(v4u*)(WGT + (size_t)rho * 768 + k0) = pack8(f); }
    } else {
        const float* wuv = pin(P, I_DSA_W_UV); const float* wo = pin(P, I_W_OUT) + (size_t)1024 * 1024; bf16* WO = (bf16*)(ws + WB_WOUT);
        for (int i = gtid; i < 1024 * 12 * 16; i += nthr) { const int n = i & 1023, rest = i >> 10, c8 = rest & 15, h = rest >> 4; float a[8] = {0.f, 0.f, 0.f, 0.f, 0.f, 0.f, 0.f, 0.f};
            for (int j = 0; j < 64; ++j) { const float w = wo[(size_t)(64 * h + j) * 1024 + n];
#pragma unroll
                for (int cc = 0; cc < 8; ++cc) a[cc] += wuv[((size_t)h * 128 + 8 * c8 + cc) * 64 + j] * w; }
            *(v4u*)(WO + (size_t)n * 1792 + h * 128 + 8 * c8) = pack8(a); }
    }
}

DI f32x4 mfma16(bf16x8 a, bf16x8 b, f32x4 c) { return __builtin_amdgcn_mfma_f32_16x16x32_bf16(a, b, c, 0, 0, 0); }

template <int layer, int ldp, int xq_off, int ldm, int xo_off> DI void phase_xattn(const Ctx& c0, const PV& P, const bf16* __restrict__ PROJ, bf16* __restrict__ MIX) {
    const Ctx c = relaunder(c0);
    const bf16* MKVO = (const bf16*)(P.ws + WB_MKVO);
    const float* xqg = pin(P, I_XQ_NORM) + layer * 64; const float* xkg = pin(P, I_XK_NORM) + layer * 64;
    LAS bf16* Ks = (LAS bf16*)c.lds;
    LAS bf16* Vt = (LAS bf16*)(c.lds + 36864);
    const int lane = c.lane, l15 = lane & 15, g = lane >> 4;
    for (int unit = c.blk; unit < 256; unit += c.G) {
        const int b = unit >> 7, h = (unit >> 5) & 3, tr = unit & 31, tok0 = b * SEQ + tr * 512;
        __syncthreads();
#pragma unroll
        for (int i = 0; i < 4; ++i) { const int p = c.tid + 512 * i, key = p >> 3, ch = p & 7;
            const bf16* src = MKVO + (size_t)(b * 256 + key) * 512 + h * 64 + ch * 8;
            float f[8]; unpack8(*(const v4u*)src, f);
            float ss = 0.f;
#pragma unroll
            for (int j = 0; j < 8; ++j) ss += f[j] * f[j];
            ss += __shfl_xor(ss, 1); ss += __shfl_xor(ss, 2); ss += __shfl_xor(ss, 4);
            const float r = 1.0f / sqrtf(ss * (1.0f / 64.0f) + EPS);
#pragma unroll
            for (int j = 0; j < 8; ++j) f[j] = f[j] * r * xkg[ch * 8 + j];
            *(LAS v4u*)(Ks + key * 72 + ch * 8) = pack8(f);
            const v4u vw = *(const v4u*)(src + 256);
            const unsigned ww[4] = {vw.x, vw.y, vw.z, vw.w};
#pragma unroll
            for (int j = 0; j < 4; ++j) { Vt[(ch * 8 + 2 * j) * 264 + key] = (bf16)(ww[j] & 0xffffu); Vt[(ch * 8 + 2 * j + 1) * 264 + key] = (bf16)(ww[j] >> 16); }
        }
        __syncthreads();
#pragma unroll 1
        for (int tile = c.wave; tile < 32; tile += 8) {
            const int row = tok0 + tile * 16 + l15;
            const bf16* qp = PROJ + (size_t)row * ldp + xq_off + h * 64 + 8 * g;
            float q0[8], q1[8]; unpack8(*(const v4u*)qp, q0); unpack8(*(const v4u*)(qp + 32), q1);
            float ss = 0.f;
#pragma unroll
            for (int j = 0; j < 8; ++j) ss += q0[j] * q0[j] + q1[j] * q1[j];
            ss += __shfl_xor(ss, 16); ss += __shfl_xor(ss, 32);
            const float r = 0.125f / sqrtf(ss * (1.0f / 64.0f) + EPS);
#pragma unroll
            for (int j = 0; j < 8; ++j) { q0[j] = q0[j] * r * xqg[8 * g + j]; q1[j] = q1[j] * r * xqg[32 + 8 * g + j]; }
            const bf16x8 B0 = __builtin_bit_cast(bf16x8, pack8(q0)), B1 = __builtin_bit_cast(bf16x8, pack8(q1));
            f32x4 S[16];
#pragma unroll
            for (int kt = 0; kt < 16; ++kt) {
                const bf16x8 A0 = *(const LAS bf16x8*)(Ks + (16 * kt + l15) * 72 + 8 * g), A1 = *(const LAS bf16x8*)(Ks + (16 * kt + l15) * 72 + 32 + 8 * g);
                f32x4 z = {0.f, 0.f, 0.f, 0.f}; z = mfma16(A0, B0, z); S[kt] = mfma16(A1, B1, z);
                if ((kt & 3) == 3) __builtin_amdgcn_sched_barrier(0);
            }
            float mx = -3.0e38f;
#pragma unroll
            for (int kt = 0; kt < 16; ++kt) mx = fmaxf(mx, fmaxf(fmaxf(S[kt][0], S[kt][1]), fmaxf(S[kt][2], S[kt][3])));
            mx = fmaxf(mx, __shfl_xor(mx, 16)); mx = fmaxf(mx, __shfl_xor(mx, 32));
            float l = 0.f;
#pragma unroll
            for (int kt = 0; kt < 16; ++kt) {
#pragma unroll
                for (int i = 0; i < 4; ++i) { const float p = __expf(S[kt][i] - mx); S[kt][i] = p; l += p; } }
            l += __shfl_xor(l, 16); l += __shfl_xor(l, 32);
            f32x4 O[4];
#pragma unroll
            for (int dt = 0; dt < 4; ++dt) O[dt] = (f32x4){0.f, 0.f, 0.f, 0.f};
#pragma unroll
            for (int jb = 0; jb < 8; ++jb) {
                v4u pw; pw.x = pk2(S[2 * jb][0], S[2 * jb][1]); pw.y = pk2(S[2 * jb][2], S[2 * jb][3]); pw.z = pk2(S[2 * jb + 1][0], S[2 * jb + 1][1]); pw.w = pk2(S[2 * jb + 1][2], S[2 * jb + 1][3]);
                const bf16x8 Pb = __builtin_bit_cast(bf16x8, pw);
#pragma unroll
                for (int dt = 0; dt < 4; ++dt) { const LAS bf16* vp = Vt + (16 * dt + l15) * 264 + 32 * jb + 4 * g;
                    const v2u a0 = *(const LAS v2u*)vp, a1 = *(const LAS v2u*)(vp + 16);
                    v4u aw; aw.x = a0.x; aw.y = a0.y; aw.z = a1.x; aw.w = a1.y;
                    O[dt] = mfma16(__builtin_bit_cast(bf16x8, aw), Pb, O[dt]); }
                __builtin_amdgcn_sched_barrier(0);
            }
            const float il = 1.0f / l;
            bf16* op = MIX + (size_t)row * ldm + xo_off + h * 64 + 4 * g;
#pragma unroll
            for (int dt = 0; dt < 4; ++dt) { v2u o; o.x = pk2(O[dt][0] * il, O[dt][1] * il); o.y = pk2(O[dt][2] * il, O[dt][3] * il); *(v2u*)(op + 16 * dt) = o; }
        }
    }
}

DI void phase_conv(const Ctx& c0, const PV& P) {
    const Ctx c = relaunder(c0);
    const bf16* PROJ = (const bf16*)(P.ws + AR_PROJ); bf16* XSC = (bf16*)(P.ws + AR_XSC);
    const float* cw = pin(P, I_LRU_CONV_W); const float* cb = pin(P, I_LRU_CONV_B);
    const int gtid = c.blk * 512 + c.tid, nthr = c.G * 512;
    for (int i = gtid; i < NTOK * 96; i += nthr) { const int row = i / 96, c8 = i % 96, t = row & (SEQ - 1); float a[8];
#pragma unroll
        for (int j = 0; j < 8; ++j) a[j] = cb[8 * c8 + j];
#pragma unroll
        for (int k = 0; k < 4; ++k) { if (t - 3 + k >= 0) { float f[8]; unpack8(*(const v4u*)(PROJ + (size_t)(row - 3 + k) * 1792 + 8 * c8), f);
#pragma unroll
                for (int j = 0; j < 8; ++j) a[j] += cw[k * 768 + 8 * c8 + j] * f[j]; } }
        *(v4u*)(XSC + (size_t)row * 768 + 8 * c8) = pack8(a); }
}
DI void phase_scanA(const Ctx& c0, const PV& P) {
    const Ctx c = relaunder(c0);
    const bf16* LA = (const bf16*)(P.ws + AR_LA); const bf16* UU = (const bf16*)(P.ws + AR_UU); float* SA = (float*)(P.ws + AR_SA); float* SH = (float*)(P.ws + AR_SH);
    const int gtid = c.blk * 512 + c.tid, nthr = c.G * 512;
    for (int i = gtid; i < 512 * 192; i += nthr) { const int chunk = i / 192, c4 = i % 192; float h[4] = {0.f, 0.f, 0.f, 0.f}, sl[4] = {0.f, 0.f, 0.f, 0.f};
        const size_t base = (size_t)chunk * 64 * 768 + 4 * c4;
#pragma unroll 8
        for (int r = 0; r < 64; ++r) { const v2u lw = *(const v2u*)(LA + base + (size_t)r * 768), uw = *(const v2u*)(UU + base + (size_t)r * 768);
            const float l4[4] = {bflo(lw.x), bfhi(lw.x), bflo(lw.y), bfhi(lw.y)}, u4[4] = {bflo(uw.x), bfhi(uw.x), bflo(uw.y), bfhi(uw.y)};
#pragma unroll
            for (int j = 0; j < 4; ++j) { h[j] = __expf(l4[j]) * h[j] + u4[j]; sl[j] += l4[j]; } }
        *(f32x4*)(SA + (size_t)chunk * 768 + 4 * c4) = (f32x4){__expf(sl[0]), __expf(sl[1]), __expf(sl[2]), __expf(sl[3])};
        *(f32x4*)(SH + (size_t)chunk * 768 + 4 * c4) = (f32x4){h[0], h[1], h[2], h[3]}; }
}
DI void phase_scanB(const Ctx& c0, const PV& P) {
    const Ctx c = relaunder(c0);
    const float* SA = (const float*)(P.ws + AR_SA); const float* SH = (const float*)(P.ws + AR_SH); float* CARRY = (float*)(P.ws + AR_CARRY);
    LAS float* segP = (LAS float*)c.lds; LAS float* segQ = segP + 512;
    for (int u = c.blk; u < 48; u += c.G) { const int b = u / 24, cg = u % 24, seg = c.tid >> 5, ch = 32 * cg + (c.tid & 31);
        const size_t base = (size_t)(b * 256 + seg * 16) * 768 + ch;
        float A[16], H[16];
#pragma unroll
        for (int i = 0; i < 16; ++i) { A[i] = SA[base + (size_t)i * 768]; H[i] = SH[base + (size_t)i * 768]; }
        float Pp[16], Qq[16]; float pp = 1.f, qq = 0.f;
#pragma unroll
        for (int i = 0; i < 16; ++i) { Pp[i] = pp; Qq[i] = qq; qq = A[i] * qq + H[i]; pp = A[i] * pp; }
        __syncthreads();
        segP[c.tid] = pp; segQ[c.tid] = qq;
        __syncthreads();
        float hin = 0.f;
        for (int s = 0; s < seg; ++s) hin = segP[s * 32 + (c.tid & 31)] * hin + segQ[s * 32 + (c.tid & 31)];
#pragma unroll
        for (int i = 0; i < 16; ++i) CARRY[base + (size_t)i * 768] = Pp[i] * hin + Qq[i];
    }
}
DI void phase_scanC(const Ctx& c0, const PV& P) {
    const Ctx c = relaunder(c0);
    const bf16* LA = (const bf16*)(P.ws + AR_LA); const bf16* UU = (const bf16*)(P.ws + AR_UU); const float* CARRY = (const float*)(P.ws + AR_CARRY);
    const bf16* PROJ = (const bf16*)(P.ws + AR_PROJ); bf16* MIX = (bf16*)(P.ws + AR_MIXL);
    const int gtid = c.blk * 512 + c.tid, nthr = c.G * 512;
    for (int i = gtid; i < 512 * 192; i += nthr) { const int chunk = i / 192, c4 = i % 192;
        const f32x4 h0 = *(const f32x4*)(CARRY + (size_t)chunk * 768 + 4 * c4); float h[4] = {h0.x, h0.y, h0.z, h0.w};
        const size_t base = (size_t)chunk * 64 * 768 + 4 * c4;
#pragma unroll 8
        for (int r = 0; r < 64; ++r) { const size_t row = (size_t)chunk * 64 + r;
            const v2u lw = *(const v2u*)(LA + base + (size_t)r * 768), uw = *(const v2u*)(UU + base + (size_t)r * 768), gw = *(const v2u*)(PROJ + row * 1792 + 768 + 4 * c4);
            const float l4[4] = {bflo(lw.x), bfhi(lw.x), bflo(lw.y), bfhi(lw.y)}, u4[4] = {bflo(uw.x), bfhi(uw.x), bflo(uw.y), bfhi(uw.y)}, g4[4] = {bflo(gw.x), bfhi(gw.x), bflo(gw.y), bfhi(gw.y)};
            float y[4];
#pragma unroll
            for (int j = 0; j < 4; ++j) { h[j] = __expf(l4[j]) * h[j] + u4[j]; y[j] = h[j] * g4[j]; }
            v2u o; o.x = pk2(y[0], y[1]); o.y = pk2(y[2], y[3]); *(v2u*)(MIX + row * 1024 + 4 * c4) = o; }
    }
}

template <int layer> DI void phase_norm2(const Ctx& c0, const PV& P) {
    const Ctx c = relaunder(c0);
    const float* g = pin(P, I_NORM_FFN) + layer * 1024; bf16* HN = (bf16*)(P.ws + WS_HN);
    for (int r = c.gw; r < NTOK; r += c.NGW) { f32x4 v[4]; rms_row(P.out + (size_t)r * 1024, g, HN + (size_t)r * 1024, c.lane, v); }
}
template <int layer> DI void phase_route(const Ctx& c0, const PV& P) {
    const Ctx c = relaunder(c0);
    const float* LOG = (const float*)(P.ws + AR_LOG); int* EID = (int*)(P.ws + AR_EID); float* GATE = (float*)(P.ws + AR_GATE);
    const float* bg = pin(P, I_MOE_B_GROUP) + layer * 4; const float* br = pin(P, I_MOE_B_ROUTER) + layer * 32;
    unsigned* ctl = (unsigned*)(P.ws + WS_CTL);
    LAS unsigned* hist = (LAS unsigned*)c.lds;
    if (c.tid < 32) hist[c.tid] = 0u;
    __syncthreads();
    for (int t = c.blk * 512 + c.tid; t < NTOK; t += c.G * 512) {
        const f32x4 lg = *(const f32x4*)(LOG + (size_t)t * 64);
        const float l0 = lg.x + bg[0], l1 = lg.y + bg[1], l2 = lg.z + bg[2], l3 = lg.w + bg[3];
        int gs = 0; float gm = l0;
        if (l1 > gm) { gm = l1; gs = 1; } if (l2 > gm) { gm = l2; gs = 2; } if (l3 > gm) { gm = l3; gs = 3; }
        const float pg = 1.0f / (__expf(l0 - gm) + __expf(l1 - gm) + __expf(l2 - gm) + __expf(l3 - gm));
        const f32x4 ea = *(const f32x4*)(LOG + (size_t)t * 64 + 4 + 8 * gs), eb = *(const f32x4*)(LOG + (size_t)t * 64 + 8 + 8 * gs);
        const f32x4 ba = *(const f32x4*)(br + 8 * gs), bb = *(const f32x4*)(br + 8 * gs + 4);
        const float el[8] = {ea.x + ba.x, ea.y + ba.y, ea.z + ba.z, ea.w + ba.w, eb.x + bb.x, eb.y + bb.y, eb.z + bb.z, eb.w + bb.w};
        int i1 = 0; float m1 = el[0];
#pragma unroll
        for (int j = 1; j < 8; ++j) if (el[j] > m1) { m1 = el[j]; i1 = j; }
        int i2 = -1; float m2 = -3.0e38f;
#pragma unroll
        for (int j = 0; j < 8; ++j) if (j != i1 && el[j] > m2) { m2 = el[j]; i2 = j; }
        const float e2 = __expf(m2 - m1), inv = pg / (1.0f + e2);
        const int e1id = 8 * gs + i1, e2id = 8 * gs + i2;
        EID[2 * t] = e1id; EID[2 * t + 1] = e2id; GATE[2 * t] = inv; GATE[2 * t + 1] = e2 * inv;
        lds_add(&hist[e1id], 1u); lds_add(&hist[e2id], 1u);
    }
    __syncthreads();
    if (c.tid < 32 && hist[c.tid]) atomicAdd(ctl + CW_CNT + layer * CW_LSTRIDE + c.tid, hist[c.tid]);
}
template <int layer> DI void phase_scatter(const Ctx& c0, const PV& P) {
    const Ctx c = relaunder(c0);
    unsigned* ctl = (unsigned*)(P.ws + WS_CTL);
    const int* EID = (const int*)(P.ws + AR_EID); int* DEST = (int*)(P.ws + AR_DEST);
    const bf16* HN = (const bf16*)(P.ws + WS_HN); bf16* XS = (bf16*)(P.ws + AR_XS);
    LAS int* cnt = (LAS int*)c.lds; LAS int* pstart = cnt + 32; LAS unsigned* hist = (LAS unsigned*)(cnt + 64); LAS unsigned* base = hist + 32; LAS unsigned* lcnt = base + 32; LAS int* dl = (LAS int*)(lcnt + 32);
    __syncthreads();
    if (c.tid < 32) cnt[c.tid] = (int)ctl[CW_CNT + layer * CW_LSTRIDE + c.tid];
    __syncthreads();
    if (c.tid == 0) { int acc = 0; for (int e = 0; e < 32; ++e) { pstart[e] = acc; acc += (cnt[e] + 255) & ~255; }
        if (c.blk == 0) { ctl[CW_NT + layer * CW_LSTRIDE] = (unsigned)(acc >> 8);
            for (int e = 0; e < 32; ++e) { const int t0 = pstart[e] >> 8, t1 = (pstart[e] + ((cnt[e] + 255) & ~255)) >> 8; for (int t = t0; t < t1; ++t) ctl[CW_TE + layer * CW_TE_STRIDE + t] = (unsigned)e; } } }
    __syncthreads();
    for (int tb = c.blk; tb < NTOK / 128; tb += c.G) {
        if (c.tid < 32) { hist[c.tid] = 0u; lcnt[c.tid] = 0u; }
        __syncthreads();
        int e = 0, t = 0;
        if (c.tid < 256) { t = tb * 128 + (c.tid >> 1); e = EID[2 * t + (c.tid & 1)]; lds_add(&hist[e], 1u); }
        __syncthreads();
        if (c.tid < 32) base[c.tid] = hist[c.tid] ? atomicAdd(ctl + CW_CUR + layer * CW_LSTRIDE + c.tid, hist[c.tid]) : 0u;
        __syncthreads();
        if (c.tid < 256) { const unsigned rank = lds_add(&lcnt[e], 1u); const int d = pstart[e] + (int)base[e] + (int)rank; DEST[2 * t + (c.tid & 1)] = d; dl[c.tid] = d; }
        __syncthreads();
        for (int a = c.wave * 32; a < c.wave * 32 + 32; ++a) { const int tt = tb * 128 + (a >> 1), d = dl[a];
            const v4u* s = (const v4u*)(HN + (size_t)tt * 1024) + c.lane; v4u* o = (v4u*)(XS + (size_t)d * 1024) + c.lane;
            const v4u x0 = s[0], x1 = s[64]; o[0] = x0; o[64] = x1; }
        __syncthreads();
    }
    for (int e = 0; e < 32; ++e) { const int npad = ((cnt[e] + 255) & ~255) - cnt[e], r0 = pstart[e] + cnt[e];
        for (int r = c.gw; r < npad; r += c.NGW) { v4u* o = (v4u*)(XS + (size_t)(r0 + r) * 1024) + c.lane; const v4u z = {0u, 0u, 0u, 0u}; o[0] = z; o[64] = z; } }
}
DI void phase_combine(const Ctx& c0, const PV& P) {
    const Ctx c = relaunder(c0);
    const int* DEST = (const int*)(P.ws + AR_DEST); const float* GATE = (const float*)(P.ws + AR_GATE); const bf16* Y = (const bf16*)(P.ws + AR_XS);
    for (int t = c.gw; t < NTOK; t += c.NGW) { const int d0 = DEST[2 * t], d1 = DEST[2 * t + 1]; const float g0 = GATE[2 * t], g1 = GATE[2 * t + 1];
        f32x4* op = (f32x4*)(P.out + (size_t)t * 1024) + c.lane; const v2u* y0 = (const v2u*)(Y + (size_t)d0 * 1024) + c.lane; const v2u* y1 = (const v2u*)(Y + (size_t)d1 * 1024) + c.lane;
#pragma unroll
        for (int j = 0; j < 4; ++j) { f32x4 o = op[64 * j]; const v2u a = y0[64 * j], b = y1[64 * j];
            o.x += g0 * bflo(a.x) + g1 * bflo(b.x); o.y += g0 * bfhi(a.x) + g1 * bfhi(b.x); o.z += g0 * bflo(a.y) + g1 * bflo(b.y); o.w += g0 * bfhi(a.y) + g1 * bfhi(b.y); op[64 * j] = o; } }
}

DI void phase_dsaprep(const Ctx& c0, const PV& P) {
    const Ctx c = relaunder(c0);
    const bf16* PROJ = (const bf16*)(P.ws + AR_PROJ); bf16* KN = (bf16*)(P.ws + AR_KN); bf16* KIN = (bf16*)(P.ws + AR_KIN); bf16* QIW = (bf16*)(P.ws + AR_QIW);
    const float* WI = (const float*)(P.ws + AR_WI); const float* kg = pin(P, I_DSA_K_NORM);
    const int l = c.lane;
    for (int row = c.gw; row < NTOK; row += c.NGW) {
        const int col = l < 8 ? 768 + 8 * l : (l < 16 ? 1216 + 8 * (l - 8) : 960 + 8 * (l - 16));
        float f[8] = {0.f, 0.f, 0.f, 0.f, 0.f, 0.f, 0.f, 0.f};
        if (l < 48) unpack8(*(const v4u*)(PROJ + (size_t)row * 1536 + col), f);
        float ss = 0.f;
#pragma unroll
        for (int j = 0; j < 8; ++j) ss += f[j] * f[j];
        ss += __shfl_xor(ss, 1); ss += __shfl_xor(ss, 2); ss += __shfl_xor(ss, 4);
        const float r = 1.0f / sqrtf(ss * (1.0f / 64.0f) + EPS);
        if (l < 8) {
#pragma unroll
            for (int j = 0; j < 8; ++j) f[j] = f[j] * r * kg[8 * l + j];
            *(v4u*)(KN + (size_t)row * 64 + 8 * l) = pack8(f);
        } else if (l < 16) {
#pragma unroll
            for (int j = 0; j < 8; ++j) f[j] *= r;
            *(v4u*)(KIN + (size_t)row * 64 + 8 * (l - 8)) = pack8(f);
        } else if (l < 48) {
            const float w = WI[(size_t)row * 4 + ((l - 16) >> 3)] * 0.125f;
#pragma unroll
            for (int j = 0; j < 8; ++j) f[j] *= w;
            *(v4u*)(QIW + (size_t)row * 256 + 8 * (l - 16)) = pack8(f);
        }
    }
}
DI unsigned idx_compact(LAS unsigned* qb, LAS unsigned* hist, int n, int lane) {
    unsigned e[8];
#pragma unroll
    for (int i = 0; i < 8; ++i) { const int idx = lane + 64 * i; e[i] = idx < n ? qb[idx] : 0u; }
    unsigned prefix = 0u, maskbits = 0u; int want = 256;
#pragma unroll
    for (int pass = 0; pass < 4; ++pass) { const int shift = 24 - 8 * pass;
        *(LAS v4u*)(hist + 4 * lane) = (v4u){0u, 0u, 0u, 0u};
        LDS_WAIT();
#pragma unroll
        for (int i = 0; i < 8; ++i) if (e[i] != 0u && (e[i] & maskbits) == prefix) lds_add(&hist[(e[i] >> shift) & 255u], 1u);
        LDS_WAIT();
        const v4u h4 = *(const LAS v4u*)(hist + 4 * lane);
        LDS_WAIT();
        const int s = (int)(h4.x + h4.y + h4.z + h4.w); int x = s;
#pragma unroll
        for (int d = 1; d < 64; d <<= 1) { const int y = __shfl_down(x, d); if (lane + d < 64) x += y; }
        const int c3 = x - s, c2 = c3 + (int)h4.w, c1 = c2 + (int)h4.z, c0 = c1 + (int)h4.y;
        int fb = -1, fa = 0;
        if (c3 < want && want <= c3 + (int)h4.w) { fb = 3; fa = c3; }
        else if (c2 < want && want <= c2 + (int)h4.z) { fb = 2; fa = c2; }
        else if (c1 < want && want <= c1 + (int)h4.y) { fb = 1; fa = c1; }
        else if (c0 < want && want <= c0 + (int)h4.x) { fb = 0; fa = c0; }
        const unsigned long long m = __ballot(fb >= 0);
        const int src = m ? (int)__builtin_ctzll(m) : 0;
        const int bin = __shfl(4 * lane + fb, src), ab = __shfl(fa, src);
        prefix |= (unsigned)bin << shift; maskbits |= 0xFFu << shift; want -= ab;
    }
    int base = 0;
#pragma unroll
    for (int i = 0; i < 8; ++i) { const bool pred = e[i] >= prefix && e[i] != 0u; const unsigned long long m = __ballot(pred);
        const int pos = base + (int)__builtin_amdgcn_mbcnt_hi((unsigned)(m >> 32), __builtin_amdgcn_mbcnt_lo((unsigned)m, 0u));
        if (pred) qb[pos] = e[i];
        base += (int)__builtin_popcountll(m); }
    LDS_WAIT();
    return prefix;
}
DI void phase_indexer(const Ctx& c0, const PV& P) {
    const Ctx c = relaunder(c0);
    const bf16* KIN = (const bf16*)(P.ws + AR_KIN); const bf16* QIW = (const bf16*)(P.ws + AR_QIW); const float* WI = (const float*)(P.ws + AR_WI); int* SEL = (int*)(P.ws + AR_SEL);
    LAS unsigned* buf = (LAS unsigned*)(c.lds + c.wave * 17408);
    LAS unsigned* hist = buf + 4096;
    const int lane = c.lane, hh = lane >> 5, l31 = lane & 31;
    const float INF = __builtin_inff();
    for (int pair = c.blk; pair < 256; pair += c.G) {
        const int b = pair >> 7, jj = pair & 127;
        for (int half = 0; half < 2; ++half) {
            const int unit = half ? (255 - jj) : jj, t0w = unit * 64 + c.wave * 8, rowbase = b * SEQ;
            bf16x8 A[4];
#pragma unroll
            for (int ks = 0; ks < 4; ++ks) A[ks] = *(const bf16x8*)(QIW + (size_t)(rowbase + t0w + (l31 >> 2)) * 256 + (l31 & 3) * 64 + 16 * ks + 8 * hh);
            float lo[4][4], hi[4][4]; unsigned tau[4]; int cnt[4], tq[4];
#pragma unroll
            for (int j = 0; j < 4; ++j) { tq[j] = t0w + 2 * j + hh; tau[j] = 0u; cnt[j] = 0;
                const f32x4 w = *(const f32x4*)(WI + (size_t)(rowbase + tq[j]) * 4);
#pragma unroll
                for (int i = 0; i < 4; ++i) { lo[j][i] = w[i] > 0.f ? 0.f : -INF; hi[j][i] = w[i] > 0.f ? INF : 0.f; } }
            const int ntile = (t0w + 7) / 32 + 1;
            bf16x8 Bn[4];
#pragma unroll
            for (int ks = 0; ks < 4; ++ks) Bn[ks] = *(const bf16x8*)(KIN + (size_t)(rowbase + l31) * 64 + 16 * ks + 8 * hh);
            for (int tile = 0; tile < ntile; ++tile) {
                const int s = tile * 32 + l31;
                bf16x8 B[4];
#pragma unroll
                for (int ks = 0; ks < 4; ++ks) B[ks] = Bn[ks];
                if (tile + 1 < ntile) {
#pragma unroll
                    for (int ks = 0; ks < 4; ++ks) Bn[ks] = *(const bf16x8*)(KIN + (size_t)(rowbase + s + 32) * 64 + 16 * ks + 8 * hh);
                }
                f32x16 acc;
#pragma unroll
                for (int i = 0; i < 16; ++i) acc[i] = 0.f;
#pragma unroll
                for (int ks = 0; ks < 4; ++ks) acc = __builtin_amdgcn_mfma_f32_32x32x16_bf16(A[ks], B[ks], acc, 0, 0, 0);
#pragma unroll
                for (int j = 0; j < 4; ++j) {
                    const float sc = (__builtin_amdgcn_fmed3f(acc[4 * j], lo[j][0], hi[j][0]) + __builtin_amdgcn_fmed3f(acc[4 * j + 1], lo[j][1], hi[j][1]))
                                   + (__builtin_amdgcn_fmed3f(acc[4 * j + 2], lo[j][2], hi[j][2]) + __builtin_amdgcn_fmed3f(acc[4 * j + 3], lo[j][3], hi[j][3]));
                    unsigned u = __float_as_uint(sc); u ^= (unsigned)((int)u >> 31) | 0x80000000u;
                    unsigned key = (u & 0xFFFFC000u) | (unsigned)(16383 - s);
                    if (s > tq[j]) key = 0u;
                    const bool pred = key > tau[j];
                    const unsigned long long m = __ballot(pred);
                    if (m) { const unsigned hm = hh ? (unsigned)(m >> 32) : (unsigned)m;
                        const int rank = __builtin_popcount(hm & ((1u << l31) - 1u));
                        if (pred) buf[(2 * j + hh) * 512 + cnt[j] + rank] = key;
                        cnt[j] += __builtin_popcount(hm); }
                }
#pragma unroll
                for (int j = 0; j < 4; ++j) {
                    const unsigned long long mm = __ballot(cnt[j] > 480);
                    if (mm & 1ull) { const int n = __builtin_amdgcn_readlane(cnt[j], 0); LDS_WAIT(); const unsigned T = idx_compact(buf + (2 * j) * 512, hist, n, lane); if (hh == 0) { tau[j] = T; cnt[j] = 256; } }
                    if ((mm >> 32) & 1ull) { const int n = __builtin_amdgcn_readlane(cnt[j], 32); LDS_WAIT(); const unsigned T = idx_compact(buf + (2 * j + 1) * 512, hist, n, lane); if (hh == 1) { tau[j] = T; cnt[j] = 256; } }
                }
            }
            LDS_WAIT();
#pragma unroll
            for (int j = 0; j < 4; ++j) {
#pragma unroll
                for (int h2 = 0; h2 < 2; ++h2) {
                    int n = __builtin_amdgcn_readlane(cnt[j], h2 * 32);
                    LAS unsigned* qb = buf + (2 * j + h2) * 512;
                    if (n > 256) { (void)idx_compact(qb, hist, n, lane); n = 256; }
                    int* sp = SEL + (size_t)(rowbase + t0w + 2 * j + h2) * 256;
#pragma unroll
                    for (int i = 0; i < 4; ++i) { const int idx = lane + 64 * i; sp[idx] = idx < n ? (16383 - (int)(qb[idx] & 0x3FFFu)) : -1; }
                }
            }
            LDS_WAIT();
        }
    }
}
DI int t5_bucket(int d) {
    if (d < 16) return d;
    return 16 + (d >= 19) + (d >= 21) + (d >= 24) + (d >= 27) + (d >= 31) + (d >= 35) + (d >= 40) + (d >= 46) + (d >= 52) + (d >= 59) + (d >= 67) + (d >= 77) + (d >= 87) + (d >= 99) + (d >= 113);
}
DI void phase_sattn(const Ctx& c0, const PV& P) {
    const Ctx c = relaunder(c0);
    const bf16* PROJ = (const bf16*)(P.ws + AR_PROJ); const bf16* KN = (const bf16*)(P.ws + AR_KN); const int* SEL = (const int*)(P.ws + AR_SEL); bf16* MIX = (bf16*)(P.ws + AR_MIXD);
    const float* qg = pin(P, I_DSA_Q_NORM); const float* rb = pin(P, I_REL_BIAS);
    LAS int* bk = (LAS int*)(c.lds + c.wave * 10752);
    LAS int* selL = bk + 256;
    LAS bf16* Vs = (LAS bf16*)(selL + 256);
    LAS float* relb = (LAS float*)(c.lds + 8 * 10752);
    const int lane = c.lane, l15 = lane & 15, g = lane >> 4;
    __syncthreads();
    relb[c.tid] = (c.tid & 15) < 12 ? rb[(c.tid >> 4) * 12 + (c.tid & 15)] : 0.f;
    __syncthreads();
#pragma unroll 1
    for (int row = c.gw; row < NTOK; row += c.NGW) {
        const int b = row >> 14, t = row & (SEQ - 1), rowbase = b << 14;
        const v4i s4 = *(const v4i*)(SEL + (size_t)row * 256 + 4 * lane);
        const int sv[4] = {s4.x, s4.y, s4.z, s4.w};
        int bv[4], cv[4];
#pragma unroll
        for (int i = 0; i < 4; ++i) { bv[i] = sv[i] >= 0 ? t5_bucket(t - sv[i]) : -1; cv[i] = sv[i] >= 0 ? sv[i] : 0; }
        *(LAS v4i*)(bk + 4 * lane) = (v4i){bv[0], bv[1], bv[2], bv[3]};
        *(LAS v4i*)(selL + 4 * lane) = (v4i){cv[0], cv[1], cv[2], cv[3]};
        float q0[8], q1[8];
        { v4u w0 = {0u, 0u, 0u, 0u}, w1 = {0u, 0u, 0u, 0u};
          if (l15 < 12) { const bf16* qp = PROJ + (size_t)row * 1536 + l15 * 64 + 8 * g; w0 = *(const v4u*)qp; w1 = *(const v4u*)(qp + 32); }
          unpack8(w0, q0); unpack8(w1, q1); }
        float ss = 0.f;
#pragma unroll
        for (int j = 0; j < 8; ++j) ss += q0[j] * q0[j] + q1[j] * q1[j];
        ss += __shfl_xor(ss, 16); ss += __shfl_xor(ss, 32);
        const float r = 0.125f / sqrtf(ss * (1.0f / 64.0f) + EPS);
#pragma unroll
        for (int j = 0; j < 8; ++j) { q0[j] = q0[j] * r * qg[8 * g + j]; q1[j] = q1[j] * r * qg[32 + 8 * g + j]; }
        const bf16x8 B0 = __builtin_bit_cast(bf16x8, pack8(q0)), B1 = __builtin_bit_cast(bf16x8, pack8(q1));
        LDS_WAIT();
        f32x4 S[16];
#pragma unroll
        for (int kt = 0; kt < 16; ++kt) {
            const int sk = selL[16 * kt + l15];
            const bf16* kp = KN + (size_t)(rowbase + sk) * 64 + 8 * g;
            const bf16x8 A0 = *(const bf16x8*)kp, A1 = *(const bf16x8*)(kp + 32);
            f32x4 z = {0.f, 0.f, 0.f, 0.f}; z = mfma16(A0, B0, z); S[kt] = mfma16(A1, B1, z);
            if ((kt & 3) == 3) __builtin_amdgcn_sched_barrier(0);
        }
        float mx = -3.0e38f;
#pragma unroll
        for (int kt = 0; kt < 16; ++kt) { const v4i b4 = *(const LAS v4i*)(bk + 16 * kt + 4 * g); const int bb[4] = {b4.x, b4.y, b4.z, b4.w};
#pragma unroll
            for (int i = 0; i < 4; ++i) { const float v = bb[i] >= 0 ? S[kt][i] + relb[bb[i] * 16 + l15] : -3.0e38f; S[kt][i] = v; mx = fmaxf(mx, v); } }
        mx = fmaxf(mx, __shfl_xor(mx, 16)); mx = fmaxf(mx, __shfl_xor(mx, 32));
        float l = 0.f;
#pragma unroll
        for (int kt = 0; kt < 16; ++kt) {
#pragma unroll
            for (int i = 0; i < 4; ++i) { const float p = S[kt][i] > -1.0e38f ? __expf(S[kt][i] - mx) : 0.f; S[kt][i] = p; l += p; } }
        l += __shfl_xor(l, 16); l += __shfl_xor(l, 32);
        f32x4 O[8];
#pragma unroll
        for (int ct = 0; ct < 8; ++ct) O[ct] = (f32x4){0.f, 0.f, 0.f, 0.f};
#pragma unroll
        for (int jb = 0; jb < 8; ++jb) {
#pragma unroll
            for (int i = 0; i < 8; ++i) { const int kk = 4 * i + g; const int sk = selL[32 * jb + kk];
                const v4u v = *(const v4u*)(PROJ + (size_t)(rowbase + sk) * 1536 + 832 + 8 * l15);
                LAS v2u* d = (LAS v2u*)(Vs + kk * 132 + 8 * l15); d[0] = (v2u){v.x, v.y}; d[1] = (v2u){v.z, v.w}; }
            LDS_WAIT();
            float p8[8];
#pragma unroll
            for (int i = 0; i < 4; ++i) { p8[i] = 0.f; p8[4 + i] = 0.f; }
#pragma unroll
            for (int kt = 0; kt < 16; ++kt) { if (kt == 2 * jb) { p8[0] = S[kt][0]; p8[1] = S[kt][1]; p8[2] = S[kt][2]; p8[3] = S[kt][3]; } if (kt == 2 * jb + 1) { p8[4] = S[kt][0]; p8[5] = S[kt][1]; p8[6] = S[kt][2]; p8[7] = S[kt][3]; } }
            const bf16x8 Pb = __builtin_bit_cast(bf16x8, pack8(p8));
#pragma unroll
            for (int ct = 0; ct < 8; ++ct) { const LAS bf16* vp = Vs + (4 * g) * 132 + 16 * ct + l15;
                bf16x8 Af;
#pragma unroll
                for (int i = 0; i < 4; ++i) { Af[i] = (short)vp[i * 132]; Af[4 + i] = (short)vp[(16 + i) * 132]; }
                O[ct] = mfma16(Af, Pb, O[ct]); }
            LDS_WAIT();
            __builtin_amdgcn_sched_barrier(0);
        }
        if (l15 < 12) { const float il = 1.0f / l; bf16* op = MIX + (size_t)row * 1792 + l15 * 128 + 4 * g;
#pragma unroll
            for (int ct = 0; ct < 8; ++ct) { v2u o; o.x = pk2(O[ct][0] * il, O[ct][1] * il); o.y = pk2(O[ct][2] * il, O[ct][3] * il); *(v2u*)(op + 16 * ct) = o; } }
        LDS_WAIT();
    }
}

#ifndef ONLY
#define ONLY -1
#endif
#define PH(n) (ONLY < 0 || ONLY == (n))
#define GRID_BAR() xcd_barrier(bar)
template <int layer> DI void layer_body(const Ctx& c, const PV& P, const XcdBarrier& bar) {
    unsigned char* ws = P.ws;
    unsigned* ctl = (unsigned*)(ws + WS_CTL);
    PG8_LAS unsigned char* glds = (PG8_LAS unsigned char*)c.lds;
    const pg8::bf16_t* HN = (const pg8::bf16_t*)(ws + WS_HN);
    if (PH(0)) phase_prep<layer>(c, P);
    GRID_BAR();
    if (PH(1)) {
        { pg8::Gemm g{(const pg8::bf16_t*)(ws + WB_MEMN), (const pg8::bf16_t*)(ws + WB_MKV), 1024, 1024, 1024}; pg8::StaticOrder S; S.init(2, 2, c.G, c.G - 1 - c.blk);
          pg8::EpiBf16<false> E{(pg8::bf16_t*)(ws + WB_MKVO), 512, 0, 0};
          pg8::gemm_phase<pg8::EpiBf16<false>, pg8::StaticOrder, true, true>(glds, g, S, E); }
        __syncthreads();
        if (layer == 0) { pg8::Gemm g{HN, (const pg8::bf16_t*)(ws + WB_WIN), 1024, 1024, 1024}; pg8::StaticOrder S; S.init(128, 7, c.G, c.blk);
          pg8::EpiBf16<true> E{(pg8::bf16_t*)(ws + AR_PROJ), 1792, 3, 6};
          pg8::gemm_phase<pg8::EpiBf16<true>, pg8::StaticOrder, true, true>(glds, g, S, E); }
        else { pg8::Gemm g{HN, (const pg8::bf16_t*)(ws + WB_WIN), 1024, 1024, 1024}; pg8::StaticOrder S; S.init(128, 6, c.G, c.blk);
          pg8::EpiBf16<false> E{(pg8::bf16_t*)(ws + AR_PROJ), 1536, 0, 0};
          pg8::gemm_phase<pg8::EpiBf16<false>, pg8::StaticOrder, true, true>(glds, g, S, E); }
    }
    GRID_BAR();
    if (layer == 0) {
        if (PH(2)) phase_conv(c, P);
        if (PH(2)) phase_xattn<0, 1792, 1536, 1024, 768>(c, P, (const bf16*)(ws + AR_PROJ), (bf16*)(ws + AR_MIXL));
        GRID_BAR();
        if (PH(3)) { pg8::Gemm g{(const pg8::bf16_t*)(ws + AR_XSC), (const pg8::bf16_t*)(ws + WB_WGT), 768, 768, 768}; pg8::StaticOrder S; S.init(128, 6, c.G, c.blk);
          pg8::EpiLruGate E{(pg8::bf16_t*)(ws + AR_LA), (pg8::bf16_t*)(ws + AR_UU), (const pg8::bf16_t*)(ws + AR_XSC), 768, pin(P, I_LRU_B_A), pin(P, I_LRU_B_X), pin(P, I_LRU_LAMBDA)};
          pg8::gemm_phase<pg8::EpiLruGate, pg8::StaticOrder, true, true>(glds, g, S, E); }
        GRID_BAR();
        if (PH(4)) phase_scanA(c, P);
        GRID_BAR();
        if (PH(5)) phase_scanB(c, P);
        GRID_BAR();
        if (PH(6)) phase_scanC(c, P);
        GRID_BAR();
        if (PH(7)) { pg8::Gemm g{(const pg8::bf16_t*)(ws + AR_MIXL), (const pg8::bf16_t*)(ws + WB_WOUT), 1024, 1024, 1024}; pg8::StaticOrder S; S.init(128, 4, c.G, c.blk);
          pg8::EpiResF32 E{P.out, pin(P, I_X), 1024};
          pg8::gemm_phase<pg8::EpiResF32, pg8::StaticOrder, true, true>(glds, g, S, E); }
    } else {
        if (PH(8)) phase_dsaprep(c, P);
        if (PH(8)) phase_xattn<1, 1536, 1280, 1792, 1536>(c, P, (const bf16*)(ws + AR_PROJ), (bf16*)(ws + AR_MIXD));
        GRID_BAR();
        if (PH(9)) phase_indexer(c, P);
        GRID_BAR();
        if (PH(10)) phase_sattn(c, P);
        GRID_BAR();
        if (PH(11)) { pg8::Gemm g{(const pg8::bf16_t*)(ws + AR_MIXD), (const pg8::bf16_t*)(ws + WB_WOUT), 1792, 1792, 1792}; pg8::StaticOrder S; S.init(128, 4, c.G, c.blk);
          pg8::EpiResF32 E{P.out, P.out, 1024};
          pg8::gemm_phase<pg8::EpiResF32, pg8::StaticOrder, true, true>(glds, g, S, E); }
    }
    GRID_BAR();
    if (PH(12)) phase_norm2<layer>(c, P);
    GRID_BAR();
    if (PH(13)) { pg8::Gemm g{HN, (const pg8::bf16_t*)(ws + WB_WR), 1024, 1024, 1024}; pg8::StaticOrder S; S.init(128, 1, c.G, c.blk);
      pg8::EpiLogits E{(float*)(ws + AR_LOG)};
      pg8::gemm_phase<pg8::EpiLogits, pg8::StaticOrder, true, true>(glds, g, S, E); }
    GRID_BAR();
    if (PH(14)) phase_route<layer>(c, P);
    GRID_BAR();
    if (PH(15)) phase_scatter<layer>(c, P);
    GRID_BAR();
    if (PH(16)) { const int ntile = (int)__hip_atomic_load(ctl + CW_NT + layer * CW_LSTRIDE, RLX_AGENT);
        pg8::Gemm g{(const pg8::bf16_t*)(ws + AR_XS), (const pg8::bf16_t*)(ws + WB_WGU), 1024, 1024, 1024}; pg8::GroupedOrder S; S.init(ntile, 4, c.G, c.blk);
        S.te = (const int*)(ctl + CW_TE + layer * CW_TE_STRIDE); S.estride = (size_t)1024 * 1024 * 2;
        pg8::EpiSwiglu E{(pg8::bf16_t*)(ws + AR_ACT), 512};
        pg8::gemm_phase<pg8::EpiSwiglu, pg8::GroupedOrder, true, true>(glds, g, S, E); }
    GRID_BAR();
    if (PH(17)) { const int ntile = (int)__hip_atomic_load(ctl + CW_NT + layer * CW_LSTRIDE, RLX_AGENT);
        pg8::Gemm g{(const pg8::bf16_t*)(ws + AR_ACT), (const pg8::bf16_t*)(ws + WB_WD), 512, 512, 512}; pg8::GroupedOrder S; S.init(ntile, 4, c.G, c.blk);
        S.te = (const int*)(ctl + CW_TE + layer * CW_TE_STRIDE); S.estride = (size_t)1024 * 512 * 2;
        pg8::EpiBf16<false> E{(pg8::bf16_t*)(ws + AR_XS), 1024, 0, 0};
        pg8::gemm_phase<pg8::EpiBf16<false>, pg8::GroupedOrder, true, true>(glds, g, S, E); }
    GRID_BAR();
    if (PH(18)) phase_combine(c, P);
    GRID_BAR();
}
__global__ void __launch_bounds__(512, 2) fwd(const Params P) {
    extern __shared__ __attribute__((aligned(16))) unsigned char lds_raw[];
    Ctx c;
    c.lds = (LAS unsigned char*)lds_raw;
    c.tid = threadIdx.x; c.lane = c.tid & 63; c.wave = __builtin_amdgcn_readfirstlane(c.tid >> 6);
    c.G = gridDim.x; c.blk = blockIdx.x; c.gw = c.blk * 8 + c.wave; c.NGW = c.G * 8;
    volatile LAS unsigned* MISC = (volatile LAS unsigned*)(c.lds + MISC_OFF);
    if (c.tid < 64) MISC[c.tid] = 0u;
    if (c.tid < 29) ((LAS unsigned long long*)(c.lds + MISC_OFF + 512))[c.tid] = (unsigned long long)P.in[c.tid];
    __syncthreads();
    XcdBarrier bar = xcd_barrier_post((unsigned*)(P.ws + WS_CTL) + CW_BAR, MISC + 8);
    PV pv; pv.ws = P.ws; pv.out = P.out; pv.tab = (LAS unsigned long long*)(c.lds + MISC_OFF + 512);
#ifndef ONLY_LAYER
    layer_body<0>(c, pv, bar);
    layer_body<1>(c, pv, bar);
#else
    layer_body<ONLY_LAYER>(c, pv, bar);
#endif
}

extern "C" void kernel_launch(void* const* d_in, const int* in_sizes, int n_in, void* d_out, int out_size, void* d_ws, size_t ws_size, hipStream_t stream) {
    static int grid = 0;
    if (grid == 0) {
        if (n_in != 29 || out_size != NTOK * DM || ws_size < WS_END) { fprintf(stderr, "kernel_launch: unexpected shapes (n_in %d out %d ws %zu need %zu)\n", n_in, out_size, ws_size, (size_t)WS_END); grid = -1; return; }
        int dev = 0, cus = 0, per_cu = 0;
        if (hipGetDevice(&dev) != hipSuccess || hipDeviceGetAttribute(&cus, hipDeviceAttributeMultiprocessorCount, dev) != hipSuccess) { grid = -1; return; }
        if (hipFuncSetAttribute((const void*)fwd, hipFuncAttributeMaxDynamicSharedMemorySize, LDS_BYTES) != hipSuccess) { fprintf(stderr, "kernel_launch: hipFuncSetAttribute failed\n"); grid = -1; return; }
        if (hipOccupancyMaxActiveBlocksPerMultiprocessor(&per_cu, (const void*)fwd, 512, LDS_BYTES) != hipSuccess || per_cu < 1) { fprintf(stderr, "kernel_launch: occupancy query reports %d\n", per_cu); }
        (void)hipGetLastError();
        grid = cus;
    }
    if (grid < 0) return;
    if (hipMemsetAsync((char*)d_ws + WS_CTL, 0, CTL_ZERO_BYTES, stream) != hipSuccess) return;
    Params p{};
    for (int i = 0; i < 29; ++i) p.in[i] = (const float*)d_in[i];
    p.out = (float*)d_out; p.ws = (unsigned char*)d_ws;
    hipLaunchKernelGGL(fwd, dim3(grid), dim3(512), LDS_BYTES, stream, p);
}
```

```cpp
#include <hip/hip_runtime.h>
#include <cstdio>
#include <cstdint>
namespace pg8 {
#define PG8_LAS __attribute__((address_space(3)))
typedef unsigned short bf16_t;
typedef short bf16x8 __attribute__((ext_vector_type(8)));
typedef float f32x4 __attribute__((ext_vector_type(4)));
typedef float f32x2 __attribute__((ext_vector_type(2)));
typedef unsigned u32x4 __attribute__((ext_vector_type(4)));
constexpr int BM = 256, BK = 64, HALF = 128, HTB = HALF * BK * 2  , STAGE_BYTES = 8 * HTB, NXCD = 8, WGM = 8;

__host__ __device__ __forceinline__ int lds_byte(int r, int c) { const int st = (r >> 4) * 2 + (c >> 5), rr = r & 15, cc = c & 31, ob = rr * 64 + cc * 2; return st * 1024 + (ob ^ (((ob >> 9) & 1) << 5)); }
__host__ __device__ __forceinline__ void stage_rc(int b, int& R, int& C) { const int st = b / 1024, sb = b % 1024, swz = sb ^ (((sb >> 9) & 1) << 5); R = (st >> 1) * 16 + swz / 64; C = (st & 1) * 32 + (swz % 64) / 2; }
__host__ __device__ __forceinline__ int perm32(int rho) { const int n = rho >> 4, i = rho & 15; return 8 * (i >> 2) + 4 * n + (i & 3); }

struct Unit { int pm, pn; size_t boff; };
struct Gemm { const bf16_t* A; const bf16_t* Bt; int lda, ldb, K; };

struct StaticOrder {
    int nM, nN, nwg, G, c;
    __host__ __device__ void init(int nM_, int nN_, int G_, int c_) { nM = nM_; nN = nN_; nwg = nM * nN; G = G_; c = c_; }
    __host__ __device__ bool next(int i, Unit& u) const {
        const long L = (long)i * G + c; if (L >= nwg) return false;
        int wgid = (int)L; { const int q = nwg / NXCD, r = nwg % NXCD, xcd = wgid % NXCD, off = wgid / NXCD; wgid = (xcd < r ? xcd * (q + 1) : r * (q + 1) + (xcd - r) * q) + off; }
        const int nig = WGM * nN, gid = wgid / nig, fm = gid * WGM, gsz = (nM - fm) < WGM ? (nM - fm) : WGM;
        u.pm = fm + ((wgid % nig) % gsz); u.pn = (wgid % nig) / gsz; u.boff = 0; return true;
    }
    __device__ __forceinline__ void a_ready(const Unit&) const {}
    __device__ __forceinline__ void done(const Unit&) const {}
};
struct GroupedOrder : StaticOrder {
    const int* te; size_t estride;
    __device__ bool next(int i, Unit& u) const { if (!StaticOrder::next(i, u)) return false; u.boff = (size_t)te[u.pm] * estride; return true; }
};

__device__ __forceinline__ unsigned cvt_pk_bf16(float lo, float hi) { unsigned r; asm volatile("v_cvt_pk_bf16_f32 %0, %1, %2" : "=v"(r) : "v"(lo), "v"(hi)); return r; }
__device__ __forceinline__ float bf_lo(unsigned w) { return __uint_as_float(w << 16); }
__device__ __forceinline__ float bf_hi(unsigned w) { return __uint_as_float(w & 0xffff0000u); }
__device__ __forceinline__ float sigmoidf_(float v) { return __builtin_amdgcn_rcpf(1.0f + __expf(-v)); }
__device__ __forceinline__ float gelu_tanh(float v) { const float z = 1.5957691216057308f * (v + 0.044715f * v * v * v); return v * sigmoidf_(z); }

template <bool GELU> struct EpiBf16 {
    static constexpr bool PERM = true, AFTER_DRAIN = false;
    bf16_t* O; int ldc; int gelu_lo, gelu_hi;
    __device__ __forceinline__ void operator()(const f32x4 (&acc)[2][2][4][2], const Unit& u, int wr, int wc, int fr, int fq) const {
        const int row0 = u.pm * BM + wr * 64 + fr, col0 = u.pn * BM + wc * 32 + 8 * fq;
        const bool act = GELU && (u.pn >= gelu_lo && u.pn < gelu_hi);
#pragma unroll
        for (int ai = 0; ai < 2; ++ai)
#pragma unroll
            for (int m = 0; m < 4; ++m) { bf16_t* rowp = O + (size_t)(row0 + ai * HALF + m * 16) * ldc + col0;
#pragma unroll
                for (int bj = 0; bj < 2; ++bj) { f32x4 v0 = acc[ai][bj][m][0], v1 = acc[ai][bj][m][1];
                    if (act) {
#pragma unroll
                        for (int j = 0; j < 4; ++j) { v0[j] = gelu_tanh(v0[j]); v1[j] = gelu_tanh(v1[j]); } }
                    u32x4 w; w.x = cvt_pk_bf16(v0[0], v0[1]); w.y = cvt_pk_bf16(v0[2], v0[3]); w.z = cvt_pk_bf16(v1[0], v1[1]); w.w = cvt_pk_bf16(v1[2], v1[3]);
                    *(u32x4*)(rowp + bj * HALF) = w; } }
    }
};
struct EpiSwiglu {
    static constexpr bool PERM = true, AFTER_DRAIN = false;
    bf16_t* O; int ldc;
    __device__ __forceinline__ void operator()(const f32x4 (&acc)[2][2][4][2], const Unit& u, int wr, int wc, int fr, int fq) const {
        const int row0 = u.pm * BM + wr * 64 + fr, col0 = u.pn * HALF + wc * 32 + 8 * fq;
#pragma unroll
        for (int ai = 0; ai < 2; ++ai)
#pragma unroll
            for (int m = 0; m < 4; ++m) { bf16_t* rowp = O + (size_t)(row0 + ai * HALF + m * 16) * ldc + col0;
                f32x4 v0, v1;
#pragma unroll
                for (int j = 0; j < 4; ++j) { const float g0 = acc[ai][0][m][0][j], g1 = acc[ai][0][m][1][j];
                    v0[j] = g0 * sigmoidf_(g0) * acc[ai][1][m][0][j]; v1[j] = g1 * sigmoidf_(g1) * acc[ai][1][m][1][j]; }
                u32x4 w; w.x = cvt_pk_bf16(v0[0], v0[1]); w.y = cvt_pk_bf16(v0[2], v0[3]); w.z = cvt_pk_bf16(v1[0], v1[1]); w.w = cvt_pk_bf16(v1[2], v1[3]);
                *(u32x4*)rowp = w; }
    }
};
struct EpiLruGate {
    static constexpr bool PERM = true, AFTER_DRAIN = false;
    bf16_t* LA; bf16_t* U; const bf16_t* XS; int ldc; const float* b_a; const float* b_x; const float* lam;
    __device__ __forceinline__ void operator()(const f32x4 (&acc)[2][2][4][2], const Unit& u, int wr, int wc, int fr, int fq) const {
        const int row0 = u.pm * BM + wr * 64 + fr, ch0 = u.pn * HALF + wc * 32 + 8 * fq;
        float ba[8], bx[8], sp8[8];
#pragma unroll
        for (int j = 0; j < 8; ++j) { ba[j] = b_a[ch0 + j]; bx[j] = b_x[ch0 + j]; const float l = lam[ch0 + j];
            sp8[j] = 8.0f * ((l > 15.f) ? __expf(-l) : __logf(1.0f + __expf(-l))); }
#pragma unroll
        for (int ai = 0; ai < 2; ++ai)
#pragma unroll
            for (int m = 0; m < 4; ++m) { const size_t off = (size_t)(row0 + ai * HALF + m * 16) * ldc + ch0;
                const u32x4 xw = *(const u32x4*)(XS + off);
                float xv[8] = {bf_lo(xw.x), bf_hi(xw.x), bf_lo(xw.y), bf_hi(xw.y), bf_lo(xw.z), bf_hi(xw.z), bf_lo(xw.w), bf_hi(xw.w)};
                float la[8], uu[8];
#pragma unroll
                for (int j = 0; j < 8; ++j) { const float rp = acc[ai][0][m][j >> 2][j & 3] + ba[j], ip = acc[ai][1][m][j >> 2][j & 3] + bx[j];
                    const float r = sigmoidf_(rp), ig = sigmoidf_(ip);
                    const float l = -sp8[j] * r; const float t = 2.0f * l;
                    const float om = (t > -0.02f) ? -t * (1.0f + t * (0.5f + t * (0.16666667f + t * 0.041666667f))) : 1.0f - __expf(t);
                    la[j] = l; uu[j] = sqrtf(om) * ig * xv[j]; }
                u32x4 w; w.x = cvt_pk_bf16(la[0], la[1]); w.y = cvt_pk_bf16(la[2], la[3]); w.z = cvt_pk_bf16(la[4], la[5]); w.w = cvt_pk_bf16(la[6], la[7]);
                *(u32x4*)(LA + off) = w;
                u32x4 w2; w2.x = cvt_pk_bf16(uu[0], uu[1]); w2.y = cvt_pk_bf16(uu[2], uu[3]); w2.z = cvt_pk_bf16(uu[4], uu[5]); w2.w = cvt_pk_bf16(uu[6], uu[7]);
                *(u32x4*)(U + off) = w2; __builtin_amdgcn_sched_barrier(0); }
    }
};
struct EpiResF32 {
    static constexpr bool PERM = false, AFTER_DRAIN = false;
    float* C; const float* R; int ldc;
    __device__ __forceinline__ void operator()(const f32x4 (&acc)[2][2][4][2], const Unit& u, int wr, int wc, int fr, int fq) const {
        const int row0 = u.pm * BM + wr * 64 + fr, col0 = u.pn * BM + wc * 32 + 4 * fq;
#pragma unroll
        for (int ai = 0; ai < 2; ++ai)
#pragma unroll
            for (int m = 0; m < 4; ++m) { const size_t ro = (size_t)(row0 + ai * HALF + m * 16) * ldc + col0;
#pragma unroll
                for (int bj = 0; bj < 2; ++bj)
#pragma unroll
                    for (int n = 0; n < 2; ++n) { const f32x4 r = *(const f32x4*)(R + ro + bj * HALF + n * 16); *(f32x4*)(C + ro + bj * HALF + n * 16) = r + acc[ai][bj][m][n]; }  __builtin_amdgcn_sched_barrier(0); }
    }
};
struct EpiLogits {
    static constexpr bool PERM = false, AFTER_DRAIN = false;
    float* C;
    __device__ __forceinline__ void operator()(const f32x4 (&acc)[2][2][4][2], const Unit& u, int wr, int wc, int fr, int fq) const {
        if (wc >= 2 || u.pn != 0) return;
        const int row0 = u.pm * BM + wr * 64 + fr, col0 = wc * 32 + 4 * fq;
#pragma unroll
        for (int ai = 0; ai < 2; ++ai)
#pragma unroll
            for (int m = 0; m < 4; ++m) { float* rowp = C + (size_t)(row0 + ai * HALF + m * 16) * 64 + col0;
#pragma unroll
                for (int n = 0; n < 2; ++n) *(f32x4*)(rowp + n * 16) = acc[ai][0][m][n]; }
    }
};
template <class Epi, class Sched, bool ALIGN_EPI = false, bool SP2 = false>
__device__ __forceinline__ void gemm_phase(PG8_LAS unsigned char* lds, const Gemm g, const Sched& S, const Epi& E) {
    int tid_ = threadIdx.x; asm volatile("" : "+v"(tid_));
    const int tid = tid_, wid = __builtin_amdgcn_readfirstlane(tid >> 6), lane = tid & 63, wr = wid >> 2, wc = wid & 3, fr = lane & 15, fq = lane >> 4;
    const int K = g.K, nt = K / BK;
    unsigned voffA[2], voffB[2];
#pragma unroll
    for (int i = 0; i < 2; ++i) { int R, C; stage_rc(tid * 16 + i * 8192, R, C); const int Rb = Epi::PERM ? ((R & ~31) + perm32(R & 31)) : R;
        voffA[i] = (unsigned)(R * g.lda + C) * 2u; voffB[i] = (unsigned)(Rb * g.ldb + C) * 2u; }
    const size_t kstep = (size_t)(BK * 2);
    const size_t hsA = (size_t)HALF * g.lda * 2, hsB = (size_t)HALF * g.ldb * 2;
    const size_t tsA = 2 * hsA, tsB = 2 * hsB;
    const unsigned ldsw = (unsigned)wid * 1024u;
    const int aoff = lds_byte(wr * 64 + fr, fq * 8), boff = lds_byte(wc * 32 + fr, fq * 8);
#define PG8_SA(b, h) (((b) * 2 + (h)) * HTB)
#define PG8_SB(b, h) ((4 + (b) * 2 + (h)) * HTB)
#define PG8_STAGE(bufoff, gbase, voff) do { _Pragma("unroll") for (int _i = 0; _i < 2; ++_i) \
        __builtin_amdgcn_global_load_lds((const unsigned*)((const char*)(gbase) + (voff)[_i]), (PG8_LAS unsigned*)(lds + (bufoff) + ldsw + _i * 8192), 16, 0, 0); } while (0)
#define PG8_LDA(dst, b, h) do { _Pragma("unroll") for (int m = 0; m < 4; ++m) _Pragma("unroll") for (int k = 0; k < 2; ++k) dst[m][k] = *(const PG8_LAS bf16x8*)(lds + PG8_SA(b, h) + aoff + m * 2048 + k * 1024); } while (0)
#define PG8_LDB(dst, b, h) do { _Pragma("unroll") for (int n = 0; n < 2; ++n) _Pragma("unroll") for (int k = 0; k < 2; ++k) dst[n][k] = *(const PG8_LAS bf16x8*)(lds + PG8_SB(b, h) + boff + n * 2048 + k * 1024); } while (0)
#define PG8_MMA(ai, bj, At, Bt) do { __builtin_amdgcn_s_setprio(1); _Pragma("unroll") for (int m = 0; m < 4; ++m) _Pragma("unroll") for (int n = 0; n < 2; ++n) _Pragma("unroll") for (int k = 0; k < 2; ++k) \
        acc[ai][bj][m][n] = __builtin_amdgcn_mfma_f32_16x16x32_bf16(Bt[n][k], At[m][k], acc[ai][bj][m][n], 0, 0, 0); __builtin_amdgcn_s_setprio(0); } while (0)
#define PG8_WAIT_V(n) asm volatile("s_waitcnt vmcnt(" #n ")" ::: "memory")
#define PG8_WAIT_L(n) asm volatile("s_waitcnt lgkmcnt(" #n ")" ::: "memory")
#define PG8_BAR __builtin_amdgcn_s_barrier()
#define PG8_SCHED __builtin_amdgcn_sched_barrier(0)
    Unit cur, nxt; int ui = 0;
    if (!S.next(0, cur)) return;
    f32x4 acc[2][2][4][2];
#pragma unroll
    for (int a = 0; a < 2; ++a)
#pragma unroll
        for (int b = 0; b < 2; ++b)
#pragma unroll
            for (int m = 0; m < 4; ++m)
#pragma unroll
                for (int n = 0; n < 2; ++n) acc[a][b][m][n] = (f32x4){0.f, 0.f, 0.f, 0.f};
    bf16x8 At[4][2], B0[2][2], B1[2][2];
    const char* cA = (const char*)g.A + (size_t)cur.pm * tsA; const char* cB = (const char*)g.Bt + cur.boff + (size_t)cur.pn * tsB;
    S.a_ready(cur);
    if constexpr (SP2) {
        PG8_STAGE(PG8_SB(0, 0), cB, voffB); PG8_STAGE(PG8_SB(0, 1), cB + hsB, voffB); PG8_STAGE(PG8_SA(0, 0), cA, voffA); PG8_STAGE(PG8_SA(0, 1), cA + hsA, voffA);
        if (wr == 1) PG8_BAR;
        PG8_WAIT_V(2); PG8_BAR;
        PG8_STAGE(PG8_SB(1, 0), cB + kstep, voffB); PG8_STAGE(PG8_SA(1, 0), cA + kstep, voffA); PG8_STAGE(PG8_SB(1, 1), cB + hsB + kstep, voffB);
        PG8_WAIT_V(6); PG8_BAR;
    } else {
        PG8_STAGE(PG8_SB(0, 0), cB, voffB); PG8_STAGE(PG8_SA(0, 0), cA, voffA); PG8_STAGE(PG8_SB(0, 1), cB + hsB, voffB); PG8_STAGE(PG8_SA(0, 1), cA + hsA, voffA);
        if (wr == 1) PG8_BAR;
        PG8_WAIT_V(4); PG8_BAR;
        PG8_STAGE(PG8_SB(1, 0), cB + kstep, voffB); PG8_STAGE(PG8_SA(1, 0), cA + kstep, voffA); PG8_STAGE(PG8_SB(1, 1), cB + hsB + kstep, voffB);
        PG8_WAIT_V(6); PG8_BAR;
    }
    for (;;) {
        const bool has_next = S.next(ui + 1, nxt);
        const char* nA = has_next ? (const char*)g.A + (size_t)nxt.pm * tsA : cA; const char* nB = has_next ? (const char*)g.Bt + nxt.boff + (size_t)nxt.pn * tsB : cB;
        for (int t = 0; t < nt; t += 2) {
            const bool last = (t == nt - 2);
            const char* a1 = cA + (size_t)(t + 1) * kstep;
            const char* a2 = last ? nA : cA + (size_t)(t + 2) * kstep; const char* b2 = last ? nB : cB + (size_t)(t + 2) * kstep;
            const char* a3 = a2 + kstep; const char* b3 = b2 + kstep;
            if (last && has_next) S.a_ready(nxt);
            if constexpr (SP2) {
            PG8_LDB(B0, 0, 0); PG8_LDB(B1, 0, 1); PG8_SCHED; PG8_LDA(At, 0, 0); PG8_STAGE(PG8_SA(1, 1), a1 + hsA, voffA);
            PG8_WAIT_V(8); PG8_WAIT_L(0); PG8_BAR; PG8_MMA(0, 0, At, B0); PG8_MMA(0, 1, At, B1); PG8_BAR; PG8_SCHED;
            PG8_LDA(At, 0, 1); PG8_STAGE(PG8_SB(0, 0), b2, voffB); PG8_STAGE(PG8_SB(0, 1), b2 + hsB, voffB); PG8_STAGE(PG8_SA(0, 0), a2, voffA);
            PG8_WAIT_V(8); PG8_WAIT_L(0); PG8_BAR; PG8_MMA(1, 0, At, B0); PG8_MMA(1, 1, At, B1); PG8_BAR; PG8_SCHED;
            PG8_LDB(B0, 1, 0); PG8_LDB(B1, 1, 1); PG8_SCHED; PG8_LDA(At, 1, 0); PG8_STAGE(PG8_SA(0, 1), a2 + hsA, voffA);
            PG8_WAIT_V(8); PG8_WAIT_L(0); PG8_BAR; PG8_MMA(0, 0, At, B0); PG8_MMA(0, 1, At, B1); PG8_BAR; PG8_SCHED;
            PG8_LDA(At, 1, 1); PG8_STAGE(PG8_SB(1, 0), b3, voffB); PG8_STAGE(PG8_SB(1, 1), b3 + hsB, voffB); PG8_STAGE(PG8_SA(1, 0), a3, voffA);
            PG8_WAIT_V(8); PG8_WAIT_L(0); PG8_BAR; PG8_MMA(1, 0, At, B0); PG8_MMA(1, 1, At, B1); PG8_BAR; PG8_SCHED;
            } else {
            PG8_LDB(B0, 0, 0); PG8_SCHED; PG8_LDA(At, 0, 0); PG8_STAGE(PG8_SA(1, 1), a1 + hsA, voffA);
            PG8_WAIT_L(8); PG8_BAR; PG8_WAIT_L(0); PG8_MMA(0, 0, At, B0); PG8_BAR; PG8_SCHED;
            PG8_LDB(B1, 0, 1); PG8_STAGE(PG8_SB(0, 0), b2, voffB);
            PG8_BAR; PG8_WAIT_L(0); PG8_MMA(0, 1, At, B1); PG8_BAR;
            PG8_LDA(At, 0, 1); PG8_STAGE(PG8_SA(0, 0), a2, voffA);
            PG8_BAR; PG8_WAIT_L(0); PG8_MMA(1, 0, At, B0); PG8_BAR; PG8_SCHED;
            PG8_STAGE(PG8_SB(0, 1), b2 + hsB, voffB);
            PG8_WAIT_V(6); PG8_BAR; PG8_MMA(1, 1, At, B1); PG8_BAR;
            PG8_LDB(B0, 1, 0); PG8_SCHED; PG8_LDA(At, 1, 0); PG8_STAGE(PG8_SA(0, 1), a2 + hsA, voffA);
            PG8_WAIT_L(8); PG8_BAR; PG8_WAIT_L(0); PG8_MMA(0, 0, At, B0); PG8_BAR; PG8_SCHED;
            PG8_LDB(B1, 1, 1); PG8_STAGE(PG8_SB(1, 0), b3, voffB);
            PG8_BAR; PG8_WAIT_L(0); PG8_MMA(0, 1, At, B1); PG8_BAR;
            PG8_LDA(At, 1, 1); PG8_STAGE(PG8_SA(1, 0), a3, voffA);
            PG8_BAR; PG8_WAIT_L(0); PG8_MMA(1, 0, At, B0); PG8_BAR; PG8_SCHED;
            PG8_STAGE(PG8_SB(1, 1), b3 + hsB, voffB);
            PG8_WAIT_V(6); PG8_BAR; PG8_MMA(1, 1, At, B1); PG8_BAR;
            }
        }
        if constexpr (ALIGN_EPI) { if (wr == 0) PG8_BAR; }
        if constexpr (!Epi::AFTER_DRAIN) { E(acc, cur, wr, wc, fr, fq); S.done(cur); }
        if (!has_next) break;
#pragma unroll
        for (int a = 0; a < 2; ++a)
#pragma unroll
            for (int b = 0; b < 2; ++b)
#pragma unroll
                for (int m = 0; m < 4; ++m)
#pragma unroll
                    for (int n = 0; n < 2; ++n) acc[a][b][m][n] = (f32x4){0.f, 0.f, 0.f, 0.f};
        cur = nxt; cA = nA; cB = nB; ++ui;
        if constexpr (ALIGN_EPI) { if (wr == 1) PG8_BAR; }
    }
    PG8_WAIT_V(0);
    if constexpr (!ALIGN_EPI) { if (wr == 0) PG8_BAR; }
    PG8_BAR;
    if constexpr (Epi::AFTER_DRAIN) { E.fused(acc, cur, wr, wc, fr, fq, lds, wid, lane); S.done(cur); }
#undef PG8_SA
#undef PG8_SB
#undef PG8_STAGE
#undef PG8_LDA
#undef PG8_LDB
#undef PG8_MMA
#undef PG8_WAIT_V
#undef PG8_WAIT_L
#undef PG8_BAR
#undef PG8_SCHED
}
}

constexpr int NTOK = 32768, SEQ = 16384, DM = 1024;
constexpr float EPS = 1e-6f;
constexpr size_t MiB = 1u << 20;
constexpr size_t WS_CTL = 0, CTL_ZERO_BYTES = 1 * MiB;
constexpr size_t WS_WB = 1 * MiB;
constexpr size_t WB_MKV = WS_WB + 0 * MiB;
constexpr size_t WB_MEMN = WS_WB + 1 * MiB;
constexpr size_t WB_MKVO = WS_WB + 2 * MiB;
constexpr size_t WB_WR = WS_WB + 3 * MiB;
constexpr size_t WB_WIN = WS_WB + 4 * MiB;
constexpr size_t WB_WGT = WS_WB + 8 * MiB;
constexpr size_t WB_WOUT = WS_WB + 11 * MiB;
constexpr size_t WB_WGU = WS_WB + 16 * MiB;
constexpr size_t WB_WD = WS_WB + 80 * MiB;
constexpr size_t WS_HN = WS_WB + 112 * MiB;
constexpr size_t WS_AR = WS_HN + 64 * MiB;
constexpr size_t AR_PROJ = WS_AR;
constexpr size_t AR_XSC = WS_AR + 112 * MiB;
constexpr size_t AR_LA = WS_AR + 160 * MiB;
constexpr size_t AR_UU = WS_AR + 208 * MiB;
constexpr size_t AR_MIXL = WS_AR + 256 * MiB;
constexpr size_t AR_SA = WS_AR + 320 * MiB;
constexpr size_t AR_SH = WS_AR + 322 * MiB;
constexpr size_t AR_CARRY = WS_AR + 324 * MiB;
constexpr size_t AR_KN = WS_AR + 96 * MiB;
constexpr size_t AR_KIN = WS_AR + 100 * MiB;
constexpr size_t AR_QIW = WS_AR + 104 * MiB;
constexpr size_t AR_WI = WS_AR + 120 * MiB;
constexpr size_t AR_SEL = WS_AR + 121 * MiB;
constexpr size_t AR_MIXD = WS_AR + 160 * MiB;
constexpr size_t AR_XS = WS_AR;
constexpr size_t AR_ACT = WS_AR + 144 * MiB;
constexpr size_t AR_LOG = WS_AR + 216 * MiB;
constexpr size_t AR_EID = WS_AR + 224 * MiB;
constexpr size_t AR_GATE = WS_AR + 225 * MiB;
constexpr size_t AR_DEST = WS_AR + 226 * MiB;
constexpr size_t WS_END = WS_AR + 328 * MiB;
constexpr int CW_TMO = 0, CW_CODE = 1;
constexpr int CW_CNT = 256, CW_CUR = 320, CW_NT = 384, CW_LSTRIDE = 256;
constexpr int CW_TE = 1024, CW_TE_STRIDE = 512;
constexpr int CW_BAR = 4096;
constexpr int LDS_BYTES = 159744, MISC_OFF = 155648;

#define GAS __attribute__((address_space(1)))
#define LAS __attribute__((address_space(3)))
#define DI __device__ __forceinline__
typedef unsigned short bf16;
typedef unsigned v4u __attribute__((ext_vector_type(4)));
typedef unsigned v2u __attribute__((ext_vector_type(2)));
typedef int v4i __attribute__((ext_vector_type(4)));
typedef float f32x4 __attribute__((ext_vector_type(4)));
typedef float f32x16 __attribute__((ext_vector_type(16)));
typedef short bf16x8 __attribute__((ext_vector_type(8)));
typedef GAS unsigned gu32;
#define RLX_AGENT __ATOMIC_RELAXED, __HIP_MEMORY_SCOPE_AGENT
#define LDS_WAIT() asm volatile("s_waitcnt lgkmcnt(0)" ::: "memory")
DI unsigned f2bf(float f) { unsigned u = __builtin_bit_cast(unsigned, f); return (u + 0x7fffu + ((u >> 16) & 1u)) >> 16; }
DI unsigned pk2(float lo, float hi) { return f2bf(lo) | (f2bf(hi) << 16); }
DI float bflo(unsigned w) { return __uint_as_float(w << 16); }
DI float bfhi(unsigned w) { return __uint_as_float(w & 0xffff0000u); }
DI void unpack8(const v4u w, float (&f)[8]) { f[0] = bflo(w.x); f[1] = bfhi(w.x); f[2] = bflo(w.y); f[3] = bfhi(w.y); f[4] = bflo(w.z); f[5] = bfhi(w.z); f[6] = bflo(w.w); f[7] = bfhi(w.w); }
DI v4u pack8(const float (&f)[8]) { v4u w; w.x = pk2(f[0], f[1]); w.y = pk2(f[2], f[3]); w.z = pk2(f[4], f[5]); w.w = pk2(f[6], f[7]); return w; }
DI unsigned lds_add(LAS unsigned* p, unsigned v) { return __hip_atomic_fetch_add(p, v, __ATOMIC_RELAXED, __HIP_MEMORY_SCOPE_WORKGROUP); }
DI float wave_sum(float v) {
#pragma unroll
    for (int o = 1; o < 64; o <<= 1) v += __shfl_xor(v, o);
    return v;
}

#define XB_TMO      128
#define XB_XCNT(j)  (256  + 64 * (j))
#define XB_XSUB(j)  (1280 + 64 * (j))
#define XB_XGEN(j)  (2304 + 64 * (j))
#define XB_TOP      3328
#define XB_TOPGEN   3392
#define XCD_BAR_WORDS 3456
#define XB_SPIN_CAP (1u << 22)
DI unsigned xb_ld(unsigned* p)              { return __hip_atomic_load(p, __ATOMIC_RELAXED, __HIP_MEMORY_SCOPE_AGENT); }
DI unsigned xb_add(unsigned* p, unsigned v) { return __hip_atomic_fetch_add(p, v, __ATOMIC_RELAXED, __HIP_MEMORY_SCOPE_AGENT); }
DI unsigned xb_xcc_id() { return (unsigned)__builtin_amdgcn_s_getreg((3 << 11) | 20) & 0xFu; }
#define XB_SPIN(cond, bar) do { unsigned _sp = 0; while (cond) { __builtin_amdgcn_s_sleep(1); \
    if ((++_sp & 255u) == 0u) { if (xb_ld(&(bar)[XB_TMO])) break; if (_sp > XB_SPIN_CAP) { atomicAdd(&(bar)[XB_TMO], 1u); break; } } } } while (0)
struct XcdBarrier { unsigned* bar; unsigned x; volatile LAS unsigned* st; };
DI XcdBarrier xcd_barrier_post(unsigned* bar, volatile LAS unsigned* st) {
    XcdBarrier b; b.bar = bar; b.x = xb_xcc_id(); b.st = st;
    if (threadIdx.x == 0) (void)xb_add(&bar[XB_XCNT(b.x)], 1u);
    return b;
}
DI void xcd_barrier_complete(unsigned* bar, unsigned x, unsigned& nloc, unsigned& nx) {
    const unsigned G = gridDim.x * gridDim.y * gridDim.z;
    unsigned sum, cnt, mine, sp = 0u;
    for (;;) {
        sum = 0u; cnt = 0u; mine = 0u;
#pragma unroll
        for (unsigned j = 0; j < 16; ++j) { const unsigned c = xb_ld(&bar[XB_XCNT(j)]); sum += c; cnt += (c > 0u) ? 1u : 0u; mine = (j == x) ? c : mine; }
        if (sum == G) break;
        __builtin_amdgcn_s_sleep(1);
        if ((++sp & 255u) == 0u) { if (xb_ld(&bar[XB_TMO])) break; if (sp > XB_SPIN_CAP) { atomicAdd(&bar[XB_TMO], 1u); break; } }
    }
    nloc = mine > 0u ? mine : 1u; nx = cnt > 0u ? cnt : 1u;
}
DI void xcd_barrier(const XcdBarrier& b) {
    asm volatile("s_waitcnt vmcnt(0)" ::: "memory");
    __syncthreads();
    if (threadIdx.x == 0) {
        unsigned* bar = b.bar;
        __builtin_amdgcn_s_waitcnt(0);
        unsigned nloc = b.st[0], nx = b.st[1];
        if (nloc == 0u) { xcd_barrier_complete(bar, b.x, nloc, nx); b.st[0] = nloc; b.st[1] = nx; }
        const unsigned old = xb_add(&bar[XB_XSUB(b.x)], 1u);
        const unsigned gen = old / nloc;
        if (old + 1u == (gen + 1u) * nloc) {
            __builtin_amdgcn_fence(__ATOMIC_RELEASE, "agent");
            asm volatile("s_waitcnt vmcnt(0)" ::: "memory");
            const unsigned og = xb_add(&bar[XB_TOP], 1u);
            const unsigned tg = og / nx;
            if (og + 1u == (tg + 1u) * nx) xb_add(&bar[XB_TOPGEN], 1u);
            else XB_SPIN(xb_ld(&bar[XB_TOPGEN]) == tg, bar);
            __builtin_amdgcn_fence(__ATOMIC_ACQUIRE, "agent");
            xb_add(&bar[XB_XGEN(b.x)], 1u);
            asm volatile("s_waitcnt vmcnt(0)" ::: "memory");
        } else {
            XB_SPIN(xb_ld(&bar[XB_XGEN(b.x)]) == gen, bar);
            __builtin_amdgcn_fence(__ATOMIC_ACQUIRE, "agent");
            asm volatile("s_waitcnt vmcnt(0)" ::: "memory");
        }
    }
    __syncthreads();
}

struct Params { const float* in[29]; float* out; unsigned char* ws; };
struct PV { unsigned char* ws; float* out; LAS unsigned long long* tab; };
DI const float* pin(const PV& P, int i) { const unsigned long long v = P.tab[i]; const unsigned lo = __builtin_amdgcn_readfirstlane((unsigned)v), hi = __builtin_amdgcn_readfirstlane((unsigned)(v >> 32)); return (const float*)(((unsigned long long)hi << 32) | lo); }
struct Ctx { LAS unsigned char* lds; int tid, lane, wave, G, blk, gw, NGW; };
DI Ctx relaunder(const Ctx& c0) { Ctx c = c0; int t = threadIdx.x; asm volatile("" : "+v"(t)); c.tid = t; c.lane = t & 63; c.wave = __builtin_amdgcn_readfirstlane(t >> 6); c.gw = c.blk * 8 + c.wave; return c; }
enum { I_X = 0, I_MEM, I_NORM_MIX, I_NORM_FFN, I_MEM_NORM, I_W_MEM_KV, I_XQ_NORM, I_XK_NORM, I_W_OUT, I_LRU_W_IN, I_LRU_CONV_W, I_LRU_CONV_B, I_LRU_W_A, I_LRU_B_A,
       I_LRU_W_X, I_LRU_B_X, I_LRU_LAMBDA, I_DSA_W_IN, I_DSA_Q_NORM, I_DSA_K_NORM, I_DSA_W_UV, I_REL_BIAS, I_MOE_W_GROUP, I_MOE_B_GROUP, I_MOE_W_ROUTER, I_MOE_B_ROUTER,
       I_MOE_W_GATE, I_MOE_W_UP, I_MOE_W_DOWN };

DI void tr_tile(const float* __restrict__ W, int ldw, bf16* __restrict__ WT, int ldk, LAS unsigned* scr, int lane) {
    const int m = lane & 15, q = lane >> 4;
#pragma unroll
    for (int i = 0; i < 8; ++i) {
        const int kk = 8 * i + 2 * q;
        const f32x4 v0 = *(const f32x4*)(W + (size_t)kk * ldw + 4 * m);
        const f32x4 v1 = *(const f32x4*)(W + (size_t)(kk + 1) * ldw + 4 * m);
        const int sw = 4 * (i ^ (m & 7)) + q;
        scr[(4 * m + 0) * 32 + sw] = pk2(v0.x, v1.x);
        scr[(4 * m + 1) * 32 + sw] = pk2(v0.y, v1.y);
        scr[(4 * m + 2) * 32 + sw] = pk2(v0.z, v1.z);
        scr[(4 * m + 3) * 32 + sw] = pk2(v0.w, v1.w);
    }
    LDS_WAIT();
#pragma unroll
    for (int r = 0; r < 8; ++r) {
        const int n = 8 * r + (lane >> 3), c = lane & 7;
        const v4u o = *(const LAS v4u*)(scr + n * 32 + 4 * (c ^ ((n >> 2) & 7)));
        *(v4u*)(WT + (size_t)n * ldk + 8 * c) = o;
    }
    LDS_WAIT();
}
DI void rms_row(const float* __restrict__ xrow, const float* __restrict__ g, bf16* __restrict__ orow, int lane, f32x4 (&v)[4]) {
    const f32x4* xr = (const f32x4*)xrow + lane; const f32x4* gr = (const f32x4*)g + lane;
    float s = 0.f;
#pragma unroll
    for (int j = 0; j < 4; ++j) { v[j] = xr[64 * j]; s += (v[j].x * v[j].x + v[j].y * v[j].y) + (v[j].z * v[j].z + v[j].w * v[j].w); }
    const float r = 1.0f / sqrtf(wave_sum(s) * (1.0f / 1024.0f) + EPS);
    v2u* o8 = (v2u*)orow + lane;
#pragma unroll
    for (int j = 0; j < 4; ++j) { const f32x4 gg = gr[64 * j]; v[j] = v[j] * r * gg; v2u o; o.x = pk2(v[j].x, v[j].y); o.y = pk2(v[j].z, v[j].w); o8[64 * j] = o; }
}
struct TrJob { const float* src; bf16* dst; int ldw, ldk, nN, items; };
template <int layer> DI void phase_prep(const Ctx& c0, const PV& P) {
    const Ctx c = relaunder(c0);
    unsigned char* ws = P.ws;
    LAS unsigned* scr = (LAS unsigned*)(c.lds + c.wave * 8192);
    LAS TrJob* jobs = (LAS TrJob*)(c.lds + 65536);
    LAS int* njp = (LAS int*)(c.lds + 65536 + 512);
    LAS f32x4* wiw = (LAS f32x4*)(c.lds + 69632);
    if (c.tid == 0) {
        int nj = 0;
#define ADDJOB(S_, D_, K_, N_, LDW_, LDK_) do { jobs[nj].src = (S_); jobs[nj].dst = (D_); jobs[nj].ldw = (LDW_); jobs[nj].ldk = (LDK_); jobs[nj].nN = (N_) / 64; jobs[nj].items = ((K_) / 64) * ((N_) / 64); ++nj; } while (0)
        ADDJOB(pin(P, I_W_MEM_KV) + (size_t)layer * 1024 * 512, (bf16*)(ws + WB_MKV), 1024, 512, 512, 1024);
        if (layer == 0) {
            ADDJOB(pin(P, I_LRU_W_IN), (bf16*)(ws + WB_WIN), 1024, 1792, 1792, 1024);
            ADDJOB(pin(P, I_W_OUT), (bf16*)(ws + WB_WOUT), 1024, 1024, 1024, 1024);
        } else {
            ADDJOB(pin(P, I_DSA_W_IN), (bf16*)(ws + WB_WIN), 1024, 1280, 1540, 1024);
            ADDJOB(pin(P, I_DSA_W_IN) + 1284, (bf16*)(ws + WB_WIN) + (size_t)1280 * 1024, 1024, 256, 1540, 1024);
            ADDJOB(pin(P, I_W_OUT) + (size_t)1024 * 1024 + (size_t)768 * 1024, (bf16*)(ws + WB_WOUT) + 1536, 256, 1024, 1024, 1792);
        }
#undef ADDJOB
        *njp = nj;
    }
    if (layer == 1) { for (int k = c.tid; k < 1024; k += 512) wiw[k] = *(const f32x4*)(pin(P, I_DSA_W_IN) + (size_t)k * 1540 + 1280); }
    __syncthreads();
    {
        const float* xin = (layer == 0) ? pin(P, I_X) : P.out;
        const float* g = pin(P, I_NORM_MIX) + layer * 1024;
        bf16* HN = (bf16*)(ws + WS_HN); float* WI = (float*)(ws + AR_WI);
        for (int r = c.gw; r < NTOK; r += c.NGW) {
            f32x4 v[4]; rms_row(xin + (size_t)r * 1024, g, HN + (size_t)r * 1024, c.lane, v);
            if (layer == 1) {
                f32x4 a = {0.f, 0.f, 0.f, 0.f};
#pragma unroll
                for (int j = 0; j < 4; ++j) { const int k0 = 4 * (c.lane + 64 * j); a += v[j].x * wiw[k0] + v[j].y * wiw[k0 + 1] + v[j].z * wiw[k0 + 2] + v[j].w * wiw[k0 + 3]; }
                a.x = wave_sum(a.x); a.y = wave_sum(a.y); a.z = wave_sum(a.z); a.w = wave_sum(a.w);
                if (c.lane == 0) *(f32x4*)(WI + (size_t)r * 4) = a * 0.5f;
            }
        }
        const float* gm = pin(P, I_MEM_NORM) + layer * 1024; bf16* MEMN = (bf16*)(ws + WB_MEMN);
        for (int r = c.gw; r < 512; r += c.NGW) { f32x4 v[4]; rms_row(pin(P, I_MEM) + (size_t)r * 1024, gm, MEMN + (size_t)r * 1024, c.lane, v); }
    }
    {
        const int nj = *njp; int gen_total = 0;
        for (int j = 0; j < nj; ++j) gen_total += jobs[j].items;
        const int total = gen_total + 3 * 32 * 128;
        const float* wg = pin(P, I_MOE_W_GATE) + (size_t)layer * 32 * 1024 * 512;
        const float* wu = pin(P, I_MOE_W_UP) + (size_t)layer * 32 * 1024 * 512;
        const float* wd = pin(P, I_MOE_W_DOWN) + (size_t)layer * 32 * 512 * 1024;
        bf16* WGU = (bf16*)(ws + WB_WGU); bf16* WD = (bf16*)(ws + WB_WD);
        for (int it = c.gw; it < total; it += c.NGW) {
            const float* src; bf16* dst; int ldw, ldk;
            if (it < gen_total) {
                int r = it, j = 0;
                while (r >= jobs[j].items) { r -= jobs[j].items; ++j; }
                const int nN = jobs[j].nN, kb = r / nN, nb = r % nN;
                ldw = jobs[j].ldw; ldk = jobs[j].ldk;
                src = jobs[j].src + (size_t)kb * 64 * ldw + nb * 64; dst = jobs[j].dst + (size_t)nb * 64 * ldk + kb * 64;
            } else {
                const int r = it - gen_total, type = r >> 12, e = (r >> 7) & 31, ti = r & 127;
                if (type < 2) { const int kb = ti >> 3, nb = ti & 7; ldw = 512; ldk = 1024;
                    src = (type == 0 ? wg : wu) + (size_t)e * 1024 * 512 + (size_t)kb * 64 * 512 + nb * 64;
                    const int drow = 256 * (nb >> 1) + 64 * (nb & 1) + 128 * type;
                    dst = WGU + (size_t)e * 1024 * 1024 + (size_t)drow * 1024 + kb * 64;
                } else { const int kb = ti >> 4, nb = ti & 15; ldw = 1024; ldk = 512;
                    src = wd + (size_t)e * 512 * 1024 + (size_t)kb * 64 * 1024 + nb * 64;
                    dst = WD + (size_t)e * 1024 * 512 + (size_t)nb * 64 * 512 + kb * 64; }
            }
            tr_tile(src, ldw, dst, ldk, scr, c.lane);
        }
    }
    const int gtid = c.blk * 512 + c.tid, nthr = c.G * 512;
    {
        const float* wgr = pin(P, I_MOE_W_GROUP) + (size_t)layer * 1024 * 4; const float* wrt = pin(P, I_MOE_W_ROUTER) + (size_t)layer * 1024 * 32;
        bf16* WR = (bf16*)(ws + WB_WR);
        for (int i = gtid; i < 256 * 128; i += nthr) { const int row = i >> 7, k8 = i & 127; float f[8];
#pragma unroll
            for (int kk = 0; kk < 8; ++kk) { const int k = 8 * k8 + kk; f[kk] = row < 4 ? wgr[k * 4 + row] : (row < 36 ? wrt[k * 32 + (row - 4)] : 0.f); }
            *(v4u*)(WR + (size_t)row * 1024 + 8 * k8) = pack8(f); }
    }
    if (layer == 0) {
        bf16* WGT = (bf16*)(ws + WB_WGT);
        for (int i = gtid; i < 1536 * 96; i += nthr) { const int rho = i / 96, k8 = i % 96; const int pn = rho >> 8, bj = (rho >> 7) & 1, j = rho & 127, ch = 128 * pn + j, blkc = ch / 192, cc = ch % 192;
            const float* src = (bj ? pin(P, I_LRU_W_X) : pin(P, I_LRU_W_A)) + (size_t)blkc * 192 * 192; float f[8];
            const int k0 = 8 * k8; const bool in = (k0 / 192) == blkc;
#pragma unroll
            for (int kk = 0; kk < 8; ++kk) f[kk] = in ? src[((k0 + kk) % 192) * 192 + cc] : 0.f;
            *(v4u*)(WGT + (size_t)rho * 768 + k0) = pack8(f); }
    } else {
        const float* wuv = pin(P, I_DSA_W_UV); const float* wo = pin(P, I_W_OUT) + (size_t)1024 * 1024; bf16* WO = (bf16*)(ws + WB_WOUT);
        for (int i = gtid; i < 1024 * 12 * 16; i += nthr) { const int n = i & 1023, rest = i >> 10, c8 = rest & 15, h = rest >> 4; float a[8] = {0.f, 0.f, 0.f, 0.f, 0.f, 0.f, 0.f, 0.f};
            for (int j = 0; j < 64; ++j) { const float w = wo[(size_t)(64 * h + j) * 1024 + n];
#pragma unroll
                for (int cc = 0; cc < 8; ++cc) a[cc] += wuv[((size_t)h * 128 + 8 * c8 + cc) * 64 + j] * w; }
            *(v4u*)(WO + (size_t)n * 1792 + h * 128 + 8 * c8) = pack8(a); }
    }
}

DI f32x4 mfma16(bf16x8 a, bf16x8 b, f32x4 c) { return __builtin_amdgcn_mfma_f32_16x16x32_bf16(a, b, c, 0, 0, 0); }

template <int layer, int ldp, int xq_off, int ldm, int xo_off> DI void phase_xattn(const Ctx& c0, const PV& P, const bf16* __restrict__ PROJ, bf16* __restrict__ MIX) {
    const Ctx c = relaunder(c0);
    const bf16* MKVO = (const bf16*)(P.ws + WB_MKVO);
    const float* xqg = pin(P, I_XQ_NORM) + layer * 64; const float* xkg = pin(P, I_XK_NORM) + layer * 64;
    LAS bf16* Ks = (LAS bf16*)c.lds;
    LAS bf16* Vt = (LAS bf16*)(c.lds + 36864);
    const int lane = c.lane, l15 = lane & 15, g = lane >> 4;
    for (int unit = c.blk; unit < 256; unit += c.G) {
        const int b = unit >> 7, h = (unit >> 5) & 3, tr = unit & 31, tok0 = b * SEQ + tr * 512;
        __syncthreads();
#pragma unroll
        for (int i = 0; i < 4; ++i) { const int p = c.tid + 512 * i, key = p >> 3, ch = p & 7;
            const bf16* src = MKVO + (size_t)(b * 256 + key) * 512 + h * 64 + ch * 8;
            float f[8]; unpack8(*(const v4u*)src, f);
            float ss = 0.f;
#pragma unroll
            for (int j = 0; j < 8; ++j) ss += f[j] * f[j];
            ss += __shfl_xor(ss, 1); ss += __shfl_xor(ss, 2); ss += __shfl_xor(ss, 4);
            const float r = 1.0f / sqrtf(ss * (1.0f / 64.0f) + EPS);
#pragma unroll
            for (int j = 0; j < 8; ++j) f[j] = f[j] * r * xkg[ch * 8 + j];
            *(LAS v4u*)(Ks + key * 72 + ch * 8) = pack8(f);
            const v4u vw = *(const v4u*)(src + 256);
            const unsigned ww[4] = {vw.x, vw.y, vw.z, vw.w};
#pragma unroll
            for (int j = 0; j < 4; ++j) { Vt[(ch * 8 + 2 * j) * 264 + key] = (bf16)(ww[j] & 0xffffu); Vt[(ch * 8 + 2 * j + 1) * 264 + key] = (bf16)(ww[j] >> 16); }
        }
        __syncthreads();
#pragma unroll 1
        for (int tile = c.wave; tile < 32; tile += 8) {
            const int row = tok0 + tile * 16 + l15;
            const bf16* qp = PROJ + (size_t)row * ldp + xq_off + h * 64 + 8 * g;
            float q0[8], q1[8]; unpack8(*(const v4u*)qp, q0); unpack8(*(const v4u*)(qp + 32), q1);
            float ss = 0.f;
#pragma unroll
            for (int j = 0; j < 8; ++j) ss += q0[j] * q0[j] + q1[j] * q1[j];
            ss += __shfl_xor(ss, 16); ss += __shfl_xor(ss, 32);
            const float r = 0.125f / sqrtf(ss * (1.0f / 64.0f) + EPS);
#pragma unroll
            for (int j = 0; j < 8; ++j) { q0[j] = q0[j] * r * xqg[8 * g + j]; q1[j] = q1[j] * r * xqg[32 + 8 * g + j]; }
            const bf16x8 B0 = __builtin_bit_cast(bf16x8, pack8(q0)), B1 = __builtin_bit_cast(bf16x8, pack8(q1));
            f32x4 S[16];
#pragma unroll
            for (int kt = 0; kt < 16; ++kt) {
                const bf16x8 A0 = *(const LAS bf16x8*)(Ks + (16 * kt + l15) * 72 + 8 * g), A1 = *(const LAS bf16x8*)(Ks + (16 * kt + l15) * 72 + 32 + 8 * g);
                f32x4 z = {0.f, 0.f, 0.f, 0.f}; z = mfma16(A0, B0, z); S[kt] = mfma16(A1, B1, z);
                if ((kt & 3) == 3) __builtin_amdgcn_sched_barrier(0);
            }
            float mx = -3.0e38f;
#pragma unroll
            for (int kt = 0; kt < 16; ++kt) mx = fmaxf(mx, fmaxf(fmaxf(S[kt][0], S[kt][1]), fmaxf(S[kt][2], S[kt][3])));
            mx = fmaxf(mx, __shfl_xor(mx, 16)); mx = fmaxf(mx, __shfl_xor(mx, 32));
            float l = 0.f;
#pragma unroll
            for (int kt = 0; kt < 16; ++kt) {
#pragma unroll
                for (int i = 0; i < 4; ++i) { const float p = __expf(S[kt][i] - mx); S[kt][i] = p; l += p; } }
            l += __shfl_xor(l, 16); l += __shfl_xor(l, 32);
            f32x4 O[4];
#pragma unroll
            for (int dt = 0; dt < 4; ++dt) O[dt] = (f32x4){0.f, 0.f, 0.f, 0.f};
#pragma unroll
            for (int jb = 0; jb < 8; ++jb) {
                v4u pw; pw.x = pk2(S[2 * jb][0], S[2 * jb][1]); pw.y = pk2(S[2 * jb][2], S[2 * jb][3]); pw.z = pk2(S[2 * jb + 1][0], S[2 * jb + 1][1]); pw.w = pk2(S[2 * jb + 1][2], S[2 * jb + 1][3]);
                const bf16x8 Pb = __builtin_bit_cast(bf16x8, pw);
#pragma unroll
                for (int dt = 0; dt < 4; ++dt) { const LAS bf16* vp = Vt + (16 * dt + l15) * 264 + 32 * jb + 4 * g;
                    const v2u a0 = *(const LAS v2u*)vp, a1 = *(const LAS v2u*)(vp + 16);
                    v4u aw; aw.x = a0.x; aw.y = a0.y; aw.z = a1.x; aw.w = a1.y;
                    O[dt] = mfma16(__builtin_bit_cast(bf16x8, aw), Pb, O[dt]); }
                __builtin_amdgcn_sched_barrier(0);
            }
            const float il = 1.0f / l;
            bf16* op = MIX + (size_t)row * ldm + xo_off + h * 64 + 4 * g;
#pragma unroll
            for (int dt = 0; dt < 4; ++dt) { v2u o; o.x = pk2(O[dt][0] * il, O[dt][1] * il); o.y = pk2(O[dt][2] * il, O[dt][3] * il); *(v2u*)(op + 16 * dt) = o; }
        }
    }
}

DI void phase_conv(const Ctx& c0, const PV& P) {
    const Ctx c = relaunder(c0);
    const bf16* PROJ = (const bf16*)(P.ws + AR_PROJ); bf16* XSC = (bf16*)(P.ws + AR_XSC);
    const float* cw = pin(P, I_LRU_CONV_W); const float* cb = pin(P, I_LRU_CONV_B);
    const int gtid = c.blk * 512 + c.tid, nthr = c.G * 512;
    for (int i = gtid; i < NTOK * 96; i += nthr) { const int row = i / 96, c8 = i % 96, t = row & (SEQ - 1); float a[8];
#pragma unroll
        for (int j = 0; j < 8; ++j) a[j] = cb[8 * c8 + j];
#pragma unroll
        for (int k = 0; k < 4; ++k) { if (t - 3 + k >= 0) { float f[8]; unpack8(*(const v4u*)(PROJ + (size_t)(row - 3 + k) * 1792 + 8 * c8), f);
#pragma unroll
                for (int j = 0; j < 8; ++j) a[j] += cw[k * 768 + 8 * c8 + j] * f[j]; } }
        *(v4u*)(XSC + (size_t)row * 768 + 8 * c8) = pack8(a); }
}
DI void phase_scanA(const Ctx& c0, const PV& P) {
    const Ctx c = relaunder(c0);
    const bf16* LA = (const bf16*)(P.ws + AR_LA); const bf16* UU = (const bf16*)(P.ws + AR_UU); float* SA = (float*)(P.ws + AR_SA); float* SH = (float*)(P.ws + AR_SH);
    const int gtid = c.blk * 512 + c.tid, nthr = c.G * 512;
    for (int i = gtid; i < 512 * 192; i += nthr) { const int chunk = i / 192, c4 = i % 192; float h[4] = {0.f, 0.f, 0.f, 0.f}, sl[4] = {0.f, 0.f, 0.f, 0.f};
        const size_t base = (size_t)chunk * 64 * 768 + 4 * c4;
#pragma unroll 8
        for (int r = 0; r < 64; ++r) { const v2u lw = *(const v2u*)(LA + base + (size_t)r * 768), uw = *(const v2u*)(UU + base + (size_t)r * 768);
            const float l4[4] = {bflo(lw.x), bfhi(lw.x), bflo(lw.y), bfhi(lw.y)}, u4[4] = {bflo(uw.x), bfhi(uw.x), bflo(uw.y), bfhi(uw.y)};
#pragma unroll
            for (int j = 0; j < 4; ++j) { h[j] = __expf(l4[j]) * h[j] + u4[j]; sl[j] += l4[j]; } }
        *(f32x4*)(SA + (size_t)chunk * 768 + 4 * c4) = (f32x4){__expf(sl[0]), __expf(sl[1]), __expf(sl[2]), __expf(sl[3])};
        *(f32x4*)(SH + (size_t)chunk * 768 + 4 * c4) = (f32x4){h[0], h[1], h[2], h[3]}; }
}
DI void phase_scanB(const Ctx& c0, const PV& P) {
    const Ctx c = relaunder(c0);
    const float* SA = (const float*)(P.ws + AR_SA); const float* SH = (const float*)(P.ws + AR_SH); float* CARRY = (float*)(P.ws + AR_CARRY);
    LAS float* segP = (LAS float*)c.lds; LAS float* segQ = segP + 512;
    for (int u = c.blk; u < 48; u += c.G) { const int b = u / 24, cg = u % 24, seg = c.tid >> 5, ch = 32 * cg + (c.tid & 31);
        const size_t base = (size_t)(b * 256 + seg * 16) * 768 + ch;
        float A[16], H[16];
#pragma unroll
        for (int i = 0; i < 16; ++i) { A[i] = SA[base + (size_t)i * 768]; H[i] = SH[base + (size_t)i * 768]; }
        float Pp[16], Qq[16]; float pp = 1.f, qq = 0.f;
#pragma unroll
        for (int i = 0; i < 16; ++i) { Pp[i] = pp; Qq[i] = qq; qq = A[i] * qq + H[i]; pp = A[i] * pp; }
        __syncthreads();
        segP[c.tid] = pp; segQ[c.tid] = qq;
        __syncthreads();
        float hin = 0.f;
        for (int s = 0; s < seg; ++s) hin = segP[s * 32 + (c.tid & 31)] * hin + segQ[s * 32 + (c.tid & 31)];
#pragma unroll
        for (int i = 0; i < 16; ++i) CARRY[base + (size_t)i * 768] = Pp[i] * hin + Qq[i];
    }
}
DI void phase_scanC(const Ctx& c0, const PV& P) {
    const Ctx c = relaunder(c0);
    const bf16* LA = (const bf16*)(P.ws + AR_LA); const bf16* UU = (const bf16*)(P.ws + AR_UU); const float* CARRY = (const float*)(P.ws + AR_CARRY);
    const bf16* PROJ = (const bf16*)(P.ws + AR_PROJ); bf16* MIX = (bf16*)(P.ws + AR_MIXL);
    const int gtid = c.blk * 512 + c.tid, nthr = c.G * 512;
    for (int i = gtid; i < 512 * 192; i += nthr) { const int chunk = i / 192, c4 = i % 192;
        const f32x4 h0 = *(const f32x4*)(CARRY + (size_t)chunk * 768 + 4 * c4); float h[4] = {h0.x, h0.y, h0.z, h0.w};
        const size_t base = (size_t)chunk * 64 * 768 + 4 * c4;
#pragma unroll 8
        for (int r = 0; r < 64; ++r) { const size_t row = (size_t)chunk * 64 + r;
            const v2u lw = *(const v2u*)(LA + base + (size_t)r * 768), uw = *(const v2u*)(UU + base + (size_t)r * 768), gw = *(const v2u*)(PROJ + row * 1792 + 768 + 4 * c4);
            const float l4[4] = {bflo(lw.x), bfhi(lw.x), bflo(lw.y), bfhi(lw.y)}, u4[4] = {bflo(uw.x), bfhi(uw.x), bflo(uw.y), bfhi(uw.y)}, g4[4] = {bflo(gw.x), bfhi(gw.x), bflo(gw.y), bfhi(gw.y)};
            float y[4];
#pragma unroll
            for (int j = 0; j < 4; ++j) { h[j] = __expf(l4[j]) * h[j] + u4[j]; y[j] = h[j] * g4[j]; }
            v2u o; o.x = pk2(y[0], y[1]); o.y = pk2(y[2], y[3]); *(v2u*)(MIX + row * 1024 + 4 * c4) = o; }
    }
}

template <int layer> DI void phase_norm2(const Ctx& c0, const PV& P) {
    const Ctx c = relaunder(c0);
    const float* g = pin(P, I_NORM_FFN) + layer * 1024; bf16* HN = (bf16*)(P.ws + WS_HN);
    for (int r = c.gw; r < NTOK; r += c.NGW) { f32x4 v[4]; rms_row(P.out + (size_t)r * 1024, g, HN + (size_t)r * 1024, c.lane, v); }
}
template <int layer> DI void phase_route(const Ctx& c0, const PV& P) {
    const Ctx c = relaunder(c0);
    const float* LOG = (const float*)(P.ws + AR_LOG); int* EID = (int*)(P.ws + AR_EID); float* GATE = (float*)(P.ws + AR_GATE);
    const float* bg = pin(P, I_MOE_B_GROUP) + layer * 4; const float* br = pin(P, I_MOE_B_ROUTER) + layer * 32;
    unsigned* ctl = (unsigned*)(P.ws + WS_CTL);
    LAS unsigned* hist = (LAS unsigned*)c.lds;
    if (c.tid < 32) hist[c.tid] = 0u;
    __syncthreads();
    for (int t = c.blk * 512 + c.tid; t < NTOK; t += c.G * 512) {
        const f32x4 lg = *(const f32x4*)(LOG + (size_t)t * 64);
        const float l0 = lg.x + bg[0], l1 = lg.y + bg[1], l2 = lg.z + bg[2], l3 = lg.w + bg[3];
        int gs = 0; float gm = l0;
        if (l1 > gm) { gm = l1; gs = 1; } if (l2 > gm) { gm = l2; gs = 2; } if (l3 > gm) { gm = l3; gs = 3; }
        const float pg = 1.0f / (__expf(l0 - gm) + __expf(l1 - gm) + __expf(l2 - gm) + __expf(l3 - gm));
        const f32x4 ea = *(const f32x4*)(LOG + (size_t)t * 64 + 4 + 8 * gs), eb = *(const f32x4*)(LOG + (size_t)t * 64 + 8 + 8 * gs);
        const f32x4 ba = *(const f32x4*)(br + 8 * gs), bb = *(const f32x4*)(br + 8 * gs + 4);
        const float el[8] = {ea.x + ba.x, ea.y + ba.y, ea.z + ba.z, ea.w + ba.w, eb.x + bb.x, eb.y + bb.y, eb.z + bb.z, eb.w + bb.w};
        int i1 = 0; float m1 = el[0];
#pragma unroll
        for (int j = 1; j < 8; ++j) if (el[j] > m1) { m1 = el[j]; i1 = j; }
        int i2 = -1; float m2 = -3.0e38f;
#pragma unroll
        for (int j = 0; j < 8; ++j) if (j != i1 && el[j] > m2) { m2 = el[j]; i2 = j; }
        const float e2 = __expf(m2 - m1), inv = pg / (1.0f + e2);
        const int e1id = 8 * gs + i1, e2id = 8 * gs + i2;
        EID[2 * t] = e1id; EID[2 * t + 1] = e2id; GATE[2 * t] = inv; GATE[2 * t + 1] = e2 * inv;
        lds_add(&hist[e1id], 1u); lds_add(&hist[e2id], 1u);
    }
    __syncthreads();
    if (c.tid < 32 && hist[c.tid]) atomicAdd(ctl + CW_CNT + layer * CW_LSTRIDE + c.tid, hist[c.tid]);
}
template <int layer> DI void phase_scatter(const Ctx& c0, const PV& P) {
    const Ctx c = relaunder(c0);
    unsigned* ctl = (unsigned*)(P.ws + WS_CTL);
    const int* EID = (const int*)(P.ws + AR_EID); int* DEST = (int*)(P.ws + AR_DEST);
    const bf16* HN = (const bf16*)(P.ws + WS_HN); bf16* XS = (bf16*)(P.ws + AR_XS);
    LAS int* cnt = (LAS int*)c.lds; LAS int* pstart = cnt + 32; LAS unsigned* hist = (LAS unsigned*)(cnt + 64); LAS unsigned* base = hist + 32; LAS unsigned* lcnt = base + 32; LAS int* dl = (LAS int*)(lcnt + 32);
    __syncthreads();
    if (c.tid < 32) cnt[c.tid] = (int)ctl[CW_CNT + layer * CW_LSTRIDE + c.tid];
    __syncthreads();
    if (c.tid == 0) { int acc = 0; for (int e = 0; e < 32; ++e) { pstart[e] = acc; acc += (cnt[e] + 255) & ~255; }
        if (c.blk == 0) { ctl[CW_NT + layer * CW_LSTRIDE] = (unsigned)(acc >> 8);
            for (int e = 0; e < 32; ++e) { const int t0 = pstart[e] >> 8, t1 = (pstart[e] + ((cnt[e] + 255) & ~255)) >> 8; for (int t = t0; t < t1; ++t) ctl[CW_TE + layer * CW_TE_STRIDE + t] = (unsigned)e; } } }
    __syncthreads();
    for (int tb = c.blk; tb < NTOK / 128; tb += c.G) {
        if (c.tid < 32) { hist[c.tid] = 0u; lcnt[c.tid] = 0u; }
        __syncthreads();
        int e = 0, t = 0;
        if (c.tid < 256) { t = tb * 128 + (c.tid >> 1); e = EID[2 * t + (c.tid & 1)]; lds_add(&hist[e], 1u); }
        __syncthreads();
        if (c.tid < 32) base[c.tid] = hist[c.tid] ? atomicAdd(ctl + CW_CUR + layer * CW_LSTRIDE + c.tid, hist[c.tid]) : 0u;
        __syncthreads();
        if (c.tid < 256) { const unsigned rank = lds_add(&lcnt[e], 1u); const int d = pstart[e] + (int)base[e] + (int)rank; DEST[2 * t + (c.tid & 1)] = d; dl[c.tid] = d; }
        __syncthreads();
        for (int a = c.wave * 32; a < c.wave * 32 + 32; ++a) { const int tt = tb * 128 + (a >> 1), d = dl[a];
            const v4u* s = (const v4u*)(HN + (size_t)tt * 1024) + c.lane; v4u* o = (v4u*)(XS + (size_t)d * 1024) + c.lane;
            const v4u x0 = s[0], x1 = s[64]; o[0] = x0; o[64] = x1; }
        __syncthreads();
    }
    for (int e = 0; e < 32; ++e) { const int npad = ((cnt[e] + 255) & ~255) - cnt[e], r0 = pstart[e] + cnt[e];
        for (int r = c.gw; r < npad; r += c.NGW) { v4u* o = (v4u*)(XS + (size_t)(r0 + r) * 1024) + c.lane; const v4u z = {0u, 0u, 0u, 0u}; o[0] = z; o[64] = z; } }
}
DI void phase_combine(const Ctx& c0, const PV& P) {
    const Ctx c = relaunder(c0);
    const int* DEST = (const int*)(P.ws + AR_DEST); const float* GATE = (const float*)(P.ws + AR_GATE); const bf16* Y = (const bf16*)(P.ws + AR_XS);
    for (int t = c.gw; t < NTOK; t += c.NGW) { const int d0 = DEST[2 * t], d1 = DEST[2 * t + 1]; const float g0 = GATE[2 * t], g1 = GATE[2 * t + 1];
        f32x4* op = (f32x4*)(P.out + (size_t)t * 1024) + c.lane; const v2u* y0 = (const v2u*)(Y + (size_t)d0 * 1024) + c.lane; const v2u* y1 = (const v2u*)(Y + (size_t)d1 * 1024) + c.lane;
#pragma unroll
        for (int j = 0; j < 4; ++j) { f32x4 o = op[64 * j]; const v2u a = y0[64 * j], b = y1[64 * j];
            o.x += g0 * bflo(a.x) + g1 * bflo(b.x); o.y += g0 * bfhi(a.x) + g1 * bfhi(b.x); o.z += g0 * bflo(a.y) + g1 * bflo(b.y); o.w += g0 * bfhi(a.y) + g1 * bfhi(b.y); op[64 * j] = o; } }
}

DI void phase_dsaprep(const Ctx& c0, const PV& P) {
    const Ctx c = relaunder(c0);
    const bf16* PROJ = (const bf16*)(P.ws + AR_PROJ); bf16* KN = (bf16*)(P.ws + AR_KN); bf16* KIN = (bf16*)(P.ws + AR_KIN); bf16* QIW = (bf16*)(P.ws + AR_QIW);
    const float* WI = (const float*)(P.ws + AR_WI); const float* kg = pin(P, I_DSA_K_NORM);
    const int l = c.lane;
    for (int row = c.gw; row < NTOK; row += c.NGW) {
        const int col = l < 8 ? 768 + 8 * l : (l < 16 ? 1216 + 8 * (l - 8) : 960 + 8 * (l - 16));
        float f[8] = {0.f, 0.f, 0.f, 0.f, 0.f, 0.f, 0.f, 0.f};
        if (l < 48) unpack8(*(const v4u*)(PROJ + (size_t)row * 1536 + col), f);
        float ss = 0.f;
#pragma unroll
        for (int j = 0; j < 8; ++j) ss += f[j] * f[j];
        ss += __shfl_xor(ss, 1); ss += __shfl_xor(ss, 2); ss += __shfl_xor(ss, 4);
        const float r = 1.0f / sqrtf(ss * (1.0f / 64.0f) + EPS);
        if (l < 8) {
#pragma unroll
            for (int j = 0; j < 8; ++j) f[j] = f[j] * r * kg[8 * l + j];
            *(v4u*)(KN + (size_t)row * 64 + 8 * l) = pack8(f);
        } else if (l < 16) {
#pragma unroll
            for (int j = 0; j < 8; ++j) f[j] *= r;
            *(v4u*)(KIN + (size_t)row * 64 + 8 * (l - 8)) = pack8(f);
        } else if (l < 48) {
            const float w = WI[(size_t)row * 4 + ((l - 16) >> 3)] * 0.125f;
#pragma unroll
            for (int j = 0; j < 8; ++j) f[j] *= w;
            *(v4u*)(QIW + (size_t)row * 256 + 8 * (l - 16)) = pack8(f);
        }
    }
}
DI unsigned idx_compact(LAS unsigned* qb, LAS unsigned* hist, int n, int lane) {
    unsigned e[8];
#pragma unroll
    for (int i = 0; i < 8; ++i) { const int idx = lane + 64 * i; e[i] = idx < n ? qb[idx] : 0u; }
    unsigned prefix = 0u, maskbits = 0u; int want = 256;
#pragma unroll
    for (int pass = 0; pass < 4; ++pass) { const int shift = 24 - 8 * pass;
        *(LAS v4u*)(hist + 4 * lane) = (v4u){0u, 0u, 0u, 0u};
        LDS_WAIT();
#pragma unroll
        for (int i = 0; i < 8; ++i) if (e[i] != 0u && (e[i] & maskbits) == prefix) lds_add(&hist[(e[i] >> shift) & 255u], 1u);
        LDS_WAIT();
        const v4u h4 = *(const LAS v4u*)(hist + 4 * lane);
        LDS_WAIT();
        const int s = (int)(h4.x + h4.y + h4.z + h4.w); int x = s;
#pragma unroll
        for (int d = 1; d < 64; d <<= 1) { const int y = __shfl_down(x, d); if (lane + d < 64) x += y; }
        const int c3 = x - s, c2 = c3 + (int)h4.w, c1 = c2 + (int)h4.z, c0 = c1 + (int)h4.y;
        int fb = -1, fa = 0;
        if (c3 < want && want <= c3 + (int)h4.w) { fb = 3; fa = c3; }
        else if (c2 < want && want <= c2 + (int)h4.z) { fb = 2; fa = c2; }
        else if (c1 < want && want <= c1 + (int)h4.y) { fb = 1; fa = c1; }
        else if (c0 < want && want <= c0 + (int)h4.x) { fb = 0; fa = c0; }
        const unsigned long long m = __ballot(fb >= 0);
        const int src = m ? (int)__builtin_ctzll(m) : 0;
        const int bin = __shfl(4 * lane + fb, src), ab = __shfl(fa, src);
        prefix |= (unsigned)bin << shift; maskbits |= 0xFFu << shift; want -= ab;
    }
    int base = 0;
#pragma unroll
    for (int i = 0; i < 8; ++i) { const bool pred = e[i] >= prefix && e[i] != 0u; const unsigned long long m = __ballot(pred);
        const int pos = base + (int)__builtin_amdgcn_mbcnt_hi((unsigned)(m >> 32), __builtin_amdgcn_mbcnt_lo((unsigned)m, 0u));
        if (pred) qb[pos] = e[i];
        base += (int)__builtin_popcountll(m); }
    LDS_WAIT();
    return prefix;
}
DI void phase_indexer(const Ctx& c0, const PV& P) {
    const Ctx c = relaunder(c0);
    const bf16* KIN = (const bf16*)(P.ws + AR_KIN); const bf16* QIW = (const bf16*)(P.ws + AR_QIW); const float* WI = (const float*)(P.ws + AR_WI); int* SEL = (int*)(P.ws + AR_SEL);
    LAS unsigned* buf = (LAS unsigned*)(c.lds + c.wave * 17408);
    LAS unsigned* hist = buf + 4096;
    const int lane = c.lane, hh = lane >> 5, l31 = lane & 31;
    const float INF = __builtin_inff();
    for (int pair = c.blk; pair < 256; pair += c.G) {
        const int b = pair >> 7, jj = pair & 127;
        for (int half = 0; half < 2; ++half) {
            const int unit = half ? (255 - jj) : jj, t0w = unit * 64 + c.wave * 8, rowbase = b * SEQ;
            bf16x8 A[4];
#pragma unroll
            for (int ks = 0; ks < 4; ++ks) A[ks] = *(const bf16x8*)(QIW + (size_t)(rowbase + t0w + (l31 >> 2)) * 256 + (l31 & 3) * 64 + 16 * ks + 8 * hh);
            float lo[4][4], hi[4][4]; unsigned tau[4]; int cnt[4], tq[4];
#pragma unroll
            for (int j = 0; j < 4; ++j) { tq[j] = t0w + 2 * j + hh; tau[j] = 0u; cnt[j] = 0;
                const f32x4 w = *(const f32x4*)(WI + (size_t)(rowbase + tq[j]) * 4);
#pragma unroll
                for (int i = 0; i < 4; ++i) { lo[j][i] = w[i] > 0.f ? 0.f : -INF; hi[j][i] = w[i] > 0.f ? INF : 0.f; } }
            const int ntile = (t0w + 7) / 32 + 1;
            bf16x8 Bn[4];
#pragma unroll
            for (int ks = 0; ks < 4; ++ks) Bn[ks] = *(const bf16x8*)(KIN + (size_t)(rowbase + l31) * 64 + 16 * ks + 8 * hh);
            for (int tile = 0; tile < ntile; ++tile) {
                const int s = tile * 32 + l31;
                bf16x8 B[4];
#pragma unroll
                for (int ks = 0; ks < 4; ++ks) B[ks] = Bn[ks];
                if (tile + 1 < ntile) {
#pragma unroll
                    for (int ks = 0; ks < 4; ++ks) Bn[ks] = *(const bf16x8*)(KIN + (size_t)(rowbase + s + 32) * 64 + 16 * ks + 8 * hh);
                }
                f32x16 acc;
#pragma unroll
                for (int i = 0; i < 16; ++i) acc[i] = 0.f;
#pragma unroll
                for (int ks = 0; ks < 4; ++ks) acc = __builtin_amdgcn_mfma_f32_32x32x16_bf16(A[ks], B[ks], acc, 0, 0, 0);
#pragma unroll
                for (int j = 0; j < 4; ++j) {
                    const float sc = (__builtin_amdgcn_fmed3f(acc[4 * j], lo[j][0], hi[j][0]) + __builtin_amdgcn_fmed3f(acc[4 * j + 1], lo[j][1], hi[j][1]))
                                   + (__builtin_amdgcn_fmed3f(acc[4 * j + 2], lo[j][2], hi[j][2]) + __builtin_amdgcn_fmed3f(acc[4 * j + 3], lo[j][3], hi[j][3]));
                    unsigned u = __float_as_uint(sc); u ^= (unsigned)((int)u >> 31) | 0x80000000u;
                    unsigned key = (u & 0xFFFFC000u) | (unsigned)(16383 - s);
                    if (s > tq[j]) key = 0u;
                    const bool pred = key > tau[j];
                    const unsigned long long m = __ballot(pred);
                    if (m) { const unsigned hm = hh ? (unsigned)(m >> 32) : (unsigned)m;
                        const int rank = __builtin_popcount(hm & ((1u << l31) - 1u));
                        if (pred) buf[(2 * j + hh) * 512 + cnt[j] + rank] = key;
                        cnt[j] += __builtin_popcount(hm); }
                }
#pragma unroll
                for (int j = 0; j < 4; ++j) {
                    const unsigned long long mm = __ballot(cnt[j] > 480);
                    if (mm & 1ull) { const int n = __builtin_amdgcn_readlane(cnt[j], 0); LDS_WAIT(); const unsigned T = idx_compact(buf + (2 * j) * 512, hist, n, lane); if (hh == 0) { tau[j] = T; cnt[j] = 256; } }
                    if ((mm >> 32) & 1ull) { const int n = __builtin_amdgcn_readlane(cnt[j], 32); LDS_WAIT(); const unsigned T = idx_compact(buf + (2 * j + 1) * 512, hist, n, lane); if (hh == 1) { tau[j] = T; cnt[j] = 256; } }
                }
            }
            LDS_WAIT();
#pragma unroll
            for (int j = 0; j < 4; ++j) {
#pragma unroll
                for (int h2 = 0; h2 < 2; ++h2) {
                    int n = __builtin_amdgcn_readlane(cnt[j], h2 * 32);
                    LAS unsigned* qb = buf + (2 * j + h2) * 512;
                    if (n > 256) { (void)idx_compact(qb, hist, n, lane); n = 256; }
                    int* sp = SEL + (size_t)(rowbase + t0w + 2 * j + h2) * 256;
#pragma unroll
                    for (int i = 0; i < 4; ++i) { const int idx = lane + 64 * i; sp[idx] = idx < n ? (16383 - (int)(qb[idx] & 0x3FFFu)) : -1; }
                }
            }
            LDS_WAIT();
        }
    }
}
DI int t5_bucket(int d) {
    if (d < 16) return d;
    return 16 + (d >= 19) + (d >= 21) + (d >= 24) + (d >= 27) + (d >= 31) + (d >= 35) + (d >= 40) + (d >= 46) + (d >= 52) + (d >= 59) + (d >= 67) + (d >= 77) + (d >= 87) + (d >= 99) + (d >= 113);
}
typedef short s16x4 __attribute__((ext_vector_type(4)));
DI void phase_sattn(const Ctx& c0, const PV& P) {
    const Ctx c = relaunder(c0);
    const bf16* PROJ = (const bf16*)(P.ws + AR_PROJ); const bf16* KN = (const bf16*)(P.ws + AR_KN); const int* SEL = (const int*)(P.ws + AR_SEL); bf16* MIX = (bf16*)(P.ws + AR_MIXD);
    const float* qg = pin(P, I_DSA_Q_NORM); const float* rb = pin(P, I_REL_BIAS);
    constexpr int WST = 11264, VRS = 144;
    LAS int* bk = (LAS int*)(c.lds + c.wave * WST);
    LAS int* selL = bk + 256;
    LAS bf16* Vs = (LAS bf16*)(selL + 256);
    LAS float* relb = (LAS float*)(c.lds + 8 * WST);
    const int lane = c.lane, l15 = lane & 15, g = lane >> 4;
    __syncthreads();
    relb[c.tid] = (c.tid & 15) < 12 ? rb[(c.tid >> 4) * 12 + (c.tid & 15)] : 0.f;
    __syncthreads();
    float qgv0[8], qgv1[8];
#pragma unroll
    for (int j = 0; j < 8; ++j) { qgv0[j] = qg[8 * g + j]; qgv1[j] = qg[32 + 8 * g + j]; }
    const LAS bf16* trp = Vs + (4 * g + (l15 >> 2)) * VRS + 4 * (l15 & 3);
    int row = c.gw;
    v4i s4n = {0, 0, 0, 0}; v4u qn0 = {0u, 0u, 0u, 0u}, qn1 = {0u, 0u, 0u, 0u};
    if (row < NTOK) { s4n = *(const v4i*)(SEL + (size_t)row * 256 + 4 * lane);
        if (l15 < 12) { const bf16* qp = PROJ + (size_t)row * 1536 + l15 * 64 + 8 * g; qn0 = *(const v4u*)qp; qn1 = *(const v4u*)(qp + 32); } }
#pragma unroll 1
    for (; row < NTOK; row += c.NGW) {
        const int b = row >> 14, t = row & (SEQ - 1), rowbase = b << 14;
        const v4i s4 = s4n; const v4u w0 = qn0, w1 = qn1;
        { const int nrow = row + c.NGW;
          if (nrow < NTOK) { s4n = *(const v4i*)(SEL + (size_t)nrow * 256 + 4 * lane);
              if (l15 < 12) { const bf16* qp = PROJ + (size_t)nrow * 1536 + l15 * 64 + 8 * g; qn0 = *(const v4u*)qp; qn1 = *(const v4u*)(qp + 32); } } }
        const int sv[4] = {s4.x, s4.y, s4.z, s4.w};
        int bv[4], cv[4];
#pragma unroll
        for (int i = 0; i < 4; ++i) { bv[i] = sv[i] >= 0 ? t5_bucket(t - sv[i]) : -1; cv[i] = sv[i] >= 0 ? sv[i] : 0; }
        *(LAS v4i*)(bk + 4 * lane) = (v4i){bv[0], bv[1], bv[2], bv[3]};
        *(LAS v4i*)(selL + 4 * lane) = (v4i){cv[0], cv[1], cv[2], cv[3]};
        float q0[8], q1[8]; unpack8(w0, q0); unpack8(w1, q1);
        float ss = 0.f;
#pragma unroll
        for (int j = 0; j < 8; ++j) ss += q0[j] * q0[j] + q1[j] * q1[j];
        ss += __shfl_xor(ss, 16); ss += __shfl_xor(ss, 32);
        const float r = 0.125f / sqrtf(ss * (1.0f / 64.0f) + EPS);
#pragma unroll
        for (int j = 0; j < 8; ++j) { q0[j] = q0[j] * r * qgv0[j]; q1[j] = q1[j] * r * qgv1[j]; }
        const bf16x8 B0 = __builtin_bit_cast(bf16x8, pack8(q0)), B1 = __builtin_bit_cast(bf16x8, pack8(q1));
        LDS_WAIT();
        v4u vb[2][8];
#pragma unroll
        for (int i = 0; i < 8; ++i) { const int sk = selL[4 * i + g]; vb[0][i] = *(const v4u*)(PROJ + (size_t)(rowbase + sk) * 1536 + 832 + 8 * l15); }
        f32x4 S[16];
#pragma unroll
        for (int hb = 0; hb < 2; ++hb) {
            bf16x8 A0[8], A1[8];
#pragma unroll
            for (int k8 = 0; k8 < 8; ++k8) { const int sk = selL[16 * (8 * hb + k8) + l15]; const bf16* kp = KN + (size_t)(rowbase + sk) * 64 + 8 * g; A0[k8] = *(const bf16x8*)kp; A1[k8] = *(const bf16x8*)(kp + 32); }
#pragma unroll
            for (int k8 = 0; k8 < 8; ++k8) { f32x4 z = {0.f, 0.f, 0.f, 0.f}; z = mfma16(A0[k8], B0, z); S[8 * hb + k8] = mfma16(A1[k8], B1, z); }
            __builtin_amdgcn_sched_barrier(0);
        }
        float mx = -3.0e38f;
#pragma unroll
        for (int kt = 0; kt < 16; ++kt) { const v4i b4 = *(const LAS v4i*)(bk + 16 * kt + 4 * g); const int bb[4] = {b4.x, b4.y, b4.z, b4.w};
#pragma unroll
            for (int i = 0; i < 4; ++i) { const float v = bb[i] >= 0 ? S[kt][i] + relb[bb[i] * 16 + l15] : -3.0e38f; S[kt][i] = v; mx = fmaxf(mx, v); } }
        mx = fmaxf(mx, __shfl_xor(mx, 16)); mx = fmaxf(mx, __shfl_xor(mx, 32));
        float l = 0.f;
#pragma unroll
        for (int kt = 0; kt < 16; ++kt) {
#pragma unroll
            for (int i = 0; i < 4; ++i) { const float p = S[kt][i] > -1.0e38f ? __expf(S[kt][i] - mx) : 0.f; S[kt][i] = p; l += p; } }
        l += __shfl_xor(l, 16); l += __shfl_xor(l, 32);
        f32x4 O[8];
#pragma unroll
        for (int ct = 0; ct < 8; ++ct) O[ct] = (f32x4){0.f, 0.f, 0.f, 0.f};
#pragma unroll
        for (int jb = 0; jb < 8; ++jb) {
            if (jb + 1 < 8) {
#pragma unroll
                for (int i = 0; i < 8; ++i) { const int sk = selL[32 * (jb + 1) + 4 * i + g]; vb[(jb + 1) & 1][i] = *(const v4u*)(PROJ + (size_t)(rowbase + sk) * 1536 + 832 + 8 * l15); } }
#pragma unroll
            for (int i = 0; i < 8; ++i) { const v4u v = vb[jb & 1][i]; LAS v2u* d = (LAS v2u*)(Vs + (4 * i + g) * VRS + 8 * l15); d[0] = (v2u){v.x, v.y}; d[1] = (v2u){v.z, v.w}; }
            v4u pw; pw.x = pk2(S[2 * jb][0], S[2 * jb][1]); pw.y = pk2(S[2 * jb][2], S[2 * jb][3]); pw.z = pk2(S[2 * jb + 1][0], S[2 * jb + 1][1]); pw.w = pk2(S[2 * jb + 1][2], S[2 * jb + 1][3]);
            const bf16x8 Pb = __builtin_bit_cast(bf16x8, pw);
            LDS_WAIT();
#pragma unroll
            for (int ct = 0; ct < 8; ++ct) {
                const s16x4 a = __builtin_amdgcn_ds_read_tr16_b64_v4i16((LAS s16x4*)(trp + 16 * ct));
                const s16x4 bq = __builtin_amdgcn_ds_read_tr16_b64_v4i16((LAS s16x4*)(trp + 16 * VRS + 16 * ct));
                const bf16x8 Af = {a[0], a[1], a[2], a[3], bq[0], bq[1], bq[2], bq[3]};
                O[ct] = mfma16(Af, Pb, O[ct]); }
            LDS_WAIT();
            __builtin_amdgcn_sched_barrier(0);
        }
        if (l15 < 12) { const float il = 1.0f / l; bf16* op = MIX + (size_t)row * 1792 + l15 * 128 + 4 * g;
#pragma unroll
            for (int ct = 0; ct < 8; ++ct) { v2u o; o.x = pk2(O[ct][0] * il, O[ct][1] * il); o.y = pk2(O[ct][2] * il, O[ct][3] * il); *(v2u*)(op + 16 * ct) = o; } }
        LDS_WAIT();
    }
}

#ifndef ONLY
#define ONLY -1
#endif
#define PH(n) (ONLY < 0 || ONLY == (n))
#ifndef REP0
#define REP0 1
#endif
#ifndef REP1
#define REP1 1
#endif
#ifndef REP2
#define REP2 1
#endif
#ifndef REP3
#define REP3 1
#endif
#ifndef REP4
#define REP4 1
#endif
#ifndef REP5
#define REP5 1
#endif
#ifndef REP6
#define REP6 1
#endif
#ifndef REP7
#define REP7 1
#endif
#ifndef REP8
#define REP8 1
#endif
#ifndef REP9
#define REP9 1
#endif
#ifndef REP10
#define REP10 1
#endif
#ifndef REP11
#define REP11 1
#endif
#ifndef REP12
#define REP12 1
#endif
#ifndef REP13
#define REP13 1
#endif
#ifndef REP14
#define REP14 1
#endif
#ifndef REP15
#define REP15 1
#endif
#ifndef REP16
#define REP16 1
#endif
#ifndef REP17
#define REP17 1
#endif
#ifndef REP18
#define REP18 1
#endif
#define RB(n) for (int r_ = 0; r_ < REP##n; ++r_) { if (r_) GRID_BAR();
#define RE }
#define GRID_BAR() xcd_barrier(bar)
template <int layer> DI void layer_body(const Ctx& c, const PV& P, const XcdBarrier& bar) {
    unsigned char* ws = P.ws;
    unsigned* ctl = (unsigned*)(ws + WS_CTL);
    PG8_LAS unsigned char* glds = (PG8_LAS unsigned char*)c.lds;
    const pg8::bf16_t* HN = (const pg8::bf16_t*)(ws + WS_HN);
    RB(0) if (PH(0)) phase_prep<layer>(c, P); RE
    GRID_BAR();
    RB(1) if (PH(1)) {
        { pg8::Gemm g{(const pg8::bf16_t*)(ws + WB_MEMN), (const pg8::bf16_t*)(ws + WB_MKV), 1024, 1024, 1024}; pg8::StaticOrder S; S.init(2, 2, c.G, c.G - 1 - c.blk);
          pg8::EpiBf16<false> E{(pg8::bf16_t*)(ws + WB_MKVO), 512, 0, 0};
          pg8::gemm_phase<pg8::EpiBf16<false>, pg8::StaticOrder, true, true>(glds, g, S, E); }
        __syncthreads();
        if (layer == 0) { pg8::Gemm g{HN, (const pg8::bf16_t*)(ws + WB_WIN), 1024, 1024, 1024}; pg8::StaticOrder S; S.init(128, 7, c.G, c.blk);
          pg8::EpiBf16<true> E{(pg8::bf16_t*)(ws + AR_PROJ), 1792, 3, 6};
          pg8::gemm_phase<pg8::EpiBf16<true>, pg8::StaticOrder, true, true>(glds, g, S, E); }
        else { pg8::Gemm g{HN, (const pg8::bf16_t*)(ws + WB_WIN), 1024, 1024, 1024}; pg8::StaticOrder S; S.init(128, 6, c.G, c.blk);
          pg8::EpiBf16<false> E{(pg8::bf16_t*)(ws + AR_PROJ), 1536, 0, 0};
          pg8::gemm_phase<pg8::EpiBf16<false>, pg8::StaticOrder, true, true>(glds, g, S, E); }
    } RE
    GRID_BAR();
    if (layer == 0) {
        RB(2) if (PH(2)) phase_conv(c, P);
        if (PH(2)) phase_xattn<0, 1792, 1536, 1024, 768>(c, P, (const bf16*)(ws + AR_PROJ), (bf16*)(ws + AR_MIXL)); RE
        GRID_BAR();
        RB(3) if (PH(3)) { pg8::Gemm g{(const pg8::bf16_t*)(ws + AR_XSC), (const pg8::bf16_t*)(ws + WB_WGT), 768, 768, 768}; pg8::StaticOrder S; S.init(128, 6, c.G, c.blk);
          pg8::EpiLruGate E{(pg8::bf16_t*)(ws + AR_LA), (pg8::bf16_t*)(ws + AR_UU), (const pg8::bf16_t*)(ws + AR_XSC), 768, pin(P, I_LRU_B_A), pin(P, I_LRU_B_X), pin(P, I_LRU_LAMBDA)};
          pg8::gemm_phase<pg8::EpiLruGate, pg8::StaticOrder, true, true>(glds, g, S, E); } RE
        GRID_BAR();
        RB(4) if (PH(4)) phase_scanA(c, P); RE
        GRID_BAR();
        RB(5) if (PH(5)) phase_scanB(c, P); RE
        GRID_BAR();
        RB(6) if (PH(6)) phase_scanC(c, P); RE
        GRID_BAR();
        RB(7) if (PH(7)) { pg8::Gemm g{(const pg8::bf16_t*)(ws + AR_MIXL), (const pg8::bf16_t*)(ws + WB_WOUT), 1024, 1024, 1024}; pg8::StaticOrder S; S.init(128, 4, c.G, c.blk);
          pg8::EpiResF32 E{P.out, pin(P, I_X), 1024};
          pg8::gemm_phase<pg8::EpiResF32, pg8::StaticOrder, true, true>(glds, g, S, E); } RE
    } else {
        RB(8) if (PH(8)) phase_dsaprep(c, P);
        if (PH(8)) phase_xattn<1, 1536, 1280, 1792, 1536>(c, P, (const bf16*)(ws + AR_PROJ), (bf16*)(ws + AR_MIXD)); RE
        GRID_BAR();
        RB(9) if (PH(9)) phase_indexer(c, P); RE
        GRID_BAR();
        RB(10) if (PH(10)) phase_sattn(c, P); RE
        GRID_BAR();
        RB(11) if (PH(11)) { pg8::Gemm g{(const pg8::bf16_t*)(ws + AR_MIXD), (const pg8::bf16_t*)(ws + WB_WOUT), 1792, 1792, 1792}; pg8::StaticOrder S; S.init(128, 4, c.G, c.blk);
          pg8::EpiResF32 E{(r_ + 1 < REP11) ? (float*)(ws + WS_AR) : P.out, P.out, 1024};
          pg8::gemm_phase<pg8::EpiResF32, pg8::StaticOrder, true, true>(glds, g, S, E); } RE
    }
    GRID_BAR();
    RB(12) if (PH(12)) phase_norm2<layer>(c, P); RE
    GRID_BAR();
    RB(13) if (PH(13)) { pg8::Gemm g{HN, (const pg8::bf16_t*)(ws + WB_WR), 1024, 1024, 1024}; pg8::StaticOrder S; S.init(128, 1, c.G, c.blk);
      pg8::EpiLogits E{(float*)(ws + AR_LOG)};
      pg8::gemm_phase<pg8::EpiLogits, pg8::StaticOrder, true, true>(glds, g, S, E); } RE
    GRID_BAR();
    if (PH(14)) phase_route<layer>(c, P);
    GRID_BAR();
    if (PH(15)) phase_scatter<layer>(c, P);
    GRID_BAR();
    RB(16) if (PH(16)) { const int ntile = (int)__hip_atomic_load(ctl + CW_NT + layer * CW_LSTRIDE, RLX_AGENT);
        pg8::Gemm g{(const pg8::bf16_t*)(ws + AR_XS), (const pg8::bf16_t*)(ws + WB_WGU), 1024, 1024, 1024}; pg8::GroupedOrder S; S.init(ntile, 4, c.G, c.blk);
        S.te = (const int*)(ctl + CW_TE + layer * CW_TE_STRIDE); S.estride = (size_t)1024 * 1024 * 2;
        pg8::EpiSwiglu E{(pg8::bf16_t*)(ws + AR_ACT), 512};
        pg8::gemm_phase<pg8::EpiSwiglu, pg8::GroupedOrder, true, true>(glds, g, S, E); } RE
    GRID_BAR();
    RB(17) if (PH(17)) { const int ntile = (int)__hip_atomic_load(ctl + CW_NT + layer * CW_LSTRIDE, RLX_AGENT);
        pg8::Gemm g{(const pg8::bf16_t*)(ws + AR_ACT), (const pg8::bf16_t*)(ws + WB_WD), 512, 512, 512}; pg8::GroupedOrder S; S.init(ntile, 4, c.G, c.blk);
        S.te = (const int*)(ctl + CW_TE + layer * CW_TE_STRIDE); S.estride = (size_t)1024 * 512 * 2;
        pg8::EpiBf16<false> E{(pg8::bf16_t*)(ws + AR_XS), 1024, 0, 0};
        pg8::gemm_phase<pg8::EpiBf16<false>, pg8::GroupedOrder, true, true>(glds, g, S, E); } RE
    GRID_BAR();
    if (PH(18)) phase_combine(c, P);
    GRID_BAR();
}
__global__ void __launch_bounds__(512, 2) fwd(const Params P) {
    extern __shared__ __attribute__((aligned(16))) unsigned char lds_raw[];
    Ctx c;
    c.lds = (LAS unsigned char*)lds_raw;
    c.tid = threadIdx.x; c.lane = c.tid & 63; c.wave = __builtin_amdgcn_readfirstlane(c.tid >> 6);
    c.G = gridDim.x; c.blk = blockIdx.x; c.gw = c.blk * 8 + c.wave; c.NGW = c.G * 8;
    volatile LAS unsigned* MISC = (volatile LAS unsigned*)(c.lds + MISC_OFF);
    if (c.tid < 64) MISC[c.tid] = 0u;
    if (c.tid < 29) ((LAS unsigned long long*)(c.lds + MISC_OFF + 512))[c.tid] = (unsigned long long)P.in[c.tid];
    __syncthreads();
    XcdBarrier bar = xcd_barrier_post((unsigned*)(P.ws + WS_CTL) + CW_BAR, MISC + 8);
    PV pv; pv.ws = P.ws; pv.out = P.out; pv.tab = (LAS unsigned long long*)(c.lds + MISC_OFF + 512);
#ifndef ONLY_LAYER
    layer_body<0>(c, pv, bar);
    layer_body<1>(c, pv, bar);
#else
    layer_body<ONLY_LAYER>(c, pv, bar);
#endif
}

extern "C" void kernel_launch(void* const* d_in, const int* in_sizes, int n_in, void* d_out, int out_size, void* d_ws, size_t ws_size, hipStream_t stream) {
    static int grid = 0;
    if (grid == 0) {
        if (n_in != 29 || out_size != NTOK * DM || ws_size < WS_END) { fprintf(stderr, "kernel_launch: unexpected shapes (n_in %d out %d ws %zu need %zu)\n", n_in, out_size, ws_size, (size_t)WS_END); grid = -1; return; }
        int dev = 0, cus = 0, per_cu = 0;
        if (hipGetDevice(&dev) != hipSuccess || hipDeviceGetAttribute(&cus, hipDeviceAttributeMultiprocessorCount, dev) != hipSuccess) { grid = -1; return; }
        if (hipFuncSetAttribute((const void*)fwd, hipFuncAttributeMaxDynamicSharedMemorySize, LDS_BYTES) != hipSuccess) { fprintf(stderr, "kernel_launch: hipFuncSetAttribute failed\n"); grid = -1; return; }
        if (hipOccupancyMaxActiveBlocksPerMultiprocessor(&per_cu, (const void*)fwd, 512, LDS_BYTES) != hipSuccess || per_cu < 1) { fprintf(stderr, "kernel_launch: occupancy query reports %d\n", per_cu); }
        (void)hipGetLastError();
        grid = cus;
    }
    if (grid < 0) return;
    if (hipMemsetAsync((char*)d_ws + WS_CTL, 0, CTL_ZERO_BYTES, stream) != hipSuccess) return;
    Params p{};
    for (int i = 0; i < 29; ++i) p.in[i] = (const float*)d_in[i];
    p.out = (float*)d_out; p.ws = (unsigned char*)d_ws;
    hipLaunchKernelGGL(fwd, dim3(grid), dim3(512), LDS_BYTES, stream, p);
}
```

```cpp
#include <hip/hip_runtime.h>
#include <cstdio>
#include <cstdint>
namespace pg8 {
#define PG8_LAS __attribute__((address_space(3)))
typedef unsigned short bf16_t;
typedef short bf16x8 __attribute__((ext_vector_type(8)));
typedef float f32x4 __attribute__((ext_vector_type(4)));
typedef float f32x2 __attribute__((ext_vector_type(2)));
typedef unsigned u32x4 __attribute__((ext_vector_type(4)));
constexpr int BM = 256, BK = 64, HALF = 128, HTB = HALF * BK * 2  , STAGE_BYTES = 8 * HTB, NXCD = 8, WGM = 8;

__host__ __device__ __forceinline__ int lds_byte(int r, int c) { const int st = (r >> 4) * 2 + (c >> 5), rr = r & 15, cc = c & 31, ob = rr * 64 + cc * 2; return st * 1024 + (ob ^ (((ob >> 9) & 1) << 5)); }
__host__ __device__ __forceinline__ void stage_rc(int b, int& R, int& C) { const int st = b / 1024, sb = b % 1024, swz = sb ^ (((sb >> 9) & 1) << 5); R = (st >> 1) * 16 + swz / 64; C = (st & 1) * 32 + (swz % 64) / 2; }
__host__ __device__ __forceinline__ int perm32(int rho) { const int n = rho >> 4, i = rho & 15; return 8 * (i >> 2) + 4 * n + (i & 3); }

struct Unit { int pm, pn; size_t boff; };
struct Gemm { const bf16_t* A; const bf16_t* Bt; int lda, ldb, K; };

struct StaticOrder {
    int nM, nN, nwg, G, c;
    __host__ __device__ void init(int nM_, int nN_, int G_, int c_) { nM = nM_; nN = nN_; nwg = nM * nN; G = G_; c = c_; }
    __host__ __device__ bool next(int i, Unit& u) const {
        const long L = (long)i * G + c; if (L >= nwg) return false;
        int wgid = (int)L; { const int q = nwg / NXCD, r = nwg % NXCD, xcd = wgid % NXCD, off = wgid / NXCD; wgid = (xcd < r ? xcd * (q + 1) : r * (q + 1) + (xcd - r) * q) + off; }
        const int nig = WGM * nN, gid = wgid / nig, fm = gid * WGM, gsz = (nM - fm) < WGM ? (nM - fm) : WGM;
        u.pm = fm + ((wgid % nig) % gsz); u.pn = (wgid % nig) / gsz; u.boff = 0; return true;
    }
    __device__ __forceinline__ void a_ready(const Unit&) const {}
    __device__ __forceinline__ void done(const Unit&) const {}
};
struct GroupedOrder : StaticOrder {
    const int* te; size_t estride;
    __device__ bool next(int i, Unit& u) const { if (!StaticOrder::next(i, u)) return false; u.boff = (size_t)te[u.pm] * estride; return true; }
};

__device__ __forceinline__ unsigned cvt_pk_bf16(float lo, float hi) { unsigned r; asm volatile("v_cvt_pk_bf16_f32 %0, %1, %2" : "=v"(r) : "v"(lo), "v"(hi)); return r; }
__device__ __forceinline__ float bf_lo(unsigned w) { return __uint_as_float(w << 16); }
__device__ __forceinline__ float bf_hi(unsigned w) { return __uint_as_float(w & 0xffff0000u); }
__device__ __forceinline__ float sigmoidf_(float v) { return __builtin_amdgcn_rcpf(1.0f + __expf(-v)); }
__device__ __forceinline__ float gelu_tanh(float v) { const float z = 1.5957691216057308f * (v + 0.044715f * v * v * v); return v * sigmoidf_(z); }

template <bool GELU> struct EpiBf16 {
    static constexpr bool PERM = true, AFTER_DRAIN = false;
    bf16_t* O; int ldc; int gelu_lo, gelu_hi;
    __device__ __forceinline__ void operator()(const f32x4 (&acc)[2][2][4][2], const Unit& u, int wr, int wc, int fr, int fq) const {
        const int row0 = u.pm * BM + wr * 64 + fr, col0 = u.pn * BM + wc * 32 + 8 * fq;
        const bool act = GELU && (u.pn >= gelu_lo && u.pn < gelu_hi);
#pragma unroll
        for (int ai = 0; ai < 2; ++ai)
#pragma unroll
            for (int m = 0; m < 4; ++m) { bf16_t* rowp = O + (size_t)(row0 + ai * HALF + m * 16) * ldc + col0;
#pragma unroll
                for (int bj = 0; bj < 2; ++bj) { f32x4 v0 = acc[ai][bj][m][0], v1 = acc[ai][bj][m][1];
                    if (act) {
#pragma unroll
                        for (int j = 0; j < 4; ++j) { v0[j] = gelu_tanh(v0[j]); v1[j] = gelu_tanh(v1[j]); } }
                    u32x4 w; w.x = cvt_pk_bf16(v0[0], v0[1]); w.y = cvt_pk_bf16(v0[2], v0[3]); w.z = cvt_pk_bf16(v1[0], v1[1]); w.w = cvt_pk_bf16(v1[2], v1[3]);
                    *(u32x4*)(rowp + bj * HALF) = w; } }
    }
};
struct EpiSwiglu {
    static constexpr bool PERM = true, AFTER_DRAIN = false;
    bf16_t* O; int ldc;
    __device__ __forceinline__ void operator()(const f32x4 (&acc)[2][2][4][2], const Unit& u, int wr, int wc, int fr, int fq) const {
        const int row0 = u.pm * BM + wr * 64 + fr, col0 = u.pn * HALF + wc * 32 + 8 * fq;
#pragma unroll
        for (int ai = 0; ai < 2; ++ai)
#pragma unroll
            for (int m = 0; m < 4; ++m) { bf16_t* rowp = O + (size_t)(row0 + ai * HALF + m * 16) * ldc + col0;
                f32x4 v0, v1;
#pragma unroll
                for (int j = 0; j < 4; ++j) { const float g0 = acc[ai][0][m][0][j], g1 = acc[ai][0][m][1][j];
                    v0[j] = g0 * sigmoidf_(g0) * acc[ai][1][m][0][j]; v1[j] = g1 * sigmoidf_(g1) * acc[ai][1][m][1][j]; }
                u32x4 w; w.x = cvt_pk_bf16(v0[0], v0[1]); w.y = cvt_pk_bf16(v0[2], v0[3]); w.z = cvt_pk_bf16(v1[0], v1[1]); w.w = cvt_pk_bf16(v1[2], v1[3]);
                *(u32x4*)rowp = w; }
    }
};
struct EpiLruGate {
    static constexpr bool PERM = true, AFTER_DRAIN = false;
    bf16_t* LA; bf16_t* U; const bf16_t* XS; int ldc; const float* b_a; const float* b_x; const float* lam;
    __device__ __forceinline__ void operator()(const f32x4 (&acc)[2][2][4][2], const Unit& u, int wr, int wc, int fr, int fq) const {
        const int row0 = u.pm * BM + wr * 64 + fr, ch0 = u.pn * HALF + wc * 32 + 8 * fq;
        float ba[8], bx[8], sp8[8];
#pragma unroll
        for (int j = 0; j < 8; ++j) { ba[j] = b_a[ch0 + j]; bx[j] = b_x[ch0 + j]; const float l = lam[ch0 + j];
            sp8[j] = 8.0f * ((l > 15.f) ? __expf(-l) : __logf(1.0f + __expf(-l))); }
#pragma unroll
        for (int ai = 0; ai < 2; ++ai)
#pragma unroll
            for (int m = 0; m < 4; ++m) { const size_t off = (size_t)(row0 + ai * HALF + m * 16) * ldc + ch0;
                const u32x4 xw = *(const u32x4*)(XS + off);
                float xv[8] = {bf_lo(xw.x), bf_hi(xw.x), bf_lo(xw.y), bf_hi(xw.y), bf_lo(xw.z), bf_hi(xw.z), bf_lo(xw.w), bf_hi(xw.w)};
                float la[8], uu[8];
#pragma unroll
                for (int j = 0; j < 8; ++j) { const float rp = acc[ai][0][m][j >> 2][j & 3] + ba[j], ip = acc[ai][1][m][j >> 2][j & 3] + bx[j];
                    const float r = sigmoidf_(rp), ig = sigmoidf_(ip);
                    const float l = -sp8[j] * r; const float t = 2.0f * l;
                    const float om = (t > -0.02f) ? -t * (1.0f + t * (0.5f + t * (0.16666667f + t * 0.041666667f))) : 1.0f - __expf(t);
                    la[j] = l; uu[j] = sqrtf(om) * ig * xv[j]; }
                u32x4 w; w.x = cvt_pk_bf16(la[0], la[1]); w.y = cvt_pk_bf16(la[2], la[3]); w.z = cvt_pk_bf16(la[4], la[5]); w.w = cvt_pk_bf16(la[6], la[7]);
                *(u32x4*)(LA + off) = w;
                u32x4 w2; w2.x = cvt_pk_bf16(uu[0], uu[1]); w2.y = cvt_pk_bf16(uu[2], uu[3]); w2.z = cvt_pk_bf16(uu[4], uu[5]); w2.w = cvt_pk_bf16(uu[6], uu[7]);
                *(u32x4*)(U + off) = w2; __builtin_amdgcn_sched_barrier(0); }
    }
};
struct EpiResF32 {
    static constexpr bool PERM = false, AFTER_DRAIN = false;
    float* C; const float* R; int ldc;
    __device__ __forceinline__ void operator()(const f32x4 (&acc)[2][2][4][2], const Unit& u, int wr, int wc, int fr, int fq) const {
        const int row0 = u.pm * BM + wr * 64 + fr, col0 = u.pn * BM + wc * 32 + 4 * fq;
#pragma unroll
        for (int ai = 0; ai < 2; ++ai)
#pragma unroll
            for (int m = 0; m < 4; ++m) { const size_t ro = (size_t)(row0 + ai * HALF + m * 16) * ldc + col0;
#pragma unroll
                for (int bj = 0; bj < 2; ++bj)
#pragma unroll
                    for (int n = 0; n < 2; ++n) { const f32x4 r = *(const f32x4*)(R + ro + bj * HALF + n * 16); *(f32x4*)(C + ro + bj * HALF + n * 16) = r + acc[ai][bj][m][n]; }  __builtin_amdgcn_sched_barrier(0); }
    }
};
struct EpiLogits {
    static constexpr bool PERM = false, AFTER_DRAIN = false;
    float* C;
    __device__ __forceinline__ void operator()(const f32x4 (&acc)[2][2][4][2], const Unit& u, int wr, int wc, int fr, int fq) const {
        if (wc >= 2 || u.pn != 0) return;
        const int row0 = u.pm * BM + wr * 64 + fr, col0 = wc * 32 + 4 * fq;
#pragma unroll
        for (int ai = 0; ai < 2; ++ai)
#pragma unroll
            for (int m = 0; m < 4; ++m) { float* rowp = C + (size_t)(row0 + ai * HALF + m * 16) * 64 + col0;
#pragma unroll
                for (int n = 0; n < 2; ++n) *(f32x4*)(rowp + n * 16) = acc[ai][0][m][n]; }
    }
};
template <class Epi, class Sched, bool ALIGN_EPI = false, bool SP2 = false>
__device__ __forceinline__ void gemm_phase(PG8_LAS unsigned char* lds, const Gemm g, const Sched& S, const Epi& E) {
    int tid_ = threadIdx.x; asm volatile("" : "+v"(tid_));
    const int tid = tid_, wid = __builtin_amdgcn_readfirstlane(tid >> 6), lane = tid & 63, wr = wid >> 2, wc = wid & 3, fr = lane & 15, fq = lane >> 4;
    const int K = g.K, nt = K / BK;
    unsigned voffA[2], voffB[2];
#pragma unroll
    for (int i = 0; i < 2; ++i) { int R, C; stage_rc(tid * 16 + i * 8192, R, C); const int Rb = Epi::PERM ? ((R & ~31) + perm32(R & 31)) : R;
        voffA[i] = (unsigned)(R * g.lda + C) * 2u; voffB[i] = (unsigned)(Rb * g.ldb + C) * 2u; }
    const size_t kstep = (size_t)(BK * 2);
    const size_t hsA = (size_t)HALF * g.lda * 2, hsB = (size_t)HALF * g.ldb * 2;
    const size_t tsA = 2 * hsA, tsB = 2 * hsB;
    const unsigned ldsw = (unsigned)wid * 1024u;
    const int aoff = lds_byte(wr * 64 + fr, fq * 8), boff = lds_byte(wc * 32 + fr, fq * 8);
#define PG8_SA(b, h) (((b) * 2 + (h)) * HTB)
#define PG8_SB(b, h) ((4 + (b) * 2 + (h)) * HTB)
#define PG8_STAGE(bufoff, gbase, voff) do { _Pragma("unroll") for (int _i = 0; _i < 2; ++_i) \
        __builtin_amdgcn_global_load_lds((const unsigned*)((const char*)(gbase) + (voff)[_i]), (PG8_LAS unsigned*)(lds + (bufoff) + ldsw + _i * 8192), 16, 0, 0); } while (0)
#define PG8_LDA(dst, b, h) do { _Pragma("unroll") for (int m = 0; m < 4; ++m) _Pragma("unroll") for (int k = 0; k < 2; ++k) dst[m][k] = *(const PG8_LAS bf16x8*)(lds + PG8_SA(b, h) + aoff + m * 2048 + k * 1024); } while (0)
#define PG8_LDB(dst, b, h) do { _Pragma("unroll") for (int n = 0; n < 2; ++n) _Pragma("unroll") for (int k = 0; k < 2; ++k) dst[n][k] = *(const PG8_LAS bf16x8*)(lds + PG8_SB(b, h) + boff + n * 2048 + k * 1024); } while (0)
#define PG8_MMA(ai, bj, At, Bt) do { __builtin_amdgcn_s_setprio(1); _Pragma("unroll") for (int m = 0; m < 4; ++m) _Pragma("unroll") for (int n = 0; n < 2; ++n) _Pragma("unroll") for (int k = 0; k < 2; ++k) \
        acc[ai][bj][m][n] = __builtin_amdgcn_mfma_f32_16x16x32_bf16(Bt[n][k], At[m][k], acc[ai][bj][m][n], 0, 0, 0); __builtin_amdgcn_s_setprio(0); } while (0)
#define PG8_WAIT_V(n) asm volatile("s_waitcnt vmcnt(" #n ")" ::: "memory")
#define PG8_WAIT_L(n) asm volatile("s_waitcnt lgkmcnt(" #n ")" ::: "memory")
#define PG8_BAR __builtin_amdgcn_s_barrier()
#define PG8_SCHED __builtin_amdgcn_sched_barrier(0)
    Unit cur, nxt; int ui = 0;
    if (!S.next(0, cur)) return;
    f32x4 acc[2][2][4][2];
#pragma unroll
    for (int a = 0; a < 2; ++a)
#pragma unroll
        for (int b = 0; b < 2; ++b)
#pragma unroll
            for (int m = 0; m < 4; ++m)
#pragma unroll
                for (int n = 0; n < 2; ++n) acc[a][b][m][n] = (f32x4){0.f, 0.f, 0.f, 0.f};
    bf16x8 At[4][2], B0[2][2], B1[2][2];
    const char* cA = (const char*)g.A + (size_t)cur.pm * tsA; const char* cB = (const char*)g.Bt + cur.boff + (size_t)cur.pn * tsB;
    S.a_ready(cur);
    if constexpr (SP2) {
        PG8_STAGE(PG8_SB(0, 0), cB, voffB); PG8_STAGE(PG8_SB(0, 1), cB + hsB, voffB); PG8_STAGE(PG8_SA(0, 0), cA, voffA); PG8_STAGE(PG8_SA(0, 1), cA + hsA, voffA);
        if (wr == 1) PG8_BAR;
        PG8_WAIT_V(2); PG8_BAR;
        PG8_STAGE(PG8_SB(1, 0), cB + kstep, voffB); PG8_STAGE(PG8_SA(1, 0), cA + kstep, voffA); PG8_STAGE(PG8_SB(1, 1), cB + hsB + kstep, voffB);
        PG8_WAIT_V(6); PG8_BAR;
    } else {
        PG8_STAGE(PG8_SB(0, 0), cB, voffB); PG8_STAGE(PG8_SA(0, 0), cA, voffA); PG8_STAGE(PG8_SB(0, 1), cB + hsB, voffB); PG8_STAGE(PG8_SA(0, 1), cA + hsA, voffA);
        if (wr == 1) PG8_BAR;
        PG8_WAIT_V(4); PG8_BAR;
        PG8_STAGE(PG8_SB(1, 0), cB + kstep, voffB); PG8_STAGE(PG8_SA(1, 0), cA + kstep, voffA); PG8_STAGE(PG8_SB(1, 1), cB + hsB + kstep, voffB);
        PG8_WAIT_V(6); PG8_BAR;
    }
    for (;;) {
        const bool has_next = S.next(ui + 1, nxt);
        const char* nA = has_next ? (const char*)g.A + (size_t)nxt.pm * tsA : cA; const char* nB = has_next ? (const char*)g.Bt + nxt.boff + (size_t)nxt.pn * tsB : cB;
        for (int t = 0; t < nt; t += 2) {
            const bool last = (t == nt - 2);
            const char* a1 = cA + (size_t)(t + 1) * kstep;
            const char* a2 = last ? nA : cA + (size_t)(t + 2) * kstep; const char* b2 = last ? nB : cB + (size_t)(t + 2) * kstep;
            const char* a3 = a2 + kstep; const char* b3 = b2 + kstep;
            if (last && has_next) S.a_ready(nxt);
            if constexpr (SP2) {
            PG8_LDB(B0, 0, 0); PG8_LDB(B1, 0, 1); PG8_SCHED; PG8_LDA(At, 0, 0); PG8_STAGE(PG8_SA(1, 1), a1 + hsA, voffA);
            PG8_WAIT_V(8); PG8_WAIT_L(0); PG8_BAR; PG8_MMA(0, 0, At, B0); PG8_MMA(0, 1, At, B1); PG8_BAR; PG8_SCHED;
            PG8_LDA(At, 0, 1); PG8_STAGE(PG8_SB(0, 0), b2, voffB); PG8_STAGE(PG8_SB(0, 1), b2 + hsB, voffB); PG8_STAGE(PG8_SA(0, 0), a2, voffA);
            PG8_WAIT_V(8); PG8_WAIT_L(0); PG8_BAR; PG8_MMA(1, 0, At, B0); PG8_MMA(1, 1, At, B1); PG8_BAR; PG8_SCHED;
            PG8_LDB(B0, 1, 0); PG8_LDB(B1, 1, 1); PG8_SCHED; PG8_LDA(At, 1, 0); PG8_STAGE(PG8_SA(0, 1), a2 + hsA, voffA);
            PG8_WAIT_V(8); PG8_WAIT_L(0); PG8_BAR; PG8_MMA(0, 0, At, B0); PG8_MMA(0, 1, At, B1); PG8_BAR; PG8_SCHED;
            PG8_LDA(At, 1, 1); PG8_STAGE(PG8_SB(1, 0), b3, voffB); PG8_STAGE(PG8_SB(1, 1), b3 + hsB, voffB); PG8_STAGE(PG8_SA(1, 0), a3, voffA);
            PG8_WAIT_V(8); PG8_WAIT_L(0); PG8_BAR; PG8_MMA(1, 0, At, B0); PG8_MMA(1, 1, At, B1); PG8_BAR; PG8_SCHED;
            } else {
            PG8_LDB(B0, 0, 0); PG8_SCHED; PG8_LDA(At, 0, 0); PG8_STAGE(PG8_SA(1, 1), a1 + hsA, voffA);
            PG8_WAIT_L(8); PG8_BAR; PG8_WAIT_L(0); PG8_MMA(0, 0, At, B0); PG8_BAR; PG8_SCHED;
            PG8_LDB(B1, 0, 1); PG8_STAGE(PG8_SB(0, 0), b2, voffB);
            PG8_BAR; PG8_WAIT_L(0); PG8_MMA(0, 1, At, B1); PG8_BAR;
            PG8_LDA(At, 0, 1); PG8_STAGE(PG8_SA(0, 0), a2, voffA);
            PG8_BAR; PG8_WAIT_L(0); PG8_MMA(1, 0, At, B0); PG8_BAR; PG8_SCHED;
            PG8_STAGE(PG8_SB(0, 1), b2 + hsB, voffB);
            PG8_WAIT_V(6); PG8_BAR; PG8_MMA(1, 1, At, B1); PG8_BAR;
            PG8_LDB(B0, 1, 0); PG8_SCHED; PG8_LDA(At, 1, 0); PG8_STAGE(PG8_SA(0, 1), a2 + hsA, voffA);
            PG8_WAIT_L(8); PG8_BAR; PG8_WAIT_L(0); PG8_MMA(0, 0, At, B0); PG8_BAR; PG8_SCHED;
            PG8_LDB(B1, 1, 1); PG8_STAGE(PG8_SB(1, 0), b3, voffB);
            PG8_BAR; PG8_WAIT_L(0); PG8_MMA(0, 1, At, B1); PG8_BAR;
            PG8_LDA(At, 1, 1); PG8_STAGE(PG8_SA(1, 0), a3, voffA);
            PG8_BAR; PG8_WAIT_L(0); PG8_MMA(1, 0, At, B0); PG8_BAR; PG8_SCHED;
            PG8_STAGE(PG8_SB(1, 1), b3 + hsB, voffB);
            PG8_WAIT_V(6); PG8_BAR; PG8_MMA(1, 1, At, B1); PG8_BAR;
            }
        }
        if constexpr (ALIGN_EPI) { if (wr == 0) PG8_BAR; }
        if constexpr (!Epi::AFTER_DRAIN) { E(acc, cur, wr, wc, fr, fq); S.done(cur); }
        if (!has_next) break;
#pragma unroll
        for (int a = 0; a < 2; ++a)
#pragma unroll
            for (int b = 0; b < 2; ++b)
#pragma unroll
                for (int m = 0; m < 4; ++m)
#pragma unroll
                    for (int n = 0; n < 2; ++n) acc[a][b][m][n] = (f32x4){0.f, 0.f, 0.f, 0.f};
        cur = nxt; cA = nA; cB = nB; ++ui;
        if constexpr (ALIGN_EPI) { if (wr == 1) PG8_BAR; }
    }
    PG8_WAIT_V(0);
    if constexpr (!ALIGN_EPI) { if (wr == 0) PG8_BAR; }
    PG8_BAR;
    if constexpr (Epi::AFTER_DRAIN) { E.fused(acc, cur, wr, wc, fr, fq, lds, wid, lane); S.done(cur); }
#undef PG8_SA
#undef PG8_SB
#undef PG8_STAGE
#undef PG8_LDA
#undef PG8_LDB
#undef PG8_MMA
#undef PG8_WAIT_V
#undef PG8_WAIT_L
#undef PG8_BAR
#undef PG8_SCHED
}
}

constexpr int NTOK = 32768, SEQ = 16384, DM = 1024;
constexpr float EPS = 1e-6f;
constexpr size_t MiB = 1u << 20;
constexpr size_t WS_CTL = 0, CTL_ZERO_BYTES = 1 * MiB;
constexpr size_t WS_WB = 1 * MiB;
constexpr size_t WB_MKV = WS_WB + 0 * MiB;
constexpr size_t WB_MEMN = WS_WB + 1 * MiB;
constexpr size_t WB_MKVO = WS_WB + 2 * MiB;
constexpr size_t WB_WR = WS_WB + 3 * MiB;
constexpr size_t WB_WIN = WS_WB + 4 * MiB;
constexpr size_t WB_WGT = WS_WB + 8 * MiB;
constexpr size_t WB_WOUT = WS_WB + 11 * MiB;
constexpr size_t WB_WGU = WS_WB + 16 * MiB;
constexpr size_t WB_WD = WS_WB + 80 * MiB;
constexpr size_t WS_HN = WS_WB + 112 * MiB;
constexpr size_t WS_AR = WS_HN + 64 * MiB;
constexpr size_t AR_PROJ = WS_AR;
constexpr size_t AR_XSC = WS_AR + 112 * MiB;
constexpr size_t AR_LA = WS_AR + 160 * MiB;
constexpr size_t AR_UU = WS_AR + 208 * MiB;
constexpr size_t AR_MIXL = WS_AR + 256 * MiB;
constexpr size_t AR_SA = WS_AR + 320 * MiB;
constexpr size_t AR_SH = WS_AR + 322 * MiB;
constexpr size_t AR_CARRY = WS_AR + 324 * MiB;
constexpr size_t AR_KN = WS_AR + 96 * MiB;
constexpr size_t AR_KIN = WS_AR + 100 * MiB;
constexpr size_t AR_QIW = WS_AR + 104 * MiB;
constexpr size_t AR_WI = WS_AR + 120 * MiB;
constexpr size_t AR_SEL = WS_AR + 121 * MiB;
constexpr size_t AR_MIXD = WS_AR + 160 * MiB;
constexpr size_t AR_XS = WS_AR;
constexpr size_t AR_ACT = WS_AR + 144 * MiB;
constexpr size_t AR_LOG = WS_AR + 216 * MiB;
constexpr size_t AR_EID = WS_AR + 224 * MiB;
constexpr size_t AR_GATE = WS_AR + 225 * MiB;
constexpr size_t AR_DEST = WS_AR + 226 * MiB;
constexpr size_t WS_END = WS_AR + 328 * MiB;
constexpr int CW_TMO = 0, CW_CODE = 1;
constexpr int CW_CNT = 256, CW_CUR = 320, CW_NT = 384, CW_LSTRIDE = 256;
constexpr int CW_TE = 1024, CW_TE_STRIDE = 512;
constexpr int CW_BAR = 4096;
constexpr int LDS_BYTES = 159744, MISC_OFF = 155648;

#define GAS __attribute__((address_space(1)))
#define LAS __attribute__((address_space(3)))
#define DI __device__ __forceinline__
typedef unsigned short bf16;
typedef unsigned v4u __attribute__((ext_vector_type(4)));
typedef unsigned v2u __attribute__((ext_vector_type(2)));
typedef int v4i __attribute__((ext_vector_type(4)));
typedef float f32x4 __attribute__((ext_vector_type(4)));
typedef float f32x16 __attribute__((ext_vector_type(16)));
typedef short bf16x8 __attribute__((ext_vector_type(8)));
typedef GAS unsigned gu32;
#define RLX_AGENT __ATOMIC_RELAXED, __HIP_MEMORY_SCOPE_AGENT
#define LDS_WAIT() asm volatile("s_waitcnt lgkmcnt(0)" ::: "memory")
DI unsigned f2bf(float f) { unsigned u = __builtin_bit_cast(unsigned, f); return (u + 0x7fffu + ((u >> 16) & 1u)) >> 16; }
DI unsigned pk2(float lo, float hi) { return f2bf(lo) | (f2bf(hi) << 16); }
DI float bflo(unsigned w) { return __uint_as_float(w << 16); }
DI float bfhi(unsigned w) { return __uint_as_float(w & 0xffff0000u); }
DI void unpack8(const v4u w, float (&f)[8]) { f[0] = bflo(w.x); f[1] = bfhi(w.x); f[2] = bflo(w.y); f[3] = bfhi(w.y); f[4] = bflo(w.z); f[5] = bfhi(w.z); f[6] = bflo(w.w); f[7] = bfhi(w.w); }
DI v4u pack8(const float (&f)[8]) { v4u w; w.x = pk2(f[0], f[1]); w.y = pk2(f[2], f[3]); w.z = pk2(f[4], f[5]); w.w = pk2(f[6], f[7]); return w; }
DI unsigned lds_add(LAS unsigned* p, unsigned v) { return __hip_atomic_fetch_add(p, v, __ATOMIC_RELAXED, __HIP_MEMORY_SCOPE_WORKGROUP); }
DI float wave_sum(float v) {
#pragma unroll
    for (int o = 1; o < 64; o <<= 1) v += __shfl_xor(v, o);
    return v;
}

#define XB_TMO      128
#define XB_XCNT(j)  (256  + 64 * (j))
#define XB_XSUB(j)  (1280 + 64 * (j))
#define XB_XGEN(j)  (2304 + 64 * (j))
#define XB_TOP      3328
#define XB_TOPGEN   3392
#define XCD_BAR_WORDS 3456
#define XB_SPIN_CAP (1u << 22)
DI unsigned xb_ld(unsigned* p)              { return __hip_atomic_load(p, __ATOMIC_RELAXED, __HIP_MEMORY_SCOPE_AGENT); }
DI unsigned xb_add(unsigned* p, unsigned v) { return __hip_atomic_fetch_add(p, v, __ATOMIC_RELAXED, __HIP_MEMORY_SCOPE_AGENT); }
DI unsigned xb_xcc_id() { return (unsigned)__builtin_amdgcn_s_getreg((3 << 11) | 20) & 0xFu; }
#define XB_SPIN(cond, bar) do { unsigned _sp = 0; while (cond) { __builtin_amdgcn_s_sleep(1); \
    if ((++_sp & 255u) == 0u) { if (xb_ld(&(bar)[XB_TMO])) break; if (_sp > XB_SPIN_CAP) { atomicAdd(&(bar)[XB_TMO], 1u); break; } } } } while (0)
struct XcdBarrier { unsigned* bar; unsigned x; volatile LAS unsigned* st; };
DI XcdBarrier xcd_barrier_post(unsigned* bar, volatile LAS unsigned* st) {
    XcdBarrier b; b.bar = bar; b.x = xb_xcc_id(); b.st = st;
    if (threadIdx.x == 0) (void)xb_add(&bar[XB_XCNT(b.x)], 1u);
    return b;
}
DI void xcd_barrier_complete(unsigned* bar, unsigned x, unsigned& nloc, unsigned& nx) {
    const unsigned G = gridDim.x * gridDim.y * gridDim.z;
    unsigned sum, cnt, mine, sp = 0u;
    for (;;) {
        sum = 0u; cnt = 0u; mine = 0u;
#pragma unroll
        for (unsigned j = 0; j < 16; ++j) { const unsigned c = xb_ld(&bar[XB_XCNT(j)]); sum += c; cnt += (c > 0u) ? 1u : 0u; mine = (j == x) ? c : mine; }
        if (sum == G) break;
        __builtin_amdgcn_s_sleep(1);
        if ((++sp & 255u) == 0u) { if (xb_ld(&bar[XB_TMO])) break; if (sp > XB_SPIN_CAP) { atomicAdd(&bar[XB_TMO], 1u); break; } }
    }
    nloc = mine > 0u ? mine : 1u; nx = cnt > 0u ? cnt : 1u;
}
DI void xcd_barrier(const XcdBarrier& b) {
    asm volatile("s_waitcnt vmcnt(0)" ::: "memory");
    __syncthreads();
    if (threadIdx.x == 0) {
        unsigned* bar = b.bar;
        __builtin_amdgcn_s_waitcnt(0);
        unsigned nloc = b.st[0], nx = b.st[1];
        if (nloc == 0u) { xcd_barrier_complete(bar, b.x, nloc, nx); b.st[0] = nloc; b.st[1] = nx; }
        const unsigned old = xb_add(&bar[XB_XSUB(b.x)], 1u);
        const unsigned gen = old / nloc;
        if (old + 1u == (gen + 1u) * nloc) {
            __builtin_amdgcn_fence(__ATOMIC_RELEASE, "agent");
            asm volatile("s_waitcnt vmcnt(0)" ::: "memory");
            const unsigned og = xb_add(&bar[XB_TOP], 1u);
            const unsigned tg = og / nx;
            if (og + 1u == (tg + 1u) * nx) xb_add(&bar[XB_TOPGEN], 1u);
            else XB_SPIN(xb_ld(&bar[XB_TOPGEN]) == tg, bar);
            __builtin_amdgcn_fence(__ATOMIC_ACQUIRE, "agent");
            xb_add(&bar[XB_XGEN(b.x)], 1u);
            asm volatile("s_waitcnt vmcnt(0)" ::: "memory");
        } else {
            XB_SPIN(xb_ld(&bar[XB_XGEN(b.x)]) == gen, bar);
            __builtin_amdgcn_fence(__ATOMIC_ACQUIRE, "agent");
            asm volatile("s_waitcnt vmcnt(0)" ::: "memory");
        }
    }
    __syncthreads();
}

struct Params { const float* in[29]; float* out; unsigned char* ws; };
struct PV { unsigned char* ws; float* out; LAS unsigned long long* tab; };
DI const float* pin(const PV& P, int i) { const unsigned long long v = P.tab[i]; const unsigned lo = __builtin_amdgcn_readfirstlane((unsigned)v), hi = __builtin_amdgcn_readfirstlane((unsigned)(v >> 32)); return (const float*)(((unsigned long long)hi << 32) | lo); }
struct Ctx { LAS unsigned char* lds; int tid, lane, wave, G, blk, gw, NGW; };
DI Ctx relaunder(const Ctx& c0) { Ctx c = c0; int t = threadIdx.x; asm volatile("" : "+v"(t)); c.tid = t; c.lane = t & 63; c.wave = __builtin_amdgcn_readfirstlane(t >> 6); c.gw = c.blk * 8 + c.wave; return c; }
enum { I_X = 0, I_MEM, I_NORM_MIX, I_NORM_FFN, I_MEM_NORM, I_W_MEM_KV, I_XQ_NORM, I_XK_NORM, I_W_OUT, I_LRU_W_IN, I_LRU_CONV_W, I_LRU_CONV_B, I_LRU_W_A, I_LRU_B_A,
       I_LRU_W_X, I_LRU_B_X, I_LRU_LAMBDA, I_DSA_W_IN, I_DSA_Q_NORM, I_DSA_K_NORM, I_DSA_W_UV, I_REL_BIAS, I_MOE_W_GROUP, I_MOE_B_GROUP, I_MOE_W_ROUTER, I_MOE_B_ROUTER,
       I_MOE_W_GATE, I_MOE_W_UP, I_MOE_W_DOWN };

DI void tr_tile(const float* __restrict__ W, int ldw, bf16* __restrict__ WT, int ldk, LAS unsigned* scr, int lane) {
    const int m = lane & 15, q = lane >> 4;
#pragma unroll
    for (int i = 0; i < 8; ++i) {
        const int kk = 8 * i + 2 * q;
        const f32x4 v0 = *(const f32x4*)(W + (size_t)kk * ldw + 4 * m);
        const f32x4 v1 = *(const f32x4*)(W + (size_t)(kk + 1) * ldw + 4 * m);
        const int sw = 4 * (i ^ (m & 7)) + q;
        scr[(4 * m + 0) * 32 + sw] = pk2(v0.x, v1.x);
        scr[(4 * m + 1) * 32 + sw] = pk2(v0.y, v1.y);
        scr[(4 * m + 2) * 32 + sw] = pk2(v0.z, v1.z);
        scr[(4 * m + 3) * 32 + sw] = pk2(v0.w, v1.w);
    }
    LDS_WAIT();
#pragma unroll
    for (int r = 0; r < 8; ++r) {
        const int n = 8 * r + (lane >> 3), c = lane & 7;
        const v4u o = *(const LAS v4u*)(scr + n * 32 + 4 * (c ^ ((n >> 2) & 7)));
        *(v4u*)(WT + (size_t)n * ldk + 8 * c) = o;
    }
    LDS_WAIT();
}
DI void rms_row(const float* __restrict__ xrow, const float* __restrict__ g, bf16* __restrict__ orow, int lane, f32x4 (&v)[4]) {
    const f32x4* xr = (const f32x4*)xrow + lane; const f32x4* gr = (const f32x4*)g + lane;
    float s = 0.f;
#pragma unroll
    for (int j = 0; j < 4; ++j) { v[j] = xr[64 * j]; s += (v[j].x * v[j].x + v[j].y * v[j].y) + (v[j].z * v[j].z + v[j].w * v[j].w); }
    const float r = 1.0f / sqrtf(wave_sum(s) * (1.0f / 1024.0f) + EPS);
    v2u* o8 = (v2u*)orow + lane;
#pragma unroll
    for (int j = 0; j < 4; ++j) { const f32x4 gg = gr[64 * j]; v[j] = v[j] * r * gg; v2u o; o.x = pk2(v[j].x, v[j].y); o.y = pk2(v[j].z, v[j].w); o8[64 * j] = o; }
}
struct TrJob { const float* src; bf16* dst; int ldw, ldk, nN, items; };
template <int layer> DI void phase_prep(const Ctx& c0, const PV& P) {
    const Ctx c = relaunder(c0);
    unsigned char* ws = P.ws;
    LAS unsigned* scr = (LAS unsigned*)(c.lds + c.wave * 8192);
    LAS TrJob* jobs = (LAS TrJob*)(c.lds + 65536);
    LAS int* njp = (LAS int*)(c.lds + 65536 + 512);
    LAS f32x4* wiw = (LAS f32x4*)(c.lds + 69632);
    if (c.tid == 0) {
        int nj = 0;
#define ADDJOB(S_, D_, K_, N_, LDW_, LDK_) do { jobs[nj].src = (S_); jobs[nj].dst = (D_); jobs[nj].ldw = (LDW_); jobs[nj].ldk = (LDK_); jobs[nj].nN = (N_) / 64; jobs[nj].items = ((K_) / 64) * ((N_) / 64); ++nj; } while (0)
        ADDJOB(pin(P, I_W_MEM_KV) + (size_t)layer * 1024 * 512, (bf16*)(ws + WB_MKV), 1024, 512, 512, 1024);
        if (layer == 0) {
            ADDJOB(pin(P, I_LRU_W_IN), (bf16*)(ws + WB_WIN), 1024, 1792, 1792, 1024);
            ADDJOB(pin(P, I_W_OUT), (bf16*)(ws + WB_WOUT), 1024, 1024, 1024, 1024);
        } else {
            ADDJOB(pin(P, I_DSA_W_IN), (bf16*)(ws + WB_WIN), 1024, 1280, 1540, 1024);
            ADDJOB(pin(P, I_DSA_W_IN) + 1284, (bf16*)(ws + WB_WIN) + (size_t)1280 * 1024, 1024, 256, 1540, 1024);
            ADDJOB(pin(P, I_W_OUT) + (size_t)1024 * 1024 + (size_t)768 * 1024, (bf16*)(ws + WB_WOUT) + 1536, 256, 1024, 1024, 1792);
        }
#undef ADDJOB
        *njp = nj;
    }
    if (layer == 1) { for (int k = c.tid; k < 1024; k += 512) wiw[k] = *(const f32x4*)(pin(P, I_DSA_W_IN) + (size_t)k * 1540 + 1280); }
    __syncthreads();
    {
        const float* xin = (layer == 0) ? pin(P, I_X) : P.out;
        const float* g = pin(P, I_NORM_MIX) + layer * 1024;
        bf16* HN = (bf16*)(ws + WS_HN); float* WI = (float*)(ws + AR_WI);
        for (int r = c.gw; r < NTOK; r += c.NGW) {
            f32x4 v[4]; rms_row(xin + (size_t)r * 1024, g, HN + (size_t)r * 1024, c.lane, v);
            if (layer == 1) {
                f32x4 a = {0.f, 0.f, 0.f, 0.f};
#pragma unroll
                for (int j = 0; j < 4; ++j) { const int k0 = 4 * (c.lane + 64 * j); a += v[j].x * wiw[k0] + v[j].y * wiw[k0 + 1] + v[j].z * wiw[k0 + 2] + v[j].w * wiw[k0 + 3]; }
                a.x = wave_sum(a.x); a.y = wave_sum(a.y); a.z = wave_sum(a.z); a.w = wave_sum(a.w);
                if (c.lane == 0) *(f32x4*)(WI + (size_t)r * 4) = a * 0.5f;
            }
        }
        const float* gm = pin(P, I_MEM_NORM) + layer * 1024; bf16* MEMN = (bf16*)(ws + WB_MEMN);
        for (int r = c.gw; r < 512; r += c.NGW) { f32x4 v[4]; rms_row(pin(P, I_MEM) + (size_t)r * 1024, gm, MEMN + (size_t)r * 1024, c.lane, v); }
    }
    {
        const int nj = *njp; int gen_total = 0;
        for (int j = 0; j < nj; ++j) gen_total += jobs[j].items;
        const int total = gen_total + 3 * 32 * 128;
        const float* wg = pin(P, I_MOE_W_GATE) + (size_t)layer * 32 * 1024 * 512;
        const float* wu = pin(P, I_MOE_W_UP) + (size_t)layer * 32 * 1024 * 512;
        const float* wd = pin(P, I_MOE_W_DOWN) + (size_t)layer * 32 * 512 * 1024;
        bf16* WGU = (bf16*)(ws + WB_WGU); bf16* WD = (bf16*)(ws + WB_WD);
        for (int it = c.gw; it < total; it += c.NGW) {
            const float* src; bf16* dst; int ldw, ldk;
            if (it < gen_total) {
                int r = it, j = 0;
                while (r >= jobs[j].items) { r -= jobs[j].items; ++j; }
                const int nN = jobs[j].nN, kb = r / nN, nb = r % nN;
                ldw = jobs[j].ldw; ldk = jobs[j].ldk;
                src = jobs[j].src + (size_t)kb * 64 * ldw + nb * 64; dst = jobs[j].dst + (size_t)nb * 64 * ldk + kb * 64;
            } else {
                const int r = it - gen_total, type = r >> 12, e = (r >> 7) & 31, ti = r & 127;
                if (type < 2) { const int kb = ti >> 3, nb = ti & 7; ldw = 512; ldk = 1024;
                    src = (type == 0 ? wg : wu) + (size_t)e * 1024 * 512 + (size_t)kb * 64 * 512 + nb * 64;
                    const int drow = 256 * (nb >> 1) + 64 * (nb & 1) + 128 * type;
                    dst = WGU + (size_t)e * 1024 * 1024 + (size_t)drow * 1024 + kb * 64;
                } else { const int kb = ti >> 4, nb = ti & 15; ldw = 1024; ldk = 512;
                    src = wd + (size_t)e * 512 * 1024 + (size_t)kb * 64 * 1024 + nb * 64;
                    dst = WD + (size_t)e * 1024 * 512 + (size_t)nb * 64 * 512 + kb * 64; }
            }
            tr_tile(src, ldw, dst, ldk, scr, c.lane);
        }
    }
    const int gtid = c.blk * 512 + c.tid, nthr = c.G * 512;
    {
        const float* wgr = pin(P, I_MOE_W_GROUP) + (size_t)layer * 1024 * 4; const float* wrt = pin(P, I_MOE_W_ROUTER) + (size_t)layer * 1024 * 32;
        bf16* WR = (bf16*)(ws + WB_WR);
        for (int i = gtid; i < 256 * 128; i += nthr) { const int row = i >> 7, k8 = i & 127; float f[8];
#pragma unroll
            for (int kk = 0; kk < 8; ++kk) { const int k = 8 * k8 + kk; f[kk] = row < 4 ? wgr[k * 4 + row] : (row < 36 ? wrt[k * 32 + (row - 4)] : 0.f); }
            *(v4u*)(WR + (size_t)row * 1024 + 8 * k8) = pack8(f); }
    }
    if (layer == 0) {
        bf16* WGT = (bf16*)(ws + WB_WGT);
        for (int i = gtid; i < 1536 * 96; i += nthr) { const int rho = i / 96, k8 = i % 96; const int pn = rho >> 8, bj = (rho >> 7) & 1, j = rho & 127, ch = 128 * pn + j, blkc = ch / 192, cc = ch % 192;
            const float* src = (bj ? pin(P, I_LRU_W_X) : pin(P, I_LRU_W_A)) + (size_t)blkc * 192 * 192; float f[8];
            const int k0 = 8 * k8; const bool in = (k0 / 192) == blkc;
#pragma unroll
            for (int kk = 0; kk < 8; ++kk) f[kk] = in ? src[((k0 + kk) % 192) * 192 + cc] : 0.f;
            *(v4u*)(WGT + (size_t)rho * 768 + k0) = pack8(f); }
    } else {
        const float* wuv = pin(P, I_DSA_W_UV); const float* wo = pin(P, I_W_OUT) + (size_t)1024 * 1024; bf16* WO = (bf16*)(ws + WB_WOUT);
        for (int i = gtid; i < 1024 * 12 * 16; i += nthr) { const int n = i & 1023, rest = i >> 10, c8 = rest & 15, h = rest >> 4; float a[8] = {0.f, 0.f, 0.f, 0.f, 0.f, 0.f, 0.f, 0.f};
            for (int j = 0; j < 64; ++j) { const float w = wo[(size_t)(64 * h + j) * 1024 + n];
#pragma unroll
                for (int cc = 0; cc < 8; ++cc) a[cc] += wuv[((size_t)h * 128 + 8 * c8 + cc) * 64 + j] * w; }
            *(v4u*)(WO + (size_t)n * 1792 + h * 128 + 8 * c8) = pack8(a); }
    }
}

DI f32x4 mfma16(bf16x8 a, bf16x8 b, f32x4 c) { return __builtin_amdgcn_mfma_f32_16x16x32_bf16(a, b, c, 0, 0, 0); }

template <int layer, int ldp, int xq_off, int ldm, int xo_off> DI void phase_xattn(const Ctx& c0, const PV& P, const bf16* __restrict__ PROJ, bf16* __restrict__ MIX) {
    const Ctx c = relaunder(c0);
    const bf16* MKVO = (const bf16*)(P.ws + WB_MKVO);
    const float* xqg = pin(P, I_XQ_NORM) + layer * 64; const float* xkg = pin(P, I_XK_NORM) + layer * 64;
    LAS bf16* Ks = (LAS bf16*)c.lds;
    LAS bf16* Vt = (LAS bf16*)(c.lds + 36864);
    const int lane = c.lane, l15 = lane & 15, g = lane >> 4;
    for (int unit = c.blk; unit < 256; unit += c.G) {
        const int b = unit >> 7, h = (unit >> 5) & 3, tr = unit & 31, tok0 = b * SEQ + tr * 512;
        __syncthreads();
#pragma unroll
        for (int i = 0; i < 4; ++i) { const int p = c.tid + 512 * i, key = p >> 3, ch = p & 7;
            const bf16* src = MKVO + (size_t)(b * 256 + key) * 512 + h * 64 + ch * 8;
            float f[8]; unpack8(*(const v4u*)src, f);
            float ss = 0.f;
#pragma unroll
            for (int j = 0; j < 8; ++j) ss += f[j] * f[j];
            ss += __shfl_xor(ss, 1); ss += __shfl_xor(ss, 2); ss += __shfl_xor(ss, 4);
            const float r = 1.0f / sqrtf(ss * (1.0f / 64.0f) + EPS);
#pragma unroll
            for (int j = 0; j < 8; ++j) f[j] = f[j] * r * xkg[ch * 8 + j];
            *(LAS v4u*)(Ks + key * 72 + ch * 8) = pack8(f);
            const v4u vw = *(const v4u*)(src + 256);
            const unsigned ww[4] = {vw.x, vw.y, vw.z, vw.w};
#pragma unroll
            for (int j = 0; j < 4; ++j) { Vt[(ch * 8 + 2 * j) * 264 + key] = (bf16)(ww[j] & 0xffffu); Vt[(ch * 8 + 2 * j + 1) * 264 + key] = (bf16)(ww[j] >> 16); }
        }
        __syncthreads();
#pragma unroll 1
        for (int tile = c.wave; tile < 32; tile += 8) {
            const int row = tok0 + tile * 16 + l15;
            const bf16* qp = PROJ + (size_t)row * ldp + xq_off + h * 64 + 8 * g;
            float q0[8], q1[8]; unpack8(*(const v4u*)qp, q0); unpack8(*(const v4u*)(qp + 32), q1);
            float ss = 0.f;
#pragma unroll
            for (int j = 0; j < 8; ++j) ss += q0[j] * q0[j] + q1[j] * q1[j];
            ss += __shfl_xor(ss, 16); ss += __shfl_xor(ss, 32);
            const float r = 0.125f / sqrtf(ss * (1.0f / 64.0f) + EPS);
#pragma unroll
            for (int j = 0; j < 8; ++j) { q0[j] = q0[j] * r * xqg[8 * g + j]; q1[j] = q1[j] * r * xqg[32 + 8 * g + j]; }
            const bf16x8 B0 = __builtin_bit_cast(bf16x8, pack8(q0)), B1 = __builtin_bit_cast(bf16x8, pack8(q1));
            f32x4 S[16];
#pragma unroll
            for (int kt = 0; kt < 16; ++kt) {
                const bf16x8 A0 = *(const LAS bf16x8*)(Ks + (16 * kt + l15) * 72 + 8 * g), A1 = *(const LAS bf16x8*)(Ks + (16 * kt + l15) * 72 + 32 + 8 * g);
                f32x4 z = {0.f, 0.f, 0.f, 0.f}; z = mfma16(A0, B0, z); S[kt] = mfma16(A1, B1, z);
                if ((kt & 3) == 3) __builtin_amdgcn_sched_barrier(0);
            }
            float mx = -3.0e38f;
#pragma unroll
            for (int kt = 0; kt < 16; ++kt) mx = fmaxf(mx, fmaxf(fmaxf(S[kt][0], S[kt][1]), fmaxf(S[kt][2], S[kt][3])));
            mx = fmaxf(mx, __shfl_xor(mx, 16)); mx = fmaxf(mx, __shfl_xor(mx, 32));
            float l = 0.f;
#pragma unroll
            for (int kt = 0; kt < 16; ++kt) {
#pragma unroll
                for (int i = 0; i < 4; ++i) { const float p = __expf(S[kt][i] - mx); S[kt][i] = p; l += p; } }
            l += __shfl_xor(l, 16); l += __shfl_xor(l, 32);
            f32x4 O[4];
#pragma unroll
            for (int dt = 0; dt < 4; ++dt) O[dt] = (f32x4){0.f, 0.f, 0.f, 0.f};
#pragma unroll
            for (int jb = 0; jb < 8; ++jb) {
                v4u pw; pw.x = pk2(S[2 * jb][0], S[2 * jb][1]); pw.y = pk2(S[2 * jb][2], S[2 * jb][3]); pw.z = pk2(S[2 * jb + 1][0], S[2 * jb + 1][1]); pw.w = pk2(S[2 * jb + 1][2], S[2 * jb + 1][3]);
                const bf16x8 Pb = __builtin_bit_cast(bf16x8, pw);
#pragma unroll
                for (int dt = 0; dt < 4; ++dt) { const LAS bf16* vp = Vt + (16 * dt + l15) * 264 + 32 * jb + 4 * g;
                    const v2u a0 = *(const LAS v2u*)vp, a1 = *(const LAS v2u*)(vp + 16);
                    v4u aw; aw.x = a0.x; aw.y = a0.y; aw.z = a1.x; aw.w = a1.y;
                    O[dt] = mfma16(__builtin_bit_cast(bf16x8, aw), Pb, O[dt]); }
                __builtin_amdgcn_sched_barrier(0);
            }
            const float il = 1.0f / l;
            bf16* op = MIX + (size_t)row * ldm + xo_off + h * 64 + 4 * g;
#pragma unroll
            for (int dt = 0; dt < 4; ++dt) { v2u o; o.x = pk2(O[dt][0] * il, O[dt][1] * il); o.y = pk2(O[dt][2] * il, O[dt][3] * il); *(v2u*)(op + 16 * dt) = o; }
        }
    }
}

DI void phase_conv(const Ctx& c0, const PV& P) {
    const Ctx c = relaunder(c0);
    const bf16* PROJ = (const bf16*)(P.ws + AR_PROJ); bf16* XSC = (bf16*)(P.ws + AR_XSC);
    const float* cw = pin(P, I_LRU_CONV_W); const float* cb = pin(P, I_LRU_CONV_B);
    const int gtid = c.blk * 512 + c.tid, nthr = c.G * 512;
    for (int i = gtid; i < NTOK * 96; i += nthr) { const int row = i / 96, c8 = i % 96, t = row & (SEQ - 1); float a[8];
#pragma unroll
        for (int j = 0; j < 8; ++j) a[j] = cb[8 * c8 + j];
#pragma unroll
        for (int k = 0; k < 4; ++k) { if (t - 3 + k >= 0) { float f[8]; unpack8(*(const v4u*)(PROJ + (size_t)(row - 3 + k) * 1792 + 8 * c8), f);
#pragma unroll
                for (int j = 0; j < 8; ++j) a[j] += cw[k * 768 + 8 * c8 + j] * f[j]; } }
        *(v4u*)(XSC + (size_t)row * 768 + 8 * c8) = pack8(a); }
}
DI void phase_scanA(const Ctx& c0, const PV& P) {
    const Ctx c = relaunder(c0);
    const bf16* LA = (const bf16*)(P.ws + AR_LA); const bf16* UU = (const bf16*)(P.ws + AR_UU); float* SA = (float*)(P.ws + AR_SA); float* SH = (float*)(P.ws + AR_SH);
    const int gtid = c.blk * 512 + c.tid, nthr = c.G * 512;
    for (int i = gtid; i < 512 * 192; i += nthr) { const int chunk = i / 192, c4 = i % 192; float h[4] = {0.f, 0.f, 0.f, 0.f}, sl[4] = {0.f, 0.f, 0.f, 0.f};
        const size_t base = (size_t)chunk * 64 * 768 + 4 * c4;
#pragma unroll 8
        for (int r = 0; r < 64; ++r) { const v2u lw = *(const v2u*)(LA + base + (size_t)r * 768), uw = *(const v2u*)(UU + base + (size_t)r * 768);
            const float l4[4] = {bflo(lw.x), bfhi(lw.x), bflo(lw.y), bfhi(lw.y)}, u4[4] = {bflo(uw.x), bfhi(uw.x), bflo(uw.y), bfhi(uw.y)};
#pragma unroll
            for (int j = 0; j < 4; ++j) { h[j] = __expf(l4[j]) * h[j] + u4[j]; sl[j] += l4[j]; } }
        *(f32x4*)(SA + (size_t)chunk * 768 + 4 * c4) = (f32x4){__expf(sl[0]), __expf(sl[1]), __expf(sl[2]), __expf(sl[3])};
        *(f32x4*)(SH + (size_t)chunk * 768 + 4 * c4) = (f32x4){h[0], h[1], h[2], h[3]}; }
}
DI void phase_scanB(const Ctx& c0, const PV& P) {
    const Ctx c = relaunder(c0);
    const float* SA = (const float*)(P.ws + AR_SA); const float* SH = (const float*)(P.ws + AR_SH); float* CARRY = (float*)(P.ws + AR_CARRY);
    LAS float* segP = (LAS float*)c.lds; LAS float* segQ = segP + 512;
    for (int u = c.blk; u < 48; u += c.G) { const int b = u / 24, cg = u % 24, seg = c.tid >> 5, ch = 32 * cg + (c.tid & 31);
        const size_t base = (size_t)(b * 256 + seg * 16) * 768 + ch;
        float A[16], H[16];
#pragma unroll
        for (int i = 0; i < 16; ++i) { A[i] = SA[base + (size_t)i * 768]; H[i] = SH[base + (size_t)i * 768]; }
        float Pp[16], Qq[16]; float pp = 1.f, qq = 0.f;
#pragma unroll
        for (int i = 0; i < 16; ++i) { Pp[i] = pp; Qq[i] = qq; qq = A[i] * qq + H[i]; pp = A[i] * pp; }
        __syncthreads();
        segP[c.tid] = pp; segQ[c.tid] = qq;
        __syncthreads();
        float hin = 0.f;
        for (int s = 0; s < seg; ++s) hin = segP[s * 32 + (c.tid & 31)] * hin + segQ[s * 32 + (c.tid & 31)];
#pragma unroll
        for (int i = 0; i < 16; ++i) CARRY[base + (size_t)i * 768] = Pp[i] * hin + Qq[i];
    }
}
DI void phase_scanC(const Ctx& c0, const PV& P) {
    const Ctx c = relaunder(c0);
    const bf16* LA = (const bf16*)(P.ws + AR_LA); const bf16* UU = (const bf16*)(P.ws + AR_UU); const float* CARRY = (const float*)(P.ws + AR_CARRY);
    const bf16* PROJ = (const bf16*)(P.ws + AR_PROJ); bf16* MIX = (bf16*)(P.ws + AR_MIXL);
    const int gtid = c.blk * 512 + c.tid, nthr = c.G * 512;
    for (int i = gtid; i < 512 * 192; i += nthr) { const int chunk = i / 192, c4 = i % 192;
        const f32x4 h0 = *(const f32x4*)(CARRY + (size_t)chunk * 768 + 4 * c4); float h[4] = {h0.x, h0.y, h0.z, h0.w};
        const size_t base = (size_t)chunk * 64 * 768 + 4 * c4;
#pragma unroll 8
        for (int r = 0; r < 64; ++r) { const size_t row = (size_t)chunk * 64 + r;
            const v2u lw = *(const v2u*)(LA + base + (size_t)r * 768), uw = *(const v2u*)(UU + base + (size_t)r * 768), gw = *(const v2u*)(PROJ + row * 1792 + 768 + 4 * c4);
            const float l4[4] = {bflo(lw.x), bfhi(lw.x), bflo(lw.y), bfhi(lw.y)}, u4[4] = {bflo(uw.x), bfhi(uw.x), bflo(uw.y), bfhi(uw.y)}, g4[4] = {bflo(gw.x), bfhi(gw.x), bflo(gw.y), bfhi(gw.y)};
            float y[4];
#pragma unroll
            for (int j = 0; j < 4; ++j) { h[j] = __expf(l4[j]) * h[j] + u4[j]; y[j] = h[j] * g4[j]; }
            v2u o; o.x = pk2(y[0], y[1]); o.y = pk2(y[2], y[3]); *(v2u*)(MIX + row * 1024 + 4 * c4) = o; }
    }
}

template <int layer> DI void phase_norm2(const Ctx& c0, const PV& P) {
    const Ctx c = relaunder(c0);
    const float* g = pin(P, I_NORM_FFN) + layer * 1024; bf16* HN = (bf16*)(P.ws + WS_HN);
    for (int r = c.gw; r < NTOK; r += c.NGW) { f32x4 v[4]; rms_row(P.out + (size_t)r * 1024, g, HN + (size_t)r * 1024, c.lane, v); }
}
template <int layer> DI void phase_route(const Ctx& c0, const PV& P) {
    const Ctx c = relaunder(c0);
    const float* LOG = (const float*)(P.ws + AR_LOG); int* EID = (int*)(P.ws + AR_EID); float* GATE = (float*)(P.ws + AR_GATE);
    const float* bg = pin(P, I_MOE_B_GROUP) + layer * 4; const float* br = pin(P, I_MOE_B_ROUTER) + layer * 32;
    unsigned* ctl = (unsigned*)(P.ws + WS_CTL);
    LAS unsigned* hist = (LAS unsigned*)c.lds;
    if (c.tid < 32) hist[c.tid] = 0u;
    __syncthreads();
    for (int t = c.blk * 512 + c.tid; t < NTOK; t += c.G * 512) {
        const f32x4 lg = *(const f32x4*)(LOG + (size_t)t * 64);
        const float l0 = lg.x + bg[0], l1 = lg.y + bg[1], l2 = lg.z + bg[2], l3 = lg.w + bg[3];
        int gs = 0; float gm = l0;
        if (l1 > gm) { gm = l1; gs = 1; } if (l2 > gm) { gm = l2; gs = 2; } if (l3 > gm) { gm = l3; gs = 3; }
        const float pg = 1.0f / (__expf(l0 - gm) + __expf(l1 - gm) + __expf(l2 - gm) + __expf(l3 - gm));
        const f32x4 ea = *(const f32x4*)(LOG + (size_t)t * 64 + 4 + 8 * gs), eb = *(const f32x4*)(LOG + (size_t)t * 64 + 8 + 8 * gs);
        const f32x4 ba = *(const f32x4*)(br + 8 * gs), bb = *(const f32x4*)(br + 8 * gs + 4);
        const float el[8] = {ea.x + ba.x, ea.y + ba.y, ea.z + ba.z, ea.w + ba.w, eb.x + bb.x, eb.y + bb.y, eb.z + bb.z, eb.w + bb.w};
        int i1 = 0; float m1 = el[0];
#pragma unroll
        for (int j = 1; j < 8; ++j) if (el[j] > m1) { m1 = el[j]; i1 = j; }
        int i2 = -1; float m2 = -3.0e38f;
#pragma unroll
        for (int j = 0; j < 8; ++j) if (j != i1 && el[j] > m2) { m2 = el[j]; i2 = j; }
        const float e2 = __expf(m2 - m1), inv = pg / (1.0f + e2);
        const int e1id = 8 * gs + i1, e2id = 8 * gs + i2;
        EID[2 * t] = e1id; EID[2 * t + 1] = e2id; GATE[2 * t] = inv; GATE[2 * t + 1] = e2 * inv;
        lds_add(&hist[e1id], 1u); lds_add(&hist[e2id], 1u);
    }
    __syncthreads();
    if (c.tid < 32 && hist[c.tid]) atomicAdd(ctl + CW_CNT + layer * CW_LSTRIDE + c.tid, hist[c.tid]);
}
template <int layer> DI void phase_scatter(const Ctx& c0, const PV& P) {
    const Ctx c = relaunder(c0);
    unsigned* ctl = (unsigned*)(P.ws + WS_CTL);
    const int* EID = (const int*)(P.ws + AR_EID); int* DEST = (int*)(P.ws + AR_DEST);
    const bf16* HN = (const bf16*)(P.ws + WS_HN); bf16* XS = (bf16*)(P.ws + AR_XS);
    LAS int* cnt = (LAS int*)c.lds; LAS int* pstart = cnt + 32; LAS unsigned* hist = (LAS unsigned*)(cnt + 64); LAS unsigned* base = hist + 32; LAS unsigned* lcnt = base + 32; LAS int* dl = (LAS int*)(lcnt + 32);
    __syncthreads();
    if (c.tid < 32) cnt[c.tid] = (int)ctl[CW_CNT + layer * CW_LSTRIDE + c.tid];
    __syncthreads();
    if (c.tid == 0) { int acc = 0; for (int e = 0; e < 32; ++e) { pstart[e] = acc; acc += (cnt[e] + 255) & ~255; }
        if (c.blk == 0) { ctl[CW_NT + layer * CW_LSTRIDE] = (unsigned)(acc >> 8);
            for (int e = 0; e < 32; ++e) { const int t0 = pstart[e] >> 8, t1 = (pstart[e] + ((cnt[e] + 255) & ~255)) >> 8; for (int t = t0; t < t1; ++t) ctl[CW_TE + layer * CW_TE_STRIDE + t] = (unsigned)e; } } }
    __syncthreads();
    for (int tb = c.blk; tb < NTOK / 128; tb += c.G) {
        if (c.tid < 32) { hist[c.tid] = 0u; lcnt[c.tid] = 0u; }
        __syncthreads();
        int e = 0, t = 0;
        if (c.tid < 256) { t = tb * 128 + (c.tid >> 1); e = EID[2 * t + (c.tid & 1)]; lds_add(&hist[e], 1u); }
        __syncthreads();
        if (c.tid < 32) base[c.tid] = hist[c.tid] ? atomicAdd(ctl + CW_CUR + layer * CW_LSTRIDE + c.tid, hist[c.tid]) : 0u;
        __syncthreads();
        if (c.tid < 256) { const unsigned rank = lds_add(&lcnt[e], 1u); const int d = pstart[e] + (int)base[e] + (int)rank; DEST[2 * t + (c.tid & 1)] = d; dl[c.tid] = d; }
        __syncthreads();
        for (int a = c.wave * 32; a < c.wave * 32 + 32; ++a) { const int tt = tb * 128 + (a >> 1), d = dl[a];
            const v4u* s = (const v4u*)(HN + (size_t)tt * 1024) + c.lane; v4u* o = (v4u*)(XS + (size_t)d * 1024) + c.lane;
            const v4u x0 = s[0], x1 = s[64]; o[0] = x0; o[64] = x1; }
        __syncthreads();
    }
    for (int e = 0; e < 32; ++e) { const int npad = ((cnt[e] + 255) & ~255) - cnt[e], r0 = pstart[e] + cnt[e];
        for (int r = c.gw; r < npad; r += c.NGW) { v4u* o = (v4u*)(XS + (size_t)(r0 + r) * 1024) + c.lane; const v4u z = {0u, 0u, 0u, 0u}; o[0] = z; o[64] = z; } }
}
DI void phase_combine(const Ctx& c0, const PV& P) {
    const Ctx c = relaunder(c0);
    const int* DEST = (const int*)(P.ws + AR_DEST); const float* GATE = (const float*)(P.ws + AR_GATE); const bf16* Y = (const bf16*)(P.ws + AR_XS);
    for (int t = c.gw; t < NTOK; t += c.NGW) { const int d0 = DEST[2 * t], d1 = DEST[2 * t + 1]; const float g0 = GATE[2 * t], g1 = GATE[2 * t + 1];
        f32x4* op = (f32x4*)(P.out + (size_t)t * 1024) + c.lane; const v2u* y0 = (const v2u*)(Y + (size_t)d0 * 1024) + c.lane; const v2u* y1 = (const v2u*)(Y + (size_t)d1 * 1024) + c.lane;
#pragma unroll
        for (int j = 0; j < 4; ++j) { f32x4 o = op[64 * j]; const v2u a = y0[64 * j], b = y1[64 * j];
            o.x += g0 * bflo(a.x) + g1 * bflo(b.x); o.y += g0 * bfhi(a.x) + g1 * bfhi(b.x); o.z += g0 * bflo(a.y) + g1 * bflo(b.y); o.w += g0 * bfhi(a.y) + g1 * bfhi(b.y); op[64 * j] = o; } }
}

DI void phase_dsaprep(const Ctx& c0, const PV& P) {
    const Ctx c = relaunder(c0);
    const bf16* PROJ = (const bf16*)(P.ws + AR_PROJ); bf16* KN = (bf16*)(P.ws + AR_KN); bf16* KIN = (bf16*)(P.ws + AR_KIN); bf16* QIW = (bf16*)(P.ws + AR_QIW);
    const float* WI = (const float*)(P.ws + AR_WI); const float* kg = pin(P, I_DSA_K_NORM);
    const int l = c.lane;
    for (int row = c.gw; row < NTOK; row += c.NGW) {
        const int col = l < 8 ? 768 + 8 * l : (l < 16 ? 1216 + 8 * (l - 8) : 960 + 8 * (l - 16));
        float f[8] = {0.f, 0.f, 0.f, 0.f, 0.f, 0.f, 0.f, 0.f};
        if (l < 48) unpack8(*(const v4u*)(PROJ + (size_t)row * 1536 + col), f);
        float ss = 0.f;
#pragma unroll
        for (int j = 0; j < 8; ++j) ss += f[j] * f[j];
        ss += __shfl_xor(ss, 1); ss += __shfl_xor(ss, 2); ss += __shfl_xor(ss, 4);
        const float r = 1.0f / sqrtf(ss * (1.0f / 64.0f) + EPS);
        if (l < 8) {
#pragma unroll
            for (int j = 0; j < 8; ++j) f[j] = f[j] * r * kg[8 * l + j];
            *(v4u*)(KN + (size_t)row * 64 + 8 * l) = pack8(f);
        } else if (l < 16) {
#pragma unroll
            for (int j = 0; j < 8; ++j) f[j] *= r;
            *(v4u*)(KIN + (size_t)row * 64 + 8 * (l - 8)) = pack8(f);
        } else if (l < 48) {
            const float w = WI[(size_t)row * 4 + ((l - 16) >> 3)] * 0.125f;
#pragma unroll
            for (int j = 0; j < 8; ++j) f[j] *= w;
            *(v4u*)(QIW + (size_t)row * 256 + 8 * (l - 16)) = pack8(f);
        }
    }
}
DI int dpp_scan_add(int v) {
    v += __builtin_amdgcn_update_dpp(0, v, 0x111, 0xf, 0xf, true); v += __builtin_amdgcn_update_dpp(0, v, 0x112, 0xf, 0xf, true);
    v += __builtin_amdgcn_update_dpp(0, v, 0x114, 0xf, 0xf, true); v += __builtin_amdgcn_update_dpp(0, v, 0x118, 0xf, 0xf, true);
    v += __builtin_amdgcn_update_dpp(0, v, 0x142, 0xa, 0xf, false); v += __builtin_amdgcn_update_dpp(0, v, 0x143, 0xc, 0xf, false);
    return v;
}
DI unsigned dpp_scan_max(unsigned v) {
#define DPPMAX_(ctrl, rm, bc) { const unsigned o_ = (unsigned)__builtin_amdgcn_update_dpp(0, (int)v, ctrl, rm, 0xf, bc); v = v > o_ ? v : o_; }
    DPPMAX_(0x111, 0xf, true) DPPMAX_(0x112, 0xf, true) DPPMAX_(0x114, 0xf, true) DPPMAX_(0x118, 0xf, true) DPPMAX_(0x142, 0xa, false) DPPMAX_(0x143, 0xc, false)
#undef DPPMAX_
    return v;
}
DI unsigned idx_compact(LAS unsigned* qb, LAS unsigned* hist, int n, int lane) {
    unsigned e[8];
#pragma unroll
    for (int i = 0; i < 8; ++i) { const int idx = lane + 64 * i; e[i] = idx < n ? qb[idx] : 0u; }
    unsigned prefix = 0u, maskbits = 0u; int want = 256;
#pragma unroll
    for (int pass = 0; pass < 4; ++pass) { const int shift = 24 - 8 * pass;
        *(LAS v4u*)(hist + 4 * lane) = (v4u){0u, 0u, 0u, 0u};
        LDS_WAIT();
#pragma unroll
        for (int i = 0; i < 8; ++i) if (e[i] != 0u && (e[i] & maskbits) == prefix) lds_add(&hist[255u - ((e[i] >> shift) & 255u)], 1u);
        LDS_WAIT();
        const v4u h4 = *(const LAS v4u*)(hist + 4 * lane);
        LDS_WAIT();
        const int s = (int)(h4.x + h4.y + h4.z + h4.w);
        const int c0 = dpp_scan_add(s) - s, c1 = c0 + (int)h4.x, c2 = c1 + (int)h4.y, c3 = c2 + (int)h4.z;
        int fb = -1, fa = 0;
        if (c0 < want && want <= c0 + (int)h4.x) { fb = 0; fa = c0; }
        else if (c1 < want && want <= c1 + (int)h4.y) { fb = 1; fa = c1; }
        else if (c2 < want && want <= c2 + (int)h4.z) { fb = 2; fa = c2; }
        else if (c3 < want && want <= c3 + (int)h4.w) { fb = 3; fa = c3; }
        const unsigned long long m = __ballot(fb >= 0);
        const int src = m ? (int)__builtin_ctzll(m) : 0;
        const int slot = __builtin_amdgcn_readlane(4 * lane + fb, src), ab = __builtin_amdgcn_readlane(fa, src);
        prefix |= (unsigned)(255 - slot) << shift; maskbits |= 0xFFu << shift; want -= ab;
    }
    int base = 0;
#pragma unroll
    for (int i = 0; i < 8; ++i) { const bool pred = e[i] >= prefix && e[i] != 0u; const unsigned long long m = __ballot(pred);
        const int pos = base + (int)__builtin_amdgcn_mbcnt_hi((unsigned)(m >> 32), __builtin_amdgcn_mbcnt_lo((unsigned)m, 0u));
        if (pred) qb[pos] = e[i];
        base += (int)__builtin_popcountll(m); }
    LDS_WAIT();
    return prefix;
}
DI int idx_compact_coarse(LAS unsigned* qb, LAS unsigned* hist, int n, unsigned lo, unsigned& tau, int lane) {
    unsigned e[8]; unsigned mx = 0u;
#pragma unroll
    for (int i = 0; i < 8; ++i) { const int idx = lane + 64 * i; e[i] = idx < n ? qb[idx] : 0u; mx = e[i] > mx ? e[i] : mx; }
    const unsigned hi = (unsigned)__builtin_amdgcn_readlane((int)dpp_scan_max(mx), 63);
    const unsigned range = hi - lo;
    const int sh = range >= 256u ? (24 - (int)__builtin_clz(range)) : 0;
    *(LAS v4u*)(hist + 4 * lane) = (v4u){0u, 0u, 0u, 0u};
    LDS_WAIT();
#pragma unroll
    for (int i = 0; i < 8; ++i) if (e[i] != 0u) lds_add(&hist[255u - ((e[i] - lo) >> sh)], 1u);
    LDS_WAIT();
    const v4u h4 = *(const LAS v4u*)(hist + 4 * lane);
    LDS_WAIT();
    const int s = (int)(h4.x + h4.y + h4.z + h4.w);
    const int c0 = dpp_scan_add(s) - s, c1 = c0 + (int)h4.x, c2 = c1 + (int)h4.y, c3 = c2 + (int)h4.z;
    int fb = -1, fk = 0;
    if (c0 < 256 && 256 <= c0 + (int)h4.x) { fb = 0; fk = c0 + (int)h4.x; }
    else if (c1 < 256 && 256 <= c1 + (int)h4.y) { fb = 1; fk = c1 + (int)h4.y; }
    else if (c2 < 256 && 256 <= c2 + (int)h4.z) { fb = 2; fk = c2 + (int)h4.z; }
    else if (c3 < 256 && 256 <= c3 + (int)h4.w) { fb = 3; fk = c3 + (int)h4.w; }
    const unsigned long long m = __ballot(fb >= 0);
    const int src = m ? (int)__builtin_ctzll(m) : 0;
    const int slot = __builtin_amdgcn_readlane(4 * lane + fb, src), kept = __builtin_amdgcn_readlane(fk, src);
    if (kept > 352) { tau = idx_compact(qb, hist, n, lane); return 256; }
    const unsigned edge = lo + ((unsigned)(255 - slot) << sh);
    int base = 0;
#pragma unroll
    for (int i = 0; i < 8; ++i) { const bool pred = e[i] >= edge && e[i] != 0u; const unsigned long long mm = __ballot(pred);
        const int pos = base + (int)__builtin_amdgcn_mbcnt_hi((unsigned)(mm >> 32), __builtin_amdgcn_mbcnt_lo((unsigned)mm, 0u));
        if (pred) qb[pos] = e[i];
        base += (int)__builtin_popcountll(mm); }
    LDS_WAIT();
    tau = edge - 1u;
    return base;
}
template <int SHADOW> DI void phase_indexer(const Ctx& c0, const PV& P) {
    const Ctx c = relaunder(c0);
    const bf16* KIN = (const bf16*)(P.ws + AR_KIN); const bf16* QIW = (const bf16*)(P.ws + AR_QIW); const float* WI = (const float*)(P.ws + AR_WI); int* SEL = (int*)(P.ws + (SHADOW ? WS_AR + 272 * MiB : AR_SEL));
    LAS unsigned* buf = (LAS unsigned*)(c.lds + c.wave * 17408);
    LAS unsigned* hist = buf + 4096;
    const int lane = c.lane, hh = lane >> 5, l31 = lane & 31;
    const float INF = __builtin_inff();
    for (int pair = c.blk; pair < 256; pair += c.G) {
        const int b = pair >> 7, jj = pair & 127;
        for (int half = 0; half < 2; ++half) {
            const int unit = half ? (255 - jj) : jj, t0w = unit * 64 + c.wave * 8, rowbase = b * SEQ;
            bf16x8 A[4];
#pragma unroll
            for (int ks = 0; ks < 4; ++ks) A[ks] = *(const bf16x8*)(QIW + (size_t)(rowbase + t0w + (l31 >> 2)) * 256 + (l31 & 3) * 64 + 16 * ks + 8 * hh);
            float lo[4][4], hi[4][4]; unsigned tau[4]; int cnt[4], tq[4];
#pragma unroll
            for (int j = 0; j < 4; ++j) { tq[j] = t0w + 2 * j + hh; tau[j] = 0u; cnt[j] = 0;
                const f32x4 w = *(const f32x4*)(WI + (size_t)(rowbase + tq[j]) * 4);
#pragma unroll
                for (int i = 0; i < 4; ++i) { lo[j][i] = w[i] > 0.f ? 0.f : -INF; hi[j][i] = w[i] > 0.f ? INF : 0.f; } }
            const int nstep = (t0w + 7) / 64 + 1;
            const bf16* kbase = KIN + (size_t)(rowbase + l31) * 64 + 8 * hh;
            bf16x8 Bn[2][4];
#pragma unroll
            for (int u = 0; u < 2; ++u)
#pragma unroll
                for (int ks = 0; ks < 4; ++ks) Bn[u][ks] = *(const bf16x8*)(kbase + (size_t)(32 * u) * 64 + 16 * ks);
            for (int step = 0; step < nstep; ++step) {
                bf16x8 B[2][4];
#pragma unroll
                for (int u = 0; u < 2; ++u)
#pragma unroll
                    for (int ks = 0; ks < 4; ++ks) B[u][ks] = Bn[u][ks];
                if (SHADOW != 2 && step + 1 < nstep) {
#pragma unroll
                    for (int u = 0; u < 2; ++u)
#pragma unroll
                        for (int ks = 0; ks < 4; ++ks) Bn[u][ks] = *(const bf16x8*)(kbase + (size_t)(64 * (step + 1) + 32 * u) * 64 + 16 * ks);
                }
                f32x16 acc[2];
#pragma unroll
                for (int u = 0; u < 2; ++u) {
#pragma unroll
                    for (int i = 0; i < 16; ++i) acc[u][i] = 0.f; }
#pragma unroll
                for (int ks = 0; ks < 4; ++ks) {
#pragma unroll
                    for (int u = 0; u < 2; ++u) acc[u] = __builtin_amdgcn_mfma_f32_32x32x16_bf16(A[ks], B[u][ks], acc[u], 0, 0, 0); }
#pragma unroll
                for (int u = 0; u < 2; ++u) {
                    const int s = step * 64 + 32 * u + l31;
#pragma unroll
                    for (int j = 0; j < 4; ++j) {
                        const float sc = (__builtin_amdgcn_fmed3f(acc[u][4 * j], lo[j][0], hi[j][0]) + __builtin_amdgcn_fmed3f(acc[u][4 * j + 1], lo[j][1], hi[j][1]))
                                       + (__builtin_amdgcn_fmed3f(acc[u][4 * j + 2], lo[j][2], hi[j][2]) + __builtin_amdgcn_fmed3f(acc[u][4 * j + 3], lo[j][3], hi[j][3]));
                        unsigned uu = __float_as_uint(sc); uu ^= (unsigned)((int)uu >> 31) | 0x80000000u;
                        unsigned key = (uu & 0xFFFFC000u) | (unsigned)(16383 - s);
                        if (s > tq[j]) key = 0u;
                        const bool pred = key > tau[j];
                        const unsigned long long m = __ballot(pred);
                        if (m) { const unsigned hm = hh ? (unsigned)(m >> 32) : (unsigned)m;
                            const int rank = __builtin_popcount(hm & ((1u << l31) - 1u));
                            if (pred) buf[(2 * j + hh) * 512 + cnt[j] + rank] = key;
                            cnt[j] += __builtin_popcount(hm); }
                    }
                }
#pragma unroll
                for (int j = 0; j < 4; ++j) {
                    const unsigned long long mm = __ballot(cnt[j] > 448);
                    if (SHADOW == 1) { if (cnt[j] > 448) cnt[j] = 256; continue; }
                    if (mm & 1ull) { const int n = __builtin_amdgcn_readlane(cnt[j], 0); const unsigned lo0 = (unsigned)__builtin_amdgcn_readlane((int)tau[j], 0); LDS_WAIT();
                        unsigned T; const int k = idx_compact_coarse(buf + (2 * j) * 512, hist, n, lo0, T, lane); if (hh == 0) { tau[j] = T; cnt[j] = k; } }
                    if ((mm >> 32) & 1ull) { const int n = __builtin_amdgcn_readlane(cnt[j], 32); const unsigned lo1 = (unsigned)__builtin_amdgcn_readlane((int)tau[j], 32); LDS_WAIT();
                        unsigned T; const int k = idx_compact_coarse(buf + (2 * j + 1) * 512, hist, n, lo1, T, lane); if (hh == 1) { tau[j] = T; cnt[j] = k; } }
                }
            }
            LDS_WAIT();
#pragma unroll
            for (int j = 0; j < 4; ++j) {
#pragma unroll
                for (int h2 = 0; h2 < 2; ++h2) {
                    int n = __builtin_amdgcn_readlane(cnt[j], h2 * 32);
                    LAS unsigned* qb = buf + (2 * j + h2) * 512;
                    if (n > 256) { (void)idx_compact(qb, hist, n, lane); n = 256; }
                    int* sp = SEL + (size_t)(rowbase + t0w + 2 * j + h2) * 256;
#pragma unroll
                    for (int i = 0; i < 4; ++i) { const int idx = lane + 64 * i; sp[idx] = idx < n ? (16383 - (int)(qb[idx] & 0x3FFFu)) : -1; }
                }
            }
            LDS_WAIT();
        }
    }
}
DI int t5_bucket(int d) {
    if (d < 16) return d;
    return 16 + (d >= 19) + (d >= 21) + (d >= 24) + (d >= 27) + (d >= 31) + (d >= 35) + (d >= 40) + (d >= 46) + (d >= 52) + (d >= 59) + (d >= 67) + (d >= 77) + (d >= 87) + (d >= 99) + (d >= 113);
}
typedef short s16x4 __attribute__((ext_vector_type(4)));
DI void phase_sattn(const Ctx& c0, const PV& P) {
    const Ctx c = relaunder(c0);
    const bf16* PROJ = (const bf16*)(P.ws + AR_PROJ); const bf16* KN = (const bf16*)(P.ws + AR_KN); const int* SEL = (const int*)(P.ws + AR_SEL); bf16* MIX = (bf16*)(P.ws + AR_MIXD);
    const float* qg = pin(P, I_DSA_Q_NORM); const float* rb = pin(P, I_REL_BIAS);
    constexpr int WST = 11264, VRS = 144;
    LAS int* bk = (LAS int*)(c.lds + c.wave * WST);
    LAS int* selL = bk + 256;
    LAS bf16* Vs = (LAS bf16*)(selL + 256);
    LAS float* relb = (LAS float*)(c.lds + 8 * WST);
    const int lane = c.lane, l15 = lane & 15, g = lane >> 4;
    __syncthreads();
    relb[c.tid] = (c.tid & 15) < 12 ? rb[(c.tid >> 4) * 12 + (c.tid & 15)] : 0.f;
    __syncthreads();
    float qgv0[8], qgv1[8];
#pragma unroll
    for (int j = 0; j < 8; ++j) { qgv0[j] = qg[8 * g + j]; qgv1[j] = qg[32 + 8 * g + j]; }
    const LAS bf16* trp = Vs + (4 * g + (l15 >> 2)) * VRS + 4 * (l15 & 3);
    int row = c.gw;
    v4i s4n = {0, 0, 0, 0}; v4u qn0 = {0u, 0u, 0u, 0u}, qn1 = {0u, 0u, 0u, 0u};
    if (row < NTOK) { s4n = *(const v4i*)(SEL + (size_t)row * 256 + 4 * lane);
        if (l15 < 12) { const bf16* qp = PROJ + (size_t)row * 1536 + l15 * 64 + 8 * g; qn0 = *(const v4u*)qp; qn1 = *(const v4u*)(qp + 32); } }
#pragma unroll 1
    for (; row < NTOK; row += c.NGW) {
        const int b = row >> 14, t = row & (SEQ - 1), rowbase = b << 14;
        const v4i s4 = s4n; const v4u w0 = qn0, w1 = qn1;
        { const int nrow = row + c.NGW;
          if (nrow < NTOK) { s4n = *(const v4i*)(SEL + (size_t)nrow * 256 + 4 * lane);
              if (l15 < 12) { const bf16* qp = PROJ + (size_t)nrow * 1536 + l15 * 64 + 8 * g; qn0 = *(const v4u*)qp; qn1 = *(const v4u*)(qp + 32); } } }
        const int sv[4] = {s4.x, s4.y, s4.z, s4.w};
        int bv[4], cv[4];
#pragma unroll
        for (int i = 0; i < 4; ++i) { bv[i] = sv[i] >= 0 ? t5_bucket(t - sv[i]) : -1; cv[i] = sv[i] >= 0 ? sv[i] : 0; }
        *(LAS v4i*)(bk + 4 * lane) = (v4i){bv[0], bv[1], bv[2], bv[3]};
        *(LAS v4i*)(selL + 4 * lane) = (v4i){cv[0], cv[1], cv[2], cv[3]};
        float q0[8], q1[8]; unpack8(w0, q0); unpack8(w1, q1);
        float ss = 0.f;
#pragma unroll
        for (int j = 0; j < 8; ++j) ss += q0[j] * q0[j] + q1[j] * q1[j];
        ss += __shfl_xor(ss, 16); ss += __shfl_xor(ss, 32);
        const float r = 0.125f / sqrtf(ss * (1.0f / 64.0f) + EPS);
#pragma unroll
        for (int j = 0; j < 8; ++j) { q0[j] = q0[j] * r * qgv0[j]; q1[j] = q1[j] * r * qgv1[j]; }
        const bf16x8 B0 = __builtin_bit_cast(bf16x8, pack8(q0)), B1 = __builtin_bit_cast(bf16x8, pack8(q1));
        LDS_WAIT();
        v4u vb[2][8];
#pragma unroll
        for (int i = 0; i < 8; ++i) { const int sk = selL[4 * i + g]; vb[0][i] = *(const v4u*)(PROJ + (size_t)(rowbase + sk) * 1536 + 832 + 8 * l15); }
        f32x4 S[16];
#pragma unroll
        for (int hb = 0; hb < 2; ++hb) {
            bf16x8 A0[8], A1[8];
#pragma unroll
            for (int k8 = 0; k8 < 8; ++k8) { const int sk = selL[16 * (8 * hb + k8) + l15]; const bf16* kp = KN + (size_t)(rowbase + sk) * 64 + 8 * g; A0[k8] = *(const bf16x8*)kp; A1[k8] = *(const bf16x8*)(kp + 32); }
#pragma unroll
            for (int k8 = 0; k8 < 8; ++k8) { f32x4 z = {0.f, 0.f, 0.f, 0.f}; z = mfma16(A0[k8], B0, z); S[8 * hb + k8] = mfma16(A1[k8], B1, z); }
            __builtin_amdgcn_sched_barrier(0);
        }
        float mx = -3.0e38f;
#pragma unroll
        for (int kt = 0; kt < 16; ++kt) { const v4i b4 = *(const LAS v4i*)(bk + 16 * kt + 4 * g); const int bb[4] = {b4.x, b4.y, b4.z, b4.w};
#pragma unroll
            for (int i = 0; i < 4; ++i) { const float v = bb[i] >= 0 ? S[kt][i] + relb[bb[i] * 16 + l15] : -3.0e38f; S[kt][i] = v; mx = fmaxf(mx, v); } }
        mx = fmaxf(mx, __shfl_xor(mx, 16)); mx = fmaxf(mx, __shfl_xor(mx, 32));
        float l = 0.f;
#pragma unroll
        for (int kt = 0; kt < 16; ++kt) {
#pragma unroll
            for (int i = 0; i < 4; ++i) { const float p = S[kt][i] > -1.0e38f ? __expf(S[kt][i] - mx) : 0.f; S[kt][i] = p; l += p; } }
        l += __shfl_xor(l, 16); l += __shfl_xor(l, 32);
        f32x4 O[8];
#pragma unroll
        for (int ct = 0; ct < 8; ++ct) O[ct] = (f32x4){0.f, 0.f, 0.f, 0.f};
#pragma unroll
        for (int jb = 0; jb < 8; ++jb) {
            if (jb + 1 < 8) {
#pragma unroll
                for (int i = 0; i < 8; ++i) { const int sk = selL[32 * (jb + 1) + 4 * i + g]; vb[(jb + 1) & 1][i] = *(const v4u*)(PROJ + (size_t)(rowbase + sk) * 1536 + 832 + 8 * l15); } }
#pragma unroll
            for (int i = 0; i < 8; ++i) { const v4u v = vb[jb & 1][i]; LAS v2u* d = (LAS v2u*)(Vs + (4 * i + g) * VRS + 8 * l15); d[0] = (v2u){v.x, v.y}; d[1] = (v2u){v.z, v.w}; }
            v4u pw; pw.x = pk2(S[2 * jb][0], S[2 * jb][1]); pw.y = pk2(S[2 * jb][2], S[2 * jb][3]); pw.z = pk2(S[2 * jb + 1][0], S[2 * jb + 1][1]); pw.w = pk2(S[2 * jb + 1][2], S[2 * jb + 1][3]);
            const bf16x8 Pb = __builtin_bit_cast(bf16x8, pw);
            LDS_WAIT();
#pragma unroll
            for (int ct = 0; ct < 8; ++ct) {
                const s16x4 a = __builtin_amdgcn_ds_read_tr16_b64_v4i16((LAS s16x4*)(trp + 16 * ct));
                const s16x4 bq = __builtin_amdgcn_ds_read_tr16_b64_v4i16((LAS s16x4*)(trp + 16 * VRS + 16 * ct));
                const bf16x8 Af = {a[0], a[1], a[2], a[3], bq[0], bq[1], bq[2], bq[3]};
                O[ct] = mfma16(Af, Pb, O[ct]); }
            LDS_WAIT();
            __builtin_amdgcn_sched_barrier(0);
        }
        if (l15 < 12) { const float il = 1.0f / l; bf16* op = MIX + (size_t)row * 1792 + l15 * 128 + 4 * g;
#pragma unroll
            for (int ct = 0; ct < 8; ++ct) { v2u o; o.x = pk2(O[ct][0] * il, O[ct][1] * il); o.y = pk2(O[ct][2] * il, O[ct][3] * il); *(v2u*)(op + 16 * ct) = o; } }
        LDS_WAIT();
    }
}

#ifndef ONLY
#define ONLY -1
#endif
#define PH(n) (ONLY < 0 || ONLY == (n))
#ifndef REP0
#define REP0 1
#endif
#ifndef REP1
#define REP1 1
#endif
#ifndef REP2
#define REP2 1
#endif
#ifndef REP3
#define REP3 1
#endif
#ifndef REP4
#define REP4 1
#endif
#ifndef REP5
#define REP5 1
#endif
#ifndef REP6
#define REP6 1
#endif
#ifndef REP7
#define REP7 1
#endif
#ifndef REP8
#define REP8 1
#endif
#ifndef REP9
#define REP9 1
#endif
#ifndef REP10
#define REP10 1
#endif
#ifndef REP11
#define REP11 1
#endif
#ifndef REP12
#define REP12 1
#endif
#ifndef REP13
#define REP13 1
#endif
#ifndef REP14
#define REP14 1
#endif
#ifndef REP15
#define REP15 1
#endif
#ifndef REP16
#define REP16 1
#endif
#ifndef REP17
#define REP17 1
#endif
#ifndef REP18
#define REP18 1
#endif
#define RB(n) for (int r_ = 0; r_ < REP##n; ++r_) { if (r_) GRID_BAR();
#define RE }
#define GRID_BAR() xcd_barrier(bar)
template <int layer> DI void layer_body(const Ctx& c, const PV& P, const XcdBarrier& bar) {
    unsigned char* ws = P.ws;
    unsigned* ctl = (unsigned*)(ws + WS_CTL);
    PG8_LAS unsigned char* glds = (PG8_LAS unsigned char*)c.lds;
    const pg8::bf16_t* HN = (const pg8::bf16_t*)(ws + WS_HN);
    RB(0) if (PH(0)) phase_prep<layer>(c, P); RE
    GRID_BAR();
    RB(1) if (PH(1)) {
        { pg8::Gemm g{(const pg8::bf16_t*)(ws + WB_MEMN), (const pg8::bf16_t*)(ws + WB_MKV), 1024, 1024, 1024}; pg8::StaticOrder S; S.init(2, 2, c.G, c.G - 1 - c.blk);
          pg8::EpiBf16<false> E{(pg8::bf16_t*)(ws + WB_MKVO), 512, 0, 0};
          pg8::gemm_phase<pg8::EpiBf16<false>, pg8::StaticOrder, true, true>(glds, g, S, E); }
        __syncthreads();
        if (layer == 0) { pg8::Gemm g{HN, (const pg8::bf16_t*)(ws + WB_WIN), 1024, 1024, 1024}; pg8::StaticOrder S; S.init(128, 7, c.G, c.blk);
          pg8::EpiBf16<true> E{(pg8::bf16_t*)(ws + AR_PROJ), 1792, 3, 6};
          pg8::gemm_phase<pg8::EpiBf16<true>, pg8::StaticOrder, true, true>(glds, g, S, E); }
        else { pg8::Gemm g{HN, (const pg8::bf16_t*)(ws + WB_WIN), 1024, 1024, 1024}; pg8::StaticOrder S; S.init(128, 6, c.G, c.blk);
          pg8::EpiBf16<false> E{(pg8::bf16_t*)(ws + AR_PROJ), 1536, 0, 0};
          pg8::gemm_phase<pg8::EpiBf16<false>, pg8::StaticOrder, true, true>(glds, g, S, E); }
    } RE
    GRID_BAR();
    if (layer == 0) {
        RB(2) if (PH(2)) phase_conv(c, P);
        if (PH(2)) phase_xattn<0, 1792, 1536, 1024, 768>(c, P, (const bf16*)(ws + AR_PROJ), (bf16*)(ws + AR_MIXL)); RE
        GRID_BAR();
        RB(3) if (PH(3)) { pg8::Gemm g{(const pg8::bf16_t*)(ws + AR_XSC), (const pg8::bf16_t*)(ws + WB_WGT), 768, 768, 768}; pg8::StaticOrder S; S.init(128, 6, c.G, c.blk);
          pg8::EpiLruGate E{(pg8::bf16_t*)(ws + AR_LA), (pg8::bf16_t*)(ws + AR_UU), (const pg8::bf16_t*)(ws + AR_XSC), 768, pin(P, I_LRU_B_A), pin(P, I_LRU_B_X), pin(P, I_LRU_LAMBDA)};
          pg8::gemm_phase<pg8::EpiLruGate, pg8::StaticOrder, true, true>(glds, g, S, E); } RE
        GRID_BAR();
        RB(4) if (PH(4)) phase_scanA(c, P); RE
        GRID_BAR();
        RB(5) if (PH(5)) phase_scanB(c, P); RE
        GRID_BAR();
        RB(6) if (PH(6)) phase_scanC(c, P); RE
        GRID_BAR();
        RB(7) if (PH(7)) { pg8::Gemm g{(const pg8::bf16_t*)(ws + AR_MIXL), (const pg8::bf16_t*)(ws + WB_WOUT), 1024, 1024, 1024}; pg8::StaticOrder S; S.init(128, 4, c.G, c.blk);
          pg8::EpiResF32 E{P.out, pin(P, I_X), 1024};
          pg8::gemm_phase<pg8::EpiResF32, pg8::StaticOrder, true, true>(glds, g, S, E); } RE
    } else {
        RB(8) if (PH(8)) phase_dsaprep(c, P);
        if (PH(8)) phase_xattn<1, 1536, 1280, 1792, 1536>(c, P, (const bf16*)(ws + AR_PROJ), (bf16*)(ws + AR_MIXD)); RE
        GRID_BAR();
#ifndef IDX_SHADOW
#define IDX_SHADOW 0
#endif
        RB(9) if (PH(9)) { if (r_ + 1 < REP9) phase_indexer<IDX_SHADOW>(c, P); else phase_indexer<0>(c, P); } RE
        GRID_BAR();
        RB(10) if (PH(10)) phase_sattn(c, P); RE
        GRID_BAR();
        RB(11) if (PH(11)) { pg8::Gemm g{(const pg8::bf16_t*)(ws + AR_MIXD), (const pg8::bf16_t*)(ws + WB_WOUT), 1792, 1792, 1792}; pg8::StaticOrder S; S.init(128, 4, c.G, c.blk);
          pg8::EpiResF32 E{(r_ + 1 < REP11) ? (float*)(ws + WS_AR) : P.out, P.out, 1024};
          pg8::gemm_phase<pg8::EpiResF32, pg8::StaticOrder, true, true>(glds, g, S, E); } RE
    }
    GRID_BAR();
    RB(12) if (PH(12)) phase_norm2<layer>(c, P); RE
    GRID_BAR();
    RB(13) if (PH(13)) { pg8::Gemm g{HN, (const pg8::bf16_t*)(ws + WB_WR), 1024, 1024, 1024}; pg8::StaticOrder S; S.init(128, 1, c.G, c.blk);
      pg8::EpiLogits E{(float*)(ws + AR_LOG)};
      pg8::gemm_phase<pg8::EpiLogits, pg8::StaticOrder, true, true>(glds, g, S, E); } RE
    GRID_BAR();
    if (PH(14)) phase_route<layer>(c, P);
    GRID_BAR();
    if (PH(15)) phase_scatter<layer>(c, P);
    GRID_BAR();
    RB(16) if (PH(16)) { const int ntile = (int)__hip_atomic_load(ctl + CW_NT + layer * CW_LSTRIDE, RLX_AGENT);
        pg8::Gemm g{(const pg8::bf16_t*)(ws + AR_XS), (const pg8::bf16_t*)(ws + WB_WGU), 1024, 1024, 1024}; pg8::GroupedOrder S; S.init(ntile, 4, c.G, c.blk);
        S.te = (const int*)(ctl + CW_TE + layer * CW_TE_STRIDE); S.estride = (size_t)1024 * 1024 * 2;
        pg8::EpiSwiglu E{(pg8::bf16_t*)(ws + AR_ACT), 512};
        pg8::gemm_phase<pg8::EpiSwiglu, pg8::GroupedOrder, true, true>(glds, g, S, E); } RE
    GRID_BAR();
    RB(17) if (PH(17)) { const int ntile = (int)__hip_atomic_load(ctl + CW_NT + layer * CW_LSTRIDE, RLX_AGENT);
        pg8::Gemm g{(const pg8::bf16_t*)(ws + AR_ACT), (const pg8::bf16_t*)(ws + WB_WD), 512, 512, 512}; pg8::GroupedOrder S; S.init(ntile, 4, c.G, c.blk);
        S.te = (const int*)(ctl + CW_TE + layer * CW_TE_STRIDE); S.estride = (size_t)1024 * 512 * 2;
        pg8::EpiBf16<false> E{(pg8::bf16_t*)(ws + AR_XS), 1024, 0, 0};
        pg8::gemm_phase<pg8::EpiBf16<false>, pg8::GroupedOrder, true, true>(glds, g, S, E); } RE
    GRID_BAR();
    if (PH(18)) phase_combine(c, P);
    GRID_BAR();
}
__global__ void __launch_bounds__(512, 2) fwd(const Params P) {
    extern __shared__ __attribute__((aligned(16))) unsigned char lds_raw[];
    Ctx c;
    c.lds = (LAS unsigned char*)lds_raw;
    c.tid = threadIdx.x; c.lane = c.tid & 63; c.wave = __builtin_amdgcn_readfirstlane(c.tid >> 6);
    c.G = gridDim.x; c.blk = blockIdx.x; c.gw = c.blk * 8 + c.wave; c.NGW = c.G * 8;
    volatile LAS unsigned* MISC = (volatile LAS unsigned*)(c.lds + MISC_OFF);
    if (c.tid < 64) MISC[c.tid] = 0u;
    if (c.tid < 29) ((LAS unsigned long long*)(c.lds + MISC_OFF + 512))[c.tid] = (unsigned long long)P.in[c.tid];
    __syncthreads();
    XcdBarrier bar = xcd_barrier_post((unsigned*)(P.ws + WS_CTL) + CW_BAR, MISC + 8);
    PV pv; pv.ws = P.ws; pv.out = P.out; pv.tab = (LAS unsigned long long*)(c.lds + MISC_OFF + 512);
#ifndef ONLY_LAYER
    layer_body<0>(c, pv, bar);
    layer_body<1>(c, pv, bar);
#else
    layer_body<ONLY_LAYER>(c, pv, bar);
#endif
}

extern "C" void kernel_launch(void* const* d_in, const int* in_sizes, int n_in, void* d_out, int out_size, void* d_ws, size_t ws_size, hipStream_t stream) {
    static int grid = 0;
    if (grid == 0) {
        if (n_in != 29 || out_size != NTOK * DM || ws_size < WS_END) { fprintf(stderr, "kernel_launch: unexpected shapes (n_in %d out %d ws %zu need %zu)\n", n_in, out_size, ws_size, (size_t)WS_END); grid = -1; return; }
        int dev = 0, cus = 0, per_cu = 0;
        if (hipGetDevice(&dev) != hipSuccess || hipDeviceGetAttribute(&cus, hipDeviceAttributeMultiprocessorCount, dev) != hipSuccess) { grid = -1; return; }
        if (hipFuncSetAttribute((const void*)fwd, hipFuncAttributeMaxDynamicSharedMemorySize, LDS_BYTES) != hipSuccess) { fprintf(stderr, "kernel_launch: hipFuncSetAttribute failed\n"); grid = -1; return; }
        if (hipOccupancyMaxActiveBlocksPerMultiprocessor(&per_cu, (const void*)fwd, 512, LDS_BYTES) != hipSuccess || per_cu < 1) { fprintf(stderr, "kernel_launch: occupancy query reports %d\n", per_cu); }
        (void)hipGetLastError();
        grid = cus;
    }
    if (grid < 0) return;
    if (hipMemsetAsync((char*)d_ws + WS_CTL, 0, CTL_ZERO_BYTES, stream) != hipSuccess) return;
    Params p{};
    for (int i = 0; i < 29; ++i) p.in[i] = (const float*)d_in[i];
    p.out = (float*)d_out; p.ws = (unsigned char*)d_ws;
    hipLaunchKernelGGL(fwd, dim3(grid), dim3(512), LDS_BYTES, stream, p);
}
```

```cpp
#include <hip/hip_runtime.h>
#include <cstdio>
#include <cstdint>
namespace pg8 {
#define PG8_LAS __attribute__((address_space(3)))
typedef unsigned short bf16_t;
typedef short bf16x8 __attribute__((ext_vector_type(8)));
typedef float f32x4 __attribute__((ext_vector_type(4)));
typedef float f32x2 __attribute__((ext_vector_type(2)));
typedef unsigned u32x4 __attribute__((ext_vector_type(4)));
constexpr int BM = 256, BK = 64, HALF = 128, HTB = HALF * BK * 2  , STAGE_BYTES = 8 * HTB, NXCD = 8, WGM = 8;

__host__ __device__ __forceinline__ int lds_byte(int r, int c) { const int st = (r >> 4) * 2 + (c >> 5), rr = r & 15, cc = c & 31, ob = rr * 64 + cc * 2; return st * 1024 + (ob ^ (((ob >> 9) & 1) << 5)); }
__host__ __device__ __forceinline__ void stage_rc(int b, int& R, int& C) { const int st = b / 1024, sb = b % 1024, swz = sb ^ (((sb >> 9) & 1) << 5); R = (st >> 1) * 16 + swz / 64; C = (st & 1) * 32 + (swz % 64) / 2; }
__host__ __device__ __forceinline__ int perm32(int rho) { const int n = rho >> 4, i = rho & 15; return 8 * (i >> 2) + 4 * n + (i & 3); }

struct Unit { int pm, pn; size_t boff; };
struct Gemm { const bf16_t* A; const bf16_t* Bt; int lda, ldb, K; };

struct StaticOrder {
    int nM, nN, nwg, G, c;
    __host__ __device__ void init(int nM_, int nN_, int G_, int c_) { nM = nM_; nN = nN_; nwg = nM * nN; G = G_; c = c_; }
    __host__ __device__ bool next(int i, Unit& u) const {
        const long L = (long)i * G + c; if (L >= nwg) return false;
        int wgid = (int)L; { const int q = nwg / NXCD, r = nwg % NXCD, xcd = wgid % NXCD, off = wgid / NXCD; wgid = (xcd < r ? xcd * (q + 1) : r * (q + 1) + (xcd - r) * q) + off; }
        const int nig = WGM * nN, gid = wgid / nig, fm = gid * WGM, gsz = (nM - fm) < WGM ? (nM - fm) : WGM;
        u.pm = fm + ((wgid % nig) % gsz); u.pn = (wgid % nig) / gsz; u.boff = 0; return true;
    }
    __device__ __forceinline__ void a_ready(const Unit&) const {}
    __device__ __forceinline__ void done(const Unit&) const {}
};
struct GroupedOrder : StaticOrder {
    const int* te; size_t estride;
    __device__ bool next(int i, Unit& u) const { if (!StaticOrder::next(i, u)) return false; u.boff = (size_t)te[u.pm] * estride; return true; }
};

__device__ __forceinline__ unsigned cvt_pk_bf16(float lo, float hi) { unsigned r; asm volatile("v_cvt_pk_bf16_f32 %0, %1, %2" : "=v"(r) : "v"(lo), "v"(hi)); return r; }
__device__ __forceinline__ float bf_lo(unsigned w) { return __uint_as_float(w << 16); }
__device__ __forceinline__ float bf_hi(unsigned w) { return __uint_as_float(w & 0xffff0000u); }
__device__ __forceinline__ float sigmoidf_(float v) { return __builtin_amdgcn_rcpf(1.0f + __expf(-v)); }
__device__ __forceinline__ float gelu_tanh(float v) { const float z = 1.5957691216057308f * (v + 0.044715f * v * v * v); return v * sigmoidf_(z); }

template <bool GELU> struct EpiBf16 {
    static constexpr bool PERM = true, AFTER_DRAIN = false;
    bf16_t* O; int ldc; int gelu_lo, gelu_hi;
    __device__ __forceinline__ void operator()(const f32x4 (&acc)[2][2][4][2], const Unit& u, int wr, int wc, int fr, int fq) const {
        const int row0 = u.pm * BM + wr * 64 + fr, col0 = u.pn * BM + wc * 32 + 8 * fq;
        const bool act = GELU && (u.pn >= gelu_lo && u.pn < gelu_hi);
#pragma unroll
        for (int ai = 0; ai < 2; ++ai)
#pragma unroll
            for (int m = 0; m < 4; ++m) { bf16_t* rowp = O + (size_t)(row0 + ai * HALF + m * 16) * ldc + col0;
#pragma unroll
                for (int bj = 0; bj < 2; ++bj) { f32x4 v0 = acc[ai][bj][m][0], v1 = acc[ai][bj][m][1];
                    if (act) {
#pragma unroll
                        for (int j = 0; j < 4; ++j) { v0[j] = gelu_tanh(v0[j]); v1[j] = gelu_tanh(v1[j]); } }
                    u32x4 w; w.x = cvt_pk_bf16(v0[0], v0[1]); w.y = cvt_pk_bf16(v0[2], v0[3]); w.z = cvt_pk_bf16(v1[0], v1[1]); w.w = cvt_pk_bf16(v1[2], v1[3]);
                    *(u32x4*)(rowp + bj * HALF) = w; } }
    }
};
struct EpiSwiglu {
    static constexpr bool PERM = true, AFTER_DRAIN = false;
    bf16_t* O; int ldc;
    __device__ __forceinline__ void operator()(const f32x4 (&acc)[2][2][4][2], const Unit& u, int wr, int wc, int fr, int fq) const {
        const int row0 = u.pm * BM + wr * 64 + fr, col0 = u.pn * HALF + wc * 32 + 8 * fq;
#pragma unroll
        for (int ai = 0; ai < 2; ++ai)
#pragma unroll
            for (int m = 0; m < 4; ++m) { bf16_t* rowp = O + (size_t)(row0 + ai * HALF + m * 16) * ldc + col0;
                f32x4 v0, v1;
#pragma unroll
                for (int j = 0; j < 4; ++j) { const float g0 = acc[ai][0][m][0][j], g1 = acc[ai][0][m][1][j];
                    v0[j] = g0 * sigmoidf_(g0) * acc[ai][1][m][0][j]; v1[j] = g1 * sigmoidf_(g1) * acc[ai][1][m][1][j]; }
                u32x4 w; w.x = cvt_pk_bf16(v0[0], v0[1]); w.y = cvt_pk_bf16(v0[2], v0[3]); w.z = cvt_pk_bf16(v1[0], v1[1]); w.w = cvt_pk_bf16(v1[2], v1[3]);
                *(u32x4*)rowp = w; }
    }
};
struct EpiLruGate {
    static constexpr bool PERM = true, AFTER_DRAIN = false;
    bf16_t* LA; bf16_t* U; const bf16_t* XS; int ldc; const float* b_a; const float* b_x; const float* lam;
    __device__ __forceinline__ void operator()(const f32x4 (&acc)[2][2][4][2], const Unit& u, int wr, int wc, int fr, int fq) const {
        const int row0 = u.pm * BM + wr * 64 + fr, ch0 = u.pn * HALF + wc * 32 + 8 * fq;
        float ba[8], bx[8], sp8[8];
#pragma unroll
        for (int j = 0; j < 8; ++j) { ba[j] = b_a[ch0 + j]; bx[j] = b_x[ch0 + j]; const float l = lam[ch0 + j];
            sp8[j] = 8.0f * ((l > 15.f) ? __expf(-l) : __logf(1.0f + __expf(-l))); }
#pragma unroll
        for (int ai = 0; ai < 2; ++ai)
#pragma unroll
            for (int m = 0; m < 4; ++m) { const size_t off = (size_t)(row0 + ai * HALF + m * 16) * ldc + ch0;
                const u32x4 xw = *(const u32x4*)(XS + off);
                float xv[8] = {bf_lo(xw.x), bf_hi(xw.x), bf_lo(xw.y), bf_hi(xw.y), bf_lo(xw.z), bf_hi(xw.z), bf_lo(xw.w), bf_hi(xw.w)};
                float la[8], uu[8];
#pragma unroll
                for (int j = 0; j < 8; ++j) { const float rp = acc[ai][0][m][j >> 2][j & 3] + ba[j], ip = acc[ai][1][m][j >> 2][j & 3] + bx[j];
                    const float r = sigmoidf_(rp), ig = sigmoidf_(ip);
                    const float l = -sp8[j] * r; const float t = 2.0f * l;
                    const float om = (t > -0.02f) ? -t * (1.0f + t * (0.5f + t * (0.16666667f + t * 0.041666667f))) : 1.0f - __expf(t);
                    la[j] = l; uu[j] = sqrtf(om) * ig * xv[j]; }
                u32x4 w; w.x = cvt_pk_bf16(la[0], la[1]); w.y = cvt_pk_bf16(la[2], la[3]); w.z = cvt_pk_bf16(la[4], la[5]); w.w = cvt_pk_bf16(la[6], la[7]);
                *(u32x4*)(LA + off) = w;
                u32x4 w2; w2.x = cvt_pk_bf16(uu[0], uu[1]); w2.y = cvt_pk_bf16(uu[2], uu[3]); w2.z = cvt_pk_bf16(uu[4], uu[5]); w2.w = cvt_pk_bf16(uu[6], uu[7]);
                *(u32x4*)(U + off) = w2; __builtin_amdgcn_sched_barrier(0); }
    }
};
struct EpiResF32 {
    static constexpr bool PERM = false, AFTER_DRAIN = false;
    float* C; const float* R; int ldc;
    __device__ __forceinline__ void operator()(const f32x4 (&acc)[2][2][4][2], const Unit& u, int wr, int wc, int fr, int fq) const {
        const int row0 = u.pm * BM + wr * 64 + fr, col0 = u.pn * BM + wc * 32 + 4 * fq;
#pragma unroll
        for (int ai = 0; ai < 2; ++ai)
#pragma unroll
            for (int m = 0; m < 4; ++m) { const size_t ro = (size_t)(row0 + ai * HALF + m * 16) * ldc + col0;
#pragma unroll
                for (int bj = 0; bj < 2; ++bj)
#pragma unroll
                    for (int n = 0; n < 2; ++n) { const f32x4 r = *(const f32x4*)(R + ro + bj * HALF + n * 16); *(f32x4*)(C + ro + bj * HALF + n * 16) = r + acc[ai][bj][m][n]; }  __builtin_amdgcn_sched_barrier(0); }
    }
};
struct EpiLogits {
    static constexpr bool PERM = false, AFTER_DRAIN = false;
    float* C;
    __device__ __forceinline__ void operator()(const f32x4 (&acc)[2][2][4][2], const Unit& u, int wr, int wc, int fr, int fq) const {
        if (wc >= 2 || u.pn != 0) return;
        const int row0 = u.pm * BM + wr * 64 + fr, col0 = wc * 32 + 4 * fq;
#pragma unroll
        for (int ai = 0; ai < 2; ++ai)
#pragma unroll
            for (int m = 0; m < 4; ++m) { float* rowp = C + (size_t)(row0 + ai * HALF + m * 16) * 64 + col0;
#pragma unroll
                for (int n = 0; n < 2; ++n) *(f32x4*)(rowp + n * 16) = acc[ai][0][m][n]; }
    }
};
template <class Epi, class Sched, bool ALIGN_EPI = false, bool SP2 = false>
__device__ __forceinline__ void gemm_phase(PG8_LAS unsigned char* lds, const Gemm g, const Sched& S, const Epi& E) {
    int tid_ = threadIdx.x; asm volatile("" : "+v"(tid_));
    const int tid = tid_, wid = __builtin_amdgcn_readfirstlane(tid >> 6), lane = tid & 63, wr = wid >> 2, wc = wid & 3, fr = lane & 15, fq = lane >> 4;
    const int K = g.K, nt = K / BK;
    unsigned voffA[2], voffB[2];
#pragma unroll
    for (int i = 0; i < 2; ++i) { int R, C; stage_rc(tid * 16 + i * 8192, R, C); const int Rb = Epi::PERM ? ((R & ~31) + perm32(R & 31)) : R;
        voffA[i] = (unsigned)(R * g.lda + C) * 2u; voffB[i] = (unsigned)(Rb * g.ldb + C) * 2u; }
    const size_t kstep = (size_t)(BK * 2);
    const size_t hsA = (size_t)HALF * g.lda * 2, hsB = (size_t)HALF * g.ldb * 2;
    const size_t tsA = 2 * hsA, tsB = 2 * hsB;
    const unsigned ldsw = (unsigned)wid * 1024u;
    const int aoff = lds_byte(wr * 64 + fr, fq * 8), boff = lds_byte(wc * 32 + fr, fq * 8);
#define PG8_SA(b, h) (((b) * 2 + (h)) * HTB)
#define PG8_SB(b, h) ((4 + (b) * 2 + (h)) * HTB)
#define PG8_STAGE(bufoff, gbase, voff) do { _Pragma("unroll") for (int _i = 0; _i < 2; ++_i) \
        __builtin_amdgcn_global_load_lds((const unsigned*)((const char*)(gbase) + (voff)[_i]), (PG8_LAS unsigned*)(lds + (bufoff) + ldsw + _i * 8192), 16, 0, 0); } while (0)
#define PG8_LDA(dst, b, h) do { _Pragma("unroll") for (int m = 0; m < 4; ++m) _Pragma("unroll") for (int k = 0; k < 2; ++k) dst[m][k] = *(const PG8_LAS bf16x8*)(lds + PG8_SA(b, h) + aoff + m * 2048 + k * 1024); } while (0)
#define PG8_LDB(dst, b, h) do { _Pragma("unroll") for (int n = 0; n < 2; ++n) _Pragma("unroll") for (int k = 0; k < 2; ++k) dst[n][k] = *(const PG8_LAS bf16x8*)(lds + PG8_SB(b, h) + boff + n * 2048 + k * 1024); } while (0)
#define PG8_MMA(ai, bj, At, Bt) do { __builtin_amdgcn_s_setprio(1); _Pragma("unroll") for (int m = 0; m < 4; ++m) _Pragma("unroll") for (int n = 0; n < 2; ++n) _Pragma("unroll") for (int k = 0; k < 2; ++k) \
        acc[ai][bj][m][n] = __builtin_amdgcn_mfma_f32_16x16x32_bf16(Bt[n][k], At[m][k], acc[ai][bj][m][n], 0, 0, 0); __builtin_amdgcn_s_setprio(0); } while (0)
#define PG8_WAIT_V(n) asm volatile("s_waitcnt vmcnt(" #n ")" ::: "memory")
#define PG8_WAIT_L(n) asm volatile("s_waitcnt lgkmcnt(" #n ")" ::: "memory")
#define PG8_BAR __builtin_amdgcn_s_barrier()
#define PG8_SCHED __builtin_amdgcn_sched_barrier(0)
    Unit cur, nxt; int ui = 0;
    if (!S.next(0, cur)) return;
    f32x4 acc[2][2][4][2];
#pragma unroll
    for (int a = 0; a < 2; ++a)
#pragma unroll
        for (int b = 0; b < 2; ++b)
#pragma unroll
            for (int m = 0; m < 4; ++m)
#pragma unroll
                for (int n = 0; n < 2; ++n) acc[a][b][m][n] = (f32x4){0.f, 0.f, 0.f, 0.f};
    bf16x8 At[4][2], B0[2][2], B1[2][2];
    const char* cA = (const char*)g.A + (size_t)cur.pm * tsA; const char* cB = (const char*)g.Bt + cur.boff + (size_t)cur.pn * tsB;
    S.a_ready(cur);
    if constexpr (SP2) {
        PG8_STAGE(PG8_SB(0, 0), cB, voffB); PG8_STAGE(PG8_SB(0, 1), cB + hsB, voffB); PG8_STAGE(PG8_SA(0, 0), cA, voffA); PG8_STAGE(PG8_SA(0, 1), cA + hsA, voffA);
        if (wr == 1) PG8_BAR;
        PG8_WAIT_V(2); PG8_BAR;
        PG8_STAGE(PG8_SB(1, 0), cB + kstep, voffB); PG8_STAGE(PG8_SA(1, 0), cA + kstep, voffA); PG8_STAGE(PG8_SB(1, 1), cB + hsB + kstep, voffB);
        PG8_WAIT_V(6); PG8_BAR;
    } else {
        PG8_STAGE(PG8_SB(0, 0), cB, voffB); PG8_STAGE(PG8_SA(0, 0), cA, voffA); PG8_STAGE(PG8_SB(0, 1), cB + hsB, voffB); PG8_STAGE(PG8_SA(0, 1), cA + hsA, voffA);
        if (wr == 1) PG8_BAR;
        PG8_WAIT_V(4); PG8_BAR;
        PG8_STAGE(PG8_SB(1, 0), cB + kstep, voffB); PG8_STAGE(PG8_SA(1, 0), cA + kstep, voffA); PG8_STAGE(PG8_SB(1, 1), cB + hsB + kstep, voffB);
        PG8_WAIT_V(6); PG8_BAR;
    }
    for (;;) {
        const bool has_next = S.next(ui + 1, nxt);
        const char* nA = has_next ? (const char*)g.A + (size_t)nxt.pm * tsA : cA; const char* nB = has_next ? (const char*)g.Bt + nxt.boff + (size_t)nxt.pn * tsB : cB;
        for (int t = 0; t < nt; t += 2) {
            const bool last = (t == nt - 2);
            const char* a1 = cA + (size_t)(t + 1) * kstep;
            const char* a2 = last ? nA : cA + (size_t)(t + 2) * kstep; const char* b2 = last ? nB : cB + (size_t)(t + 2) * kstep;
            const char* a3 = a2 + kstep; const char* b3 = b2 + kstep;
            if (last && has_next) S.a_ready(nxt);
            if constexpr (SP2) {
            PG8_LDB(B0, 0, 0); PG8_LDB(B1, 0, 1); PG8_SCHED; PG8_LDA(At, 0, 0); PG8_STAGE(PG8_SA(1, 1), a1 + hsA, voffA);
            PG8_WAIT_V(8); PG8_WAIT_L(0); PG8_BAR; PG8_MMA(0, 0, At, B0); PG8_MMA(0, 1, At, B1); PG8_BAR; PG8_SCHED;
            PG8_LDA(At, 0, 1); PG8_STAGE(PG8_SB(0, 0), b2, voffB); PG8_STAGE(PG8_SB(0, 1), b2 + hsB, voffB); PG8_STAGE(PG8_SA(0, 0), a2, voffA);
            PG8_WAIT_V(8); PG8_WAIT_L(0); PG8_BAR; PG8_MMA(1, 0, At, B0); PG8_MMA(1, 1, At, B1); PG8_BAR; PG8_SCHED;
            PG8_LDB(B0, 1, 0); PG8_LDB(B1, 1, 1); PG8_SCHED; PG8_LDA(At, 1, 0); PG8_STAGE(PG8_SA(0, 1), a2 + hsA, voffA);
            PG8_WAIT_V(8); PG8_WAIT_L(0); PG8_BAR; PG8_MMA(0, 0, At, B0); PG8_MMA(0, 1, At, B1); PG8_BAR; PG8_SCHED;
            PG8_LDA(At, 1, 1); PG8_STAGE(PG8_SB(1, 0), b3, voffB); PG8_STAGE(PG8_SB(1, 1), b3 + hsB, voffB); PG8_STAGE(PG8_SA(1, 0), a3, voffA);
            PG8_WAIT_V(8); PG8_WAIT_L(0); PG8_BAR; PG8_MMA(1, 0, At, B0); PG8_MMA(1, 1, At, B1); PG8_BAR; PG8_SCHED;
            } else {
            PG8_LDB(B0, 0, 0); PG8_SCHED; PG8_LDA(At, 0, 0); PG8_STAGE(PG8_SA(1, 1), a1 + hsA, voffA);
            PG8_WAIT_L(8); PG8_BAR; PG8_WAIT_L(0); PG8_MMA(0, 0, At, B0); PG8_BAR; PG8_SCHED;
            PG8_LDB(B1, 0, 1); PG8_STAGE(PG8_SB(0, 0), b2, voffB);
            PG8_BAR; PG8_WAIT_L(0); PG8_MMA(0, 1, At, B1); PG8_BAR;
            PG8_LDA(At, 0, 1); PG8_STAGE(PG8_SA(0, 0), a2, voffA);
            PG8_BAR; PG8_WAIT_L(0); PG8_MMA(1, 0, At, B0); PG8_BAR; PG8_SCHED;
            PG8_STAGE(PG8_SB(0, 1), b2 + hsB, voffB);
            PG8_WAIT_V(6); PG8_BAR; PG8_MMA(1, 1, At, B1); PG8_BAR;
            PG8_LDB(B0, 1, 0); PG8_SCHED; PG8_LDA(At, 1, 0); PG8_STAGE(PG8_SA(0, 1), a2 + hsA, voffA);
            PG8_WAIT_L(8); PG8_BAR; PG8_WAIT_L(0); PG8_MMA(0, 0, At, B0); PG8_BAR; PG8_SCHED;
            PG8_LDB(B1, 1, 1); PG8_STAGE(PG8_SB(1, 0), b3, voffB);
            PG8_BAR; PG8_WAIT_L(0); PG8_MMA(0, 1, At, B1); PG8_BAR;
            PG8_LDA(At, 1, 1); PG8_STAGE(PG8_SA(1, 0), a3, voffA);
            PG8_BAR; PG8_WAIT_L(0); PG8_MMA(1, 0, At, B0); PG8_BAR; PG8_SCHED;
            PG8_STAGE(PG8_SB(1, 1), b3 + hsB, voffB);
            PG8_WAIT_V(6); PG8_BAR; PG8_MMA(1, 1, At, B1); PG8_BAR;
            }
        }
        if constexpr (ALIGN_EPI) { if (wr == 0) PG8_BAR; }
        if constexpr (!Epi::AFTER_DRAIN) { E(acc, cur, wr, wc, fr, fq); S.done(cur); }
        if (!has_next) break;
#pragma unroll
        for (int a = 0; a < 2; ++a)
#pragma unroll
            for (int b = 0; b < 2; ++b)
#pragma unroll
                for (int m = 0; m < 4; ++m)
#pragma unroll
                    for (int n = 0; n < 2; ++n) acc[a][b][m][n] = (f32x4){0.f, 0.f, 0.f, 0.f};
        cur = nxt; cA = nA; cB = nB; ++ui;
        if constexpr (ALIGN_EPI) { if (wr == 1) PG8_BAR; }
    }
    PG8_WAIT_V(0);
    if constexpr (!ALIGN_EPI) { if (wr == 0) PG8_BAR; }
    PG8_BAR;
    if constexpr (Epi::AFTER_DRAIN) { E.fused(acc, cur, wr, wc, fr, fq, lds, wid, lane); S.done(cur); }
#undef PG8_SA
#undef PG8_SB
#undef PG8_STAGE
#undef PG8_LDA
#undef PG8_LDB
#undef PG8_MMA
#undef PG8_WAIT_V
#undef PG8_WAIT_L
#undef PG8_BAR
#undef PG8_SCHED
}
}

constexpr int NTOK = 32768, SEQ = 16384, DM = 1024;
constexpr float EPS = 1e-6f;
constexpr size_t MiB = 1u << 20;
constexpr size_t WS_CTL = 0, CTL_ZERO_BYTES = 1 * MiB;
constexpr size_t WS_WB = 1 * MiB;
constexpr size_t WB_MKV = WS_WB + 0 * MiB;
constexpr size_t WB_MEMN = WS_WB + 1 * MiB;
constexpr size_t WB_MKVO = WS_WB + 2 * MiB;
constexpr size_t WB_WR = WS_WB + 3 * MiB;
constexpr size_t WB_WIN = WS_WB + 4 * MiB;
constexpr size_t WB_WGT = WS_WB + 8 * MiB;
constexpr size_t WB_WOUT = WS_WB + 11 * MiB;
constexpr size_t WB_WGU = WS_WB + 16 * MiB;
constexpr size_t WB_WD = WS_WB + 80 * MiB;
constexpr size_t WS_HN = WS_WB + 112 * MiB;
constexpr size_t WS_AR = WS_HN + 64 * MiB;
constexpr size_t AR_PROJ = WS_AR;
constexpr size_t AR_XSC = WS_AR + 112 * MiB;
constexpr size_t AR_LA = WS_AR + 160 * MiB;
constexpr size_t AR_UU = WS_AR + 208 * MiB;
constexpr size_t AR_MIXL = WS_AR + 256 * MiB;
constexpr size_t AR_SA = WS_AR + 320 * MiB;
constexpr size_t AR_SH = WS_AR + 322 * MiB;
constexpr size_t AR_CARRY = WS_AR + 324 * MiB;
constexpr size_t AR_KN = WS_AR + 96 * MiB;
constexpr size_t AR_KIN = WS_AR + 100 * MiB;
constexpr size_t AR_QIW = WS_AR + 104 * MiB;
constexpr size_t AR_WI = WS_AR + 120 * MiB;
constexpr size_t AR_SEL = WS_AR + 121 * MiB;
constexpr size_t AR_MIXD = WS_AR + 160 * MiB;
constexpr size_t AR_XS = WS_AR;
constexpr size_t AR_ACT = WS_AR + 144 * MiB;
constexpr size_t AR_LOG = WS_AR + 216 * MiB;
constexpr size_t AR_EID = WS_AR + 224 * MiB;
constexpr size_t AR_GATE = WS_AR + 225 * MiB;
constexpr size_t AR_DEST = WS_AR + 226 * MiB;
constexpr size_t WS_END = WS_AR + 328 * MiB;
constexpr int CW_TMO = 0, CW_CODE = 1;
constexpr int CW_CNT = 256, CW_CUR = 320, CW_NT = 384, CW_LSTRIDE = 256;
constexpr int CW_TE = 1024, CW_TE_STRIDE = 512;
constexpr int CW_BAR = 4096;
constexpr int LDS_BYTES = 159744, MISC_OFF = 155648;

#define GAS __attribute__((address_space(1)))
#define LAS __attribute__((address_space(3)))
#define DI __device__ __forceinline__
typedef unsigned short bf16;
typedef unsigned v4u __attribute__((ext_vector_type(4)));
typedef unsigned v2u __attribute__((ext_vector_type(2)));
typedef int v4i __attribute__((ext_vector_type(4)));
typedef float f32x4 __attribute__((ext_vector_type(4)));
typedef float f32x16 __attribute__((ext_vector_type(16)));
typedef short bf16x8 __attribute__((ext_vector_type(8)));
typedef GAS unsigned gu32;
#define RLX_AGENT __ATOMIC_RELAXED, __HIP_MEMORY_SCOPE_AGENT
#define LDS_WAIT() asm volatile("s_waitcnt lgkmcnt(0)" ::: "memory")
DI unsigned f2bf(float f) { unsigned u = __builtin_bit_cast(unsigned, f); return (u + 0x7fffu + ((u >> 16) & 1u)) >> 16; }
DI unsigned pk2(float lo, float hi) { return f2bf(lo) | (f2bf(hi) << 16); }
DI float bflo(unsigned w) { return __uint_as_float(w << 16); }
DI float bfhi(unsigned w) { return __uint_as_float(w & 0xffff0000u); }
DI void unpack8(const v4u w, float (&f)[8]) { f[0] = bflo(w.x); f[1] = bfhi(w.x); f[2] = bflo(w.y); f[3] = bfhi(w.y); f[4] = bflo(w.z); f[5] = bfhi(w.z); f[6] = bflo(w.w); f[7] = bfhi(w.w); }
DI v4u pack8(const float (&f)[8]) { v4u w; w.x = pk2(f[0], f[1]); w.y = pk2(f[2], f[3]); w.z = pk2(f[4], f[5]); w.w = pk2(f[6], f[7]); return w; }
DI unsigned lds_add(LAS unsigned* p, unsigned v) { return __hip_atomic_fetch_add(p, v, __ATOMIC_RELAXED, __HIP_MEMORY_SCOPE_WORKGROUP); }
DI float wave_sum(float v) {
#pragma unroll
    for (int o = 1; o < 64; o <<= 1) v += __shfl_xor(v, o);
    return v;
}

#define XB_TMO      128
#define XB_XCNT(j)  (256  + 64 * (j))
#define XB_XSUB(j)  (1280 + 64 * (j))
#define XB_XGEN(j)  (2304 + 64 * (j))
#define XB_TOP      3328
#define XB_TOPGEN   3392
#define XCD_BAR_WORDS 3456
#define XB_SPIN_CAP (1u << 22)
DI unsigned xb_ld(unsigned* p)              { return __hip_atomic_load(p, __ATOMIC_RELAXED, __HIP_MEMORY_SCOPE_AGENT); }
DI unsigned xb_add(unsigned* p, unsigned v) { return __hip_atomic_fetch_add(p, v, __ATOMIC_RELAXED, __HIP_MEMORY_SCOPE_AGENT); }
DI unsigned xb_xcc_id() { return (unsigned)__builtin_amdgcn_s_getreg((3 << 11) | 20) & 0xFu; }
#define XB_SPIN(cond, bar) do { unsigned _sp = 0; while (cond) { __builtin_amdgcn_s_sleep(1); \
    if ((++_sp & 255u) == 0u) { if (xb_ld(&(bar)[XB_TMO])) break; if (_sp > XB_SPIN_CAP) { atomicAdd(&(bar)[XB_TMO], 1u); break; } } } } while (0)
struct XcdBarrier { unsigned* bar; unsigned x; volatile LAS unsigned* st; };
DI XcdBarrier xcd_barrier_post(unsigned* bar, volatile LAS unsigned* st) {
    XcdBarrier b; b.bar = bar; b.x = xb_xcc_id(); b.st = st;
    if (threadIdx.x == 0) (void)xb_add(&bar[XB_XCNT(b.x)], 1u);
    return b;
}
DI void xcd_barrier_complete(unsigned* bar, unsigned x, unsigned& nloc, unsigned& nx) {
    const unsigned G = gridDim.x * gridDim.y * gridDim.z;
    unsigned sum, cnt, mine, sp = 0u;
    for (;;) {
        sum = 0u; cnt = 0u; mine = 0u;
#pragma unroll
        for (unsigned j = 0; j < 16; ++j) { const unsigned c = xb_ld(&bar[XB_XCNT(j)]); sum += c; cnt += (c > 0u) ? 1u : 0u; mine = (j == x) ? c : mine; }
        if (sum == G) break;
        __builtin_amdgcn_s_sleep(1);
        if ((++sp & 255u) == 0u) { if (xb_ld(&bar[XB_TMO])) break; if (sp > XB_SPIN_CAP) { atomicAdd(&bar[XB_TMO], 1u); break; } }
    }
    nloc = mine > 0u ? mine : 1u; nx = cnt > 0u ? cnt : 1u;
}
DI void xcd_barrier(const XcdBarrier& b) {
    asm volatile("s_waitcnt vmcnt(0)" ::: "memory");
    __syncthreads();
    if (threadIdx.x == 0) {
        unsigned* bar = b.bar;
        __builtin_amdgcn_s_waitcnt(0);
        unsigned nloc = b.st[0], nx = b.st[1];
        if (nloc == 0u) { xcd_barrier_complete(bar, b.x, nloc, nx); b.st[0] = nloc; b.st[1] = nx; }
        const unsigned old = xb_add(&bar[XB_XSUB(b.x)], 1u);
        const unsigned gen = old / nloc;
        if (old + 1u == (gen + 1u) * nloc) {
            __builtin_amdgcn_fence(__ATOMIC_RELEASE, "agent");
            asm volatile("s_waitcnt vmcnt(0)" ::: "memory");
            const unsigned og = xb_add(&bar[XB_TOP], 1u);
            const unsigned tg = og / nx;
            if (og + 1u == (tg + 1u) * nx) xb_add(&bar[XB_TOPGEN], 1u);
            else XB_SPIN(xb_ld(&bar[XB_TOPGEN]) == tg, bar);
            __builtin_amdgcn_fence(__ATOMIC_ACQUIRE, "agent");
            xb_add(&bar[XB_XGEN(b.x)], 1u);
            asm volatile("s_waitcnt vmcnt(0)" ::: "memory");
        } else {
            XB_SPIN(xb_ld(&bar[XB_XGEN(b.x)]) == gen, bar);
            __builtin_amdgcn_fence(__ATOMIC_ACQUIRE, "agent");
            asm volatile("s_waitcnt vmcnt(0)" ::: "memory");
        }
    }
    __syncthreads();
}

struct Params { const float* in[29]; float* out; unsigned char* ws; };
struct PV { unsigned char* ws; float* out; LAS unsigned long long* tab; };
DI const float* pin(const PV& P, int i) { const unsigned long long v = P.tab[i]; const unsigned lo = __builtin_amdgcn_readfirstlane((unsigned)v), hi = __builtin_amdgcn_readfirstlane((unsigned)(v >> 32)); return (const float*)(((unsigned long long)hi << 32) | lo); }
struct Ctx { LAS unsigned char* lds; int tid, lane, wave, G, blk, gw, NGW; };
DI Ctx relaunder(const Ctx& c0) { Ctx c = c0; int t = threadIdx.x; asm volatile("" : "+v"(t)); c.tid = t; c.lane = t & 63; c.wave = __builtin_amdgcn_readfirstlane(t >> 6); c.gw = c.blk * 8 + c.wave; return c; }
enum { I_X = 0, I_MEM, I_NORM_MIX, I_NORM_FFN, I_MEM_NORM, I_W_MEM_KV, I_XQ_NORM, I_XK_NORM, I_W_OUT, I_LRU_W_IN, I_LRU_CONV_W, I_LRU_CONV_B, I_LRU_W_A, I_LRU_B_A,
       I_LRU_W_X, I_LRU_B_X, I_LRU_LAMBDA, I_DSA_W_IN, I_DSA_Q_NORM, I_DSA_K_NORM, I_DSA_W_UV, I_REL_BIAS, I_MOE_W_GROUP, I_MOE_B_GROUP, I_MOE_W_ROUTER, I_MOE_B_ROUTER,
       I_MOE_W_GATE, I_MOE_W_UP, I_MOE_W_DOWN };

DI void tr_tile(const float* __restrict__ W, int ldw, bf16* __restrict__ WT, int ldk, LAS unsigned* scr, int lane) {
    const int m = lane & 15, q = lane >> 4;
#pragma unroll
    for (int i = 0; i < 8; ++i) {
        const int kk = 8 * i + 2 * q;
        const f32x4 v0 = *(const f32x4*)(W + (size_t)kk * ldw + 4 * m);
        const f32x4 v1 = *(const f32x4*)(W + (size_t)(kk + 1) * ldw + 4 * m);
        const int sw = 4 * (i ^ (m & 7)) + q;
        scr[(4 * m + 0) * 32 + sw] = pk2(v0.x, v1.x);
        scr[(4 * m + 1) * 32 + sw] = pk2(v0.y, v1.y);
        scr[(4 * m + 2) * 32 + sw] = pk2(v0.z, v1.z);
        scr[(4 * m + 3) * 32 + sw] = pk2(v0.w, v1.w);
    }
    LDS_WAIT();
#pragma unroll
    for (int r = 0; r < 8; ++r) {
        const int n = 8 * r + (lane >> 3), c = lane & 7;
        const v4u o = *(const LAS v4u*)(scr + n * 32 + 4 * (c ^ ((n >> 2) & 7)));
        *(v4u*)(WT + (size_t)n * ldk + 8 * c) = o;
    }
    LDS_WAIT();
}
DI void rms_row(const float* __restrict__ xrow, const float* __restrict__ g, bf16* __restrict__ orow, int lane, f32x4 (&v)[4]) {
    const f32x4* xr = (const f32x4*)xrow + lane; const f32x4* gr = (const f32x4*)g + lane;
    float s = 0.f;
#pragma unroll
    for (int j = 0; j < 4; ++j) { v[j] = xr[64 * j]; s += (v[j].x * v[j].x + v[j].y * v[j].y) + (v[j].z * v[j].z + v[j].w * v[j].w); }
    const float r = 1.0f / sqrtf(wave_sum(s) * (1.0f / 1024.0f) + EPS);
    v2u* o8 = (v2u*)orow + lane;
#pragma unroll
    for (int j = 0; j < 4; ++j) { const f32x4 gg = gr[64 * j]; v[j] = v[j] * r * gg; v2u o; o.x = pk2(v[j].x, v[j].y); o.y = pk2(v[j].z, v[j].w); o8[64 * j] = o; }
}
struct TrJob { const float* src; bf16* dst; int ldw, ldk, nN, items; };
template <int layer> DI void phase_prep(const Ctx& c0, const PV& P) {
    const Ctx c = relaunder(c0);
    unsigned char* ws = P.ws;
    LAS unsigned* scr = (LAS unsigned*)(c.lds + c.wave * 8192);
    LAS TrJob* jobs = (LAS TrJob*)(c.lds + 65536);
    LAS int* njp = (LAS int*)(c.lds + 65536 + 512);
    LAS f32x4* wiw = (LAS f32x4*)(c.lds + 69632);
    if (c.tid == 0) {
        int nj = 0;
#define ADDJOB(S_, D_, K_, N_, LDW_, LDK_) do { jobs[nj].src = (S_); jobs[nj].dst = (D_); jobs[nj].ldw = (LDW_); jobs[nj].ldk = (LDK_); jobs[nj].nN = (N_) / 64; jobs[nj].items = ((K_) / 64) * ((N_) / 64); ++nj; } while (0)
        ADDJOB(pin(P, I_W_MEM_KV) + (size_t)layer * 1024 * 512, (bf16*)(ws + WB_MKV), 1024, 512, 512, 1024);
        if (layer == 0) {
            ADDJOB(pin(P, I_LRU_W_IN), (bf16*)(ws + WB_WIN), 1024, 1792, 1792, 1024);
            ADDJOB(pin(P, I_W_OUT), (bf16*)(ws + WB_WOUT), 1024, 1024, 1024, 1024);
        } else {
            ADDJOB(pin(P, I_DSA_W_IN), (bf16*)(ws + WB_WIN), 1024, 1280, 1540, 1024);
            ADDJOB(pin(P, I_DSA_W_IN) + 1284, (bf16*)(ws + WB_WIN) + (size_t)1280 * 1024, 1024, 256, 1540, 1024);
            ADDJOB(pin(P, I_W_OUT) + (size_t)1024 * 1024 + (size_t)768 * 1024, (bf16*)(ws + WB_WOUT) + 1536, 256, 1024, 1024, 1792);
        }
#undef ADDJOB
        *njp = nj;
    }
    if (layer == 1) { for (int k = c.tid; k < 1024; k += 512) wiw[k] = *(const f32x4*)(pin(P, I_DSA_W_IN) + (size_t)k * 1540 + 1280); }
    __syncthreads();
    {
        const float* xin = (layer == 0) ? pin(P, I_X) : P.out;
        const float* g = pin(P, I_NORM_MIX) + layer * 1024;
        bf16* HN = (bf16*)(ws + WS_HN); float* WI = (float*)(ws + AR_WI);
        for (int r = c.gw; r < NTOK; r += c.NGW) {
            f32x4 v[4]; rms_row(xin + (size_t)r * 1024, g, HN + (size_t)r * 1024, c.lane, v);
            if (layer == 1) {
                f32x4 a = {0.f, 0.f, 0.f, 0.f};
#pragma unroll
                for (int j = 0; j < 4; ++j) { const int k0 = 4 * (c.lane + 64 * j); a += v[j].x * wiw[k0] + v[j].y * wiw[k0 + 1] + v[j].z * wiw[k0 + 2] + v[j].w * wiw[k0 + 3]; }
                a.x = wave_sum(a.x); a.y = wave_sum(a.y); a.z = wave_sum(a.z); a.w = wave_sum(a.w);
                if (c.lane == 0) *(f32x4*)(WI + (size_t)r * 4) = a * 0.5f;
            }
        }
        const float* gm = pin(P, I_MEM_NORM) + layer * 1024; bf16* MEMN = (bf16*)(ws + WB_MEMN);
        for (int r = c.gw; r < 512; r += c.NGW) { f32x4 v[4]; rms_row(pin(P, I_MEM) + (size_t)r * 1024, gm, MEMN + (size_t)r * 1024, c.lane, v); }
    }
    {
        const int nj = *njp; int gen_total = 0;
        for (int j = 0; j < nj; ++j) gen_total += jobs[j].items;
        const int total = gen_total + 3 * 32 * 128;
        const float* wg = pin(P, I_MOE_W_GATE) + (size_t)layer * 32 * 1024 * 512;
        const float* wu = pin(P, I_MOE_W_UP) + (size_t)layer * 32 * 1024 * 512;
        const float* wd = pin(P, I_MOE_W_DOWN) + (size_t)layer * 32 * 512 * 1024;
        bf16* WGU = (bf16*)(ws + WB_WGU); bf16* WD = (bf16*)(ws + WB_WD);
        for (int it = c.gw; it < total; it += c.NGW) {
            const float* src; bf16* dst; int ldw, ldk;
            if (it < gen_total) {
                int r = it, j = 0;
                while (r >= jobs[j].items) { r -= jobs[j].items; ++j; }
                const int nN = jobs[j].nN, kb = r / nN, nb = r % nN;
                ldw = jobs[j].ldw; ldk = jobs[j].ldk;
                src = jobs[j].src + (size_t)kb * 64 * ldw + nb * 64; dst = jobs[j].dst + (size_t)nb * 64 * ldk + kb * 64;
            } else {
                const int r = it - gen_total, type = r >> 12, e = (r >> 7) & 31, ti = r & 127;
                if (type < 2) { const int kb = ti >> 3, nb = ti & 7; ldw = 512; ldk = 1024;
                    src = (type == 0 ? wg : wu) + (size_t)e * 1024 * 512 + (size_t)kb * 64 * 512 + nb * 64;
                    const int drow = 256 * (nb >> 1) + 64 * (nb & 1) + 128 * type;
                    dst = WGU + (size_t)e * 1024 * 1024 + (size_t)drow * 1024 + kb * 64;
                } else { const int kb = ti >> 4, nb = ti & 15; ldw = 1024; ldk = 512;
                    src = wd + (size_t)e * 512 * 1024 + (size_t)kb * 64 * 1024 + nb * 64;
                    dst = WD + (size_t)e * 1024 * 512 + (size_t)nb * 64 * 512 + kb * 64; }
            }
            tr_tile(src, ldw, dst, ldk, scr, c.lane);
        }
    }
    const int gtid = c.blk * 512 + c.tid, nthr = c.G * 512;
    {
        const float* wgr = pin(P, I_MOE_W_GROUP) + (size_t)layer * 1024 * 4; const float* wrt = pin(P, I_MOE_W_ROUTER) + (size_t)layer * 1024 * 32;
        bf16* WR = (bf16*)(ws + WB_WR);
        for (int i = gtid; i < 256 * 128; i += nthr) { const int row = i >> 7, k8 = i & 127; float f[8];
#pragma unroll
            for (int kk = 0; kk < 8; ++kk) { const int k = 8 * k8 + kk; f[kk] = row < 4 ? wgr[k * 4 + row] : (row < 36 ? wrt[k * 32 + (row - 4)] : 0.f); }
            *(v4u*)(WR + (size_t)row * 1024 + 8 * k8) = pack8(f); }
    }
    if (layer == 0) {
        bf16* WGT = (bf16*)(ws + WB_WGT);
        for (int i = gtid; i < 1536 * 96; i += nthr) { const int rho = i / 96, k8 = i % 96; const int pn = rho >> 8, bj = (rho >> 7) & 1, j = rho & 127, ch = 128 * pn + j, blkc = ch / 192, cc = ch % 192;
            const float* src = (bj ? pin(P, I_LRU_W_X) : pin(P, I_LRU_W_A)) + (size_t)blkc * 192 * 192; float f[8];
            const int k0 = 8 * k8; const bool in = (k0 / 192) == blkc;
#pragma unroll
            for (int kk = 0; kk < 8; ++kk) f[kk] = in ? src[((k0 + kk) % 192) * 192 + cc] : 0.f;
            *(v4u*)(WGT + (size_t)rho * 768 + k0) = pack8(f); }
    } else {
        const float* wuv = pin(P, I_DSA_W_UV); const float* wo = pin(P, I_W_OUT) + (size_t)1024 * 1024; bf16* WO = (bf16*)(ws + WB_WOUT);
        for (int i = gtid; i < 1024 * 12 * 16; i += nthr) { const int n = i & 1023, rest = i >> 10, c8 = rest & 15, h = rest >> 4; float a[8] = {0.f, 0.f, 0.f, 0.f, 0.f, 0.f, 0.f, 0.f};
            for (int j = 0; j < 64; ++j) { const float w = wo[(size_t)(64 * h + j) * 1024 + n];
#pragma unroll
                for (int cc = 0; cc < 8; ++cc) a[cc] += wuv[((size_t)h * 128 + 8 * c8 + cc) * 64 + j] * w; }
            *(v4u*)(WO + (size_t)n * 1792 + h * 128 + 8 * c8) = pack8(a); }
    }
}

DI f32x4 mfma16(bf16x8 a, bf16x8 b, f32x4 c) { return __builtin_amdgcn_mfma_f32_16x16x32_bf16(a, b, c, 0, 0, 0); }

template <int layer, int ldp, int xq_off, int ldm, int xo_off> DI void phase_xattn(const Ctx& c0, const PV& P, const bf16* __restrict__ PROJ, bf16* __restrict__ MIX) {
    const Ctx c = relaunder(c0);
    const bf16* MKVO = (const bf16*)(P.ws + WB_MKVO);
    const float* xqg = pin(P, I_XQ_NORM) + layer * 64; const float* xkg = pin(P, I_XK_NORM) + layer * 64;
    LAS bf16* Ks = (LAS bf16*)c.lds;
    LAS bf16* Vt = (LAS bf16*)(c.lds + 36864);
    const int lane = c.lane, l15 = lane & 15, g = lane >> 4;
    for (int unit = c.blk; unit < 256; unit += c.G) {
        const int b = unit >> 7, h = (unit >> 5) & 3, tr = unit & 31, tok0 = b * SEQ + tr * 512;
        __syncthreads();
#pragma unroll
        for (int i = 0; i < 4; ++i) { const int p = c.tid + 512 * i, key = p >> 3, ch = p & 7;
            const bf16* src = MKVO + (size_t)(b * 256 + key) * 512 + h * 64 + ch * 8;
            float f[8]; unpack8(*(const v4u*)src, f);
            float ss = 0.f;
#pragma unroll
            for (int j = 0; j < 8; ++j) ss += f[j] * f[j];
            ss += __shfl_xor(ss, 1); ss += __shfl_xor(ss, 2); ss += __shfl_xor(ss, 4);
            const float r = 1.0f / sqrtf(ss * (1.0f / 64.0f) + EPS);
#pragma unroll
            for (int j = 0; j < 8; ++j) f[j] = f[j] * r * xkg[ch * 8 + j];
            *(LAS v4u*)(Ks + key * 72 + ch * 8) = pack8(f);
            const v4u vw = *(const v4u*)(src + 256);
            const unsigned ww[4] = {vw.x, vw.y, vw.z, vw.w};
#pragma unroll
            for (int j = 0; j < 4; ++j) { Vt[(ch * 8 + 2 * j) * 264 + key] = (bf16)(ww[j] & 0xffffu); Vt[(ch * 8 + 2 * j + 1) * 264 + key] = (bf16)(ww[j] >> 16); }
        }
        __syncthreads();
#pragma unroll 1
        for (int tile = c.wave; tile < 32; tile += 8) {
            const int row = tok0 + tile * 16 + l15;
            const bf16* qp = PROJ + (size_t)row * ldp + xq_off + h * 64 + 8 * g;
            float q0[8], q1[8]; unpack8(*(const v4u*)qp, q0); unpack8(*(const v4u*)(qp + 32), q1);
            float ss = 0.f;
#pragma unroll
            for (int j = 0; j < 8; ++j) ss += q0[j] * q0[j] + q1[j] * q1[j];
            ss += __shfl_xor(ss, 16); ss += __shfl_xor(ss, 32);
            const float r = 0.125f / sqrtf(ss * (1.0f / 64.0f) + EPS);
#pragma unroll
            for (int j = 0; j < 8; ++j) { q0[j] = q0[j] * r * xqg[8 * g + j]; q1[j] = q1[j] * r * xqg[32 + 8 * g + j]; }
            const bf16x8 B0 = __builtin_bit_cast(bf16x8, pack8(q0)), B1 = __builtin_bit_cast(bf16x8, pack8(q1));
            f32x4 S[16];
#pragma unroll
            for (int kt = 0; kt < 16; ++kt) {
                const bf16x8 A0 = *(const LAS bf16x8*)(Ks + (16 * kt + l15) * 72 + 8 * g), A1 = *(const LAS bf16x8*)(Ks + (16 * kt + l15) * 72 + 32 + 8 * g);
                f32x4 z = {0.f, 0.f, 0.f, 0.f}; z = mfma16(A0, B0, z); S[kt] = mfma16(A1, B1, z);
                if ((kt & 3) == 3) __builtin_amdgcn_sched_barrier(0);
            }
            float mx = -3.0e38f;
#pragma unroll
            for (int kt = 0; kt < 16; ++kt) mx = fmaxf(mx, fmaxf(fmaxf(S[kt][0], S[kt][1]), fmaxf(S[kt][2], S[kt][3])));
            mx = fmaxf(mx, __shfl_xor(mx, 16)); mx = fmaxf(mx, __shfl_xor(mx, 32));
            float l = 0.f;
#pragma unroll
            for (int kt = 0; kt < 16; ++kt) {
#pragma unroll
                for (int i = 0; i < 4; ++i) { const float p = __expf(S[kt][i] - mx); S[kt][i] = p; l += p; } }
            l += __shfl_xor(l, 16); l += __shfl_xor(l, 32);
            f32x4 O[4];
#pragma unroll
            for (int dt = 0; dt < 4; ++dt) O[dt] = (f32x4){0.f, 0.f, 0.f, 0.f};
#pragma unroll
            for (int jb = 0; jb < 8; ++jb) {
                v4u pw; pw.x = pk2(S[2 * jb][0], S[2 * jb][1]); pw.y = pk2(S[2 * jb][2], S[2 * jb][3]); pw.z = pk2(S[2 * jb + 1][0], S[2 * jb + 1][1]); pw.w = pk2(S[2 * jb + 1][2], S[2 * jb + 1][3]);
                const bf16x8 Pb = __builtin_bit_cast(bf16x8, pw);
#pragma unroll
                for (int dt = 0; dt < 4; ++dt) { const LAS bf16* vp = Vt + (16 * dt + l15) * 264 + 32 * jb + 4 * g;
                    const v2u a0 = *(const LAS v2u*)vp, a1 = *(const LAS v2u*)(vp + 16);
                    v4u aw; aw.x = a0.x; aw.y = a0.y; aw.z = a1.x; aw.w = a1.y;
                    O[dt] = mfma16(__builtin_bit_cast(bf16x8, aw), Pb, O[dt]); }
                __builtin_amdgcn_sched_barrier(0);
            }
            const float il = 1.0f / l;
            bf16* op = MIX + (size_t)row * ldm + xo_off + h * 64 + 4 * g;
#pragma unroll
            for (int dt = 0; dt < 4; ++dt) { v2u o; o.x = pk2(O[dt][0] * il, O[dt][1] * il); o.y = pk2(O[dt][2] * il, O[dt][3] * il); *(v2u*)(op + 16 * dt) = o; }
        }
    }
}

DI void phase_conv(const Ctx& c0, const PV& P) {
    const Ctx c = relaunder(c0);
    const bf16* PROJ = (const bf16*)(P.ws + AR_PROJ); bf16* XSC = (bf16*)(P.ws + AR_XSC);
    const float* cw = pin(P, I_LRU_CONV_W); const float* cb = pin(P, I_LRU_CONV_B);
    const int gtid = c.blk * 512 + c.tid, nthr = c.G * 512;
    for (int i = gtid; i < NTOK * 96; i += nthr) { const int row = i / 96, c8 = i % 96, t = row & (SEQ - 1); float a[8];
#pragma unroll
        for (int j = 0; j < 8; ++j) a[j] = cb[8 * c8 + j];
#pragma unroll
        for (int k = 0; k < 4; ++k) { if (t - 3 + k >= 0) { float f[8]; unpack8(*(const v4u*)(PROJ + (size_t)(row - 3 + k) * 1792 + 8 * c8), f);
#pragma unroll
                for (int j = 0; j < 8; ++j) a[j] += cw[k * 768 + 8 * c8 + j] * f[j]; } }
        *(v4u*)(XSC + (size_t)row * 768 + 8 * c8) = pack8(a); }
}
DI void phase_scanA(const Ctx& c0, const PV& P) {
    const Ctx c = relaunder(c0);
    const bf16* LA = (const bf16*)(P.ws + AR_LA); const bf16* UU = (const bf16*)(P.ws + AR_UU); float* SA = (float*)(P.ws + AR_SA); float* SH = (float*)(P.ws + AR_SH);
    const int gtid = c.blk * 512 + c.tid, nthr = c.G * 512;
    for (int i = gtid; i < 512 * 192; i += nthr) { const int chunk = i / 192, c4 = i % 192; float h[4] = {0.f, 0.f, 0.f, 0.f}, sl[4] = {0.f, 0.f, 0.f, 0.f};
        const size_t base = (size_t)chunk * 64 * 768 + 4 * c4;
#pragma unroll 8
        for (int r = 0; r < 64; ++r) { const v2u lw = *(const v2u*)(LA + base + (size_t)r * 768), uw = *(const v2u*)(UU + base + (size_t)r * 768);
            const float l4[4] = {bflo(lw.x), bfhi(lw.x), bflo(lw.y), bfhi(lw.y)}, u4[4] = {bflo(uw.x), bfhi(uw.x), bflo(uw.y), bfhi(uw.y)};
#pragma unroll
            for (int j = 0; j < 4; ++j) { h[j] = __expf(l4[j]) * h[j] + u4[j]; sl[j] += l4[j]; } }
        *(f32x4*)(SA + (size_t)chunk * 768 + 4 * c4) = (f32x4){__expf(sl[0]), __expf(sl[1]), __expf(sl[2]), __expf(sl[3])};
        *(f32x4*)(SH + (size_t)chunk * 768 + 4 * c4) = (f32x4){h[0], h[1], h[2], h[3]}; }
}
DI void phase_scanB(const Ctx& c0, const PV& P) {
    const Ctx c = relaunder(c0);
    const float* SA = (const float*)(P.ws + AR_SA); const float* SH = (const float*)(P.ws + AR_SH); float* CARRY = (float*)(P.ws + AR_CARRY);
    LAS float* segP = (LAS float*)c.lds; LAS float* segQ = segP + 512;
    for (int u = c.blk; u < 48; u += c.G) { const int b = u / 24, cg = u % 24, seg = c.tid >> 5, ch = 32 * cg + (c.tid & 31);
        const size_t base = (size_t)(b * 256 + seg * 16) * 768 + ch;
        float A[16], H[16];
#pragma unroll
        for (int i = 0; i < 16; ++i) { A[i] = SA[base + (size_t)i * 768]; H[i] = SH[base + (size_t)i * 768]; }
        float Pp[16], Qq[16]; float pp = 1.f, qq = 0.f;
#pragma unroll
        for (int i = 0; i < 16; ++i) { Pp[i] = pp; Qq[i] = qq; qq = A[i] * qq + H[i]; pp = A[i] * pp; }
        __syncthreads();
        segP[c.tid] = pp; segQ[c.tid] = qq;
        __syncthreads();
        float hin = 0.f;
        for (int s = 0; s < seg; ++s) hin = segP[s * 32 + (c.tid & 31)] * hin + segQ[s * 32 + (c.tid & 31)];
#pragma unroll
        for (int i = 0; i < 16; ++i) CARRY[base + (size_t)i * 768] = Pp[i] * hin + Qq[i];
    }
}
DI void phase_scanC(const Ctx& c0, const PV& P) {
    const Ctx c = relaunder(c0);
    const bf16* LA = (const bf16*)(P.ws + AR_LA); const bf16* UU = (const bf16*)(P.ws + AR_UU); const float* CARRY = (const float*)(P.ws + AR_CARRY);
    const bf16* PROJ = (const bf16*)(P.ws + AR_PROJ); bf16* MIX = (bf16*)(P.ws + AR_MIXL);
    const int gtid = c.blk * 512 + c.tid, nthr = c.G * 512;
    for (int i = gtid; i < 512 * 192; i += nthr) { const int chunk = i / 192, c4 = i % 192;
        const f32x4 h0 = *(const f32x4*)(CARRY + (size_t)chunk * 768 + 4 * c4); float h[4] = {h0.x, h0.y, h0.z, h0.w};
        const size_t base = (size_t)chunk * 64 * 768 + 4 * c4;
#pragma unroll 8
        for (int r = 0; r < 64; ++r) { const size_t row = (size_t)chunk * 64 + r;
            const v2u lw = *(const v2u*)(LA + base + (size_t)r * 768), uw = *(const v2u*)(UU + base + (size_t)r * 768), gw = *(const v2u*)(PROJ + row * 1792 + 768 + 4 * c4);
            const float l4[4] = {bflo(lw.x), bfhi(lw.x), bflo(lw.y), bfhi(lw.y)}, u4[4] = {bflo(uw.x), bfhi(uw.x), bflo(uw.y), bfhi(uw.y)}, g4[4] = {bflo(gw.x), bfhi(gw.x), bflo(gw.y), bfhi(gw.y)};
            float y[4];
#pragma unroll
            for (int j = 0; j < 4; ++j) { h[j] = __expf(l4[j]) * h[j] + u4[j]; y[j] = h[j] * g4[j]; }
            v2u o; o.x = pk2(y[0], y[1]); o.y = pk2(y[2], y[3]); *(v2u*)(MIX + row * 1024 + 4 * c4) = o; }
    }
}

template <int layer> DI void phase_norm2(const Ctx& c0, const PV& P) {
    const Ctx c = relaunder(c0);
    const float* g = pin(P, I_NORM_FFN) + layer * 1024; bf16* HN = (bf16*)(P.ws + WS_HN);
    for (int r = c.gw; r < NTOK; r += c.NGW) { f32x4 v[4]; rms_row(P.out + (size_t)r * 1024, g, HN + (size_t)r * 1024, c.lane, v); }
}
template <int layer> DI void phase_route(const Ctx& c0, const PV& P) {
    const Ctx c = relaunder(c0);
    const float* LOG = (const float*)(P.ws + AR_LOG); int* EID = (int*)(P.ws + AR_EID); float* GATE = (float*)(P.ws + AR_GATE);
    const float* bg = pin(P, I_MOE_B_GROUP) + layer * 4; const float* br = pin(P, I_MOE_B_ROUTER) + layer * 32;
    unsigned* ctl = (unsigned*)(P.ws + WS_CTL);
    LAS unsigned* hist = (LAS unsigned*)c.lds;
    if (c.tid < 32) hist[c.tid] = 0u;
    __syncthreads();
    for (int t = c.blk * 512 + c.tid; t < NTOK; t += c.G * 512) {
        const f32x4 lg = *(const f32x4*)(LOG + (size_t)t * 64);
        const float l0 = lg.x + bg[0], l1 = lg.y + bg[1], l2 = lg.z + bg[2], l3 = lg.w + bg[3];
        int gs = 0; float gm = l0;
        if (l1 > gm) { gm = l1; gs = 1; } if (l2 > gm) { gm = l2; gs = 2; } if (l3 > gm) { gm = l3; gs = 3; }
        const float pg = 1.0f / (__expf(l0 - gm) + __expf(l1 - gm) + __expf(l2 - gm) + __expf(l3 - gm));
        const f32x4 ea = *(const f32x4*)(LOG + (size_t)t * 64 + 4 + 8 * gs), eb = *(const f32x4*)(LOG + (size_t)t * 64 + 8 + 8 * gs);
        const f32x4 ba = *(const f32x4*)(br + 8 * gs), bb = *(const f32x4*)(br + 8 * gs + 4);
        const float el[8] = {ea.x + ba.x, ea.y + ba.y, ea.z + ba.z, ea.w + ba.w, eb.x + bb.x, eb.y + bb.y, eb.z + bb.z, eb.w + bb.w};
        int i1 = 0; float m1 = el[0];
#pragma unroll
        for (int j = 1; j < 8; ++j) if (el[j] > m1) { m1 = el[j]; i1 = j; }
        int i2 = -1; float m2 = -3.0e38f;
#pragma unroll
        for (int j = 0; j < 8; ++j) if (j != i1 && el[j] > m2) { m2 = el[j]; i2 = j; }
        const float e2 = __expf(m2 - m1), inv = pg / (1.0f + e2);
        const int e1id = 8 * gs + i1, e2id = 8 * gs + i2;
        EID[2 * t] = e1id; EID[2 * t + 1] = e2id; GATE[2 * t] = inv; GATE[2 * t + 1] = e2 * inv;
        lds_add(&hist[e1id], 1u); lds_add(&hist[e2id], 1u);
    }
    __syncthreads();
    if (c.tid < 32 && hist[c.tid]) atomicAdd(ctl + CW_CNT + layer * CW_LSTRIDE + c.tid, hist[c.tid]);
}
template <int layer> DI void phase_scatter(const Ctx& c0, const PV& P) {
    const Ctx c = relaunder(c0);
    unsigned* ctl = (unsigned*)(P.ws + WS_CTL);
    const int* EID = (const int*)(P.ws + AR_EID); int* DEST = (int*)(P.ws + AR_DEST);
    const bf16* HN = (const bf16*)(P.ws + WS_HN); bf16* XS = (bf16*)(P.ws + AR_XS);
    LAS int* cnt = (LAS int*)c.lds; LAS int* pstart = cnt + 32; LAS unsigned* hist = (LAS unsigned*)(cnt + 64); LAS unsigned* base = hist + 32; LAS unsigned* lcnt = base + 32; LAS int* dl = (LAS int*)(lcnt + 32);
    __syncthreads();
    if (c.tid < 32) cnt[c.tid] = (int)ctl[CW_CNT + layer * CW_LSTRIDE + c.tid];
    __syncthreads();
    if (c.tid == 0) { int acc = 0; for (int e = 0; e < 32; ++e) { pstart[e] = acc; acc += (cnt[e] + 255) & ~255; }
        if (c.blk == 0) { ctl[CW_NT + layer * CW_LSTRIDE] = (unsigned)(acc >> 8);
            for (int e = 0; e < 32; ++e) { const int t0 = pstart[e] >> 8, t1 = (pstart[e] + ((cnt[e] + 255) & ~255)) >> 8; for (int t = t0; t < t1; ++t) ctl[CW_TE + layer * CW_TE_STRIDE + t] = (unsigned)e; } } }
    __syncthreads();
    for (int tb = c.blk; tb < NTOK / 128; tb += c.G) {
        if (c.tid < 32) { hist[c.tid] = 0u; lcnt[c.tid] = 0u; }
        __syncthreads();
        int e = 0, t = 0;
        if (c.tid < 256) { t = tb * 128 + (c.tid >> 1); e = EID[2 * t + (c.tid & 1)]; lds_add(&hist[e], 1u); }
        __syncthreads();
        if (c.tid < 32) base[c.tid] = hist[c.tid] ? atomicAdd(ctl + CW_CUR + layer * CW_LSTRIDE + c.tid, hist[c.tid]) : 0u;
        __syncthreads();
        if (c.tid < 256) { const unsigned rank = lds_add(&lcnt[e], 1u); const int d = pstart[e] + (int)base[e] + (int)rank; DEST[2 * t + (c.tid & 1)] = d; dl[c.tid] = d; }
        __syncthreads();
        for (int a = c.wave * 32; a < c.wave * 32 + 32; ++a) { const int tt = tb * 128 + (a >> 1), d = dl[a];
            const v4u* s = (const v4u*)(HN + (size_t)tt * 1024) + c.lane; v4u* o = (v4u*)(XS + (size_t)d * 1024) + c.lane;
            const v4u x0 = s[0], x1 = s[64]; o[0] = x0; o[64] = x1; }
        __syncthreads();
    }
    for (int e = 0; e < 32; ++e) { const int npad = ((cnt[e] + 255) & ~255) - cnt[e], r0 = pstart[e] + cnt[e];
        for (int r = c.gw; r < npad; r += c.NGW) { v4u* o = (v4u*)(XS + (size_t)(r0 + r) * 1024) + c.lane; const v4u z = {0u, 0u, 0u, 0u}; o[0] = z; o[64] = z; } }
}
DI void phase_combine(const Ctx& c0, const PV& P) {
    const Ctx c = relaunder(c0);
    const int* DEST = (const int*)(P.ws + AR_DEST); const float* GATE = (const float*)(P.ws + AR_GATE); const bf16* Y = (const bf16*)(P.ws + AR_XS);
    for (int t = c.gw; t < NTOK; t += c.NGW) { const int d0 = DEST[2 * t], d1 = DEST[2 * t + 1]; const float g0 = GATE[2 * t], g1 = GATE[2 * t + 1];
        f32x4* op = (f32x4*)(P.out + (size_t)t * 1024) + c.lane; const v2u* y0 = (const v2u*)(Y + (size_t)d0 * 1024) + c.lane; const v2u* y1 = (const v2u*)(Y + (size_t)d1 * 1024) + c.lane;
#pragma unroll
        for (int j = 0; j < 4; ++j) { f32x4 o = op[64 * j]; const v2u a = y0[64 * j], b = y1[64 * j];
            o.x += g0 * bflo(a.x) + g1 * bflo(b.x); o.y += g0 * bfhi(a.x) + g1 * bfhi(b.x); o.z += g0 * bflo(a.y) + g1 * bflo(b.y); o.w += g0 * bfhi(a.y) + g1 * bfhi(b.y); op[64 * j] = o; } }
}

DI void phase_dsaprep(const Ctx& c0, const PV& P) {
    const Ctx c = relaunder(c0);
    const bf16* PROJ = (const bf16*)(P.ws + AR_PROJ); bf16* KN = (bf16*)(P.ws + AR_KN); bf16* KIN = (bf16*)(P.ws + AR_KIN); bf16* QIW = (bf16*)(P.ws + AR_QIW);
    const float* WI = (const float*)(P.ws + AR_WI); const float* kg = pin(P, I_DSA_K_NORM);
    const int l = c.lane;
    for (int row = c.gw; row < NTOK; row += c.NGW) {
        const int col = l < 8 ? 768 + 8 * l : (l < 16 ? 1216 + 8 * (l - 8) : 960 + 8 * (l - 16));
        float f[8] = {0.f, 0.f, 0.f, 0.f, 0.f, 0.f, 0.f, 0.f};
        if (l < 48) unpack8(*(const v4u*)(PROJ + (size_t)row * 1536 + col), f);
        float ss = 0.f;
#pragma unroll
        for (int j = 0; j < 8; ++j) ss += f[j] * f[j];
        ss += __shfl_xor(ss, 1); ss += __shfl_xor(ss, 2); ss += __shfl_xor(ss, 4);
        const float r = 1.0f / sqrtf(ss * (1.0f / 64.0f) + EPS);
        if (l < 8) {
#pragma unroll
            for (int j = 0; j < 8; ++j) f[j] = f[j] * r * kg[8 * l + j];
            *(v4u*)(KN + (size_t)row * 64 + 8 * l) = pack8(f);
        } else if (l < 16) {
#pragma unroll
            for (int j = 0; j < 8; ++j) f[j] *= r;
            { const int cch = l - 8;
              *(v4u*)(KIN + ((((size_t)(row >> 5) * 4 + (cch >> 1)) * 2 + (cch & 1)) * 32 + (row & 31)) * 8) = pack8(f); }
        } else if (l < 48) {
            const float w = WI[(size_t)row * 4 + ((l - 16) >> 3)] * 0.125f;
#pragma unroll
            for (int j = 0; j < 8; ++j) f[j] *= w;
            *(v4u*)(QIW + (size_t)row * 256 + 8 * (l - 16)) = pack8(f);
        }
    }
}
DI int dpp_scan_add(int v) {
    v += __builtin_amdgcn_update_dpp(0, v, 0x111, 0xf, 0xf, true); v += __builtin_amdgcn_update_dpp(0, v, 0x112, 0xf, 0xf, true);
    v += __builtin_amdgcn_update_dpp(0, v, 0x114, 0xf, 0xf, true); v += __builtin_amdgcn_update_dpp(0, v, 0x118, 0xf, 0xf, true);
    v += __builtin_amdgcn_update_dpp(0, v, 0x142, 0xa, 0xf, false); v += __builtin_amdgcn_update_dpp(0, v, 0x143, 0xc, 0xf, false);
    return v;
}
DI unsigned dpp_scan_max(unsigned v) {
#define DPPMAX_(ctrl, rm, bc) { const unsigned o_ = (unsigned)__builtin_amdgcn_update_dpp(0, (int)v, ctrl, rm, 0xf, bc); v = v > o_ ? v : o_; }
    DPPMAX_(0x111, 0xf, true) DPPMAX_(0x112, 0xf, true) DPPMAX_(0x114, 0xf, true) DPPMAX_(0x118, 0xf, true) DPPMAX_(0x142, 0xa, false) DPPMAX_(0x143, 0xc, false)
#undef DPPMAX_
    return v;
}
DI unsigned idx_compact(LAS unsigned* qb, LAS unsigned* hist, int n, int lane) {
    unsigned e[8];
#pragma unroll
    for (int i = 0; i < 8; ++i) { const int idx = lane + 64 * i; e[i] = idx < n ? qb[idx] : 0u; }
    unsigned prefix = 0u, maskbits = 0u; int want = 256;
#pragma unroll
    for (int pass = 0; pass < 4; ++pass) { const int shift = 24 - 8 * pass;
        *(LAS v4u*)(hist + 4 * lane) = (v4u){0u, 0u, 0u, 0u};
        LDS_WAIT();
#pragma unroll
        for (int i = 0; i < 8; ++i) if (e[i] != 0u && (e[i] & maskbits) == prefix) lds_add(&hist[255u - ((e[i] >> shift) & 255u)], 1u);
        LDS_WAIT();
        const v4u h4 = *(const LAS v4u*)(hist + 4 * lane);
        LDS_WAIT();
        const int s = (int)(h4.x + h4.y + h4.z + h4.w);
        const int c0 = dpp_scan_add(s) - s, c1 = c0 + (int)h4.x, c2 = c1 + (int)h4.y, c3 = c2 + (int)h4.z;
        int fb = -1, fa = 0;
        if (c0 < want && want <= c0 + (int)h4.x) { fb = 0; fa = c0; }
        else if (c1 < want && want <= c1 + (int)h4.y) { fb = 1; fa = c1; }
        else if (c2 < want && want <= c2 + (int)h4.z) { fb = 2; fa = c2; }
        else if (c3 < want && want <= c3 + (int)h4.w) { fb = 3; fa = c3; }
        const unsigned long long m = __ballot(fb >= 0);
        const int src = m ? (int)__builtin_ctzll(m) : 0;
        const int slot = __builtin_amdgcn_readlane(4 * lane + fb, src), ab = __builtin_amdgcn_readlane(fa, src);
        prefix |= (unsigned)(255 - slot) << shift; maskbits |= 0xFFu << shift; want -= ab;
    }
    int base = 0;
#pragma unroll
    for (int i = 0; i < 8; ++i) { const bool pred = e[i] >= prefix && e[i] != 0u; const unsigned long long m = __ballot(pred);
        const int pos = base + (int)__builtin_amdgcn_mbcnt_hi((unsigned)(m >> 32), __builtin_amdgcn_mbcnt_lo((unsigned)m, 0u));
        if (pred) qb[pos] = e[i];
        base += (int)__builtin_popcountll(m); }
    LDS_WAIT();
    return prefix;
}
DI int idx_compact_coarse(LAS unsigned* qb, LAS unsigned* hist, int n, unsigned lo, unsigned& tau, int lane) {
    unsigned e[8]; unsigned mx = 0u;
#pragma unroll
    for (int i = 0; i < 8; ++i) { const int idx = lane + 64 * i; e[i] = idx < n ? qb[idx] : 0u; mx = e[i] > mx ? e[i] : mx; }
    const unsigned hi = (unsigned)__builtin_amdgcn_readlane((int)dpp_scan_max(mx), 63);
    const unsigned range = hi - lo;
    const int sh = range >= 256u ? (24 - (int)__builtin_clz(range)) : 0;
    *(LAS v4u*)(hist + 4 * lane) = (v4u){0u, 0u, 0u, 0u};
    LDS_WAIT();
#pragma unroll
    for (int i = 0; i < 8; ++i) if (e[i] != 0u) lds_add(&hist[255u - ((e[i] - lo) >> sh)], 1u);
    LDS_WAIT();
    const v4u h4 = *(const LAS v4u*)(hist + 4 * lane);
    LDS_WAIT();
    const int s = (int)(h4.x + h4.y + h4.z + h4.w);
    const int c0 = dpp_scan_add(s) - s, c1 = c0 + (int)h4.x, c2 = c1 + (int)h4.y, c3 = c2 + (int)h4.z;
    int fb = -1, fk = 0;
    if (c0 < 256 && 256 <= c0 + (int)h4.x) { fb = 0; fk = c0 + (int)h4.x; }
    else if (c1 < 256 && 256 <= c1 + (int)h4.y) { fb = 1; fk = c1 + (int)h4.y; }
    else if (c2 < 256 && 256 <= c2 + (int)h4.z) { fb = 2; fk = c2 + (int)h4.z; }
    else if (c3 < 256 && 256 <= c3 + (int)h4.w) { fb = 3; fk = c3 + (int)h4.w; }
    const unsigned long long m = __ballot(fb >= 0);
    const int src = m ? (int)__builtin_ctzll(m) : 0;
    const int slot = __builtin_amdgcn_readlane(4 * lane + fb, src), kept = __builtin_amdgcn_readlane(fk, src);
    if (__builtin_expect(kept > 352, 0)) { tau = idx_compact(qb, hist, n, lane); return 256; }
    const unsigned edge = lo + ((unsigned)(255 - slot) << sh);
    int base = 0;
#pragma unroll
    for (int i = 0; i < 8; ++i) { const bool pred = e[i] >= edge && e[i] != 0u; const unsigned long long mm = __ballot(pred);
        const int pos = base + (int)__builtin_amdgcn_mbcnt_hi((unsigned)(mm >> 32), __builtin_amdgcn_mbcnt_lo((unsigned)mm, 0u));
        if (pred) qb[pos] = e[i];
        base += (int)__builtin_popcountll(mm); }
    LDS_WAIT();
    tau = edge - 1u;
    return base;
}
struct IdxState { float lo[4][4], hi[4][4]; unsigned tau[4]; int cnt[4]; int tq[4]; };
DI int sel4(const int (&a)[4], int j) { return j == 0 ? a[0] : (j == 1 ? a[1] : (j == 2 ? a[2] : a[3])); }
DI unsigned sel4u(const unsigned (&a)[4], int j) { return j == 0 ? a[0] : (j == 1 ? a[1] : (j == 2 ? a[2] : a[3])); }
template <int SHADOW> DI void idx_step(const bf16x8 (&A)[4], const bf16x8 (&B)[2][4], IdxState& st, LAS unsigned* buf, LAS unsigned* hist, int step, bool lastst, int lane, int hh, int l31, unsigned ltmask) {
    f32x16 acc[2];
#pragma unroll
    for (int u = 0; u < 2; ++u) {
#pragma unroll
        for (int i = 0; i < 16; ++i) acc[u][i] = 0.f; }
#pragma unroll
    for (int ks = 0; ks < 4; ++ks) {
#pragma unroll
        for (int u = 0; u < 2; ++u) acc[u] = __builtin_amdgcn_mfma_f32_32x32x16_bf16(A[ks], B[u][ks], acc[u], 0, 0, 0); }
    if (SHADOW == 5) {
        f32x16 acc2[2];
#pragma unroll
        for (int u = 0; u < 2; ++u) {
#pragma unroll
            for (int i = 0; i < 16; ++i) acc2[u][i] = 1.f; }
#pragma unroll
        for (int ks = 0; ks < 4; ++ks) {
#pragma unroll
            for (int u = 0; u < 2; ++u) acc2[u] = __builtin_amdgcn_mfma_f32_32x32x16_bf16(A[3 - ks], B[u][ks], acc2[u], 0, 0, 0); }
#pragma unroll
        for (int u = 0; u < 2; ++u) {
#pragma unroll
            for (int i = 0; i < 16; i += 4) acc[u][i] += 1e-30f * acc2[u][i]; }
    }
#pragma unroll
    for (int rep2 = 0; rep2 < (SHADOW == 6 ? 2 : 1); ++rep2)
#pragma unroll
    for (int u = 0; u < 2; ++u) {
        const int s = step * 64 + 32 * u + l31 + rep2;
#pragma unroll
        for (int j = 0; j < 4; ++j) {
            const float sc = (__builtin_amdgcn_fmed3f(acc[u][4 * j], st.lo[j][0], st.hi[j][0]) + __builtin_amdgcn_fmed3f(acc[u][4 * j + 1], st.lo[j][1], st.hi[j][1]))
                           + (__builtin_amdgcn_fmed3f(acc[u][4 * j + 2], st.lo[j][2], st.hi[j][2]) + __builtin_amdgcn_fmed3f(acc[u][4 * j + 3], st.lo[j][3], st.hi[j][3]));
            unsigned uu = __float_as_uint(sc); uu ^= (unsigned)((int)uu >> 31) | 0x80000000u;
            unsigned key = (uu & 0xFFFFC000u) | (unsigned)(16383 - s);
            if (lastst && s > st.tq[j]) key = 0u;
            const bool pred = key > st.tau[j];
            const unsigned long long m = __ballot(pred);
            const unsigned hm = hh ? (unsigned)(m >> 32) : (unsigned)m;
            const int pos = st.cnt[j] + __builtin_popcount(hm & ltmask);
            if (pred) buf[(2 * j + hh) * 512 + pos] = key;
            st.cnt[j] += __builtin_popcount(hm);
        }
    }
    const int cm = max(max(st.cnt[0], st.cnt[1]), max(st.cnt[2], st.cnt[3]));
    unsigned long long need = __ballot(cm > 448);
    if (__builtin_expect(need != 0ull, 0)) {
        unsigned qmask = 0u;
#pragma unroll
        for (int j = 0; j < 4; ++j) { const unsigned long long mm = __ballot(st.cnt[j] > 448); qmask |= ((unsigned)(mm & 1ull) << (2 * j)) | ((unsigned)((mm >> 32) & 1ull) << (2 * j + 1)); }
        LDS_WAIT();
        while (qmask) {
            const int q = __builtin_ctz(qmask); qmask &= qmask - 1u; const int j = q >> 1, h = q & 1;
            const int n = __builtin_amdgcn_readlane(sel4(st.cnt, j), h * 32); const unsigned lo0 = (unsigned)__builtin_amdgcn_readlane((int)sel4u(st.tau, j), h * 32);
            unsigned T; const int k = idx_compact_coarse(buf + q * 512, hist, n, lo0, T, lane);
#pragma unroll
            for (int jj = 0; jj < 4; ++jj) if (jj == j && hh == h) { st.tau[jj] = T; st.cnt[jj] = k; }
        }
    }
}
DI void idx_loadB(bf16x8 (&B)[2][4], const bf16* kbase, int step) {
#pragma unroll
    for (int u = 0; u < 2; ++u)
#pragma unroll
        for (int ks = 0; ks < 4; ++ks) B[u][ks] = *(const bf16x8*)(kbase + ((size_t)(2 * step + u) * 4 + ks) * 512);
}
template <int SHADOW> DI void phase_indexer(const Ctx& c0, const PV& P) {
    const Ctx c = relaunder(c0);
    const bf16* KIN = (const bf16*)(P.ws + AR_KIN); const bf16* QIW = (const bf16*)(P.ws + AR_QIW); const float* WI = (const float*)(P.ws + AR_WI); int* SEL = (int*)(P.ws + (SHADOW ? WS_AR + 272 * MiB : AR_SEL));
    LAS unsigned* buf = (LAS unsigned*)(c.lds + c.wave * 17408);
    LAS unsigned* hist = buf + 4096;
    const int lane = c.lane, hh = lane >> 5, l31 = lane & 31;
    const unsigned ltmask = (1u << l31) - 1u;
    const float INF = __builtin_inff();
    for (int pair = c.blk; pair < 256; pair += c.G) {
        const int b = pair >> 7, jj = pair & 127;
        for (int half = 0; half < 2; ++half) {
            const int unit = half ? (255 - jj) : jj, t0w = unit * 64 + c.wave * 8, rowbase = b * SEQ;
            bf16x8 A[4];
#pragma unroll
            for (int ks = 0; ks < 4; ++ks) A[ks] = *(const bf16x8*)(QIW + (size_t)(rowbase + t0w + (l31 >> 2)) * 256 + (l31 & 3) * 64 + 16 * ks + 8 * hh);
            IdxState st;
#pragma unroll
            for (int j = 0; j < 4; ++j) { st.tq[j] = t0w + 2 * j + hh; st.tau[j] = 0u; st.cnt[j] = 0;
                const f32x4 w = *(const f32x4*)(WI + (size_t)(rowbase + st.tq[j]) * 4);
#pragma unroll
                for (int i = 0; i < 4; ++i) { st.lo[j][i] = w[i] > 0.f ? 0.f : -INF; st.hi[j][i] = w[i] > 0.f ? INF : 0.f; } }
            const int nstep = (SHADOW == 7) ? ((t0w + 7) / 128 + 1) : ((t0w + 7) / 64 + 1);
            const bf16* kbase = KIN + (size_t)(rowbase >> 5) * 2048 + lane * 8;
            bf16x8 R0[2][4], R1[2][4];
            idx_loadB(R0, kbase, 0);
            if (nstep > 1) idx_loadB(R1, kbase, 1); else idx_loadB(R1, kbase, 0);
            for (int step = 0; step < nstep; step += 2) {
                idx_step<SHADOW>(A, R0, st, buf, hist, step, step + 1 >= nstep, lane, hh, l31, ltmask);
                idx_loadB(R0, kbase, min(step + 2, nstep - 1));
                idx_step<SHADOW>(A, R1, st, buf, hist, step + 1, step + 2 >= nstep, lane, hh, l31, ltmask);
                idx_loadB(R1, kbase, min(step + 3, nstep - 1));
            }
            LDS_WAIT();
            for (int q = 0; q < 8; ++q) {
                const int j = q >> 1, h2 = q & 1;
                int n = __builtin_amdgcn_readlane(sel4(st.cnt, j), h2 * 32);
                LAS unsigned* qb = buf + q * 512;
                if (SHADOW == 8) n = n > 256 ? 256 : n;
                if (n > 256) { (void)idx_compact(qb, hist, n, lane); n = 256; }
                int* sp = SEL + (size_t)(rowbase + t0w + q) * 256;
#pragma unroll
                for (int i = 0; i < 4; ++i) { const int idx = lane + 64 * i; sp[idx] = idx < n ? (16383 - (int)(qb[idx] & 0x3FFFu)) : -1; }
            }
            LDS_WAIT();
        }
    }
}
DI int t5_bucket(int d) {
    if (d < 16) return d;
    return 16 + (d >= 19) + (d >= 21) + (d >= 24) + (d >= 27) + (d >= 31) + (d >= 35) + (d >= 40) + (d >= 46) + (d >= 52) + (d >= 59) + (d >= 67) + (d >= 77) + (d >= 87) + (d >= 99) + (d >= 113);
}
typedef short s16x4 __attribute__((ext_vector_type(4)));
DI void phase_sattn(const Ctx& c0, const PV& P) {
    const Ctx c = relaunder(c0);
    const bf16* PROJ = (const bf16*)(P.ws + AR_PROJ); const bf16* KN = (const bf16*)(P.ws + AR_KN); const int* SEL = (const int*)(P.ws + AR_SEL); bf16* MIX = (bf16*)(P.ws + AR_MIXD);
    const float* qg = pin(P, I_DSA_Q_NORM); const float* rb = pin(P, I_REL_BIAS);
    constexpr int WST = 11264, VRS = 144;
    LAS int* bk = (LAS int*)(c.lds + c.wave * WST);
    LAS int* selL = bk + 256;
    LAS bf16* Vs = (LAS bf16*)(selL + 256);
    LAS float* relb = (LAS float*)(c.lds + 8 * WST);
    const int lane = c.lane, l15 = lane & 15, g = lane >> 4;
    __syncthreads();
    relb[c.tid] = (c.tid & 15) < 12 ? rb[(c.tid >> 4) * 12 + (c.tid & 15)] : 0.f;
    __syncthreads();
    float qgv0[8], qgv1[8];
#pragma unroll
    for (int j = 0; j < 8; ++j) { qgv0[j] = qg[8 * g + j]; qgv1[j] = qg[32 + 8 * g + j]; }
    const LAS bf16* trp = Vs + (4 * g + (l15 >> 2)) * VRS + 4 * (l15 & 3);
    int row = c.gw;
    v4i s4n = {0, 0, 0, 0}; v4u qn0 = {0u, 0u, 0u, 0u}, qn1 = {0u, 0u, 0u, 0u};
    if (row < NTOK) { s4n = *(const v4i*)(SEL + (size_t)row * 256 + 4 * lane);
        if (l15 < 12) { const bf16* qp = PROJ + (size_t)row * 1536 + l15 * 64 + 8 * g; qn0 = *(const v4u*)qp; qn1 = *(const v4u*)(qp + 32); } }
#pragma unroll 1
    for (; row < NTOK; row += c.NGW) {
        const int b = row >> 14, t = row & (SEQ - 1), rowbase = b << 14;
        const v4i s4 = s4n; const v4u w0 = qn0, w1 = qn1;
        { const int nrow = row + c.NGW;
          if (nrow < NTOK) { s4n = *(const v4i*)(SEL + (size_t)nrow * 256 + 4 * lane);
              if (l15 < 12) { const bf16* qp = PROJ + (size_t)nrow * 1536 + l15 * 64 + 8 * g; qn0 = *(const v4u*)qp; qn1 = *(const v4u*)(qp + 32); } } }
        const int sv[4] = {s4.x, s4.y, s4.z, s4.w};
        int bv[4], cv[4];
#pragma unroll
        for (int i = 0; i < 4; ++i) { bv[i] = sv[i] >= 0 ? t5_bucket(t - sv[i]) : -1; cv[i] = sv[i] >= 0 ? sv[i] : 0; }
        *(LAS v4i*)(bk + 4 * lane) = (v4i){bv[0], bv[1], bv[2], bv[3]};
        *(LAS v4i*)(selL + 4 * lane) = (v4i){cv[0], cv[1], cv[2], cv[3]};
        float q0[8], q1[8]; unpack8(w0, q0); unpack8(w1, q1);
        float ss = 0.f;
#pragma unroll
        for (int j = 0; j < 8; ++j) ss += q0[j] * q0[j] + q1[j] * q1[j];
        ss += __shfl_xor(ss, 16); ss += __shfl_xor(ss, 32);
        const float r = 0.125f / sqrtf(ss * (1.0f / 64.0f) + EPS);
#pragma unroll
        for (int j = 0; j < 8; ++j) { q0[j] = q0[j] * r * qgv0[j]; q1[j] = q1[j] * r * qgv1[j]; }
        const bf16x8 B0 = __builtin_bit_cast(bf16x8, pack8(q0)), B1 = __builtin_bit_cast(bf16x8, pack8(q1));
        LDS_WAIT();
        v4u vb[2][8];
#pragma unroll
        for (int i = 0; i < 8; ++i) { const int sk = selL[4 * i + g]; vb[0][i] = *(const v4u*)(PROJ + (size_t)(rowbase + sk) * 1536 + 832 + 8 * l15); }
        f32x4 S[16];
#pragma unroll
        for (int hb = 0; hb < 2; ++hb) {
            bf16x8 A0[8], A1[8];
#pragma unroll
            for (int k8 = 0; k8 < 8; ++k8) { const int sk = selL[16 * (8 * hb + k8) + l15]; const bf16* kp = KN + (size_t)(rowbase + sk) * 64 + 8 * g; A0[k8] = *(const bf16x8*)kp; A1[k8] = *(const bf16x8*)(kp + 32); }
#pragma unroll
            for (int k8 = 0; k8 < 8; ++k8) { f32x4 z = {0.f, 0.f, 0.f, 0.f}; z = mfma16(A0[k8], B0, z); S[8 * hb + k8] = mfma16(A1[k8], B1, z); }
            __builtin_amdgcn_sched_barrier(0);
        }
        float mx = -3.0e38f;
#pragma unroll
        for (int kt = 0; kt < 16; ++kt) { const v4i b4 = *(const LAS v4i*)(bk + 16 * kt + 4 * g); const int bb[4] = {b4.x, b4.y, b4.z, b4.w};
#pragma unroll
            for (int i = 0; i < 4; ++i) { const float v = bb[i] >= 0 ? S[kt][i] + relb[bb[i] * 16 + l15] : -3.0e38f; S[kt][i] = v; mx = fmaxf(mx, v); } }
        mx = fmaxf(mx, __shfl_xor(mx, 16)); mx = fmaxf(mx, __shfl_xor(mx, 32));
        float l = 0.f;
#pragma unroll
        for (int kt = 0; kt < 16; ++kt) {
#pragma unroll
            for (int i = 0; i < 4; ++i) { const float p = S[kt][i] > -1.0e38f ? __expf(S[kt][i] - mx) : 0.f; S[kt][i] = p; l += p; } }
        l += __shfl_xor(l, 16); l += __shfl_xor(l, 32);
        f32x4 O[8];
#pragma unroll
        for (int ct = 0; ct < 8; ++ct) O[ct] = (f32x4){0.f, 0.f, 0.f, 0.f};
#pragma unroll
        for (int jb = 0; jb < 8; ++jb) {
            if (jb + 1 < 8) {
#pragma unroll
                for (int i = 0; i < 8; ++i) { const int sk = selL[32 * (jb + 1) + 4 * i + g]; vb[(jb + 1) & 1][i] = *(const v4u*)(PROJ + (size_t)(rowbase + sk) * 1536 + 832 + 8 * l15); } }
#pragma unroll
            for (int i = 0; i < 8; ++i) { const v4u v = vb[jb & 1][i]; LAS v2u* d = (LAS v2u*)(Vs + (4 * i + g) * VRS + 8 * l15); d[0] = (v2u){v.x, v.y}; d[1] = (v2u){v.z, v.w}; }
            v4u pw; pw.x = pk2(S[2 * jb][0], S[2 * jb][1]); pw.y = pk2(S[2 * jb][2], S[2 * jb][3]); pw.z = pk2(S[2 * jb + 1][0], S[2 * jb + 1][1]); pw.w = pk2(S[2 * jb + 1][2], S[2 * jb + 1][3]);
            const bf16x8 Pb = __builtin_bit_cast(bf16x8, pw);
            LDS_WAIT();
#pragma unroll
            for (int ct = 0; ct < 8; ++ct) {
                const s16x4 a = __builtin_amdgcn_ds_read_tr16_b64_v4i16((LAS s16x4*)(trp + 16 * ct));
                const s16x4 bq = __builtin_amdgcn_ds_read_tr16_b64_v4i16((LAS s16x4*)(trp + 16 * VRS + 16 * ct));
                const bf16x8 Af = {a[0], a[1], a[2], a[3], bq[0], bq[1], bq[2], bq[3]};
                O[ct] = mfma16(Af, Pb, O[ct]); }
            LDS_WAIT();
            __builtin_amdgcn_sched_barrier(0);
        }
        if (l15 < 12) { const float il = 1.0f / l; bf16* op = MIX + (size_t)row * 1792 + l15 * 128 + 4 * g;
#pragma unroll
            for (int ct = 0; ct < 8; ++ct) { v2u o; o.x = pk2(O[ct][0] * il, O[ct][1] * il); o.y = pk2(O[ct][2] * il, O[ct][3] * il); *(v2u*)(op + 16 * ct) = o; } }
        LDS_WAIT();
    }
}

#ifndef ONLY
#define ONLY -1
#endif
#define PH(n) (ONLY < 0 || ONLY == (n))
#ifndef REP0
#define REP0 1
#endif
#ifndef REP1
#define REP1 1
#endif
#ifndef REP2
#define REP2 1
#endif
#ifndef REP3
#define REP3 1
#endif
#ifndef REP4
#define REP4 1
#endif
#ifndef REP5
#define REP5 1
#endif
#ifndef REP6
#define REP6 1
#endif
#ifndef REP7
#define REP7 1
#endif
#ifndef REP8
#define REP8 1
#endif
#ifndef REP9
#define REP9 1
#endif
#ifndef REP10
#define REP10 1
#endif
#ifndef REP11
#define REP11 1
#endif
#ifndef REP12
#define REP12 1
#endif
#ifndef REP13
#define REP13 1
#endif
#ifndef REP14
#define REP14 1
#endif
#ifndef REP15
#define REP15 1
#endif
#ifndef REP16
#define REP16 1
#endif
#ifndef REP17
#define REP17 1
#endif
#ifndef REP18
#define REP18 1
#endif
#define RB(n) for (int r_ = 0; r_ < REP##n; ++r_) { if (r_) GRID_BAR();
#define RE }
#define GRID_BAR() xcd_barrier(bar)
template <int layer> DI void layer_body(const Ctx& c, const PV& P, const XcdBarrier& bar) {
    unsigned char* ws = P.ws;
    unsigned* ctl = (unsigned*)(ws + WS_CTL);
    PG8_LAS unsigned char* glds = (PG8_LAS unsigned char*)c.lds;
    const pg8::bf16_t* HN = (const pg8::bf16_t*)(ws + WS_HN);
    RB(0) if (PH(0)) phase_prep<layer>(c, P); RE
    GRID_BAR();
    RB(1) if (PH(1)) {
        { pg8::Gemm g{(const pg8::bf16_t*)(ws + WB_MEMN), (const pg8::bf16_t*)(ws + WB_MKV), 1024, 1024, 1024}; pg8::StaticOrder S; S.init(2, 2, c.G, c.G - 1 - c.blk);
          pg8::EpiBf16<false> E{(pg8::bf16_t*)(ws + WB_MKVO), 512, 0, 0};
          pg8::gemm_phase<pg8::EpiBf16<false>, pg8::StaticOrder, true, true>(glds, g, S, E); }
        __syncthreads();
        if (layer == 0) { pg8::Gemm g{HN, (const pg8::bf16_t*)(ws + WB_WIN), 1024, 1024, 1024}; pg8::StaticOrder S; S.init(128, 7, c.G, c.blk);
          pg8::EpiBf16<true> E{(pg8::bf16_t*)(ws + AR_PROJ), 1792, 3, 6};
          pg8::gemm_phase<pg8::EpiBf16<true>, pg8::StaticOrder, true, true>(glds, g, S, E); }
        else { pg8::Gemm g{HN, (const pg8::bf16_t*)(ws + WB_WIN), 1024, 1024, 1024}; pg8::StaticOrder S; S.init(128, 6, c.G, c.blk);
          pg8::EpiBf16<false> E{(pg8::bf16_t*)(ws + AR_PROJ), 1536, 0, 0};
          pg8::gemm_phase<pg8::EpiBf16<false>, pg8::StaticOrder, true, true>(glds, g, S, E); }
    } RE
    GRID_BAR();
    if (layer == 0) {
        RB(2) if (PH(2)) phase_conv(c, P);
        if (PH(2)) phase_xattn<0, 1792, 1536, 1024, 768>(c, P, (const bf16*)(ws + AR_PROJ), (bf16*)(ws + AR_MIXL)); RE
        GRID_BAR();
        RB(3) if (PH(3)) { pg8::Gemm g{(const pg8::bf16_t*)(ws + AR_XSC), (const pg8::bf16_t*)(ws + WB_WGT), 768, 768, 768}; pg8::StaticOrder S; S.init(128, 6, c.G, c.blk);
          pg8::EpiLruGate E{(pg8::bf16_t*)(ws + AR_LA), (pg8::bf16_t*)(ws + AR_UU), (const pg8::bf16_t*)(ws + AR_XSC), 768, pin(P, I_LRU_B_A), pin(P, I_LRU_B_X), pin(P, I_LRU_LAMBDA)};
          pg8::gemm_phase<pg8::EpiLruGate, pg8::StaticOrder, true, true>(glds, g, S, E); } RE
        GRID_BAR();
        RB(4) if (PH(4)) phase_scanA(c, P); RE
        GRID_BAR();
        RB(5) if (PH(5)) phase_scanB(c, P); RE
        GRID_BAR();
        RB(6) if (PH(6)) phase_scanC(c, P); RE
        GRID_BAR();
        RB(7) if (PH(7)) { pg8::Gemm g{(const pg8::bf16_t*)(ws + AR_MIXL), (const pg8::bf16_t*)(ws + WB_WOUT), 1024, 1024, 1024}; pg8::StaticOrder S; S.init(128, 4, c.G, c.blk);
          pg8::EpiResF32 E{P.out, pin(P, I_X), 1024};
          pg8::gemm_phase<pg8::EpiResF32, pg8::StaticOrder, true, true>(glds, g, S, E); } RE
    } else {
        RB(8) if (PH(8)) phase_dsaprep(c, P);
        if (PH(8)) phase_xattn<1, 1536, 1280, 1792, 1536>(c, P, (const bf16*)(ws + AR_PROJ), (bf16*)(ws + AR_MIXD)); RE
        GRID_BAR();
#ifndef IDX_SHADOW
#define IDX_SHADOW 0
#endif
        RB(9) if (PH(9)) { if (r_ + 1 < REP9) phase_indexer<IDX_SHADOW>(c, P); else phase_indexer<0>(c, P); } RE
        GRID_BAR();
        RB(10) if (PH(10)) phase_sattn(c, P); RE
        GRID_BAR();
        RB(11) if (PH(11)) { pg8::Gemm g{(const pg8::bf16_t*)(ws + AR_MIXD), (const pg8::bf16_t*)(ws + WB_WOUT), 1792, 1792, 1792}; pg8::StaticOrder S; S.init(128, 4, c.G, c.blk);
          pg8::EpiResF32 E{(r_ + 1 < REP11) ? (float*)(ws + WS_AR) : P.out, P.out, 1024};
          pg8::gemm_phase<pg8::EpiResF32, pg8::StaticOrder, true, true>(glds, g, S, E); } RE
    }
    GRID_BAR();
    RB(12) if (PH(12)) phase_norm2<layer>(c, P); RE
    GRID_BAR();
    RB(13) if (PH(13)) { pg8::Gemm g{HN, (const pg8::bf16_t*)(ws + WB_WR), 1024, 1024, 1024}; pg8::StaticOrder S; S.init(128, 1, c.G, c.blk);
      pg8::EpiLogits E{(float*)(ws + AR_LOG)};
      pg8::gemm_phase<pg8::EpiLogits, pg8::StaticOrder, true, true>(glds, g, S, E); } RE
    GRID_BAR();
    if (PH(14)) phase_route<layer>(c, P);
    GRID_BAR();
    if (PH(15)) phase_scatter<layer>(c, P);
    GRID_BAR();
    RB(16) if (PH(16)) { const int ntile = (int)__hip_atomic_load(ctl + CW_NT + layer * CW_LSTRIDE, RLX_AGENT);
        pg8::Gemm g{(const pg8::bf16_t*)(ws + AR_XS), (const pg8::bf16_t*)(ws + WB_WGU), 1024, 1024, 1024}; pg8::GroupedOrder S; S.init(ntile, 4, c.G, c.blk);
        S.te = (const int*)(ctl + CW_TE + layer * CW_TE_STRIDE); S.estride = (size_t)1024 * 1024 * 2;
        pg8::EpiSwiglu E{(pg8::bf16_t*)(ws + AR_ACT), 512};
        pg8::gemm_phase<pg8::EpiSwiglu, pg8::GroupedOrder, true, true>(glds, g, S, E); } RE
    GRID_BAR();
    RB(17) if (PH(17)) { const int ntile = (int)__hip_atomic_load(ctl + CW_NT + layer * CW_LSTRIDE, RLX_AGENT);
        pg8::Gemm g{(const pg8::bf16_t*)(ws + AR_ACT), (const pg8::bf16_t*)(ws + WB_WD), 512, 512, 512}; pg8::GroupedOrder S; S.init(ntile, 4, c.G, c.blk);
        S.te = (const int*)(ctl + CW_TE + layer * CW_TE_STRIDE); S.estride = (size_t)1024 * 512 * 2;
        pg8::EpiBf16<false> E{(pg8::bf16_t*)(ws + AR_XS), 1024, 0, 0};
        pg8::gemm_phase<pg8::EpiBf16<false>, pg8::GroupedOrder, true, true>(glds, g, S, E); } RE
    GRID_BAR();
    if (PH(18)) phase_combine(c, P);
    GRID_BAR();
}
__global__ void __launch_bounds__(512, 2) fwd(const Params P) {
    extern __shared__ __attribute__((aligned(16))) unsigned char lds_raw[];
    Ctx c;
    c.lds = (LAS unsigned char*)lds_raw;
    c.tid = threadIdx.x; c.lane = c.tid & 63; c.wave = __builtin_amdgcn_readfirstlane(c.tid >> 6);
    c.G = gridDim.x; c.blk = blockIdx.x; c.gw = c.blk * 8 + c.wave; c.NGW = c.G * 8;
    volatile LAS unsigned* MISC = (volatile LAS unsigned*)(c.lds + MISC_OFF);
    if (c.tid < 64) MISC[c.tid] = 0u;
    if (c.tid < 29) ((LAS unsigned long long*)(c.lds + MISC_OFF + 512))[c.tid] = (unsigned long long)P.in[c.tid];
    __syncthreads();
    XcdBarrier bar = xcd_barrier_post((unsigned*)(P.ws + WS_CTL) + CW_BAR, MISC + 8);
    PV pv; pv.ws = P.ws; pv.out = P.out; pv.tab = (LAS unsigned long long*)(c.lds + MISC_OFF + 512);
#ifndef ONLY_LAYER
    layer_body<0>(c, pv, bar);
    layer_body<1>(c, pv, bar);
#else
    layer_body<ONLY_LAYER>(c, pv, bar);
#endif
}

extern "C" void kernel_launch(void* const* d_in, const int* in_sizes, int n_in, void* d_out, int out_size, void* d_ws, size_t ws_size, hipStream_t stream) {
    static int grid = 0;
    if (grid == 0) {
        if (n_in != 29 || out_size != NTOK * DM || ws_size < WS_END) { fprintf(stderr, "kernel_launch: unexpected shapes (n_in %d out %d ws %zu need %zu)\n", n_in, out_size, ws_size, (size_t)WS_END); grid = -1; return; }
        int dev = 0, cus = 0, per_cu = 0;
        if (hipGetDevice(&dev) != hipSuccess || hipDeviceGetAttribute(&cus, hipDeviceAttributeMultiprocessorCount, dev) != hipSuccess) { grid = -1; return; }
        if (hipFuncSetAttribute((const void*)fwd, hipFuncAttributeMaxDynamicSharedMemorySize, LDS_BYTES) != hipSuccess) { fprintf(stderr, "kernel_launch: hipFuncSetAttribute failed\n"); grid = -1; return; }
        if (hipOccupancyMaxActiveBlocksPerMultiprocessor(&per_cu, (const void*)fwd, 512, LDS_BYTES) != hipSuccess || per_cu < 1) { fprintf(stderr, "kernel_launch: occupancy query reports %d\n", per_cu); }
        (void)hipGetLastError();
        grid = cus;
    }
    if (grid < 0) return;
    if (hipMemsetAsync((char*)d_ws + WS_CTL, 0, CTL_ZERO_BYTES, stream) != hipSuccess) return;
    Params p{};
    for (int i = 0; i < 29; ++i) p.in[i] = (const float*)d_in[i];
    p.out = (float*)d_out; p.ws = (unsigned char*)d_ws;
    hipLaunchKernelGGL(fwd, dim3(grid), dim3(512), LDS_BYTES, stream, p);
}
```

```cpp
#include <hip/hip_runtime.h>
#include <cstdio>
#include <cstdint>
namespace pg8 {
#define PG8_LAS __attribute__((address_space(3)))
typedef unsigned short bf16_t;
typedef short bf16x8 __attribute__((ext_vector_type(8)));
typedef float f32x4 __attribute__((ext_vector_type(4)));
typedef float f32x2 __attribute__((ext_vector_type(2)));
typedef unsigned u32x4 __attribute__((ext_vector_type(4)));
constexpr int BM = 256, BK = 64, HALF = 128, HTB = HALF * BK * 2  , STAGE_BYTES = 8 * HTB, NXCD = 8, WGM = 8;

__host__ __device__ __forceinline__ int lds_byte(int r, int c) { const int st = (r >> 4) * 2 + (c >> 5), rr = r & 15, cc = c & 31, ob = rr * 64 + cc * 2; return st * 1024 + (ob ^ (((ob >> 9) & 1) << 5)); }
__host__ __device__ __forceinline__ void stage_rc(int b, int& R, int& C) { const int st = b / 1024, sb = b % 1024, swz = sb ^ (((sb >> 9) & 1) << 5); R = (st >> 1) * 16 + swz / 64; C = (st & 1) * 32 + (swz % 64) / 2; }
__host__ __device__ __forceinline__ int perm32(int rho) { const int n = rho >> 4, i = rho & 15; return 8 * (i >> 2) + 4 * n + (i & 3); }

struct Unit { int pm, pn; size_t boff; };
struct Gemm { const bf16_t* A; const bf16_t* Bt; int lda, ldb, K; };

struct StaticOrder {
    int nM, nN, nwg, G, c;
    __host__ __device__ void init(int nM_, int nN_, int G_, int c_) { nM = nM_; nN = nN_; nwg = nM * nN; G = G_; c = c_; }
    __host__ __device__ bool next(int i, Unit& u) const {
        const long L = (long)i * G + c; if (L >= nwg) return false;
        int wgid = (int)L; { const int q = nwg / NXCD, r = nwg % NXCD, xcd = wgid % NXCD, off = wgid / NXCD; wgid = (xcd < r ? xcd * (q + 1) : r * (q + 1) + (xcd - r) * q) + off; }
        const int nig = WGM * nN, gid = wgid / nig, fm = gid * WGM, gsz = (nM - fm) < WGM ? (nM - fm) : WGM;
        u.pm = fm + ((wgid % nig) % gsz); u.pn = (wgid % nig) / gsz; u.boff = 0; return true;
    }
    __device__ __forceinline__ void a_ready(const Unit&) const {}
    __device__ __forceinline__ void done(const Unit&) const {}
};
struct GroupedOrder : StaticOrder {
    const int* te; size_t estride;
    __device__ bool next(int i, Unit& u) const { if (!StaticOrder::next(i, u)) return false; u.boff = (size_t)te[u.pm] * estride; return true; }
};

__device__ __forceinline__ unsigned cvt_pk_bf16(float lo, float hi) { unsigned r; asm volatile("v_cvt_pk_bf16_f32 %0, %1, %2" : "=v"(r) : "v"(lo), "v"(hi)); return r; }
__device__ __forceinline__ float bf_lo(unsigned w) { return __uint_as_float(w << 16); }
__device__ __forceinline__ float bf_hi(unsigned w) { return __uint_as_float(w & 0xffff0000u); }
__device__ __forceinline__ float sigmoidf_(float v) { return __builtin_amdgcn_rcpf(1.0f + __expf(-v)); }
__device__ __forceinline__ float gelu_tanh(float v) { const float z = 1.5957691216057308f * (v + 0.044715f * v * v * v); return v * sigmoidf_(z); }

template <bool GELU> struct EpiBf16 {
    static constexpr bool PERM = true, AFTER_DRAIN = false;
    bf16_t* O; int ldc; int gelu_lo, gelu_hi;
    __device__ __forceinline__ void operator()(const f32x4 (&acc)[2][2][4][2], const Unit& u, int wr, int wc, int fr, int fq) const {
        const int row0 = u.pm * BM + wr * 64 + fr, col0 = u.pn * BM + wc * 32 + 8 * fq;
        const bool act = GELU && (u.pn >= gelu_lo && u.pn < gelu_hi);
#pragma unroll
        for (int ai = 0; ai < 2; ++ai)
#pragma unroll
            for (int m = 0; m < 4; ++m) { bf16_t* rowp = O + (size_t)(row0 + ai * HALF + m * 16) * ldc + col0;
#pragma unroll
                for (int bj = 0; bj < 2; ++bj) { f32x4 v0 = acc[ai][bj][m][0], v1 = acc[ai][bj][m][1];
                    if (act) {
#pragma unroll
                        for (int j = 0; j < 4; ++j) { v0[j] = gelu_tanh(v0[j]); v1[j] = gelu_tanh(v1[j]); } }
                    u32x4 w; w.x = cvt_pk_bf16(v0[0], v0[1]); w.y = cvt_pk_bf16(v0[2], v0[3]); w.z = cvt_pk_bf16(v1[0], v1[1]); w.w = cvt_pk_bf16(v1[2], v1[3]);
                    *(u32x4*)(rowp + bj * HALF) = w; } }
    }
};
struct EpiSwiglu {
    static constexpr bool PERM = true, AFTER_DRAIN = false;
    bf16_t* O; int ldc;
    __device__ __forceinline__ void operator()(const f32x4 (&acc)[2][2][4][2], const Unit& u, int wr, int wc, int fr, int fq) const {
        const int row0 = u.pm * BM + wr * 64 + fr, col0 = u.pn * HALF + wc * 32 + 8 * fq;
#pragma unroll
        for (int ai = 0; ai < 2; ++ai)
#pragma unroll
            for (int m = 0; m < 4; ++m) { bf16_t* rowp = O + (size_t)(row0 + ai * HALF + m * 16) * ldc + col0;
                f32x4 v0, v1;
#pragma unroll
                for (int j = 0; j < 4; ++j) { const float g0 = acc[ai][0][m][0][j], g1 = acc[ai][0][m][1][j];
                    v0[j] = g0 * sigmoidf_(g0) * acc[ai][1][m][0][j]; v1[j] = g1 * sigmoidf_(g1) * acc[ai][1][m][1][j]; }
                u32x4 w; w.x = cvt_pk_bf16(v0[0], v0[1]); w.y = cvt_pk_bf16(v0[2], v0[3]); w.z = cvt_pk_bf16(v1[0], v1[1]); w.w = cvt_pk_bf16(v1[2], v1[3]);
                *(u32x4*)rowp = w; }
    }
};
struct EpiLruGate {
    static constexpr bool PERM = true, AFTER_DRAIN = false;
    bf16_t* LA; bf16_t* U; const bf16_t* XS; int ldc; const float* b_a; const float* b_x; const float* lam;
    __device__ __forceinline__ void operator()(const f32x4 (&acc)[2][2][4][2], const Unit& u, int wr, int wc, int fr, int fq) const {
        const int row0 = u.pm * BM + wr * 64 + fr, ch0 = u.pn * HALF + wc * 32 + 8 * fq;
        float ba[8], bx[8], sp8[8];
#pragma unroll
        for (int j = 0; j < 8; ++j) { ba[j] = b_a[ch0 + j]; bx[j] = b_x[ch0 + j]; const float l = lam[ch0 + j];
            sp8[j] = 8.0f * ((l > 15.f) ? __expf(-l) : __logf(1.0f + __expf(-l))); }
#pragma unroll
        for (int ai = 0; ai < 2; ++ai)
#pragma unroll
            for (int m = 0; m < 4; ++m) { const size_t off = (size_t)(row0 + ai * HALF + m * 16) * ldc + ch0;
                const u32x4 xw = *(const u32x4*)(XS + off);
                float xv[8] = {bf_lo(xw.x), bf_hi(xw.x), bf_lo(xw.y), bf_hi(xw.y), bf_lo(xw.z), bf_hi(xw.z), bf_lo(xw.w), bf_hi(xw.w)};
                float la[8], uu[8];
#pragma unroll
                for (int j = 0; j < 8; ++j) { const float rp = acc[ai][0][m][j >> 2][j & 3] + ba[j], ip = acc[ai][1][m][j >> 2][j & 3] + bx[j];
                    const float r = sigmoidf_(rp), ig = sigmoidf_(ip);
                    const float l = -sp8[j] * r; const float t = 2.0f * l;
                    const float om = (t > -0.02f) ? -t * (1.0f + t * (0.5f + t * (0.16666667f + t * 0.041666667f))) : 1.0f - __expf(t);
                    la[j] = l; uu[j] = sqrtf(om) * ig * xv[j]; }
                u32x4 w; w.x = cvt_pk_bf16(la[0], la[1]); w.y = cvt_pk_bf16(la[2], la[3]); w.z = cvt_pk_bf16(la[4], la[5]); w.w = cvt_pk_bf16(la[6], la[7]);
                *(u32x4*)(LA + off) = w;
                u32x4 w2; w2.x = cvt_pk_bf16(uu[0], uu[1]); w2.y = cvt_pk_bf16(uu[2], uu[3]); w2.z = cvt_pk_bf16(uu[4], uu[5]); w2.w = cvt_pk_bf16(uu[6], uu[7]);
                *(u32x4*)(U + off) = w2; __builtin_amdgcn_sched_barrier(0); }
    }
};
struct EpiResF32 {
    static constexpr bool PERM = false, AFTER_DRAIN = false;
    float* C; const float* R; int ldc;
    __device__ __forceinline__ void operator()(const f32x4 (&acc)[2][2][4][2], const Unit& u, int wr, int wc, int fr, int fq) const {
        const int row0 = u.pm * BM + wr * 64 + fr, col0 = u.pn * BM + wc * 32 + 4 * fq;
#pragma unroll
        for (int ai = 0; ai < 2; ++ai)
#pragma unroll
            for (int m = 0; m < 4; ++m) { const size_t ro = (size_t)(row0 + ai * HALF + m * 16) * ldc + col0;
#pragma unroll
                for (int bj = 0; bj < 2; ++bj)
#pragma unroll
                    for (int n = 0; n < 2; ++n) { const f32x4 r = *(const f32x4*)(R + ro + bj * HALF + n * 16); *(f32x4*)(C + ro + bj * HALF + n * 16) = r + acc[ai][bj][m][n]; }  __builtin_amdgcn_sched_barrier(0); }
    }
};
struct EpiLogits {
    static constexpr bool PERM = false, AFTER_DRAIN = false;
    float* C;
    __device__ __forceinline__ void operator()(const f32x4 (&acc)[2][2][4][2], const Unit& u, int wr, int wc, int fr, int fq) const {
        if (wc >= 2 || u.pn != 0) return;
        const int row0 = u.pm * BM + wr * 64 + fr, col0 = wc * 32 + 4 * fq;
#pragma unroll
        for (int ai = 0; ai < 2; ++ai)
#pragma unroll
            for (int m = 0; m < 4; ++m) { float* rowp = C + (size_t)(row0 + ai * HALF + m * 16) * 64 + col0;
#pragma unroll
                for (int n = 0; n < 2; ++n) *(f32x4*)(rowp + n * 16) = acc[ai][0][m][n]; }
    }
};
template <class Epi, class Sched, bool ALIGN_EPI = false, bool SP2 = false>
__device__ __forceinline__ void gemm_phase(PG8_LAS unsigned char* lds, const Gemm g, const Sched& S, const Epi& E) {
    int tid_ = threadIdx.x; asm volatile("" : "+v"(tid_));
    const int tid = tid_, wid = __builtin_amdgcn_readfirstlane(tid >> 6), lane = tid & 63, wr = wid >> 2, wc = wid & 3, fr = lane & 15, fq = lane >> 4;
    const int K = g.K, nt = K / BK;
    unsigned voffA[2], voffB[2];
#pragma unroll
    for (int i = 0; i < 2; ++i) { int R, C; stage_rc(tid * 16 + i * 8192, R, C); const int Rb = Epi::PERM ? ((R & ~31) + perm32(R & 31)) : R;
        voffA[i] = (unsigned)(R * g.lda + C) * 2u; voffB[i] = (unsigned)(Rb * g.ldb + C) * 2u; }
    const size_t kstep = (size_t)(BK * 2);
    const size_t hsA = (size_t)HALF * g.lda * 2, hsB = (size_t)HALF * g.ldb * 2;
    const size_t tsA = 2 * hsA, tsB = 2 * hsB;
    const unsigned ldsw = (unsigned)wid * 1024u;
    const int aoff = lds_byte(wr * 64 + fr, fq * 8), boff = lds_byte(wc * 32 + fr, fq * 8);
#define PG8_SA(b, h) (((b) * 2 + (h)) * HTB)
#define PG8_SB(b, h) ((4 + (b) * 2 + (h)) * HTB)
#define PG8_STAGE(bufoff, gbase, voff) do { _Pragma("unroll") for (int _i = 0; _i < 2; ++_i) \
        __builtin_amdgcn_global_load_lds((const unsigned*)((const char*)(gbase) + (voff)[_i]), (PG8_LAS unsigned*)(lds + (bufoff) + ldsw + _i * 8192), 16, 0, 0); } while (0)
#define PG8_LDA(dst, b, h) do { _Pragma("unroll") for (int m = 0; m < 4; ++m) _Pragma("unroll") for (int k = 0; k < 2; ++k) dst[m][k] = *(const PG8_LAS bf16x8*)(lds + PG8_SA(b, h) + aoff + m * 2048 + k * 1024); } while (0)
#define PG8_LDB(dst, b, h) do { _Pragma("unroll") for (int n = 0; n < 2; ++n) _Pragma("unroll") for (int k = 0; k < 2; ++k) dst[n][k] = *(const PG8_LAS bf16x8*)(lds + PG8_SB(b, h) + boff + n * 2048 + k * 1024); } while (0)
#define PG8_MMA(ai, bj, At, Bt) do { __builtin_amdgcn_s_setprio(1); _Pragma("unroll") for (int m = 0; m < 4; ++m) _Pragma("unroll") for (int n = 0; n < 2; ++n) _Pragma("unroll") for (int k = 0; k < 2; ++k) \
        acc[ai][bj][m][n] = __builtin_amdgcn_mfma_f32_16x16x32_bf16(Bt[n][k], At[m][k], acc[ai][bj][m][n], 0, 0, 0); __builtin_amdgcn_s_setprio(0); } while (0)
#define PG8_WAIT_V(n) asm volatile("s_waitcnt vmcnt(" #n ")" ::: "memory")
#define PG8_WAIT_L(n) asm volatile("s_waitcnt lgkmcnt(" #n ")" ::: "memory")
#define PG8_BAR __builtin_amdgcn_s_barrier()
#define PG8_SCHED __builtin_amdgcn_sched_barrier(0)
    Unit cur, nxt; int ui = 0;
    if (!S.next(0, cur)) return;
    f32x4 acc[2][2][4][2];
#pragma unroll
    for (int a = 0; a < 2; ++a)
#pragma unroll
        for (int b = 0; b < 2; ++b)
#pragma unroll
            for (int m = 0; m < 4; ++m)
#pragma unroll
                for (int n = 0; n < 2; ++n) acc[a][b][m][n] = (f32x4){0.f, 0.f, 0.f, 0.f};
    bf16x8 At[4][2], B0[2][2], B1[2][2];
    const char* cA = (const char*)g.A + (size_t)cur.pm * tsA; const char* cB = (const char*)g.Bt + cur.boff + (size_t)cur.pn * tsB;
    S.a_ready(cur);
    if constexpr (SP2) {
        PG8_STAGE(PG8_SB(0, 0), cB, voffB); PG8_STAGE(PG8_SB(0, 1), cB + hsB, voffB); PG8_STAGE(PG8_SA(0, 0), cA, voffA); PG8_STAGE(PG8_SA(0, 1), cA + hsA, voffA);
        if (wr == 1) PG8_BAR;
        PG8_WAIT_V(2); PG8_BAR;
        PG8_STAGE(PG8_SB(1, 0), cB + kstep, voffB); PG8_STAGE(PG8_SA(1, 0), cA + kstep, voffA); PG8_STAGE(PG8_SB(1, 1), cB + hsB + kstep, voffB);
        PG8_WAIT_V(6); PG8_BAR;
    } else {
        PG8_STAGE(PG8_SB(0, 0), cB, voffB); PG8_STAGE(PG8_SA(0, 0), cA, voffA); PG8_STAGE(PG8_SB(0, 1), cB + hsB, voffB); PG8_STAGE(PG8_SA(0, 1), cA + hsA, voffA);
        if (wr == 1) PG8_BAR;
        PG8_WAIT_V(4); PG8_BAR;
        PG8_STAGE(PG8_SB(1, 0), cB + kstep, voffB); PG8_STAGE(PG8_SA(1, 0), cA + kstep, voffA); PG8_STAGE(PG8_SB(1, 1), cB + hsB + kstep, voffB);
        PG8_WAIT_V(6); PG8_BAR;
    }
    for (;;) {
        const bool has_next = S.next(ui + 1, nxt);
        const char* nA = has_next ? (const char*)g.A + (size_t)nxt.pm * tsA : cA; const char* nB = has_next ? (const char*)g.Bt + nxt.boff + (size_t)nxt.pn * tsB : cB;
        for (int t = 0; t < nt; t += 2) {
            const bool last = (t == nt - 2);
            const char* a1 = cA + (size_t)(t + 1) * kstep;
            const char* a2 = last ? nA : cA + (size_t)(t + 2) * kstep; const char* b2 = last ? nB : cB + (size_t)(t + 2) * kstep;
            const char* a3 = a2 + kstep; const char* b3 = b2 + kstep;
            if (last && has_next) S.a_ready(nxt);
            if constexpr (SP2) {
            PG8_LDB(B0, 0, 0); PG8_LDB(B1, 0, 1); PG8_SCHED; PG8_LDA(At, 0, 0); PG8_STAGE(PG8_SA(1, 1), a1 + hsA, voffA);
            PG8_WAIT_V(8); PG8_WAIT_L(0); PG8_BAR; PG8_MMA(0, 0, At, B0); PG8_MMA(0, 1, At, B1); PG8_BAR; PG8_SCHED;
            PG8_LDA(At, 0, 1); PG8_STAGE(PG8_SB(0, 0), b2, voffB); PG8_STAGE(PG8_SB(0, 1), b2 + hsB, voffB); PG8_STAGE(PG8_SA(0, 0), a2, voffA);
            PG8_WAIT_V(8); PG8_WAIT_L(0); PG8_BAR; PG8_MMA(1, 0, At, B0); PG8_MMA(1, 1, At, B1); PG8_BAR; PG8_SCHED;
            PG8_LDB(B0, 1, 0); PG8_LDB(B1, 1, 1); PG8_SCHED; PG8_LDA(At, 1, 0); PG8_STAGE(PG8_SA(0, 1), a2 + hsA, voffA);
            PG8_WAIT_V(8); PG8_WAIT_L(0); PG8_BAR; PG8_MMA(0, 0, At, B0); PG8_MMA(0, 1, At, B1); PG8_BAR; PG8_SCHED;
            PG8_LDA(At, 1, 1); PG8_STAGE(PG8_SB(1, 0), b3, voffB); PG8_STAGE(PG8_SB(1, 1), b3 + hsB, voffB); PG8_STAGE(PG8_SA(1, 0), a3, voffA);
            PG8_WAIT_V(8); PG8_WAIT_L(0); PG8_BAR; PG8_MMA(1, 0, At, B0); PG8_MMA(1, 1, At, B1); PG8_BAR; PG8_SCHED;
            } else {
            PG8_LDB(B0, 0, 0); PG8_SCHED; PG8_LDA(At, 0, 0); PG8_STAGE(PG8_SA(1, 1), a1 + hsA, voffA);
            PG8_WAIT_L(8); PG8_BAR; PG8_WAIT_L(0); PG8_MMA(0, 0, At, B0); PG8_BAR; PG8_SCHED;
            PG8_LDB(B1, 0, 1); PG8_STAGE(PG8_SB(0, 0), b2, voffB);
            PG8_BAR; PG8_WAIT_L(0); PG8_MMA(0, 1, At, B1); PG8_BAR;
            PG8_LDA(At, 0, 1); PG8_STAGE(PG8_SA(0, 0), a2, voffA);
            PG8_BAR; PG8_WAIT_L(0); PG8_MMA(1, 0, At, B0); PG8_BAR; PG8_SCHED;
            PG8_STAGE(PG8_SB(0, 1), b2 + hsB, voffB);
            PG8_WAIT_V(6); PG8_BAR; PG8_MMA(1, 1, At, B1); PG8_BAR;
            PG8_LDB(B0, 1, 0); PG8_SCHED; PG8_LDA(At, 1, 0); PG8_STAGE(PG8_SA(0, 1), a2 + hsA, voffA);
            PG8_WAIT_L(8); PG8_BAR; PG8_WAIT_L(0); PG8_MMA(0, 0, At, B0); PG8_BAR; PG8_SCHED;
            PG8_LDB(B1, 1, 1); PG8_STAGE(PG8_SB(1, 0), b3, voffB);
            PG8_BAR; PG8_WAIT_L(0); PG8_MMA(0, 1, At, B1); PG8_BAR;
            PG8_LDA(At, 1, 1); PG8_STAGE(PG8_SA(1, 0), a3, voffA);
            PG8_BAR; PG8_WAIT_L(0); PG8_MMA(1, 0, At, B0); PG8_BAR; PG8_SCHED;
            PG8_STAGE(PG8_SB(1, 1), b3 + hsB, voffB);
            PG8_WAIT_V(6); PG8_BAR; PG8_MMA(1, 1, At, B1); PG8_BAR;
            }
        }
        if constexpr (ALIGN_EPI) { if (wr == 0) PG8_BAR; }
        if constexpr (!Epi::AFTER_DRAIN) { E(acc, cur, wr, wc, fr, fq); S.done(cur); }
        if (!has_next) break;
#pragma unroll
        for (int a = 0; a < 2; ++a)
#pragma unroll
            for (int b = 0; b < 2; ++b)
#pragma unroll
                for (int m = 0; m < 4; ++m)
#pragma unroll
                    for (int n = 0; n < 2; ++n) acc[a][b][m][n] = (f32x4){0.f, 0.f, 0.f, 0.f};
        cur = nxt; cA = nA; cB = nB; ++ui;
        if constexpr (ALIGN_EPI) { if (wr == 1) PG8_BAR; }
    }
    PG8_WAIT_V(0);
    if constexpr (!ALIGN_EPI) { if (wr == 0) PG8_BAR; }
    PG8_BAR;
    if constexpr (Epi::AFTER_DRAIN) { E.fused(acc, cur, wr, wc, fr, fq, lds, wid, lane); S.done(cur); }
#undef PG8_SA
#undef PG8_SB
#undef PG8_STAGE
#undef PG8_LDA
#undef PG8_LDB
#undef PG8_MMA
#undef PG8_WAIT_V
#undef PG8_WAIT_L
#undef PG8_BAR
#undef PG8_SCHED
}
}

constexpr int NTOK = 32768, SEQ = 16384, DM = 1024;
constexpr float EPS = 1e-6f;
constexpr size_t MiB = 1u << 20;
constexpr size_t WS_CTL = 0, CTL_ZERO_BYTES = 1 * MiB;
constexpr size_t WS_WB = 1 * MiB;
constexpr size_t WB_MKV = WS_WB + 0 * MiB;
constexpr size_t WB_MEMN = WS_WB + 1 * MiB;
constexpr size_t WB_MKVO = WS_WB + 2 * MiB;
constexpr size_t WB_WR = WS_WB + 3 * MiB;
constexpr size_t WB_WIN = WS_WB + 4 * MiB;
constexpr size_t WB_WGT = WS_WB + 8 * MiB;
constexpr size_t WB_WOUT = WS_WB + 11 * MiB;
constexpr size_t WB_WGU = WS_WB + 16 * MiB;
constexpr size_t WB_WD = WS_WB + 80 * MiB;
constexpr size_t WS_HN = WS_WB + 112 * MiB;
constexpr size_t WS_AR = WS_HN + 64 * MiB;
constexpr size_t AR_PROJ = WS_AR;
constexpr size_t AR_XSC = WS_AR + 112 * MiB;
constexpr size_t AR_LA = WS_AR + 160 * MiB;
constexpr size_t AR_UU = WS_AR + 208 * MiB;
constexpr size_t AR_MIXL = WS_AR + 256 * MiB;
constexpr size_t AR_SA = WS_AR + 320 * MiB;
constexpr size_t AR_SH = WS_AR + 322 * MiB;
constexpr size_t AR_CARRY = WS_AR + 324 * MiB;
constexpr size_t AR_KN = WS_AR + 96 * MiB;
constexpr size_t AR_KIN = WS_AR + 100 * MiB;
constexpr size_t AR_QIW = WS_AR + 104 * MiB;
constexpr size_t AR_WI = WS_AR + 154 * MiB;
constexpr size_t AR_SEL = WS_AR + 121 * MiB;
constexpr size_t AR_MIXD = WS_AR + 160 * MiB;
constexpr size_t AR_XS = WS_AR;
constexpr size_t AR_ACT = WS_AR + 144 * MiB;
constexpr size_t AR_LOG = WS_AR + 216 * MiB;
constexpr size_t AR_EID = WS_AR + 224 * MiB;
constexpr size_t AR_GATE = WS_AR + 225 * MiB;
constexpr size_t AR_DEST = WS_AR + 226 * MiB;
constexpr size_t WS_END = WS_AR + 328 * MiB;
constexpr int CW_TMO = 0, CW_CODE = 1;
constexpr int CW_CNT = 256, CW_CUR = 320, CW_NT = 384, CW_LSTRIDE = 256;
constexpr int CW_TE = 1024, CW_TE_STRIDE = 512;
constexpr int CW_BAR = 4096;
constexpr int LDS_BYTES = 159744, MISC_OFF = 155648;

#define GAS __attribute__((address_space(1)))
#define LAS __attribute__((address_space(3)))
#define DI __device__ __forceinline__
typedef unsigned short bf16;
typedef unsigned v4u __attribute__((ext_vector_type(4)));
typedef unsigned v2u __attribute__((ext_vector_type(2)));
typedef int v4i __attribute__((ext_vector_type(4)));
typedef float f32x4 __attribute__((ext_vector_type(4)));
typedef float f32x16 __attribute__((ext_vector_type(16)));
typedef short bf16x8 __attribute__((ext_vector_type(8)));
typedef GAS unsigned gu32;
#define RLX_AGENT __ATOMIC_RELAXED, __HIP_MEMORY_SCOPE_AGENT
#define LDS_WAIT() asm volatile("s_waitcnt lgkmcnt(0)" ::: "memory")
DI unsigned f2bf(float f) { unsigned u = __builtin_bit_cast(unsigned, f); return (u + 0x7fffu + ((u >> 16) & 1u)) >> 16; }
DI unsigned pk2(float lo, float hi) { return f2bf(lo) | (f2bf(hi) << 16); }
DI float bflo(unsigned w) { return __uint_as_float(w << 16); }
DI float bfhi(unsigned w) { return __uint_as_float(w & 0xffff0000u); }
DI void unpack8(const v4u w, float (&f)[8]) { f[0] = bflo(w.x); f[1] = bfhi(w.x); f[2] = bflo(w.y); f[3] = bfhi(w.y); f[4] = bflo(w.z); f[5] = bfhi(w.z); f[6] = bflo(w.w); f[7] = bfhi(w.w); }
DI v4u pack8(const float (&f)[8]) { v4u w; w.x = pk2(f[0], f[1]); w.y = pk2(f[2], f[3]); w.z = pk2(f[4], f[5]); w.w = pk2(f[6], f[7]); return w; }
DI unsigned lds_add(LAS unsigned* p, unsigned v) { return __hip_atomic_fetch_add(p, v, __ATOMIC_RELAXED, __HIP_MEMORY_SCOPE_WORKGROUP); }
DI float wave_sum(float v) {
#pragma unroll
    for (int o = 1; o < 64; o <<= 1) v += __shfl_xor(v, o);
    return v;
}

#define XB_TMO      128
#define XB_XCNT(j)  (256  + 64 * (j))
#define XB_XSUB(j)  (1280 + 64 * (j))
#define XB_XGEN(j)  (2304 + 64 * (j))
#define XB_TOP      3328
#define XB_TOPGEN   3392
#define XCD_BAR_WORDS 3456
#define XB_SPIN_CAP (1u << 22)
DI unsigned xb_ld(unsigned* p)              { return __hip_atomic_load(p, __ATOMIC_RELAXED, __HIP_MEMORY_SCOPE_AGENT); }
DI unsigned xb_add(unsigned* p, unsigned v) { return __hip_atomic_fetch_add(p, v, __ATOMIC_RELAXED, __HIP_MEMORY_SCOPE_AGENT); }
DI unsigned xb_xcc_id() { return (unsigned)__builtin_amdgcn_s_getreg((3 << 11) | 20) & 0xFu; }
#define XB_SPIN(cond, bar) do { unsigned _sp = 0; while (cond) { __builtin_amdgcn_s_sleep(1); \
    if ((++_sp & 255u) == 0u) { if (xb_ld(&(bar)[XB_TMO])) break; if (_sp > XB_SPIN_CAP) { atomicAdd(&(bar)[XB_TMO], 1u); break; } } } } while (0)
struct XcdBarrier { unsigned* bar; unsigned x; volatile LAS unsigned* st; };
DI XcdBarrier xcd_barrier_post(unsigned* bar, volatile LAS unsigned* st) {
    XcdBarrier b; b.bar = bar; b.x = xb_xcc_id(); b.st = st;
    if (threadIdx.x == 0) (void)xb_add(&bar[XB_XCNT(b.x)], 1u);
    return b;
}
DI void xcd_barrier_complete(unsigned* bar, unsigned x, unsigned& nloc, unsigned& nx) {
    const unsigned G = gridDim.x * gridDim.y * gridDim.z;
    unsigned sum, cnt, mine, sp = 0u;
    for (;;) {
        sum = 0u; cnt = 0u; mine = 0u;
#pragma unroll
        for (unsigned j = 0; j < 16; ++j) { const unsigned c = xb_ld(&bar[XB_XCNT(j)]); sum += c; cnt += (c > 0u) ? 1u : 0u; mine = (j == x) ? c : mine; }
        if (sum == G) break;
        __builtin_amdgcn_s_sleep(1);
        if ((++sp & 255u) == 0u) { if (xb_ld(&bar[XB_TMO])) break; if (sp > XB_SPIN_CAP) { atomicAdd(&bar[XB_TMO], 1u); break; } }
    }
    nloc = mine > 0u ? mine : 1u; nx = cnt > 0u ? cnt : 1u;
}
DI void xcd_barrier(const XcdBarrier& b) {
    asm volatile("s_waitcnt vmcnt(0)" ::: "memory");
    __syncthreads();
    if (threadIdx.x == 0) {
        unsigned* bar = b.bar;
        __builtin_amdgcn_s_waitcnt(0);
        unsigned nloc = b.st[0], nx = b.st[1];
        if (nloc == 0u) { xcd_barrier_complete(bar, b.x, nloc, nx); b.st[0] = nloc; b.st[1] = nx; }
        const unsigned old = xb_add(&bar[XB_XSUB(b.x)], 1u);
        const unsigned gen = old / nloc;
        if (old + 1u == (gen + 1u) * nloc) {
            __builtin_amdgcn_fence(__ATOMIC_RELEASE, "agent");
            asm volatile("s_waitcnt vmcnt(0)" ::: "memory");
            const unsigned og = xb_add(&bar[XB_TOP], 1u);
            const unsigned tg = og / nx;
            if (og + 1u == (tg + 1u) * nx) xb_add(&bar[XB_TOPGEN], 1u);
            else XB_SPIN(xb_ld(&bar[XB_TOPGEN]) == tg, bar);
            __builtin_amdgcn_fence(__ATOMIC_ACQUIRE, "agent");
            xb_add(&bar[XB_XGEN(b.x)], 1u);
            asm volatile("s_waitcnt vmcnt(0)" ::: "memory");
        } else {
            XB_SPIN(xb_ld(&bar[XB_XGEN(b.x)]) == gen, bar);
            __builtin_amdgcn_fence(__ATOMIC_ACQUIRE, "agent");
            asm volatile("s_waitcnt vmcnt(0)" ::: "memory");
        }
    }
    __syncthreads();
}

struct Params { const float* in[29]; float* out; unsigned char* ws; };
struct PV { unsigned char* ws; float* out; LAS unsigned long long* tab; };
DI const float* pin(const PV& P, int i) { const unsigned long long v = P.tab[i]; const unsigned lo = __builtin_amdgcn_readfirstlane((unsigned)v), hi = __builtin_amdgcn_readfirstlane((unsigned)(v >> 32)); return (const float*)(((unsigned long long)hi << 32) | lo); }
struct Ctx { LAS unsigned char* lds; int tid, lane, wave, G, blk, gw, NGW; };
DI Ctx relaunder(const Ctx& c0) { Ctx c = c0; int t = threadIdx.x; asm volatile("" : "+v"(t)); c.tid = t; c.lane = t & 63; c.wave = __builtin_amdgcn_readfirstlane(t >> 6); c.gw = c.blk * 8 + c.wave; return c; }
enum { I_X = 0, I_MEM, I_NORM_MIX, I_NORM_FFN, I_MEM_NORM, I_W_MEM_KV, I_XQ_NORM, I_XK_NORM, I_W_OUT, I_LRU_W_IN, I_LRU_CONV_W, I_LRU_CONV_B, I_LRU_W_A, I_LRU_B_A,
       I_LRU_W_X, I_LRU_B_X, I_LRU_LAMBDA, I_DSA_W_IN, I_DSA_Q_NORM, I_DSA_K_NORM, I_DSA_W_UV, I_REL_BIAS, I_MOE_W_GROUP, I_MOE_B_GROUP, I_MOE_W_ROUTER, I_MOE_B_ROUTER,
       I_MOE_W_GATE, I_MOE_W_UP, I_MOE_W_DOWN };

DI void tr_load(const float* __restrict__ W, int ldw, f32x4 (&v)[16], int lane) {
    const int m = lane & 15, q = lane >> 4;
#pragma unroll
    for (int i = 0; i < 8; ++i) { const int kk = 8 * i + 2 * q; v[2 * i] = *(const f32x4*)(W + (size_t)kk * ldw + 4 * m); v[2 * i + 1] = *(const f32x4*)(W + (size_t)(kk + 1) * ldw + 4 * m); }
}
DI void tr_store(const f32x4 (&v)[16], bf16* __restrict__ WT, int ldk, LAS unsigned* scr, int lane) {
    const int m = lane & 15, q = lane >> 4;
#pragma unroll
    for (int i = 0; i < 8; ++i) {
        const f32x4 v0 = v[2 * i], v1 = v[2 * i + 1];
        const int sw = 4 * (i ^ (m & 7)) + q;
        scr[(4 * m + 0) * 32 + sw] = pk2(v0.x, v1.x);
        scr[(4 * m + 1) * 32 + sw] = pk2(v0.y, v1.y);
        scr[(4 * m + 2) * 32 + sw] = pk2(v0.z, v1.z);
        scr[(4 * m + 3) * 32 + sw] = pk2(v0.w, v1.w);
    }
    LDS_WAIT();
#pragma unroll
    for (int r = 0; r < 8; ++r) {
        const int n = 8 * r + (lane >> 3), c = lane & 7;
        const v4u o = *(const LAS v4u*)(scr + n * 32 + 4 * (c ^ ((n >> 2) & 7)));
        *(v4u*)(WT + (size_t)n * ldk + 8 * c) = o;
    }
    LDS_WAIT();
}
DI void rms_finish(f32x4 (&v)[4], const float* __restrict__ g, bf16* __restrict__ orow, int lane) {
    float s = 0.f;
#pragma unroll
    for (int j = 0; j < 4; ++j) s += (v[j].x * v[j].x + v[j].y * v[j].y) + (v[j].z * v[j].z + v[j].w * v[j].w);
    const float r = 1.0f / sqrtf(wave_sum(s) * (1.0f / 1024.0f) + EPS);
    const f32x4* gr = (const f32x4*)g + lane; v2u* o8 = (v2u*)orow + lane;
#pragma unroll
    for (int j = 0; j < 4; ++j) { const f32x4 gg = gr[64 * j]; v[j] = v[j] * r * gg; v2u o; o.x = pk2(v[j].x, v[j].y); o.y = pk2(v[j].z, v[j].w); o8[64 * j] = o; }
}
DI void rms_row(const float* __restrict__ xrow, const float* __restrict__ g, bf16* __restrict__ orow, int lane, f32x4 (&v)[4]) {
    const f32x4* xr = (const f32x4*)xrow + lane;
#pragma unroll
    for (int j = 0; j < 4; ++j) v[j] = xr[64 * j];
    rms_finish(v, g, orow, lane);
}
DI void wi_row(const f32x4 (&v)[4], const LAS f32x4* wiw, float* WI, int r, int lane) {
    f32x4 a = {0.f, 0.f, 0.f, 0.f};
#pragma unroll
    for (int j = 0; j < 4; ++j) { const int k0 = 4 * (lane + 64 * j); a += v[j].x * wiw[k0] + v[j].y * wiw[k0 + 1] + v[j].z * wiw[k0 + 2] + v[j].w * wiw[k0 + 3]; }
    a.x = wave_sum(a.x); a.y = wave_sum(a.y); a.z = wave_sum(a.z); a.w = wave_sum(a.w);
    if (lane == 0) *(f32x4*)(WI + (size_t)r * 4) = a * 0.5f;
}
struct TrJob { const float* src; bf16* dst; int ldw, ldk, nN, items; };
struct TileDesc { const float* src; bf16* dst; int ldw, ldk; };
template <int layer> DI void prep_setup(const Ctx& c, const PV& P) {
    unsigned char* ws = P.ws;
    LAS TrJob* jobs = (LAS TrJob*)(c.lds + 65536);
    LAS int* njp = (LAS int*)(c.lds + 65536 + 512);
    LAS f32x4* wiw = (LAS f32x4*)(c.lds + 69632);
    __syncthreads();
    if (c.tid == 0) {
        int nj = 0;
#define ADDJOB(S_, D_, K_, N_, LDW_, LDK_) do { jobs[nj].src = (S_); jobs[nj].dst = (D_); jobs[nj].ldw = (LDW_); jobs[nj].ldk = (LDK_); jobs[nj].nN = (N_) / 64; jobs[nj].items = ((K_) / 64) * ((N_) / 64); ++nj; } while (0)
        ADDJOB(pin(P, I_W_MEM_KV) + (size_t)layer * 1024 * 512, (bf16*)(ws + WB_MKV), 1024, 512, 512, 1024);
        if (layer == 0) {
            ADDJOB(pin(P, I_LRU_W_IN), (bf16*)(ws + WB_WIN), 1024, 1792, 1792, 1024);
            ADDJOB(pin(P, I_W_OUT), (bf16*)(ws + WB_WOUT), 1024, 1024, 1024, 1024);
        } else {
            ADDJOB(pin(P, I_DSA_W_IN), (bf16*)(ws + WB_WIN), 1024, 1280, 1540, 1024);
            ADDJOB(pin(P, I_DSA_W_IN) + 1284, (bf16*)(ws + WB_WIN) + (size_t)1280 * 1024, 1024, 256, 1540, 1024);
            ADDJOB(pin(P, I_W_OUT) + (size_t)1024 * 1024 + (size_t)768 * 1024, (bf16*)(ws + WB_WOUT) + 1536, 256, 1024, 1024, 1792);
        }
#undef ADDJOB
        *njp = nj;
    }
    if (layer == 1) { const float* win = pin(P, I_DSA_W_IN); for (int k = c.tid; k < 1024; k += 512) wiw[k] = *(const f32x4*)(win + (size_t)k * 1540 + 1280); }
    __syncthreads();
}
template <int layer> DI void prep_weights(const Ctx& c, const PV& P) {
    unsigned char* ws = P.ws;
    LAS unsigned* scr = (LAS unsigned*)(c.lds + c.wave * 8192);
    LAS TrJob* jobs = (LAS TrJob*)(c.lds + 65536);
    LAS int* njp = (LAS int*)(c.lds + 65536 + 512);
    { const float* gm = pin(P, I_MEM_NORM) + layer * 1024; const float* mem = pin(P, I_MEM); bf16* MEMN = (bf16*)(ws + WB_MEMN);
      for (int r = c.gw; r < 512; r += c.NGW) { f32x4 v[4]; rms_row(mem + (size_t)r * 1024, gm, MEMN + (size_t)r * 1024, c.lane, v); } }
    {
        const int nj = *njp; int gen_total = 0;
        for (int j = 0; j < nj; ++j) gen_total += jobs[j].items;
        const int total = gen_total + 3 * 32 * 128;
        const float* wg = pin(P, I_MOE_W_GATE) + (size_t)layer * 32 * 1024 * 512;
        const float* wu = pin(P, I_MOE_W_UP) + (size_t)layer * 32 * 1024 * 512;
        const float* wd = pin(P, I_MOE_W_DOWN) + (size_t)layer * 32 * 512 * 1024;
        bf16* WGU = (bf16*)(ws + WB_WGU); bf16* WD = (bf16*)(ws + WB_WD);
#define TILE_DESC(IT_, D_) do { const int it_ = (IT_); \
            if (it_ < gen_total) { int r = it_, j = 0; while (r >= jobs[j].items) { r -= jobs[j].items; ++j; } \
                const int nN = jobs[j].nN, kb = r / nN, nb = r % nN; D_.ldw = jobs[j].ldw; D_.ldk = jobs[j].ldk; \
                D_.src = jobs[j].src + (size_t)kb * 64 * D_.ldw + nb * 64; D_.dst = jobs[j].dst + (size_t)nb * 64 * D_.ldk + kb * 64; } \
            else { const int r = it_ - gen_total, type = r >> 12, e = (r >> 7) & 31, ti = r & 127; \
                if (type < 2) { const int kb = ti >> 3, nb = ti & 7; D_.ldw = 512; D_.ldk = 1024; \
                    D_.src = (type == 0 ? wg : wu) + (size_t)e * 1024 * 512 + (size_t)kb * 64 * 512 + nb * 64; \
                    D_.dst = WGU + (size_t)e * 1024 * 1024 + (size_t)(256 * (nb >> 1) + 64 * (nb & 1) + 128 * type) * 1024 + kb * 64; } \
                else { const int kb = ti >> 4, nb = ti & 15; D_.ldw = 1024; D_.ldk = 512; \
                    D_.src = wd + (size_t)e * 512 * 1024 + (size_t)kb * 64 * 1024 + nb * 64; \
                    D_.dst = WD + (size_t)e * 1024 * 512 + (size_t)nb * 64 * 512 + kb * 64; } } } while (0)
        if (c.gw < total) {
            TileDesc d0, d1; f32x4 va[16], vb[16];
            TILE_DESC(c.gw, d0); tr_load(d0.src, d0.ldw, va, c.lane);
            for (int it = c.gw; it < total; it += 2 * c.NGW) {
                const int it1 = it + c.NGW, it2 = it + 2 * c.NGW; const bool has1 = it1 < total, has2 = it2 < total;
                TILE_DESC(has1 ? it1 : it, d1); tr_load(d1.src, d1.ldw, vb, c.lane);
                tr_store(va, d0.dst, d0.ldk, scr, c.lane);
                TILE_DESC(has2 ? it2 : it, d0); tr_load(d0.src, d0.ldw, va, c.lane);
                if (has1) tr_store(vb, d1.dst, d1.ldk, scr, c.lane);
            }
        }
#undef TILE_DESC
    }
    const int gtid = c.blk * 512 + c.tid, nthr = c.G * 512;
    {
        const float* wgr = pin(P, I_MOE_W_GROUP) + (size_t)layer * 1024 * 4; const float* wrt = pin(P, I_MOE_W_ROUTER) + (size_t)layer * 1024 * 32;
        bf16* WR = (bf16*)(ws + WB_WR);
        for (int i = gtid; i < 256 * 128; i += nthr) { const int row = i >> 7, k8 = i & 127; float f[8];
#pragma unroll
            for (int kk = 0; kk < 8; ++kk) { const int k = 8 * k8 + kk; f[kk] = row < 4 ? wgr[k * 4 + row] : (row < 36 ? wrt[k * 32 + (row - 4)] : 0.f); }
            *(v4u*)(WR + (size_t)row * 1024 + 8 * k8) = pack8(f); }
    }
    if (layer == 0) {
        bf16* WGT = (bf16*)(ws + WB_WGT); const float* wa = pin(P, I_LRU_W_A); const float* wx = pin(P, I_LRU_W_X);
        for (int i = gtid; i < 1536 * 96; i += nthr) { const int rho = i / 96, k8 = i % 96; const int pn = rho >> 8, bj = (rho >> 7) & 1, j = rho & 127, ch = 128 * pn + j, blkc = ch / 192, cc = ch % 192;
            const float* src = (bj ? wx : wa) + (size_t)blkc * 192 * 192; float f[8];
            const int k0 = 8 * k8; const bool in = (k0 / 192) == blkc;
#pragma unroll
            for (int kk = 0; kk < 8; ++kk) f[kk] = in ? src[((k0 + kk) % 192) * 192 + cc] : 0.f;
            *(v4u*)(WGT + (size_t)rho * 768 + k0) = pack8(f); }
    } else {
        const float* wuv = pin(P, I_DSA_W_UV); const float* wo = pin(P, I_W_OUT) + (size_t)1024 * 1024; bf16* WO = (bf16*)(ws + WB_WOUT);
        for (int i = gtid; i < 1024 * 12 * 16; i += nthr) { const int n = i & 1023, rest = i >> 10, c8 = rest & 15, h = rest >> 4; float a[8] = {0.f, 0.f, 0.f, 0.f, 0.f, 0.f, 0.f, 0.f};
            for (int j = 0; j < 64; ++j) { const float w = wo[(size_t)(64 * h + j) * 1024 + n];
#pragma unroll
                for (int cc = 0; cc < 8; ++cc) a[cc] += wuv[((size_t)h * 128 + 8 * c8 + cc) * 64 + j] * w; }
            *(v4u*)(WO + (size_t)n * 1792 + h * 128 + 8 * c8) = pack8(a); }
    }
}
DI void phase_prep0(const Ctx& c0, const PV& P) {
    const Ctx c = relaunder(c0);
    prep_setup<0>(c, P);
    { const float* xin = pin(P, I_X); const float* g = pin(P, I_NORM_MIX); bf16* HN = (bf16*)(P.ws + WS_HN);
      for (int r = c.gw; r < NTOK; r += 2 * c.NGW) {
          const int r1 = r + c.NGW; const bool has1 = r1 < NTOK; const int rr1 = has1 ? r1 : r;
          f32x4 v0[4], v1[4];
          const f32x4* x0 = (const f32x4*)(xin + (size_t)r * 1024) + c.lane; const f32x4* x1 = (const f32x4*)(xin + (size_t)rr1 * 1024) + c.lane;
#pragma unroll
          for (int j = 0; j < 4; ++j) { v0[j] = x0[64 * j]; v1[j] = x1[64 * j]; }
          rms_finish(v0, g, HN + (size_t)r * 1024, c.lane);
          if (has1) rms_finish(v1, g, HN + (size_t)r1 * 1024, c.lane);
      } }
    prep_weights<0>(c, P);
}

DI f32x4 mfma16(bf16x8 a, bf16x8 b, f32x4 c) { return __builtin_amdgcn_mfma_f32_16x16x32_bf16(a, b, c, 0, 0, 0); }

template <int layer, int ldp, int xq_off, int ldm, int xo_off> DI void phase_xattn(const Ctx& c0, const PV& P, const bf16* __restrict__ PROJ, bf16* __restrict__ MIX) {
    const Ctx c = relaunder(c0);
    const bf16* MKVO = (const bf16*)(P.ws + WB_MKVO);
    const float* xqg = pin(P, I_XQ_NORM) + layer * 64; const float* xkg = pin(P, I_XK_NORM) + layer * 64;
    LAS bf16* Ks = (LAS bf16*)c.lds;
    LAS bf16* Vt = (LAS bf16*)(c.lds + 36864);
    const int lane = c.lane, l15 = lane & 15, g = lane >> 4;
    for (int unit = c.blk; unit < 256; unit += c.G) {
        const int b = unit >> 7, h = (unit >> 5) & 3, tr = unit & 31, tok0 = b * SEQ + tr * 512;
        __syncthreads();
#pragma unroll
        for (int i = 0; i < 4; ++i) { const int p = c.tid + 512 * i, key = p >> 3, ch = p & 7;
            const bf16* src = MKVO + (size_t)(b * 256 + key) * 512 + h * 64 + ch * 8;
            float f[8]; unpack8(*(const v4u*)src, f);
            float ss = 0.f;
#pragma unroll
            for (int j = 0; j < 8; ++j) ss += f[j] * f[j];
            ss += __shfl_xor(ss, 1); ss += __shfl_xor(ss, 2); ss += __shfl_xor(ss, 4);
            const float r = 1.0f / sqrtf(ss * (1.0f / 64.0f) + EPS);
#pragma unroll
            for (int j = 0; j < 8; ++j) f[j] = f[j] * r * xkg[ch * 8 + j];
            *(LAS v4u*)(Ks + key * 72 + ch * 8) = pack8(f);
            const v4u vw = *(const v4u*)(src + 256);
            const unsigned ww[4] = {vw.x, vw.y, vw.z, vw.w};
#pragma unroll
            for (int j = 0; j < 4; ++j) { Vt[(ch * 8 + 2 * j) * 264 + key] = (bf16)(ww[j] & 0xffffu); Vt[(ch * 8 + 2 * j + 1) * 264 + key] = (bf16)(ww[j] >> 16); }
        }
        __syncthreads();
#pragma unroll 1
        for (int tile = c.wave; tile < 32; tile += 8) {
            const int row = tok0 + tile * 16 + l15;
            const bf16* qp = PROJ + (size_t)row * ldp + xq_off + h * 64 + 8 * g;
            float q0[8], q1[8]; unpack8(*(const v4u*)qp, q0); unpack8(*(const v4u*)(qp + 32), q1);
            float ss = 0.f;
#pragma unroll
            for (int j = 0; j < 8; ++j) ss += q0[j] * q0[j] + q1[j] * q1[j];
            ss += __shfl_xor(ss, 16); ss += __shfl_xor(ss, 32);
            const float r = 0.125f / sqrtf(ss * (1.0f / 64.0f) + EPS);
#pragma unroll
            for (int j = 0; j < 8; ++j) { q0[j] = q0[j] * r * xqg[8 * g + j]; q1[j] = q1[j] * r * xqg[32 + 8 * g + j]; }
            const bf16x8 B0 = __builtin_bit_cast(bf16x8, pack8(q0)), B1 = __builtin_bit_cast(bf16x8, pack8(q1));
            f32x4 S[16];
#pragma unroll
            for (int kt = 0; kt < 16; ++kt) {
                const bf16x8 A0 = *(const LAS bf16x8*)(Ks + (16 * kt + l15) * 72 + 8 * g), A1 = *(const LAS bf16x8*)(Ks + (16 * kt + l15) * 72 + 32 + 8 * g);
                f32x4 z = {0.f, 0.f, 0.f, 0.f}; z = mfma16(A0, B0, z); S[kt] = mfma16(A1, B1, z);
                if ((kt & 3) == 3) __builtin_amdgcn_sched_barrier(0);
            }
            float mx = -3.0e38f;
#pragma unroll
            for (int kt = 0; kt < 16; ++kt) mx = fmaxf(mx, fmaxf(fmaxf(S[kt][0], S[kt][1]), fmaxf(S[kt][2], S[kt][3])));
            mx = fmaxf(mx, __shfl_xor(mx, 16)); mx = fmaxf(mx, __shfl_xor(mx, 32));
            float l = 0.f;
#pragma unroll
            for (int kt = 0; kt < 16; ++kt) {
#pragma unroll
                for (int i = 0; i < 4; ++i) { const float p = __expf(S[kt][i] - mx); S[kt][i] = p; l += p; } }
            l += __shfl_xor(l, 16); l += __shfl_xor(l, 32);
            f32x4 O[4];
#pragma unroll
            for (int dt = 0; dt < 4; ++dt) O[dt] = (f32x4){0.f, 0.f, 0.f, 0.f};
#pragma unroll
            for (int jb = 0; jb < 8; ++jb) {
                v4u pw; pw.x = pk2(S[2 * jb][0], S[2 * jb][1]); pw.y = pk2(S[2 * jb][2], S[2 * jb][3]); pw.z = pk2(S[2 * jb + 1][0], S[2 * jb + 1][1]); pw.w = pk2(S[2 * jb + 1][2], S[2 * jb + 1][3]);
                const bf16x8 Pb = __builtin_bit_cast(bf16x8, pw);
#pragma unroll
                for (int dt = 0; dt < 4; ++dt) { const LAS bf16* vp = Vt + (16 * dt + l15) * 264 + 32 * jb + 4 * g;
                    const v2u a0 = *(const LAS v2u*)vp, a1 = *(const LAS v2u*)(vp + 16);
                    v4u aw; aw.x = a0.x; aw.y = a0.y; aw.z = a1.x; aw.w = a1.y;
                    O[dt] = mfma16(__builtin_bit_cast(bf16x8, aw), Pb, O[dt]); }
                __builtin_amdgcn_sched_barrier(0);
            }
            const float il = 1.0f / l;
            bf16* op = MIX + (size_t)row * ldm + xo_off + h * 64 + 4 * g;
#pragma unroll
            for (int dt = 0; dt < 4; ++dt) { v2u o; o.x = pk2(O[dt][0] * il, O[dt][1] * il); o.y = pk2(O[dt][2] * il, O[dt][3] * il); *(v2u*)(op + 16 * dt) = o; }
        }
    }
}

DI void phase_conv(const Ctx& c0, const PV& P) {
    const Ctx c = relaunder(c0);
    const bf16* PROJ = (const bf16*)(P.ws + AR_PROJ); bf16* XSC = (bf16*)(P.ws + AR_XSC);
    const float* cw = pin(P, I_LRU_CONV_W); const float* cb = pin(P, I_LRU_CONV_B);
    const int gtid = c.blk * 512 + c.tid, nthr = c.G * 512;
    for (int i = gtid; i < NTOK * 96; i += nthr) { const int row = i / 96, c8 = i % 96, t = row & (SEQ - 1); float a[8];
#pragma unroll
        for (int j = 0; j < 8; ++j) a[j] = cb[8 * c8 + j];
#pragma unroll
        for (int k = 0; k < 4; ++k) { if (t - 3 + k >= 0) { float f[8]; unpack8(*(const v4u*)(PROJ + (size_t)(row - 3 + k) * 1792 + 8 * c8), f);
#pragma unroll
                for (int j = 0; j < 8; ++j) a[j] += cw[k * 768 + 8 * c8 + j] * f[j]; } }
        *(v4u*)(XSC + (size_t)row * 768 + 8 * c8) = pack8(a); }
}
DI void phase_scanA(const Ctx& c0, const PV& P) {
    const Ctx c = relaunder(c0);
    const bf16* LA = (const bf16*)(P.ws + AR_LA); const bf16* UU = (const bf16*)(P.ws + AR_UU); float* SA = (float*)(P.ws + AR_SA); float* SH = (float*)(P.ws + AR_SH);
    const int gtid = c.blk * 512 + c.tid, nthr = c.G * 512;
    for (int i = gtid; i < 512 * 192; i += nthr) { const int chunk = i / 192, c4 = i % 192; float h[4] = {0.f, 0.f, 0.f, 0.f}, sl[4] = {0.f, 0.f, 0.f, 0.f};
        const size_t base = (size_t)chunk * 64 * 768 + 4 * c4;
#pragma unroll 8
        for (int r = 0; r < 64; ++r) { const v2u lw = *(const v2u*)(LA + base + (size_t)r * 768), uw = *(const v2u*)(UU + base + (size_t)r * 768);
            const float l4[4] = {bflo(lw.x), bfhi(lw.x), bflo(lw.y), bfhi(lw.y)}, u4[4] = {bflo(uw.x), bfhi(uw.x), bflo(uw.y), bfhi(uw.y)};
#pragma unroll
            for (int j = 0; j < 4; ++j) { h[j] = __expf(l4[j]) * h[j] + u4[j]; sl[j] += l4[j]; } }
        *(f32x4*)(SA + (size_t)chunk * 768 + 4 * c4) = (f32x4){__expf(sl[0]), __expf(sl[1]), __expf(sl[2]), __expf(sl[3])};
        *(f32x4*)(SH + (size_t)chunk * 768 + 4 * c4) = (f32x4){h[0], h[1], h[2], h[3]}; }
}
DI void phase_scanB(const Ctx& c0, const PV& P) {
    const Ctx c = relaunder(c0);
    const float* SA = (const float*)(P.ws + AR_SA); const float* SH = (const float*)(P.ws + AR_SH); float* CARRY = (float*)(P.ws + AR_CARRY);
    LAS float* segP = (LAS float*)c.lds; LAS float* segQ = segP + 512;
    for (int u = c.blk; u < 48; u += c.G) { const int b = u / 24, cg = u % 24, seg = c.tid >> 5, ch = 32 * cg + (c.tid & 31);
        const size_t base = (size_t)(b * 256 + seg * 16) * 768 + ch;
        float A[16], H[16];
#pragma unroll
        for (int i = 0; i < 16; ++i) { A[i] = SA[base + (size_t)i * 768]; H[i] = SH[base + (size_t)i * 768]; }
        float Pp[16], Qq[16]; float pp = 1.f, qq = 0.f;
#pragma unroll
        for (int i = 0; i < 16; ++i) { Pp[i] = pp; Qq[i] = qq; qq = A[i] * qq + H[i]; pp = A[i] * pp; }
        __syncthreads();
        segP[c.tid] = pp; segQ[c.tid] = qq;
        __syncthreads();
        float hin = 0.f;
        for (int s = 0; s < seg; ++s) hin = segP[s * 32 + (c.tid & 31)] * hin + segQ[s * 32 + (c.tid & 31)];
#pragma unroll
        for (int i = 0; i < 16; ++i) CARRY[base + (size_t)i * 768] = Pp[i] * hin + Qq[i];
    }
}
DI void phase_scanC(const Ctx& c0, const PV& P) {
    const Ctx c = relaunder(c0);
    const bf16* LA = (const bf16*)(P.ws + AR_LA); const bf16* UU = (const bf16*)(P.ws + AR_UU); const float* CARRY = (const float*)(P.ws + AR_CARRY);
    const bf16* PROJ = (const bf16*)(P.ws + AR_PROJ); bf16* MIX = (bf16*)(P.ws + AR_MIXL);
    const int gtid = c.blk * 512 + c.tid, nthr = c.G * 512;
    for (int i = gtid; i < 512 * 192; i += nthr) { const int chunk = i / 192, c4 = i % 192;
        const f32x4 h0 = *(const f32x4*)(CARRY + (size_t)chunk * 768 + 4 * c4); float h[4] = {h0.x, h0.y, h0.z, h0.w};
        const size_t base = (size_t)chunk * 64 * 768 + 4 * c4;
#pragma unroll 8
        for (int r = 0; r < 64; ++r) { const size_t row = (size_t)chunk * 64 + r;
            const v2u lw = *(const v2u*)(LA + base + (size_t)r * 768), uw = *(const v2u*)(UU + base + (size_t)r * 768), gw = *(const v2u*)(PROJ + row * 1792 + 768 + 4 * c4);
            const float l4[4] = {bflo(lw.x), bfhi(lw.x), bflo(lw.y), bfhi(lw.y)}, u4[4] = {bflo(uw.x), bfhi(uw.x), bflo(uw.y), bfhi(uw.y)}, g4[4] = {bflo(gw.x), bfhi(gw.x), bflo(gw.y), bfhi(gw.y)};
            float y[4];
#pragma unroll
            for (int j = 0; j < 4; ++j) { h[j] = __expf(l4[j]) * h[j] + u4[j]; y[j] = h[j] * g4[j]; }
            v2u o; o.x = pk2(y[0], y[1]); o.y = pk2(y[2], y[3]); *(v2u*)(MIX + row * 1024 + 4 * c4) = o; }
    }
}

template <int layer> DI void phase_norm2(const Ctx& c0, const PV& P) {
    const Ctx c = relaunder(c0);
    const float* g = pin(P, I_NORM_FFN) + layer * 1024; bf16* HN = (bf16*)(P.ws + WS_HN);
    for (int r = c.gw; r < NTOK; r += c.NGW) { f32x4 v[4]; rms_row(P.out + (size_t)r * 1024, g, HN + (size_t)r * 1024, c.lane, v); }
}
template <int layer> DI void phase_route(const Ctx& c0, const PV& P) {
    const Ctx c = relaunder(c0);
    const float* LOG = (const float*)(P.ws + AR_LOG); int* EID = (int*)(P.ws + AR_EID); float* GATE = (float*)(P.ws + AR_GATE);
    const float* bg = pin(P, I_MOE_B_GROUP) + layer * 4; const float* br = pin(P, I_MOE_B_ROUTER) + layer * 32;
    unsigned* ctl = (unsigned*)(P.ws + WS_CTL);
    LAS unsigned* hist = (LAS unsigned*)c.lds;
    if (c.tid < 32) hist[c.tid] = 0u;
    __syncthreads();
    for (int t = c.blk * 512 + c.tid; t < NTOK; t += c.G * 512) {
        const f32x4 lg = *(const f32x4*)(LOG + (size_t)t * 64);
        const float l0 = lg.x + bg[0], l1 = lg.y + bg[1], l2 = lg.z + bg[2], l3 = lg.w + bg[3];
        int gs = 0; float gm = l0;
        if (l1 > gm) { gm = l1; gs = 1; } if (l2 > gm) { gm = l2; gs = 2; } if (l3 > gm) { gm = l3; gs = 3; }
        const float pg = 1.0f / (__expf(l0 - gm) + __expf(l1 - gm) + __expf(l2 - gm) + __expf(l3 - gm));
        const f32x4 ea = *(const f32x4*)(LOG + (size_t)t * 64 + 4 + 8 * gs), eb = *(const f32x4*)(LOG + (size_t)t * 64 + 8 + 8 * gs);
        const f32x4 ba = *(const f32x4*)(br + 8 * gs), bb = *(const f32x4*)(br + 8 * gs + 4);
        const float el[8] = {ea.x + ba.x, ea.y + ba.y, ea.z + ba.z, ea.w + ba.w, eb.x + bb.x, eb.y + bb.y, eb.z + bb.z, eb.w + bb.w};
        int i1 = 0; float m1 = el[0];
#pragma unroll
        for (int j = 1; j < 8; ++j) if (el[j] > m1) { m1 = el[j]; i1 = j; }
        int i2 = -1; float m2 = -3.0e38f;
#pragma unroll
        for (int j = 0; j < 8; ++j) if (j != i1 && el[j] > m2) { m2 = el[j]; i2 = j; }
        const float e2 = __expf(m2 - m1), inv = pg / (1.0f + e2);
        const int e1id = 8 * gs + i1, e2id = 8 * gs + i2;
        EID[2 * t] = e1id; EID[2 * t + 1] = e2id; GATE[2 * t] = inv; GATE[2 * t + 1] = e2 * inv;
        lds_add(&hist[e1id], 1u); lds_add(&hist[e2id], 1u);
    }
    __syncthreads();
    if (c.tid < 32 && hist[c.tid]) atomicAdd(ctl + CW_CNT + layer * CW_LSTRIDE + c.tid, hist[c.tid]);
}
template <int layer> DI void phase_scatter(const Ctx& c0, const PV& P) {
    const Ctx c = relaunder(c0);
    unsigned* ctl = (unsigned*)(P.ws + WS_CTL);
    const int* EID = (const int*)(P.ws + AR_EID); int* DEST = (int*)(P.ws + AR_DEST);
    const bf16* HN = (const bf16*)(P.ws + WS_HN); bf16* XS = (bf16*)(P.ws + AR_XS);
    LAS int* cnt = (LAS int*)c.lds; LAS int* pstart = cnt + 32; LAS unsigned* hist = (LAS unsigned*)(cnt + 64); LAS unsigned* base = hist + 32; LAS unsigned* lcnt = base + 32; LAS int* dl = (LAS int*)(lcnt + 32);
    __syncthreads();
    if (c.tid < 32) cnt[c.tid] = (int)ctl[CW_CNT + layer * CW_LSTRIDE + c.tid];
    __syncthreads();
    if (c.tid == 0) { int acc = 0; for (int e = 0; e < 32; ++e) { pstart[e] = acc; acc += (cnt[e] + 255) & ~255; }
        if (c.blk == 0) { ctl[CW_NT + layer * CW_LSTRIDE] = (unsigned)(acc >> 8);
            for (int e = 0; e < 32; ++e) { const int t0 = pstart[e] >> 8, t1 = (pstart[e] + ((cnt[e] + 255) & ~255)) >> 8; for (int t = t0; t < t1; ++t) ctl[CW_TE + layer * CW_TE_STRIDE + t] = (unsigned)e; } } }
    __syncthreads();
    for (int tb = c.blk; tb < NTOK / 128; tb += c.G) {
        if (c.tid < 32) { hist[c.tid] = 0u; lcnt[c.tid] = 0u; }
        __syncthreads();
        int e = 0, t = 0;
        if (c.tid < 256) { t = tb * 128 + (c.tid >> 1); e = EID[2 * t + (c.tid & 1)]; lds_add(&hist[e], 1u); }
        __syncthreads();
        if (c.tid < 32) base[c.tid] = hist[c.tid] ? atomicAdd(ctl + CW_CUR + layer * CW_LSTRIDE + c.tid, hist[c.tid]) : 0u;
        __syncthreads();
        if (c.tid < 256) { const unsigned rank = lds_add(&lcnt[e], 1u); const int d = pstart[e] + (int)base[e] + (int)rank; DEST[2 * t + (c.tid & 1)] = d; dl[c.tid] = d; }
        __syncthreads();
        for (int a = c.wave * 32; a < c.wave * 32 + 32; ++a) { const int tt = tb * 128 + (a >> 1), d = dl[a];
            const v4u* s = (const v4u*)(HN + (size_t)tt * 1024) + c.lane; v4u* o = (v4u*)(XS + (size_t)d * 1024) + c.lane;
            const v4u x0 = s[0], x1 = s[64]; o[0] = x0; o[64] = x1; }
        __syncthreads();
    }
    for (int e = 0; e < 32; ++e) { const int npad = ((cnt[e] + 255) & ~255) - cnt[e], r0 = pstart[e] + cnt[e];
        for (int r = c.gw; r < npad; r += c.NGW) { v4u* o = (v4u*)(XS + (size_t)(r0 + r) * 1024) + c.lane; const v4u z = {0u, 0u, 0u, 0u}; o[0] = z; o[64] = z; } }
}
template <bool NEXT> DI void phase_combine(const Ctx& c0, const PV& P) {
    const Ctx c = relaunder(c0);
    if (NEXT) prep_setup<1>(c, P);
    const int* DEST = (const int*)(P.ws + AR_DEST); const float* GATE = (const float*)(P.ws + AR_GATE); const bf16* Y = (const bf16*)(P.ws + AR_XS);
    const float* g = NEXT ? pin(P, I_NORM_MIX) + 1024 : nullptr; bf16* HN = (bf16*)(P.ws + WS_HN); float* WI = (float*)(P.ws + AR_WI);
    const LAS f32x4* wiw = (const LAS f32x4*)(c.lds + 69632);
    for (int t = c.gw; t < NTOK; t += c.NGW) { const int d0 = DEST[2 * t], d1 = DEST[2 * t + 1]; const float g0 = GATE[2 * t], g1 = GATE[2 * t + 1];
        f32x4* op = (f32x4*)(P.out + (size_t)t * 1024) + c.lane; const v2u* y0 = (const v2u*)(Y + (size_t)d0 * 1024) + c.lane; const v2u* y1 = (const v2u*)(Y + (size_t)d1 * 1024) + c.lane;
        f32x4 v[4];
#pragma unroll
        for (int j = 0; j < 4; ++j) { f32x4 o = op[64 * j]; const v2u a = y0[64 * j], b = y1[64 * j];
            o.x += g0 * bflo(a.x) + g1 * bflo(b.x); o.y += g0 * bfhi(a.x) + g1 * bfhi(b.x); o.z += g0 * bflo(a.y) + g1 * bflo(b.y); o.w += g0 * bfhi(a.y) + g1 * bfhi(b.y); op[64 * j] = o; v[j] = o; }
        if (NEXT) { rms_finish(v, g, HN + (size_t)t * 1024, c.lane); wi_row(v, wiw, WI, t, c.lane); }
    }
    if (NEXT) prep_weights<1>(c, P);
}

DI void phase_dsaprep(const Ctx& c0, const PV& P) {
    const Ctx c = relaunder(c0);
    const bf16* PROJ = (const bf16*)(P.ws + AR_PROJ); bf16* KN = (bf16*)(P.ws + AR_KN); bf16* KIN = (bf16*)(P.ws + AR_KIN); bf16* QIW = (bf16*)(P.ws + AR_QIW);
    const float* WI = (const float*)(P.ws + AR_WI); const float* kg = pin(P, I_DSA_K_NORM);
    const int l = c.lane;
    for (int row = c.gw; row < NTOK; row += c.NGW) {
        const int col = l < 8 ? 768 + 8 * l : (l < 16 ? 1216 + 8 * (l - 8) : 960 + 8 * (l - 16));
        float f[8] = {0.f, 0.f, 0.f, 0.f, 0.f, 0.f, 0.f, 0.f};
        if (l < 48) unpack8(*(const v4u*)(PROJ + (size_t)row * 1536 + col), f);
        float ss = 0.f;
#pragma unroll
        for (int j = 0; j < 8; ++j) ss += f[j] * f[j];
        ss += __shfl_xor(ss, 1); ss += __shfl_xor(ss, 2); ss += __shfl_xor(ss, 4);
        const float r = 1.0f / sqrtf(ss * (1.0f / 64.0f) + EPS);
        if (l < 8) {
#pragma unroll
            for (int j = 0; j < 8; ++j) f[j] = f[j] * r * kg[8 * l + j];
            *(v4u*)(KN + (size_t)row * 64 + 8 * l) = pack8(f);
        } else if (l < 16) {
#pragma unroll
            for (int j = 0; j < 8; ++j) f[j] *= r;
            { const int cch = l - 8;
              *(v4u*)(KIN + ((((size_t)(row >> 5) * 4 + (cch >> 1)) * 2 + (cch & 1)) * 32 + (row & 31)) * 8) = pack8(f); }
        } else if (l < 48) {
            const float w = WI[(size_t)row * 4 + ((l - 16) >> 3)] * 0.125f;
#pragma unroll
            for (int j = 0; j < 8; ++j) f[j] *= w;
            *(v4u*)(QIW + (size_t)row * 256 + 8 * (l - 16)) = pack8(f);
        }
    }
}
DI int dpp_scan_add(int v) {
    v += __builtin_amdgcn_update_dpp(0, v, 0x111, 0xf, 0xf, true); v += __builtin_amdgcn_update_dpp(0, v, 0x112, 0xf, 0xf, true);
    v += __builtin_amdgcn_update_dpp(0, v, 0x114, 0xf, 0xf, true); v += __builtin_amdgcn_update_dpp(0, v, 0x118, 0xf, 0xf, true);
    v += __builtin_amdgcn_update_dpp(0, v, 0x142, 0xa, 0xf, false); v += __builtin_amdgcn_update_dpp(0, v, 0x143, 0xc, 0xf, false);
    return v;
}
DI unsigned dpp_scan_max(unsigned v) {
#define DPPMAX_(ctrl, rm, bc) { const unsigned o_ = (unsigned)__builtin_amdgcn_update_dpp(0, (int)v, ctrl, rm, 0xf, bc); v = v > o_ ? v : o_; }
    DPPMAX_(0x111, 0xf, true) DPPMAX_(0x112, 0xf, true) DPPMAX_(0x114, 0xf, true) DPPMAX_(0x118, 0xf, true) DPPMAX_(0x142, 0xa, false) DPPMAX_(0x143, 0xc, false)
#undef DPPMAX_
    return v;
}
DI unsigned idx_compact(LAS unsigned* qb, LAS unsigned* hist, int n, int lane) {
    unsigned e[8];
#pragma unroll
    for (int i = 0; i < 8; ++i) { const int idx = lane + 64 * i; e[i] = idx < n ? qb[idx] : 0u; }
    unsigned prefix = 0u, maskbits = 0u; int want = 256;
#pragma unroll
    for (int pass = 0; pass < 4; ++pass) { const int shift = 24 - 8 * pass;
        *(LAS v4u*)(hist + 4 * lane) = (v4u){0u, 0u, 0u, 0u};
        LDS_WAIT();
#pragma unroll
        for (int i = 0; i < 8; ++i) if (e[i] != 0u && (e[i] & maskbits) == prefix) lds_add(&hist[255u - ((e[i] >> shift) & 255u)], 1u);
        LDS_WAIT();
        const v4u h4 = *(const LAS v4u*)(hist + 4 * lane);
        LDS_WAIT();
        const int s = (int)(h4.x + h4.y + h4.z + h4.w);
        const int c0 = dpp_scan_add(s) - s, c1 = c0 + (int)h4.x, c2 = c1 + (int)h4.y, c3 = c2 + (int)h4.z;
        int fb = -1, fa = 0;
        if (c0 < want && want <= c0 + (int)h4.x) { fb = 0; fa = c0; }
        else if (c1 < want && want <= c1 + (int)h4.y) { fb = 1; fa = c1; }
        else if (c2 < want && want <= c2 + (int)h4.z) { fb = 2; fa = c2; }
        else if (c3 < want && want <= c3 + (int)h4.w) { fb = 3; fa = c3; }
        const unsigned long long m = __ballot(fb >= 0);
        const int src = m ? (int)__builtin_ctzll(m) : 0;
        const int slot = __builtin_amdgcn_readlane(4 * lane + fb, src), ab = __builtin_amdgcn_readlane(fa, src);
        prefix |= (unsigned)(255 - slot) << shift; maskbits |= 0xFFu << shift; want -= ab;
    }
    int base = 0;
#pragma unroll
    for (int i = 0; i < 8; ++i) { const bool pred = e[i] >= prefix && e[i] != 0u; const unsigned long long m = __ballot(pred);
        const int pos = base + (int)__builtin_amdgcn_mbcnt_hi((unsigned)(m >> 32), __builtin_amdgcn_mbcnt_lo((unsigned)m, 0u));
        if (pred) qb[pos] = e[i];
        base += (int)__builtin_popcountll(m); }
    LDS_WAIT();
    return prefix;
}
DI int idx_compact_coarse(LAS unsigned* qb, LAS unsigned* hist, int n, unsigned lo, unsigned& tau, int lane) {
    unsigned e[8]; unsigned mx = 0u;
#pragma unroll
    for (int i = 0; i < 8; ++i) { const int idx = lane + 64 * i; e[i] = idx < n ? qb[idx] : 0u; mx = e[i] > mx ? e[i] : mx; }
    const unsigned hi = (unsigned)__builtin_amdgcn_readlane((int)dpp_scan_max(mx), 63);
    const unsigned range = hi - lo;
    const int sh = range >= 256u ? (24 - (int)__builtin_clz(range)) : 0;
    *(LAS v4u*)(hist + 4 * lane) = (v4u){0u, 0u, 0u, 0u};
    LDS_WAIT();
#pragma unroll
    for (int i = 0; i < 8; ++i) if (e[i] != 0u) lds_add(&hist[255u - ((e[i] - lo) >> sh)], 1u);
    LDS_WAIT();
    const v4u h4 = *(const LAS v4u*)(hist + 4 * lane);
    LDS_WAIT();
    const int s = (int)(h4.x + h4.y + h4.z + h4.w);
    const int c0 = dpp_scan_add(s) - s, c1 = c0 + (int)h4.x, c2 = c1 + (int)h4.y, c3 = c2 + (int)h4.z;
    int fb = -1, fk = 0;
    if (c0 < 256 && 256 <= c0 + (int)h4.x) { fb = 0; fk = c0 + (int)h4.x; }
    else if (c1 < 256 && 256 <= c1 + (int)h4.y) { fb = 1; fk = c1 + (int)h4.y; }
    else if (c2 < 256 && 256 <= c2 + (int)h4.z) { fb = 2; fk = c2 + (int)h4.z; }
    else if (c3 < 256 && 256 <= c3 + (int)h4.w) { fb = 3; fk = c3 + (int)h4.w; }
    const unsigned long long m = __ballot(fb >= 0);
    const int src = m ? (int)__builtin_ctzll(m) : 0;
    const int slot = __builtin_amdgcn_readlane(4 * lane + fb, src), kept = __builtin_amdgcn_readlane(fk, src);
    if (__builtin_expect(kept > 352, 0)) { tau = idx_compact(qb, hist, n, lane); return 256; }
    const unsigned edge = lo + ((unsigned)(255 - slot) << sh);
    int base = 0;
#pragma unroll
    for (int i = 0; i < 8; ++i) { const bool pred = e[i] >= edge && e[i] != 0u; const unsigned long long mm = __ballot(pred);
        const int pos = base + (int)__builtin_amdgcn_mbcnt_hi((unsigned)(mm >> 32), __builtin_amdgcn_mbcnt_lo((unsigned)mm, 0u));
        if (pred) qb[pos] = e[i];
        base += (int)__builtin_popcountll(mm); }
    LDS_WAIT();
    tau = edge - 1u;
    return base;
}
struct IdxState { float lo[4][4], hi[4][4]; unsigned tau[4]; int cnt[4]; int tq[4]; };
DI int sel4(const int (&a)[4], int j) { return j == 0 ? a[0] : (j == 1 ? a[1] : (j == 2 ? a[2] : a[3])); }
DI unsigned sel4u(const unsigned (&a)[4], int j) { return j == 0 ? a[0] : (j == 1 ? a[1] : (j == 2 ? a[2] : a[3])); }
template <int SHADOW> DI void idx_step(const bf16x8 (&A)[4], const bf16x8 (&B)[2][4], IdxState& st, LAS unsigned* buf, LAS unsigned* hist, int step, bool lastst, int lane, int hh, int l31, unsigned ltmask) {
    f32x16 acc[2];
#pragma unroll
    for (int u = 0; u < 2; ++u) {
#pragma unroll
        for (int i = 0; i < 16; ++i) acc[u][i] = 0.f; }
#pragma unroll
    for (int ks = 0; ks < 4; ++ks) {
#pragma unroll
        for (int u = 0; u < 2; ++u) acc[u] = __builtin_amdgcn_mfma_f32_32x32x16_bf16(A[ks], B[u][ks], acc[u], 0, 0, 0); }
    if (SHADOW == 5) {
        f32x16 acc2[2];
#pragma unroll
        for (int u = 0; u < 2; ++u) {
#pragma unroll
            for (int i = 0; i < 16; ++i) acc2[u][i] = 1.f; }
#pragma unroll
        for (int ks = 0; ks < 4; ++ks) {
#pragma unroll
            for (int u = 0; u < 2; ++u) acc2[u] = __builtin_amdgcn_mfma_f32_32x32x16_bf16(A[3 - ks], B[u][ks], acc2[u], 0, 0, 0); }
#pragma unroll
        for (int u = 0; u < 2; ++u) {
#pragma unroll
            for (int i = 0; i < 16; i += 4) acc[u][i] += 1e-30f * acc2[u][i]; }
    }
#pragma unroll
    for (int rep2 = 0; rep2 < (SHADOW == 6 ? 2 : 1); ++rep2)
#pragma unroll
    for (int u = 0; u < 2; ++u) {
        const int s = step * 64 + 32 * u + l31 + rep2;
#pragma unroll
        for (int j = 0; j < 4; ++j) {
            const float sc = (__builtin_amdgcn_fmed3f(acc[u][4 * j], st.lo[j][0], st.hi[j][0]) + __builtin_amdgcn_fmed3f(acc[u][4 * j + 1], st.lo[j][1], st.hi[j][1]))
                           + (__builtin_amdgcn_fmed3f(acc[u][4 * j + 2], st.lo[j][2], st.hi[j][2]) + __builtin_amdgcn_fmed3f(acc[u][4 * j + 3], st.lo[j][3], st.hi[j][3]));
            unsigned uu = __float_as_uint(sc); uu ^= (unsigned)((int)uu >> 31) | 0x80000000u;
            unsigned key = (uu & 0xFFFFC000u) | (unsigned)(16383 - s);
            if (lastst && s > st.tq[j]) key = 0u;
            const bool pred = key > st.tau[j];
            const unsigned long long m = __ballot(pred);
            const unsigned hm = hh ? (unsigned)(m >> 32) : (unsigned)m;
            const int pos = st.cnt[j] + __builtin_popcount(hm & ltmask);
            if (pred) buf[(2 * j + hh) * 512 + pos] = key;
            st.cnt[j] += __builtin_popcount(hm);
        }
    }
    const int cm = max(max(st.cnt[0], st.cnt[1]), max(st.cnt[2], st.cnt[3]));
    unsigned long long need = __ballot(cm > 448);
    if (__builtin_expect(need != 0ull, 0)) {
        unsigned qmask = 0u;
#pragma unroll
        for (int j = 0; j < 4; ++j) { const unsigned long long mm = __ballot(st.cnt[j] > 448); qmask |= ((unsigned)(mm & 1ull) << (2 * j)) | ((unsigned)((mm >> 32) & 1ull) << (2 * j + 1)); }
        LDS_WAIT();
        while (qmask) {
            const int q = __builtin_ctz(qmask); qmask &= qmask - 1u; const int j = q >> 1, h = q & 1;
            const int n = __builtin_amdgcn_readlane(sel4(st.cnt, j), h * 32); const unsigned lo0 = (unsigned)__builtin_amdgcn_readlane((int)sel4u(st.tau, j), h * 32);
            unsigned T; const int k = idx_compact_coarse(buf + q * 512, hist, n, lo0, T, lane);
#pragma unroll
            for (int jj = 0; jj < 4; ++jj) if (jj == j && hh == h) { st.tau[jj] = T; st.cnt[jj] = k; }
        }
    }
}
DI void idx_loadB(bf16x8 (&B)[2][4], const bf16* kbase, int step) {
#pragma unroll
    for (int u = 0; u < 2; ++u)
#pragma unroll
        for (int ks = 0; ks < 4; ++ks) B[u][ks] = *(const bf16x8*)(kbase + ((size_t)(2 * step + u) * 4 + ks) * 512);
}
template <int SHADOW> DI void phase_indexer(const Ctx& c0, const PV& P) {
    const Ctx c = relaunder(c0);
    const bf16* KIN = (const bf16*)(P.ws + AR_KIN); const bf16* QIW = (const bf16*)(P.ws + AR_QIW); const float* WI = (const float*)(P.ws + AR_WI); int* SEL = (int*)(P.ws + (SHADOW ? WS_AR + 272 * MiB : AR_SEL));
    LAS unsigned* buf = (LAS unsigned*)(c.lds + c.wave * 17408);
    LAS unsigned* hist = buf + 4096;
    const int lane = c.lane, hh = lane >> 5, l31 = lane & 31;
    const unsigned ltmask = (1u << l31) - 1u;
    const float INF = __builtin_inff();
    for (int pair = c.blk; pair < 256; pair += c.G) {
        const int b = pair >> 7, jj = pair & 127;
        for (int half = 0; half < 2; ++half) {
            const int unit = half ? (255 - jj) : jj, t0w = unit * 64 + c.wave * 8, rowbase = b * SEQ;
            bf16x8 A[4];
#pragma unroll
            for (int ks = 0; ks < 4; ++ks) A[ks] = *(const bf16x8*)(QIW + (size_t)(rowbase + t0w + (l31 >> 2)) * 256 + (l31 & 3) * 64 + 16 * ks + 8 * hh);
            IdxState st;
#pragma unroll
            for (int j = 0; j < 4; ++j) { st.tq[j] = t0w + 2 * j + hh; st.tau[j] = 0u; st.cnt[j] = 0;
                const f32x4 w = *(const f32x4*)(WI + (size_t)(rowbase + st.tq[j]) * 4);
#pragma unroll
                for (int i = 0; i < 4; ++i) { st.lo[j][i] = w[i] > 0.f ? 0.f : -INF; st.hi[j][i] = w[i] > 0.f ? INF : 0.f; } }
            const int nstep = (SHADOW == 7) ? ((t0w + 7) / 128 + 1) : ((t0w + 7) / 64 + 1);
            const bf16* kbase = KIN + (size_t)(rowbase >> 5) * 2048 + lane * 8;
            bf16x8 R0[2][4], R1[2][4];
            idx_loadB(R0, kbase, 0);
            if (nstep > 1) idx_loadB(R1, kbase, 1); else idx_loadB(R1, kbase, 0);
            for (int step = 0; step < nstep; step += 2) {
                idx_step<SHADOW>(A, R0, st, buf, hist, step, step + 1 >= nstep, lane, hh, l31, ltmask);
                idx_loadB(R0, kbase, min(step + 2, nstep - 1));
                idx_step<SHADOW>(A, R1, st, buf, hist, step + 1, step + 2 >= nstep, lane, hh, l31, ltmask);
                idx_loadB(R1, kbase, min(step + 3, nstep - 1));
            }
            LDS_WAIT();
            for (int q = 0; q < 8; ++q) {
                const int j = q >> 1, h2 = q & 1;
                int n = __builtin_amdgcn_readlane(sel4(st.cnt, j), h2 * 32);
                LAS unsigned* qb = buf + q * 512;
                if (SHADOW == 8) n = n > 256 ? 256 : n;
                if (n > 256) { (void)idx_compact(qb, hist, n, lane); n = 256; }
                int* sp = SEL + (size_t)(rowbase + t0w + q) * 256;
#pragma unroll
                for (int i = 0; i < 4; ++i) { const int idx = lane + 64 * i; sp[idx] = idx < n ? (16383 - (int)(qb[idx] & 0x3FFFu)) : -1; }
            }
            LDS_WAIT();
        }
    }
}
DI int t5_bucket(int d) {
    if (d < 16) return d;
    return 16 + (d >= 19) + (d >= 21) + (d >= 24) + (d >= 27) + (d >= 31) + (d >= 35) + (d >= 40) + (d >= 46) + (d >= 52) + (d >= 59) + (d >= 67) + (d >= 77) + (d >= 87) + (d >= 99) + (d >= 113);
}
typedef short s16x4 __attribute__((ext_vector_type(4)));
DI void phase_sattn(const Ctx& c0, const PV& P) {
    const Ctx c = relaunder(c0);
    const bf16* PROJ = (const bf16*)(P.ws + AR_PROJ); const bf16* KN = (const bf16*)(P.ws + AR_KN); const int* SEL = (const int*)(P.ws + AR_SEL); bf16* MIX = (bf16*)(P.ws + AR_MIXD);
    const float* qg = pin(P, I_DSA_Q_NORM); const float* rb = pin(P, I_REL_BIAS);
    constexpr int WST = 11264, VRS = 144;
    LAS int* bk = (LAS int*)(c.lds + c.wave * WST);
    LAS int* selL = bk + 256;
    LAS bf16* Vs = (LAS bf16*)(selL + 256);
    LAS float* relb = (LAS float*)(c.lds + 8 * WST);
    const int lane = c.lane, l15 = lane & 15, g = lane >> 4;
    __syncthreads();
    relb[c.tid] = (c.tid & 15) < 12 ? rb[(c.tid >> 4) * 12 + (c.tid & 15)] : 0.f;
    __syncthreads();
    float qgv0[8], qgv1[8];
#pragma unroll
    for (int j = 0; j < 8; ++j) { qgv0[j] = qg[8 * g + j]; qgv1[j] = qg[32 + 8 * g + j]; }
    const LAS bf16* trp = Vs + (4 * g + (l15 >> 2)) * VRS + 4 * (l15 & 3);
    int row = c.gw;
    v4i s4n = {0, 0, 0, 0}; v4u qn0 = {0u, 0u, 0u, 0u}, qn1 = {0u, 0u, 0u, 0u};
    if (row < NTOK) { s4n = *(const v4i*)(SEL + (size_t)row * 256 + 4 * lane);
        if (l15 < 12) { const bf16* qp = PROJ + (size_t)row * 1536 + l15 * 64 + 8 * g; qn0 = *(const v4u*)qp; qn1 = *(const v4u*)(qp + 32); } }
#pragma unroll 1
    for (; row < NTOK; row += c.NGW) {
        const int b = row >> 14, t = row & (SEQ - 1), rowbase = b << 14;
        const v4i s4 = s4n; const v4u w0 = qn0, w1 = qn1;
        { const int nrow = row + c.NGW;
          if (nrow < NTOK) { s4n = *(const v4i*)(SEL + (size_t)nrow * 256 + 4 * lane);
              if (l15 < 12) { const bf16* qp = PROJ + (size_t)nrow * 1536 + l15 * 64 + 8 * g; qn0 = *(const v4u*)qp; qn1 = *(const v4u*)(qp + 32); } } }
        const int sv[4] = {s4.x, s4.y, s4.z, s4.w};
        int bv[4], cv[4];
#pragma unroll
        for (int i = 0; i < 4; ++i) { bv[i] = sv[i] >= 0 ? t5_bucket(t - sv[i]) : -1; cv[i] = sv[i] >= 0 ? sv[i] : 0; }
        *(LAS v4i*)(bk + 4 * lane) = (v4i){bv[0], bv[1], bv[2], bv[3]};
        *(LAS v4i*)(selL + 4 * lane) = (v4i){cv[0], cv[1], cv[2], cv[3]};
        float q0[8], q1[8]; unpack8(w0, q0); unpack8(w1, q1);
        float ss = 0.f;
#pragma unroll
        for (int j = 0; j < 8; ++j) ss += q0[j] * q0[j] + q1[j] * q1[j];
        ss += __shfl_xor(ss, 16); ss += __shfl_xor(ss, 32);
        const float r = 0.125f / sqrtf(ss * (1.0f / 64.0f) + EPS);
#pragma unroll
        for (int j = 0; j < 8; ++j) { q0[j] = q0[j] * r * qgv0[j]; q1[j] = q1[j] * r * qgv1[j]; }
        const bf16x8 B0 = __builtin_bit_cast(bf16x8, pack8(q0)), B1 = __builtin_bit_cast(bf16x8, pack8(q1));
        LDS_WAIT();
        v4u vb[2][8];
#pragma unroll
        for (int i = 0; i < 8; ++i) { const int sk = selL[4 * i + g]; vb[0][i] = *(const v4u*)(PROJ + (size_t)(rowbase + sk) * 1536 + 832 + 8 * l15); }
        f32x4 S[16];
#pragma unroll
        for (int hb = 0; hb < 2; ++hb) {
            bf16x8 A0[8], A1[8];
#pragma unroll
            for (int k8 = 0; k8 < 8; ++k8) { const int sk = selL[16 * (8 * hb + k8) + l15]; const bf16* kp = KN + (size_t)(rowbase + sk) * 64 + 8 * g; A0[k8] = *(const bf16x8*)kp; A1[k8] = *(const bf16x8*)(kp + 32); }
#pragma unroll
            for (int k8 = 0; k8 < 8; ++k8) { f32x4 z = {0.f, 0.f, 0.f, 0.f}; z = mfma16(A0[k8], B0, z); S[8 * hb + k8] = mfma16(A1[k8], B1, z); }
            __builtin_amdgcn_sched_barrier(0);
        }
        float mx = -3.0e38f;
#pragma unroll
        for (int kt = 0; kt < 16; ++kt) { const v4i b4 = *(const LAS v4i*)(bk + 16 * kt + 4 * g); const int bb[4] = {b4.x, b4.y, b4.z, b4.w};
#pragma unroll
            for (int i = 0; i < 4; ++i) { const float v = bb[i] >= 0 ? S[kt][i] + relb[bb[i] * 16 + l15] : -3.0e38f; S[kt][i] = v; mx = fmaxf(mx, v); } }
        mx = fmaxf(mx, __shfl_xor(mx, 16)); mx = fmaxf(mx, __shfl_xor(mx, 32));
        float l = 0.f;
#pragma unroll
        for (int kt = 0; kt < 16; ++kt) {
#pragma unroll
            for (int i = 0; i < 4; ++i) { const float p = S[kt][i] > -1.0e38f ? __expf(S[kt][i] - mx) : 0.f; S[kt][i] = p; l += p; } }
        l += __shfl_xor(l, 16); l += __shfl_xor(l, 32);
        f32x4 O[8];
#pragma unroll
        for (int ct = 0; ct < 8; ++ct) O[ct] = (f32x4){0.f, 0.f, 0.f, 0.f};
#pragma unroll
        for (int jb = 0; jb < 8; ++jb) {
            if (jb + 1 < 8) {
#pragma unroll
                for (int i = 0; i < 8; ++i) { const int sk = selL[32 * (jb + 1) + 4 * i + g]; vb[(jb + 1) & 1][i] = *(const v4u*)(PROJ + (size_t)(rowbase + sk) * 1536 + 832 + 8 * l15); } }
#pragma unroll
            for (int i = 0; i < 8; ++i) { const v4u v = vb[jb & 1][i]; LAS v2u* d = (LAS v2u*)(Vs + (4 * i + g) * VRS + 8 * l15); d[0] = (v2u){v.x, v.y}; d[1] = (v2u){v.z, v.w}; }
            v4u pw; pw.x = pk2(S[2 * jb][0], S[2 * jb][1]); pw.y = pk2(S[2 * jb][2], S[2 * jb][3]); pw.z = pk2(S[2 * jb + 1][0], S[2 * jb + 1][1]); pw.w = pk2(S[2 * jb + 1][2], S[2 * jb + 1][3]);
            const bf16x8 Pb = __builtin_bit_cast(bf16x8, pw);
            LDS_WAIT();
#pragma unroll
            for (int ct = 0; ct < 8; ++ct) {
                const s16x4 a = __builtin_amdgcn_ds_read_tr16_b64_v4i16((LAS s16x4*)(trp + 16 * ct));
                const s16x4 bq = __builtin_amdgcn_ds_read_tr16_b64_v4i16((LAS s16x4*)(trp + 16 * VRS + 16 * ct));
                const bf16x8 Af = {a[0], a[1], a[2], a[3], bq[0], bq[1], bq[2], bq[3]};
                O[ct] = mfma16(Af, Pb, O[ct]); }
            LDS_WAIT();
            __builtin_amdgcn_sched_barrier(0);
        }
        if (l15 < 12) { const float il = 1.0f / l; bf16* op = MIX + (size_t)row * 1792 + l15 * 128 + 4 * g;
#pragma unroll
            for (int ct = 0; ct < 8; ++ct) { v2u o; o.x = pk2(O[ct][0] * il, O[ct][1] * il); o.y = pk2(O[ct][2] * il, O[ct][3] * il); *(v2u*)(op + 16 * ct) = o; } }
        LDS_WAIT();
    }
}

#ifndef ONLY
#define ONLY -1
#endif
#define PH(n) (ONLY < 0 || ONLY == (n))
#ifndef REP0
#define REP0 1
#endif
#ifndef REP1
#define REP1 1
#endif
#ifndef REP2
#define REP2 1
#endif
#ifndef REP3
#define REP3 1
#endif
#ifndef REP4
#define REP4 1
#endif
#ifndef REP5
#define REP5 1
#endif
#ifndef REP6
#define REP6 1
#endif
#ifndef REP7
#define REP7 1
#endif
#ifndef REP8
#define REP8 1
#endif
#ifndef REP9
#define REP9 1
#endif
#ifndef REP10
#define REP10 1
#endif
#ifndef REP11
#define REP11 1
#endif
#ifndef REP12
#define REP12 1
#endif
#ifndef REP13
#define REP13 1
#endif
#ifndef REP14
#define REP14 1
#endif
#ifndef REP15
#define REP15 1
#endif
#ifndef REP16
#define REP16 1
#endif
#ifndef REP17
#define REP17 1
#endif
#ifndef REP18
#define REP18 1
#endif
#define RB(n) for (int r_ = 0; r_ < REP##n; ++r_) { if (r_) GRID_BAR();
#define RE }
#define GRID_BAR() xcd_barrier(bar)
template <int layer> DI void layer_body(const Ctx& c, const PV& P, const XcdBarrier& bar) {
    unsigned char* ws = P.ws;
    unsigned* ctl = (unsigned*)(ws + WS_CTL);
    PG8_LAS unsigned char* glds = (PG8_LAS unsigned char*)c.lds;
    const pg8::bf16_t* HN = (const pg8::bf16_t*)(ws + WS_HN);
    if (layer == 0) { RB(0) if (PH(0)) phase_prep0(c, P); RE
    GRID_BAR(); }
    RB(1) if (PH(1)) {
        { pg8::Gemm g{(const pg8::bf16_t*)(ws + WB_MEMN), (const pg8::bf16_t*)(ws + WB_MKV), 1024, 1024, 1024}; pg8::StaticOrder S; S.init(2, 2, c.G, c.G - 1 - c.blk);
          pg8::EpiBf16<false> E{(pg8::bf16_t*)(ws + WB_MKVO), 512, 0, 0};
          pg8::gemm_phase<pg8::EpiBf16<false>, pg8::StaticOrder, true, true>(glds, g, S, E); }
        __syncthreads();
        if (layer == 0) { pg8::Gemm g{HN, (const pg8::bf16_t*)(ws + WB_WIN), 1024, 1024, 1024}; pg8::StaticOrder S; S.init(128, 7, c.G, c.blk);
          pg8::EpiBf16<true> E{(pg8::bf16_t*)(ws + AR_PROJ), 1792, 3, 6};
          pg8::gemm_phase<pg8::EpiBf16<true>, pg8::StaticOrder, true, true>(glds, g, S, E); }
        else { pg8::Gemm g{HN, (const pg8::bf16_t*)(ws + WB_WIN), 1024, 1024, 1024}; pg8::StaticOrder S; S.init(128, 6, c.G, c.blk);
          pg8::EpiBf16<false> E{(pg8::bf16_t*)(ws + AR_PROJ), 1536, 0, 0};
          pg8::gemm_phase<pg8::EpiBf16<false>, pg8::StaticOrder, true, true>(glds, g, S, E); }
    } RE
    GRID_BAR();
    if (layer == 0) {
        RB(2) if (PH(2)) phase_conv(c, P);
        if (PH(2)) phase_xattn<0, 1792, 1536, 1024, 768>(c, P, (const bf16*)(ws + AR_PROJ), (bf16*)(ws + AR_MIXL)); RE
        GRID_BAR();
        RB(3) if (PH(3)) { pg8::Gemm g{(const pg8::bf16_t*)(ws + AR_XSC), (const pg8::bf16_t*)(ws + WB_WGT), 768, 768, 768}; pg8::StaticOrder S; S.init(128, 6, c.G, c.blk);
          pg8::EpiLruGate E{(pg8::bf16_t*)(ws + AR_LA), (pg8::bf16_t*)(ws + AR_UU), (const pg8::bf16_t*)(ws + AR_XSC), 768, pin(P, I_LRU_B_A), pin(P, I_LRU_B_X), pin(P, I_LRU_LAMBDA)};
          pg8::gemm_phase<pg8::EpiLruGate, pg8::StaticOrder, true, true>(glds, g, S, E); } RE
        GRID_BAR();
        RB(4) if (PH(4)) phase_scanA(c, P); RE
        GRID_BAR();
        RB(5) if (PH(5)) phase_scanB(c, P); RE
        GRID_BAR();
        RB(6) if (PH(6)) phase_scanC(c, P); RE
        GRID_BAR();
        RB(7) if (PH(7)) { pg8::Gemm g{(const pg8::bf16_t*)(ws + AR_MIXL), (const pg8::bf16_t*)(ws + WB_WOUT), 1024, 1024, 1024}; pg8::StaticOrder S; S.init(128, 4, c.G, c.blk);
          pg8::EpiResF32 E{P.out, pin(P, I_X), 1024};
          pg8::gemm_phase<pg8::EpiResF32, pg8::StaticOrder, true, true>(glds, g, S, E); } RE
    } else {
        RB(8) if (PH(8)) phase_dsaprep(c, P);
        if (PH(8)) phase_xattn<1, 1536, 1280, 1792, 1536>(c, P, (const bf16*)(ws + AR_PROJ), (bf16*)(ws + AR_MIXD)); RE
        GRID_BAR();
#ifndef IDX_SHADOW
#define IDX_SHADOW 0
#endif
        RB(9) if (PH(9)) { if (r_ + 1 < REP9) phase_indexer<IDX_SHADOW>(c, P); else phase_indexer<0>(c, P); } RE
        GRID_BAR();
        RB(10) if (PH(10)) phase_sattn(c, P); RE
        GRID_BAR();
        RB(11) if (PH(11)) { pg8::Gemm g{(const pg8::bf16_t*)(ws + AR_MIXD), (const pg8::bf16_t*)(ws + WB_WOUT), 1792, 1792, 1792}; pg8::StaticOrder S; S.init(128, 4, c.G, c.blk);
          pg8::EpiResF32 E{(r_ + 1 < REP11) ? (float*)(ws + WS_AR) : P.out, P.out, 1024};
          pg8::gemm_phase<pg8::EpiResF32, pg8::StaticOrder, true, true>(glds, g, S, E); } RE
    }
    GRID_BAR();
    RB(12) if (PH(12)) phase_norm2<layer>(c, P); RE
    GRID_BAR();
    RB(13) if (PH(13)) { pg8::Gemm g{HN, (const pg8::bf16_t*)(ws + WB_WR), 1024, 1024, 1024}; pg8::StaticOrder S; S.init(128, 1, c.G, c.blk);
      pg8::EpiLogits E{(float*)(ws + AR_LOG)};
      pg8::gemm_phase<pg8::EpiLogits, pg8::StaticOrder, true, true>(glds, g, S, E); } RE
    GRID_BAR();
    if (PH(14)) phase_route<layer>(c, P);
    GRID_BAR();
    if (PH(15)) phase_scatter<layer>(c, P);
    GRID_BAR();
    RB(16) if (PH(16)) { const int ntile = (int)__hip_atomic_load(ctl + CW_NT + layer * CW_LSTRIDE, RLX_AGENT);
        pg8::Gemm g{(const pg8::bf16_t*)(ws + AR_XS), (const pg8::bf16_t*)(ws + WB_WGU), 1024, 1024, 1024}; pg8::GroupedOrder S; S.init(ntile, 4, c.G, c.blk);
        S.te = (const int*)(ctl + CW_TE + layer * CW_TE_STRIDE); S.estride = (size_t)1024 * 1024 * 2;
        pg8::EpiSwiglu E{(pg8::bf16_t*)(ws + AR_ACT), 512};
        pg8::gemm_phase<pg8::EpiSwiglu, pg8::GroupedOrder, true, true>(glds, g, S, E); } RE
    GRID_BAR();
    RB(17) if (PH(17)) { const int ntile = (int)__hip_atomic_load(ctl + CW_NT + layer * CW_LSTRIDE, RLX_AGENT);
        pg8::Gemm g{(const pg8::bf16_t*)(ws + AR_ACT), (const pg8::bf16_t*)(ws + WB_WD), 512, 512, 512}; pg8::GroupedOrder S; S.init(ntile, 4, c.G, c.blk);
        S.te = (const int*)(ctl + CW_TE + layer * CW_TE_STRIDE); S.estride = (size_t)1024 * 512 * 2;
        pg8::EpiBf16<false> E{(pg8::bf16_t*)(ws + AR_XS), 1024, 0, 0};
        pg8::gemm_phase<pg8::EpiBf16<false>, pg8::GroupedOrder, true, true>(glds, g, S, E); } RE
    GRID_BAR();
    if (PH(18)) phase_combine<layer == 0>(c, P);
    GRID_BAR();
}
__global__ void __launch_bounds__(512, 2) fwd(const Params P) {
    extern __shared__ __attribute__((aligned(16))) unsigned char lds_raw[];
    Ctx c;
    c.lds = (LAS unsigned char*)lds_raw;
    c.tid = threadIdx.x; c.lane = c.tid & 63; c.wave = __builtin_amdgcn_readfirstlane(c.tid >> 6);
    c.G = gridDim.x; c.blk = blockIdx.x; c.gw = c.blk * 8 + c.wave; c.NGW = c.G * 8;
    volatile LAS unsigned* MISC = (volatile LAS unsigned*)(c.lds + MISC_OFF);
    if (c.tid < 64) MISC[c.tid] = 0u;
    if (c.tid < 29) ((LAS unsigned long long*)(c.lds + MISC_OFF + 512))[c.tid] = (unsigned long long)P.in[c.tid];
    __syncthreads();
    XcdBarrier bar = xcd_barrier_post((unsigned*)(P.ws + WS_CTL) + CW_BAR, MISC + 8);
    PV pv; pv.ws = P.ws; pv.out = P.out; pv.tab = (LAS unsigned long long*)(c.lds + MISC_OFF + 512);
#ifndef ONLY_LAYER
    layer_body<0>(c, pv, bar);
    layer_body<1>(c, pv, bar);
#else
    layer_body<ONLY_LAYER>(c, pv, bar);
#endif
}

extern "C" void kernel_launch(void* const* d_in, const int* in_sizes, int n_in, void* d_out, int out_size, void* d_ws, size_t ws_size, hipStream_t stream) {
    static int grid = 0;
    if (grid == 0) {
        if (n_in != 29 || out_size != NTOK * DM || ws_size < WS_END) { fprintf(stderr, "kernel_launch: unexpected shapes (n_in %d out %d ws %zu need %zu)\n", n_in, out_size, ws_size, (size_t)WS_END); grid = -1; return; }
        int dev = 0, cus = 0, per_cu = 0;
        if (hipGetDevice(&dev) != hipSuccess || hipDeviceGetAttribute(&cus, hipDeviceAttributeMultiprocessorCount, dev) != hipSuccess) { grid = -1; return; }
        if (hipFuncSetAttribute((const void*)fwd, hipFuncAttributeMaxDynamicSharedMemorySize, LDS_BYTES) != hipSuccess) { fprintf(stderr, "kernel_launch: hipFuncSetAttribute failed\n"); grid = -1; return; }
        if (hipOccupancyMaxActiveBlocksPerMultiprocessor(&per_cu, (const void*)fwd, 512, LDS_BYTES) != hipSuccess || per_cu < 1) { fprintf(stderr, "kernel_launch: occupancy query reports %d\n", per_cu); }
        (void)hipGetLastError();
        grid = cus;
    }
    if (grid < 0) return;
    if (hipMemsetAsync((char*)d_ws + WS_CTL, 0, CTL_ZERO_BYTES, stream) != hipSuccess) return;
    Params p{};
    for (int i = 0; i < 29; ++i) p.in[i] = (const float*)d_in[i];
    p.out = (float*)d_out; p.ws = (unsigned char*)d_ws;
    hipLaunchKernelGGL(fwd, dim3(grid), dim3(512), LDS_BYTES, stream, p);
}
```

```cpp
#include <hip/hip_runtime.h>
#include <cstdio>
#include <cstdint>
namespace pg8 {
#define PG8_LAS __attribute__((address_space(3)))
typedef unsigned short bf16_t;
typedef short bf16x8 __attribute__((ext_vector_type(8)));
typedef float f32x4 __attribute__((ext_vector_type(4)));
typedef float f32x2 __attribute__((ext_vector_type(2)));
typedef unsigned u32x4 __attribute__((ext_vector_type(4)));
constexpr int BM = 256, BK = 64, HALF = 128, HTB = HALF * BK * 2  , STAGE_BYTES = 8 * HTB, NXCD = 8, WGM = 8;

__host__ __device__ __forceinline__ int lds_byte(int r, int c) { const int st = (r >> 4) * 2 + (c >> 5), rr = r & 15, cc = c & 31, ob = rr * 64 + cc * 2; return st * 1024 + (ob ^ (((ob >> 9) & 1) << 5)); }
__host__ __device__ __forceinline__ void stage_rc(int b, int& R, int& C) { const int st = b / 1024, sb = b % 1024, swz = sb ^ (((sb >> 9) & 1) << 5); R = (st >> 1) * 16 + swz / 64; C = (st & 1) * 32 + (swz % 64) / 2; }
__host__ __device__ __forceinline__ int perm32(int rho) { const int n = rho >> 4, i = rho & 15; return 8 * (i >> 2) + 4 * n + (i & 3); }

struct Unit { int pm, pn; size_t boff; };
struct Gemm { const bf16_t* A; const bf16_t* Bt; int lda, ldb, K; };

struct StaticOrder {
    int nM, nN, nwg, G, c;
    __host__ __device__ void init(int nM_, int nN_, int G_, int c_) { nM = nM_; nN = nN_; nwg = nM * nN; G = G_; c = c_; }
    __host__ __device__ bool next(int i, Unit& u) const {
        const long L = (long)i * G + c; if (L >= nwg) return false;
        int wgid = (int)L; { const int q = nwg / NXCD, r = nwg % NXCD, xcd = wgid % NXCD, off = wgid / NXCD; wgid = (xcd < r ? xcd * (q + 1) : r * (q + 1) + (xcd - r) * q) + off; }
        const int nig = WGM * nN, gid = wgid / nig, fm = gid * WGM, gsz = (nM - fm) < WGM ? (nM - fm) : WGM;
        u.pm = fm + ((wgid % nig) % gsz); u.pn = (wgid % nig) / gsz; u.boff = 0; return true;
    }
    __device__ __forceinline__ void a_ready(const Unit&) const {}
    __device__ __forceinline__ void done(const Unit&) const {}
};
struct GroupedOrder : StaticOrder {
    const int* te; size_t estride;
    __device__ bool next(int i, Unit& u) const { if (!StaticOrder::next(i, u)) return false; u.boff = (size_t)te[u.pm] * estride; return true; }
};

__device__ __forceinline__ unsigned cvt_pk_bf16(float lo, float hi) { unsigned r; asm volatile("v_cvt_pk_bf16_f32 %0, %1, %2" : "=v"(r) : "v"(lo), "v"(hi)); return r; }
__device__ __forceinline__ float bf_lo(unsigned w) { return __uint_as_float(w << 16); }
__device__ __forceinline__ float bf_hi(unsigned w) { return __uint_as_float(w & 0xffff0000u); }
__device__ __forceinline__ float sigmoidf_(float v) { return __builtin_amdgcn_rcpf(1.0f + __expf(-v)); }
__device__ __forceinline__ float gelu_tanh(float v) { const float z = 1.5957691216057308f * (v + 0.044715f * v * v * v); return v * sigmoidf_(z); }

template <bool GELU> struct EpiBf16 {
    static constexpr bool PERM = true, AFTER_DRAIN = false;
    bf16_t* O; int ldc; int gelu_lo, gelu_hi;
    __device__ __forceinline__ void operator()(const f32x4 (&acc)[2][2][4][2], const Unit& u, int wr, int wc, int fr, int fq) const {
        const int row0 = u.pm * BM + wr * 64 + fr, col0 = u.pn * BM + wc * 32 + 8 * fq;
        const bool act = GELU && (u.pn >= gelu_lo && u.pn < gelu_hi);
#pragma unroll
        for (int ai = 0; ai < 2; ++ai)
#pragma unroll
            for (int m = 0; m < 4; ++m) { bf16_t* rowp = O + (size_t)(row0 + ai * HALF + m * 16) * ldc + col0;
#pragma unroll
                for (int bj = 0; bj < 2; ++bj) { f32x4 v0 = acc[ai][bj][m][0], v1 = acc[ai][bj][m][1];
                    if (act) {
#pragma unroll
                        for (int j = 0; j < 4; ++j) { v0[j] = gelu_tanh(v0[j]); v1[j] = gelu_tanh(v1[j]); } }
                    u32x4 w; w.x = cvt_pk_bf16(v0[0], v0[1]); w.y = cvt_pk_bf16(v0[2], v0[3]); w.z = cvt_pk_bf16(v1[0], v1[1]); w.w = cvt_pk_bf16(v1[2], v1[3]);
                    *(u32x4*)(rowp + bj * HALF) = w; } }
    }
};
struct EpiSwiglu {
    static constexpr bool PERM = true, AFTER_DRAIN = false;
    bf16_t* O; int ldc;
    __device__ __forceinline__ void operator()(const f32x4 (&acc)[2][2][4][2], const Unit& u, int wr, int wc, int fr, int fq) const {
        const int row0 = u.pm * BM + wr * 64 + fr, col0 = u.pn * HALF + wc * 32 + 8 * fq;
#pragma unroll
        for (int ai = 0; ai < 2; ++ai)
#pragma unroll
            for (int m = 0; m < 4; ++m) { bf16_t* rowp = O + (size_t)(row0 + ai * HALF + m * 16) * ldc + col0;
                f32x4 v0, v1;
#pragma unroll
                for (int j = 0; j < 4; ++j) { const float g0 = acc[ai][0][m][0][j], g1 = acc[ai][0][m][1][j];
                    v0[j] = g0 * sigmoidf_(g0) * acc[ai][1][m][0][j]; v1[j] = g1 * sigmoidf_(g1) * acc[ai][1][m][1][j]; }
                u32x4 w; w.x = cvt_pk_bf16(v0[0], v0[1]); w.y = cvt_pk_bf16(v0[2], v0[3]); w.z = cvt_pk_bf16(v1[0], v1[1]); w.w = cvt_pk_bf16(v1[2], v1[3]);
                *(u32x4*)rowp = w; }
    }
};
struct EpiLruGate {
    static constexpr bool PERM = true, AFTER_DRAIN = false;
    bf16_t* LA; bf16_t* U; const bf16_t* XS; int ldc; const float* b_a; const float* b_x; const float* lam;
    __device__ __forceinline__ void operator()(const f32x4 (&acc)[2][2][4][2], const Unit& u, int wr, int wc, int fr, int fq) const {
        const int row0 = u.pm * BM + wr * 64 + fr, ch0 = u.pn * HALF + wc * 32 + 8 * fq;
        float ba[8], bx[8], sp8[8];
#pragma unroll
        for (int j = 0; j < 8; ++j) { ba[j] = b_a[ch0 + j]; bx[j] = b_x[ch0 + j]; const float l = lam[ch0 + j];
            sp8[j] = 8.0f * ((l > 15.f) ? __expf(-l) : __logf(1.0f + __expf(-l))); }
#pragma unroll
        for (int ai = 0; ai < 2; ++ai)
#pragma unroll
            for (int m = 0; m < 4; ++m) { const size_t off = (size_t)(row0 + ai * HALF + m * 16) * ldc + ch0;
                const u32x4 xw = *(const u32x4*)(XS + off);
                float xv[8] = {bf_lo(xw.x), bf_hi(xw.x), bf_lo(xw.y), bf_hi(xw.y), bf_lo(xw.z), bf_hi(xw.z), bf_lo(xw.w), bf_hi(xw.w)};
                float la[8], uu[8];
#pragma unroll
                for (int j = 0; j < 8; ++j) { const float rp = acc[ai][0][m][j >> 2][j & 3] + ba[j], ip = acc[ai][1][m][j >> 2][j & 3] + bx[j];
                    const float r = sigmoidf_(rp), ig = sigmoidf_(ip);
                    const float l = -sp8[j] * r; const float t = 2.0f * l;
                    const float om = (t > -0.02f) ? -t * (1.0f + t * (0.5f + t * (0.16666667f + t * 0.041666667f))) : 1.0f - __expf(t);
                    la[j] = l; uu[j] = sqrtf(om) * ig * xv[j]; }
                u32x4 w; w.x = cvt_pk_bf16(la[0], la[1]); w.y = cvt_pk_bf16(la[2], la[3]); w.z = cvt_pk_bf16(la[4], la[5]); w.w = cvt_pk_bf16(la[6], la[7]);
                *(u32x4*)(LA + off) = w;
                u32x4 w2; w2.x = cvt_pk_bf16(uu[0], uu[1]); w2.y = cvt_pk_bf16(uu[2], uu[3]); w2.z = cvt_pk_bf16(uu[4], uu[5]); w2.w = cvt_pk_bf16(uu[6], uu[7]);
                *(u32x4*)(U + off) = w2; __builtin_amdgcn_sched_barrier(0); }
    }
};
struct EpiResF32 {
    static constexpr bool PERM = false, AFTER_DRAIN = false;
    float* C; const float* R; int ldc;
    __device__ __forceinline__ void operator()(const f32x4 (&acc)[2][2][4][2], const Unit& u, int wr, int wc, int fr, int fq) const {
        const int row0 = u.pm * BM + wr * 64 + fr, col0 = u.pn * BM + wc * 32 + 4 * fq;
#pragma unroll
        for (int ai = 0; ai < 2; ++ai)
#pragma unroll
            for (int m = 0; m < 4; ++m) { const size_t ro = (size_t)(row0 + ai * HALF + m * 16) * ldc + col0;
#pragma unroll
                for (int bj = 0; bj < 2; ++bj)
#pragma unroll
                    for (int n = 0; n < 2; ++n) { const f32x4 r = *(const f32x4*)(R + ro + bj * HALF + n * 16); *(f32x4*)(C + ro + bj * HALF + n * 16) = r + acc[ai][bj][m][n]; }  __builtin_amdgcn_sched_barrier(0); }
    }
};
struct EpiLogits {
    static constexpr bool PERM = false, AFTER_DRAIN = false;
    float* C;
    __device__ __forceinline__ void operator()(const f32x4 (&acc)[2][2][4][2], const Unit& u, int wr, int wc, int fr, int fq) const {
        if (wc >= 2 || u.pn != 0) return;
        const int row0 = u.pm * BM + wr * 64 + fr, col0 = wc * 32 + 4 * fq;
#pragma unroll
        for (int ai = 0; ai < 2; ++ai)
#pragma unroll
            for (int m = 0; m < 4; ++m) { float* rowp = C + (size_t)(row0 + ai * HALF + m * 16) * 64 + col0;
#pragma unroll
                for (int n = 0; n < 2; ++n) *(f32x4*)(rowp + n * 16) = acc[ai][0][m][n]; }
    }
};
template <class Epi, class Sched, bool ALIGN_EPI = false, bool SP2 = false>
__device__ __forceinline__ void gemm_phase(PG8_LAS unsigned char* lds, const Gemm g, const Sched& S, const Epi& E) {
    int tid_ = threadIdx.x; asm volatile("" : "+v"(tid_));
    const int tid = tid_, wid = __builtin_amdgcn_readfirstlane(tid >> 6), lane = tid & 63, wr = wid >> 2, wc = wid & 3, fr = lane & 15, fq = lane >> 4;
    const int K = g.K, nt = K / BK;
    unsigned voffA[2], voffB[2];
#pragma unroll
    for (int i = 0; i < 2; ++i) { int R, C; stage_rc(tid * 16 + i * 8192, R, C); const int Rb = Epi::PERM ? ((R & ~31) + perm32(R & 31)) : R;
        voffA[i] = (unsigned)(R * g.lda + C) * 2u; voffB[i] = (unsigned)(Rb * g.ldb + C) * 2u; }
    const size_t kstep = (size_t)(BK * 2);
    const size_t hsA = (size_t)HALF * g.lda * 2, hsB = (size_t)HALF * g.ldb * 2;
    const size_t tsA = 2 * hsA, tsB = 2 * hsB;
    const unsigned ldsw = (unsigned)wid * 1024u;
    const int aoff = lds_byte(wr * 64 + fr, fq * 8), boff = lds_byte(wc * 32 + fr, fq * 8);
#define PG8_SA(b, h) (((b) * 2 + (h)) * HTB)
#define PG8_SB(b, h) ((4 + (b) * 2 + (h)) * HTB)
#define PG8_STAGE(bufoff, gbase, voff) do { _Pragma("unroll") for (int _i = 0; _i < 2; ++_i) \
        __builtin_amdgcn_global_load_lds((const unsigned*)((const char*)(gbase) + (voff)[_i]), (PG8_LAS unsigned*)(lds + (bufoff) + ldsw + _i * 8192), 16, 0, 0); } while (0)
#define PG8_LDA(dst, b, h) do { _Pragma("unroll") for (int m = 0; m < 4; ++m) _Pragma("unroll") for (int k = 0; k < 2; ++k) dst[m][k] = *(const PG8_LAS bf16x8*)(lds + PG8_SA(b, h) + aoff + m * 2048 + k * 1024); } while (0)
#define PG8_LDB(dst, b, h) do { _Pragma("unroll") for (int n = 0; n < 2; ++n) _Pragma("unroll") for (int k = 0; k < 2; ++k) dst[n][k] = *(const PG8_LAS bf16x8*)(lds + PG8_SB(b, h) + boff + n * 2048 + k * 1024); } while (0)
#define PG8_MMA(ai, bj, At, Bt) do { __builtin_amdgcn_s_setprio(1); _Pragma("unroll") for (int m = 0; m < 4; ++m) _Pragma("unroll") for (int n = 0; n < 2; ++n) _Pragma("unroll") for (int k = 0; k < 2; ++k) \
        acc[ai][bj][m][n] = __builtin_amdgcn_mfma_f32_16x16x32_bf16(Bt[n][k], At[m][k], acc[ai][bj][m][n], 0, 0, 0); __builtin_amdgcn_s_setprio(0); } while (0)
#define PG8_WAIT_V(n) asm volatile("s_waitcnt vmcnt(" #n ")" ::: "memory")
#define PG8_WAIT_L(n) asm volatile("s_waitcnt lgkmcnt(" #n ")" ::: "memory")
#define PG8_BAR __builtin_amdgcn_s_barrier()
#define PG8_SCHED __builtin_amdgcn_sched_barrier(0)
    Unit cur, nxt; int ui = 0;
    if (!S.next(0, cur)) return;
    f32x4 acc[2][2][4][2];
#pragma unroll
    for (int a = 0; a < 2; ++a)
#pragma unroll
        for (int b = 0; b < 2; ++b)
#pragma unroll
            for (int m = 0; m < 4; ++m)
#pragma unroll
                for (int n = 0; n < 2; ++n) acc[a][b][m][n] = (f32x4){0.f, 0.f, 0.f, 0.f};
    bf16x8 At[4][2], B0[2][2], B1[2][2];
    const char* cA = (const char*)g.A + (size_t)cur.pm * tsA; const char* cB = (const char*)g.Bt + cur.boff + (size_t)cur.pn * tsB;
    S.a_ready(cur);
    if constexpr (SP2) {
        PG8_STAGE(PG8_SB(0, 0), cB, voffB); PG8_STAGE(PG8_SB(0, 1), cB + hsB, voffB); PG8_STAGE(PG8_SA(0, 0), cA, voffA); PG8_STAGE(PG8_SA(0, 1), cA + hsA, voffA);
        if (wr == 1) PG8_BAR;
        PG8_WAIT_V(2); PG8_BAR;
        PG8_STAGE(PG8_SB(1, 0), cB + kstep, voffB); PG8_STAGE(PG8_SA(1, 0), cA + kstep, voffA); PG8_STAGE(PG8_SB(1, 1), cB + hsB + kstep, voffB);
        PG8_WAIT_V(6); PG8_BAR;
    } else {
        PG8_STAGE(PG8_SB(0, 0), cB, voffB); PG8_STAGE(PG8_SA(0, 0), cA, voffA); PG8_STAGE(PG8_SB(0, 1), cB + hsB, voffB); PG8_STAGE(PG8_SA(0, 1), cA + hsA, voffA);
        if (wr == 1) PG8_BAR;
        PG8_WAIT_V(4); PG8_BAR;
        PG8_STAGE(PG8_SB(1, 0), cB + kstep, voffB); PG8_STAGE(PG8_SA(1, 0), cA + kstep, voffA); PG8_STAGE(PG8_SB(1, 1), cB + hsB + kstep, voffB);
        PG8_WAIT_V(6); PG8_BAR;
    }
    for (;;) {
        const bool has_next = S.next(ui + 1, nxt);
        const char* nA = has_next ? (const char*)g.A + (size_t)nxt.pm * tsA : cA; const char* nB = has_next ? (const char*)g.Bt + nxt.boff + (size_t)nxt.pn * tsB : cB;
        for (int t = 0; t < nt; t += 2) {
            const bool last = (t == nt - 2);
            const char* a1 = cA + (size_t)(t + 1) * kstep;
            const char* a2 = last ? nA : cA + (size_t)(t + 2) * kstep; const char* b2 = last ? nB : cB + (size_t)(t + 2) * kstep;
            const char* a3 = a2 + kstep; const char* b3 = b2 + kstep;
            if (last && has_next) S.a_ready(nxt);
            if constexpr (SP2) {
            PG8_LDB(B0, 0, 0); PG8_LDB(B1, 0, 1); PG8_SCHED; PG8_LDA(At, 0, 0); PG8_STAGE(PG8_SA(1, 1), a1 + hsA, voffA);
            PG8_WAIT_V(8); PG8_WAIT_L(0); PG8_BAR; PG8_MMA(0, 0, At, B0); PG8_MMA(0, 1, At, B1); PG8_BAR; PG8_SCHED;
            PG8_LDA(At, 0, 1); PG8_STAGE(PG8_SB(0, 0), b2, voffB); PG8_STAGE(PG8_SB(0, 1), b2 + hsB, voffB); PG8_STAGE(PG8_SA(0, 0), a2, voffA);
            PG8_WAIT_V(8); PG8_WAIT_L(0); PG8_BAR; PG8_MMA(1, 0, At, B0); PG8_MMA(1, 1, At, B1); PG8_BAR; PG8_SCHED;
            PG8_LDB(B0, 1, 0); PG8_LDB(B1, 1, 1); PG8_SCHED; PG8_LDA(At, 1, 0); PG8_STAGE(PG8_SA(0, 1), a2 + hsA, voffA);
            PG8_WAIT_V(8); PG8_WAIT_L(0); PG8_BAR; PG8_MMA(0, 0, At, B0); PG8_MMA(0, 1, At, B1); PG8_BAR; PG8_SCHED;
            PG8_LDA(At, 1, 1); PG8_STAGE(PG8_SB(1, 0), b3, voffB); PG8_STAGE(PG8_SB(1, 1), b3 + hsB, voffB); PG8_STAGE(PG8_SA(1, 0), a3, voffA);
            PG8_WAIT_V(8); PG8_WAIT_L(0); PG8_BAR; PG8_MMA(1, 0, At, B0); PG8_MMA(1, 1, At, B1); PG8_BAR; PG8_SCHED;
            } else {
            PG8_LDB(B0, 0, 0); PG8_SCHED; PG8_LDA(At, 0, 0); PG8_STAGE(PG8_SA(1, 1), a1 + hsA, voffA);
            PG8_WAIT_L(8); PG8_BAR; PG8_WAIT_L(0); PG8_MMA(0, 0, At, B0); PG8_BAR; PG8_SCHED;
            PG8_LDB(B1, 0, 1); PG8_STAGE(PG8_SB(0, 0), b2, voffB);
            PG8_BAR; PG8_WAIT_L(0); PG8_MMA(0, 1, At, B1); PG8_BAR;
            PG8_LDA(At, 0, 1); PG8_STAGE(PG8_SA(0, 0), a2, voffA);
            PG8_BAR; PG8_WAIT_L(0); PG8_MMA(1, 0, At, B0); PG8_BAR; PG8_SCHED;
            PG8_STAGE(PG8_SB(0, 1), b2 + hsB, voffB);
            PG8_WAIT_V(6); PG8_BAR; PG8_MMA(1, 1, At, B1); PG8_BAR;
            PG8_LDB(B0, 1, 0); PG8_SCHED; PG8_LDA(At, 1, 0); PG8_STAGE(PG8_SA(0, 1), a2 + hsA, voffA);
            PG8_WAIT_L(8); PG8_BAR; PG8_WAIT_L(0); PG8_MMA(0, 0, At, B0); PG8_BAR; PG8_SCHED;
            PG8_LDB(B1, 1, 1); PG8_STAGE(PG8_SB(1, 0), b3, voffB);
            PG8_BAR; PG8_WAIT_L(0); PG8_MMA(0, 1, At, B1); PG8_BAR;
            PG8_LDA(At, 1, 1); PG8_STAGE(PG8_SA(1, 0), a3, voffA);
            PG8_BAR; PG8_WAIT_L(0); PG8_MMA(1, 0, At, B0); PG8_BAR; PG8_SCHED;
            PG8_STAGE(PG8_SB(1, 1), b3 + hsB, voffB);
            PG8_WAIT_V(6); PG8_BAR; PG8_MMA(1, 1, At, B1); PG8_BAR;
            }
        }
        if constexpr (ALIGN_EPI) { if (wr == 0) PG8_BAR; }
        if constexpr (!Epi::AFTER_DRAIN) { E(acc, cur, wr, wc, fr, fq); S.done(cur); }
        if (!has_next) break;
#pragma unroll
        for (int a = 0; a < 2; ++a)
#pragma unroll
            for (int b = 0; b < 2; ++b)
#pragma unroll
                for (int m = 0; m < 4; ++m)
#pragma unroll
                    for (int n = 0; n < 2; ++n) acc[a][b][m][n] = (f32x4){0.f, 0.f, 0.f, 0.f};
        cur = nxt; cA = nA; cB = nB; ++ui;
        if constexpr (ALIGN_EPI) { if (wr == 1) PG8_BAR; }
    }
    PG8_WAIT_V(0);
    if constexpr (!ALIGN_EPI) { if (wr == 0) PG8_BAR; }
    PG8_BAR;
    if constexpr (Epi::AFTER_DRAIN) { E.fused(acc, cur, wr, wc, fr, fq, lds, wid, lane); S.done(cur); }
#undef PG8_SA
#undef PG8_SB
#undef PG8_STAGE
#undef PG8_LDA
#undef PG8_LDB
#undef PG8_MMA
#undef PG8_WAIT_V
#undef PG8_WAIT_L
#undef PG8_BAR
#undef PG8_SCHED
}
}

constexpr int NTOK = 32768, SEQ = 16384, DM = 1024;
constexpr float EPS = 1e-6f;
constexpr size_t MiB = 1u << 20;
constexpr size_t WS_CTL = 0, CTL_ZERO_BYTES = 1 * MiB;
constexpr size_t WS_WB = 1 * MiB;
constexpr size_t WB_MKV = WS_WB + 0 * MiB;
constexpr size_t WB_MEMN = WS_WB + 1 * MiB;
constexpr size_t WB_MKVO = WS_WB + 2 * MiB;
constexpr size_t WB_WR = WS_WB + 3 * MiB;
constexpr size_t WB_WIN = WS_WB + 4 * MiB;
constexpr size_t WB_WGT = WS_WB + 8 * MiB;
constexpr size_t WB_WOUT = WS_WB + 11 * MiB;
constexpr size_t WB_WGU = WS_WB + 16 * MiB;
constexpr size_t WB_WD = WS_WB + 80 * MiB;
constexpr size_t WS_HN = WS_WB + 112 * MiB;
constexpr size_t WS_AR = WS_HN + 64 * MiB;
constexpr size_t AR_PROJ = WS_AR;
constexpr size_t AR_XSC = WS_AR + 112 * MiB;
constexpr size_t AR_LA = WS_AR + 160 * MiB;
constexpr size_t AR_UU = WS_AR + 208 * MiB;
constexpr size_t AR_MIXL = WS_AR + 256 * MiB;
constexpr size_t AR_SA = WS_AR + 320 * MiB;
constexpr size_t AR_SH = WS_AR + 322 * MiB;
constexpr size_t AR_CARRY = WS_AR + 324 * MiB;
constexpr size_t AR_KN = WS_AR + 96 * MiB;
constexpr size_t AR_KIN = WS_AR + 100 * MiB;
constexpr size_t AR_QIW = WS_AR + 104 * MiB;
constexpr size_t AR_WI = WS_AR + 154 * MiB;
constexpr size_t AR_SEL = WS_AR + 121 * MiB;
constexpr size_t AR_MIXD = WS_AR + 160 * MiB;
constexpr size_t AR_XS = WS_AR;
constexpr size_t AR_ACT = WS_AR + 144 * MiB;
constexpr size_t AR_LOG = WS_AR + 216 * MiB;
constexpr size_t AR_EID = WS_AR + 224 * MiB;
constexpr size_t AR_GATE = WS_AR + 225 * MiB;
constexpr size_t AR_DEST = WS_AR + 226 * MiB;
constexpr size_t WS_END = WS_AR + 328 * MiB;
constexpr int CW_TMO = 0, CW_CODE = 1;
constexpr int CW_CNT = 256, CW_CUR = 320, CW_NT = 384, CW_LSTRIDE = 256;
constexpr int CW_TE = 1024, CW_TE_STRIDE = 512;
constexpr int CW_BAR = 4096;
constexpr int LDS_BYTES = 159744, MISC_OFF = 155648;

#define GAS __attribute__((address_space(1)))
#define LAS __attribute__((address_space(3)))
#define DI __device__ __forceinline__
typedef unsigned short bf16;
typedef unsigned v4u __attribute__((ext_vector_type(4)));
typedef unsigned v2u __attribute__((ext_vector_type(2)));
typedef int v4i __attribute__((ext_vector_type(4)));
typedef float f32x4 __attribute__((ext_vector_type(4)));
typedef float f32x16 __attribute__((ext_vector_type(16)));
typedef short bf16x8 __attribute__((ext_vector_type(8)));
typedef GAS unsigned gu32;
#define RLX_AGENT __ATOMIC_RELAXED, __HIP_MEMORY_SCOPE_AGENT
#define LDS_WAIT() asm volatile("s_waitcnt lgkmcnt(0)" ::: "memory")
DI unsigned f2bf(float f) { unsigned u = __builtin_bit_cast(unsigned, f); return (u + 0x7fffu + ((u >> 16) & 1u)) >> 16; }
DI unsigned pk2(float lo, float hi) { return f2bf(lo) | (f2bf(hi) << 16); }
DI float bflo(unsigned w) { return __uint_as_float(w << 16); }
DI float bfhi(unsigned w) { return __uint_as_float(w & 0xffff0000u); }
DI void unpack8(const v4u w, float (&f)[8]) { f[0] = bflo(w.x); f[1] = bfhi(w.x); f[2] = bflo(w.y); f[3] = bfhi(w.y); f[4] = bflo(w.z); f[5] = bfhi(w.z); f[6] = bflo(w.w); f[7] = bfhi(w.w); }
DI v4u pack8(const float (&f)[8]) { v4u w; w.x = pk2(f[0], f[1]); w.y = pk2(f[2], f[3]); w.z = pk2(f[4], f[5]); w.w = pk2(f[6], f[7]); return w; }
DI unsigned lds_add(LAS unsigned* p, unsigned v) { return __hip_atomic_fetch_add(p, v, __ATOMIC_RELAXED, __HIP_MEMORY_SCOPE_WORKGROUP); }
DI float wave_sum(float v) {
#pragma unroll
    for (int o = 1; o < 64; o <<= 1) v += __shfl_xor(v, o);
    return v;
}

#define XB_TMO      128
#define XB_XCNT(j)  (256  + 64 * (j))
#define XB_XSUB(j)  (1280 + 64 * (j))
#define XB_XGEN(j)  (2304 + 64 * (j))
#define XB_TOP      3328
#define XB_TOPGEN   3392
#define XCD_BAR_WORDS 3456
#define XB_SPIN_CAP (1u << 22)
DI unsigned xb_ld(unsigned* p)              { return __hip_atomic_load(p, __ATOMIC_RELAXED, __HIP_MEMORY_SCOPE_AGENT); }
DI unsigned xb_add(unsigned* p, unsigned v) { return __hip_atomic_fetch_add(p, v, __ATOMIC_RELAXED, __HIP_MEMORY_SCOPE_AGENT); }
DI unsigned xb_xcc_id() { return (unsigned)__builtin_amdgcn_s_getreg((3 << 11) | 20) & 0xFu; }
#define XB_SPIN(cond, bar) do { unsigned _sp = 0; while (cond) { __builtin_amdgcn_s_sleep(1); \
    if ((++_sp & 255u) == 0u) { if (xb_ld(&(bar)[XB_TMO])) break; if (_sp > XB_SPIN_CAP) { atomicAdd(&(bar)[XB_TMO], 1u); break; } } } } while (0)
struct XcdBarrier { unsigned* bar; unsigned x; volatile LAS unsigned* st; };
DI XcdBarrier xcd_barrier_post(unsigned* bar, volatile LAS unsigned* st) {
    XcdBarrier b; b.bar = bar; b.x = xb_xcc_id(); b.st = st;
    if (threadIdx.x == 0) (void)xb_add(&bar[XB_XCNT(b.x)], 1u);
    return b;
}
DI void xcd_barrier_complete(unsigned* bar, unsigned x, unsigned& nloc, unsigned& nx) {
    const unsigned G = gridDim.x * gridDim.y * gridDim.z;
    unsigned sum, cnt, mine, sp = 0u;
    for (;;) {
        sum = 0u; cnt = 0u; mine = 0u;
#pragma unroll
        for (unsigned j = 0; j < 16; ++j) { const unsigned c = xb_ld(&bar[XB_XCNT(j)]); sum += c; cnt += (c > 0u) ? 1u : 0u; mine = (j == x) ? c : mine; }
        if (sum == G) break;
        __builtin_amdgcn_s_sleep(1);
        if ((++sp & 255u) == 0u) { if (xb_ld(&bar[XB_TMO])) break; if (sp > XB_SPIN_CAP) { atomicAdd(&bar[XB_TMO], 1u); break; } }
    }
    nloc = mine > 0u ? mine : 1u; nx = cnt > 0u ? cnt : 1u;
}
DI void xcd_barrier(const XcdBarrier& b) {
    asm volatile("s_waitcnt vmcnt(0)" ::: "memory");
    __syncthreads();
    if (threadIdx.x == 0) {
        unsigned* bar = b.bar;
        __builtin_amdgcn_s_waitcnt(0);
        unsigned nloc = b.st[0], nx = b.st[1];
        if (nloc == 0u) { xcd_barrier_complete(bar, b.x, nloc, nx); b.st[0] = nloc; b.st[1] = nx; }
        const unsigned old = xb_add(&bar[XB_XSUB(b.x)], 1u);
        const unsigned gen = old / nloc;
        if (old + 1u == (gen + 1u) * nloc) {
            __builtin_amdgcn_fence(__ATOMIC_RELEASE, "agent");
            asm volatile("s_waitcnt vmcnt(0)" ::: "memory");
            const unsigned og = xb_add(&bar[XB_TOP], 1u);
            const unsigned tg = og / nx;
            if (og + 1u == (tg + 1u) * nx) xb_add(&bar[XB_TOPGEN], 1u);
            else XB_SPIN(xb_ld(&bar[XB_TOPGEN]) == tg, bar);
            __builtin_amdgcn_fence(__ATOMIC_ACQUIRE, "agent");
            xb_add(&bar[XB_XGEN(b.x)], 1u);
            asm volatile("s_waitcnt vmcnt(0)" ::: "memory");
        } else {
            XB_SPIN(xb_ld(&bar[XB_XGEN(b.x)]) == gen, bar);
            __builtin_amdgcn_fence(__ATOMIC_ACQUIRE, "agent");
            asm volatile("s_waitcnt vmcnt(0)" ::: "memory");
        }
    }
    __syncthreads();
}

struct Params { const float* in[29]; float* out; unsigned char* ws; };
struct PV { unsigned char* ws; float* out; LAS unsigned long long* tab; };
DI const float* pin(const PV& P, int i) { const unsigned long long v = P.tab[i]; const unsigned lo = __builtin_amdgcn_readfirstlane((unsigned)v), hi = __builtin_amdgcn_readfirstlane((unsigned)(v >> 32)); return (const float*)(((unsigned long long)hi << 32) | lo); }
struct Ctx { LAS unsigned char* lds; int tid, lane, wave, G, blk, gw, NGW; };
DI Ctx relaunder(const Ctx& c0) { Ctx c = c0; int t = threadIdx.x; asm volatile("" : "+v"(t)); c.tid = t; c.lane = t & 63; c.wave = __builtin_amdgcn_readfirstlane(t >> 6); c.gw = c.blk * 8 + c.wave; return c; }
enum { I_X = 0, I_MEM, I_NORM_MIX, I_NORM_FFN, I_MEM_NORM, I_W_MEM_KV, I_XQ_NORM, I_XK_NORM, I_W_OUT, I_LRU_W_IN, I_LRU_CONV_W, I_LRU_CONV_B, I_LRU_W_A, I_LRU_B_A,
       I_LRU_W_X, I_LRU_B_X, I_LRU_LAMBDA, I_DSA_W_IN, I_DSA_Q_NORM, I_DSA_K_NORM, I_DSA_W_UV, I_REL_BIAS, I_MOE_W_GROUP, I_MOE_B_GROUP, I_MOE_W_ROUTER, I_MOE_B_ROUTER,
       I_MOE_W_GATE, I_MOE_W_UP, I_MOE_W_DOWN };

DI void tr_load(const float* __restrict__ W, int ldw, f32x4 (&v)[16], int lane) {
    const int m = lane & 15, q = lane >> 4;
#pragma unroll
    for (int i = 0; i < 8; ++i) { const int kk = 8 * i + 2 * q; v[2 * i] = *(const f32x4*)(W + (size_t)kk * ldw + 4 * m); v[2 * i + 1] = *(const f32x4*)(W + (size_t)(kk + 1) * ldw + 4 * m); }
}
DI void tr_store(const f32x4 (&v)[16], bf16* __restrict__ WT, int ldk, LAS unsigned* scr, int lane) {
    const int m = lane & 15, q = lane >> 4;
#pragma unroll
    for (int i = 0; i < 8; ++i) {
        const f32x4 v0 = v[2 * i], v1 = v[2 * i + 1];
        const int sw = 4 * (i ^ (m & 7)) + q;
        scr[(4 * m + 0) * 32 + sw] = pk2(v0.x, v1.x);
        scr[(4 * m + 1) * 32 + sw] = pk2(v0.y, v1.y);
        scr[(4 * m + 2) * 32 + sw] = pk2(v0.z, v1.z);
        scr[(4 * m + 3) * 32 + sw] = pk2(v0.w, v1.w);
    }
    LDS_WAIT();
#pragma unroll
    for (int r = 0; r < 8; ++r) {
        const int n = 8 * r + (lane >> 3), c = lane & 7;
        const v4u o = *(const LAS v4u*)(scr + n * 32 + 4 * (c ^ ((n >> 2) & 7)));
        *(v4u*)(WT + (size_t)n * ldk + 8 * c) = o;
    }
    LDS_WAIT();
}
DI void rms_finish(f32x4 (&v)[4], const float* __restrict__ g, bf16* __restrict__ orow, int lane) {
    float s = 0.f;
#pragma unroll
    for (int j = 0; j < 4; ++j) s += (v[j].x * v[j].x + v[j].y * v[j].y) + (v[j].z * v[j].z + v[j].w * v[j].w);
    const float r = 1.0f / sqrtf(wave_sum(s) * (1.0f / 1024.0f) + EPS);
    const f32x4* gr = (const f32x4*)g + lane; v2u* o8 = (v2u*)orow + lane;
#pragma unroll
    for (int j = 0; j < 4; ++j) { const f32x4 gg = gr[64 * j]; v[j] = v[j] * r * gg; v2u o; o.x = pk2(v[j].x, v[j].y); o.y = pk2(v[j].z, v[j].w); o8[64 * j] = o; }
}
DI void rms_row(const float* __restrict__ xrow, const float* __restrict__ g, bf16* __restrict__ orow, int lane, f32x4 (&v)[4]) {
    const f32x4* xr = (const f32x4*)xrow + lane;
#pragma unroll
    for (int j = 0; j < 4; ++j) v[j] = xr[64 * j];
    rms_finish(v, g, orow, lane);
}
DI void wi_row(const f32x4 (&v)[4], const LAS f32x4* wiw, float* WI, int r, int lane) {
    f32x4 a = {0.f, 0.f, 0.f, 0.f};
#pragma unroll
    for (int j = 0; j < 4; ++j) { const int k0 = 4 * (lane + 64 * j); a += v[j].x * wiw[k0] + v[j].y * wiw[k0 + 1] + v[j].z * wiw[k0 + 2] + v[j].w * wiw[k0 + 3]; }
    a.x = wave_sum(a.x); a.y = wave_sum(a.y); a.z = wave_sum(a.z); a.w = wave_sum(a.w);
    if (lane == 0) *(f32x4*)(WI + (size_t)r * 4) = a * 0.5f;
}
struct TrJob { const float* src; bf16* dst; int ldw, ldk, nN, items; };
struct TileDesc { const float* src; bf16* dst; int ldw, ldk; };
template <int layer> DI void prep_setup(const Ctx& c, const PV& P) {
    unsigned char* ws = P.ws;
    LAS TrJob* jobs = (LAS TrJob*)(c.lds + 65536);
    LAS int* njp = (LAS int*)(c.lds + 65536 + 512);
    LAS f32x4* wiw = (LAS f32x4*)(c.lds + 69632);
    __syncthreads();
    if (c.tid == 0) {
        int nj = 0;
#define ADDJOB(S_, D_, K_, N_, LDW_, LDK_) do { jobs[nj].src = (S_); jobs[nj].dst = (D_); jobs[nj].ldw = (LDW_); jobs[nj].ldk = (LDK_); jobs[nj].nN = (N_) / 64; jobs[nj].items = ((K_) / 64) * ((N_) / 64); ++nj; } while (0)
        ADDJOB(pin(P, I_W_MEM_KV) + (size_t)layer * 1024 * 512, (bf16*)(ws + WB_MKV), 1024, 512, 512, 1024);
        if (layer == 0) {
            ADDJOB(pin(P, I_LRU_W_IN), (bf16*)(ws + WB_WIN), 1024, 1792, 1792, 1024);
            ADDJOB(pin(P, I_W_OUT), (bf16*)(ws + WB_WOUT), 1024, 1024, 1024, 1024);
        } else {
            ADDJOB(pin(P, I_DSA_W_IN), (bf16*)(ws + WB_WIN), 1024, 1280, 1540, 1024);
            ADDJOB(pin(P, I_DSA_W_IN) + 1284, (bf16*)(ws + WB_WIN) + (size_t)1280 * 1024, 1024, 256, 1540, 1024);
            ADDJOB(pin(P, I_W_OUT) + (size_t)1024 * 1024 + (size_t)768 * 1024, (bf16*)(ws + WB_WOUT) + 1536, 256, 1024, 1024, 1792);
        }
#undef ADDJOB
        *njp = nj;
    }
    if (layer == 1) { const float* win = pin(P, I_DSA_W_IN); for (int k = c.tid; k < 1024; k += 512) wiw[k] = *(const f32x4*)(win + (size_t)k * 1540 + 1280); }
    __syncthreads();
}
template <int layer> DI void prep_weights(const Ctx& c, const PV& P) {
    unsigned char* ws = P.ws;
    LAS unsigned* scr = (LAS unsigned*)(c.lds + c.wave * 8192);
    LAS TrJob* jobs = (LAS TrJob*)(c.lds + 65536);
    LAS int* njp = (LAS int*)(c.lds + 65536 + 512);
    { const float* gm = pin(P, I_MEM_NORM) + layer * 1024; const float* mem = pin(P, I_MEM); bf16* MEMN = (bf16*)(ws + WB_MEMN);
      for (int r = c.gw; r < 512; r += c.NGW) { f32x4 v[4]; rms_row(mem + (size_t)r * 1024, gm, MEMN + (size_t)r * 1024, c.lane, v); } }
    {
        const int nj = *njp; int gen_total = 0;
        for (int j = 0; j < nj; ++j) gen_total += jobs[j].items;
        const int total = gen_total + 3 * 32 * 128;
        const float* wg = pin(P, I_MOE_W_GATE) + (size_t)layer * 32 * 1024 * 512;
        const float* wu = pin(P, I_MOE_W_UP) + (size_t)layer * 32 * 1024 * 512;
        const float* wd = pin(P, I_MOE_W_DOWN) + (size_t)layer * 32 * 512 * 1024;
        bf16* WGU = (bf16*)(ws + WB_WGU); bf16* WD = (bf16*)(ws + WB_WD);
#define TILE_DESC(IT_, D_) do { const int it_ = (IT_); \
            if (it_ < gen_total) { int r = it_, j = 0; while (r >= jobs[j].items) { r -= jobs[j].items; ++j; } \
                const int nN = jobs[j].nN, kb = r / nN, nb = r % nN; D_.ldw = jobs[j].ldw; D_.ldk = jobs[j].ldk; \
                D_.src = jobs[j].src + (size_t)kb * 64 * D_.ldw + nb * 64; D_.dst = jobs[j].dst + (size_t)nb * 64 * D_.ldk + kb * 64; } \
            else { const int r = it_ - gen_total, type = r >> 12, e = (r >> 7) & 31, ti = r & 127; \
                if (type < 2) { const int kb = ti >> 3, nb = ti & 7; D_.ldw = 512; D_.ldk = 1024; \
                    D_.src = (type == 0 ? wg : wu) + (size_t)e * 1024 * 512 + (size_t)kb * 64 * 512 + nb * 64; \
                    D_.dst = WGU + (size_t)e * 1024 * 1024 + (size_t)(256 * (nb >> 1) + 64 * (nb & 1) + 128 * type) * 1024 + kb * 64; } \
                else { const int kb = ti >> 4, nb = ti & 15; D_.ldw = 1024; D_.ldk = 512; \
                    D_.src = wd + (size_t)e * 512 * 1024 + (size_t)kb * 64 * 1024 + nb * 64; \
                    D_.dst = WD + (size_t)e * 1024 * 512 + (size_t)nb * 64 * 512 + kb * 64; } } } while (0)
        if (c.gw < total) {
            TileDesc d0, d1; f32x4 va[16], vb[16];
            TILE_DESC(c.gw, d0); tr_load(d0.src, d0.ldw, va, c.lane);
            for (int it = c.gw; it < total; it += 2 * c.NGW) {
                const int it1 = it + c.NGW, it2 = it + 2 * c.NGW; const bool has1 = it1 < total, has2 = it2 < total;
                TILE_DESC(has1 ? it1 : it, d1); tr_load(d1.src, d1.ldw, vb, c.lane);
                tr_store(va, d0.dst, d0.ldk, scr, c.lane);
                TILE_DESC(has2 ? it2 : it, d0); tr_load(d0.src, d0.ldw, va, c.lane);
                if (has1) tr_store(vb, d1.dst, d1.ldk, scr, c.lane);
            }
        }
#undef TILE_DESC
    }
    const int gtid = c.blk * 512 + c.tid, nthr = c.G * 512;
    {
        const float* wgr = pin(P, I_MOE_W_GROUP) + (size_t)layer * 1024 * 4; const float* wrt = pin(P, I_MOE_W_ROUTER) + (size_t)layer * 1024 * 32;
        bf16* WR = (bf16*)(ws + WB_WR);
        for (int i = gtid; i < 256 * 128; i += nthr) { const int row = i >> 7, k8 = i & 127; float f[8];
#pragma unroll
            for (int kk = 0; kk < 8; ++kk) { const int k = 8 * k8 + kk; f[kk] = row < 4 ? wgr[k * 4 + row] : (row < 36 ? wrt[k * 32 + (row - 4)] : 0.f); }
            *(v4u*)(WR + (size_t)row * 1024 + 8 * k8) = pack8(f); }
    }
    if (layer == 0) {
        bf16* WGT = (bf16*)(ws + WB_WGT); const float* wa = pin(P, I_LRU_W_A); const float* wx = pin(P, I_LRU_W_X);
        for (int i = gtid; i < 1536 * 96; i += nthr) { const int rho = i / 96, k8 = i % 96; const int pn = rho >> 8, bj = (rho >> 7) & 1, j = rho & 127, ch = 128 * pn + j, blkc = ch / 192, cc = ch % 192;
            const float* src = (bj ? wx : wa) + (size_t)blkc * 192 * 192; float f[8];
            const int k0 = 8 * k8; const bool in = (k0 / 192) == blkc;
#pragma unroll
            for (int kk = 0; kk < 8; ++kk) f[kk] = in ? src[((k0 + kk) % 192) * 192 + cc] : 0.f;
            *(v4u*)(WGT + (size_t)rho * 768 + k0) = pack8(f); }
    } else {
        const float* wuv = pin(P, I_DSA_W_UV); const float* wo = pin(P, I_W_OUT) + (size_t)1024 * 1024; bf16* WO = (bf16*)(ws + WB_WOUT);
        for (int i = gtid; i < 1024 * 12 * 16; i += nthr) { const int n = i & 1023, rest = i >> 10, c8 = rest & 15, h = rest >> 4; float a[8] = {0.f, 0.f, 0.f, 0.f, 0.f, 0.f, 0.f, 0.f};
            for (int j = 0; j < 64; ++j) { const float w = wo[(size_t)(64 * h + j) * 1024 + n];
#pragma unroll
                for (int cc = 0; cc < 8; ++cc) a[cc] += wuv[((size_t)h * 128 + 8 * c8 + cc) * 64 + j] * w; }
            *(v4u*)(WO + (size_t)n * 1792 + h * 128 + 8 * c8) = pack8(a); }
    }
}
DI void phase_prep0(const Ctx& c0, const PV& P) {
    const Ctx c = relaunder(c0);
    prep_setup<0>(c, P);
    { const float* xin = pin(P, I_X); const float* g = pin(P, I_NORM_MIX); bf16* HN = (bf16*)(P.ws + WS_HN);
      for (int r = c.gw; r < NTOK; r += 2 * c.NGW) {
          const int r1 = r + c.NGW; const bool has1 = r1 < NTOK; const int rr1 = has1 ? r1 : r;
          f32x4 v0[4], v1[4];
          const f32x4* x0 = (const f32x4*)(xin + (size_t)r * 1024) + c.lane; const f32x4* x1 = (const f32x4*)(xin + (size_t)rr1 * 1024) + c.lane;
#pragma unroll
          for (int j = 0; j < 4; ++j) { v0[j] = x0[64 * j]; v1[j] = x1[64 * j]; }
          rms_finish(v0, g, HN + (size_t)r * 1024, c.lane);
          if (has1) rms_finish(v1, g, HN + (size_t)r1 * 1024, c.lane);
      } }
    prep_weights<0>(c, P);
}

DI f32x4 mfma16(bf16x8 a, bf16x8 b, f32x4 c) { return __builtin_amdgcn_mfma_f32_16x16x32_bf16(a, b, c, 0, 0, 0); }

template <int layer, int ldp, int xq_off, int ldm, int xo_off> DI void phase_xattn(const Ctx& c0, const PV& P, const bf16* __restrict__ PROJ, bf16* __restrict__ MIX) {
    const Ctx c = relaunder(c0);
    const bf16* MKVO = (const bf16*)(P.ws + WB_MKVO);
    const float* xqg = pin(P, I_XQ_NORM) + layer * 64; const float* xkg = pin(P, I_XK_NORM) + layer * 64;
    LAS bf16* Ks = (LAS bf16*)c.lds;
    LAS bf16* Vt = (LAS bf16*)(c.lds + 36864);
    const int lane = c.lane, l15 = lane & 15, g = lane >> 4;
    for (int unit = c.blk; unit < 256; unit += c.G) {
        const int b = unit >> 7, h = (unit >> 5) & 3, tr = unit & 31, tok0 = b * SEQ + tr * 512;
        __syncthreads();
#pragma unroll
        for (int i = 0; i < 4; ++i) { const int p = c.tid + 512 * i, key = p >> 3, ch = p & 7;
            const bf16* src = MKVO + (size_t)(b * 256 + key) * 512 + h * 64 + ch * 8;
            float f[8]; unpack8(*(const v4u*)src, f);
            float ss = 0.f;
#pragma unroll
            for (int j = 0; j < 8; ++j) ss += f[j] * f[j];
            ss += __shfl_xor(ss, 1); ss += __shfl_xor(ss, 2); ss += __shfl_xor(ss, 4);
            const float r = 1.0f / sqrtf(ss * (1.0f / 64.0f) + EPS);
#pragma unroll
            for (int j = 0; j < 8; ++j) f[j] = f[j] * r * xkg[ch * 8 + j];
            *(LAS v4u*)(Ks + key * 72 + ch * 8) = pack8(f);
            const v4u vw = *(const v4u*)(src + 256);
            const unsigned ww[4] = {vw.x, vw.y, vw.z, vw.w};
#pragma unroll
            for (int j = 0; j < 4; ++j) { Vt[(ch * 8 + 2 * j) * 264 + key] = (bf16)(ww[j] & 0xffffu); Vt[(ch * 8 + 2 * j + 1) * 264 + key] = (bf16)(ww[j] >> 16); }
        }
        __syncthreads();
#pragma unroll 1
        for (int tile = c.wave; tile < 32; tile += 8) {
            const int row = tok0 + tile * 16 + l15;
            const bf16* qp = PROJ + (size_t)row * ldp + xq_off + h * 64 + 8 * g;
            float q0[8], q1[8]; unpack8(*(const v4u*)qp, q0); unpack8(*(const v4u*)(qp + 32), q1);
            float ss = 0.f;
#pragma unroll
            for (int j = 0; j < 8; ++j) ss += q0[j] * q0[j] + q1[j] * q1[j];
            ss += __shfl_xor(ss, 16); ss += __shfl_xor(ss, 32);
            const float r = 0.125f / sqrtf(ss * (1.0f / 64.0f) + EPS);
#pragma unroll
            for (int j = 0; j < 8; ++j) { q0[j] = q0[j] * r * xqg[8 * g + j]; q1[j] = q1[j] * r * xqg[32 + 8 * g + j]; }
            const bf16x8 B0 = __builtin_bit_cast(bf16x8, pack8(q0)), B1 = __builtin_bit_cast(bf16x8, pack8(q1));
            f32x4 S[16];
#pragma unroll
            for (int kt = 0; kt < 16; ++kt) {
                const bf16x8 A0 = *(const LAS bf16x8*)(Ks + (16 * kt + l15) * 72 + 8 * g), A1 = *(const LAS bf16x8*)(Ks + (16 * kt + l15) * 72 + 32 + 8 * g);
                f32x4 z = {0.f, 0.f, 0.f, 0.f}; z = mfma16(A0, B0, z); S[kt] = mfma16(A1, B1, z);
                if ((kt & 3) == 3) __builtin_amdgcn_sched_barrier(0);
            }
            float mx = -3.0e38f;
#pragma unroll
            for (int kt = 0; kt < 16; ++kt) mx = fmaxf(mx, fmaxf(fmaxf(S[kt][0], S[kt][1]), fmaxf(S[kt][2], S[kt][3])));
            mx = fmaxf(mx, __shfl_xor(mx, 16)); mx = fmaxf(mx, __shfl_xor(mx, 32));
            float l = 0.f;
#pragma unroll
            for (int kt = 0; kt < 16; ++kt) {
#pragma unroll
                for (int i = 0; i < 4; ++i) { const float p = __expf(S[kt][i] - mx); S[kt][i] = p; l += p; } }
            l += __shfl_xor(l, 16); l += __shfl_xor(l, 32);
            f32x4 O[4];
#pragma unroll
            for (int dt = 0; dt < 4; ++dt) O[dt] = (f32x4){0.f, 0.f, 0.f, 0.f};
#pragma unroll
            for (int jb = 0; jb < 8; ++jb) {
                v4u pw; pw.x = pk2(S[2 * jb][0], S[2 * jb][1]); pw.y = pk2(S[2 * jb][2], S[2 * jb][3]); pw.z = pk2(S[2 * jb + 1][0], S[2 * jb + 1][1]); pw.w = pk2(S[2 * jb + 1][2], S[2 * jb + 1][3]);
                const bf16x8 Pb = __builtin_bit_cast(bf16x8, pw);
#pragma unroll
                for (int dt = 0; dt < 4; ++dt) { const LAS bf16* vp = Vt + (16 * dt + l15) * 264 + 32 * jb + 4 * g;
                    const v2u a0 = *(const LAS v2u*)vp, a1 = *(const LAS v2u*)(vp + 16);
                    v4u aw; aw.x = a0.x; aw.y = a0.y; aw.z = a1.x; aw.w = a1.y;
                    O[dt] = mfma16(__builtin_bit_cast(bf16x8, aw), Pb, O[dt]); }
                __builtin_amdgcn_sched_barrier(0);
            }
            const float il = 1.0f / l;
            bf16* op = MIX + (size_t)row * ldm + xo_off + h * 64 + 4 * g;
#pragma unroll
            for (int dt = 0; dt < 4; ++dt) { v2u o; o.x = pk2(O[dt][0] * il, O[dt][1] * il); o.y = pk2(O[dt][2] * il, O[dt][3] * il); *(v2u*)(op + 16 * dt) = o; }
        }
    }
}

DI void phase_conv(const Ctx& c0, const PV& P) {
    const Ctx c = relaunder(c0);
    const bf16* PROJ = (const bf16*)(P.ws + AR_PROJ); bf16* XSC = (bf16*)(P.ws + AR_XSC);
    const float* cw = pin(P, I_LRU_CONV_W); const float* cb = pin(P, I_LRU_CONV_B);
    const int gtid = c.blk * 512 + c.tid, nthr = c.G * 512;
    for (int i = gtid; i < NTOK * 96; i += nthr) { const int row = i / 96, c8 = i % 96, t = row & (SEQ - 1); float a[8];
#pragma unroll
        for (int j = 0; j < 8; ++j) a[j] = cb[8 * c8 + j];
#pragma unroll
        for (int k = 0; k < 4; ++k) { if (t - 3 + k >= 0) { float f[8]; unpack8(*(const v4u*)(PROJ + (size_t)(row - 3 + k) * 1792 + 8 * c8), f);
#pragma unroll
                for (int j = 0; j < 8; ++j) a[j] += cw[k * 768 + 8 * c8 + j] * f[j]; } }
        *(v4u*)(XSC + (size_t)row * 768 + 8 * c8) = pack8(a); }
}
DI void phase_scanA(const Ctx& c0, const PV& P) {
    const Ctx c = relaunder(c0);
    const bf16* LA = (const bf16*)(P.ws + AR_LA); const bf16* UU = (const bf16*)(P.ws + AR_UU); float* SA = (float*)(P.ws + AR_SA); float* SH = (float*)(P.ws + AR_SH);
    const int gtid = c.blk * 512 + c.tid, nthr = c.G * 512;
    for (int i = gtid; i < 512 * 192; i += nthr) { const int chunk = i / 192, c4 = i % 192; float h[4] = {0.f, 0.f, 0.f, 0.f}, sl[4] = {0.f, 0.f, 0.f, 0.f};
        const size_t base = (size_t)chunk * 64 * 768 + 4 * c4;
#pragma unroll 8
        for (int r = 0; r < 64; ++r) { const v2u lw = *(const v2u*)(LA + base + (size_t)r * 768), uw = *(const v2u*)(UU + base + (size_t)r * 768);
            const float l4[4] = {bflo(lw.x), bfhi(lw.x), bflo(lw.y), bfhi(lw.y)}, u4[4] = {bflo(uw.x), bfhi(uw.x), bflo(uw.y), bfhi(uw.y)};
#pragma unroll
            for (int j = 0; j < 4; ++j) { h[j] = __expf(l4[j]) * h[j] + u4[j]; sl[j] += l4[j]; } }
        *(f32x4*)(SA + (size_t)chunk * 768 + 4 * c4) = (f32x4){__expf(sl[0]), __expf(sl[1]), __expf(sl[2]), __expf(sl[3])};
        *(f32x4*)(SH + (size_t)chunk * 768 + 4 * c4) = (f32x4){h[0], h[1], h[2], h[3]}; }
}
DI void phase_scanB(const Ctx& c0, const PV& P) {
    const Ctx c = relaunder(c0);
    const float* SA = (const float*)(P.ws + AR_SA); const float* SH = (const float*)(P.ws + AR_SH); float* CARRY = (float*)(P.ws + AR_CARRY);
    LAS float* segP = (LAS float*)c.lds; LAS float* segQ = segP + 512;
    for (int u = c.blk; u < 48; u += c.G) { const int b = u / 24, cg = u % 24, seg = c.tid >> 5, ch = 32 * cg + (c.tid & 31);
        const size_t base = (size_t)(b * 256 + seg * 16) * 768 + ch;
        float A[16], H[16];
#pragma unroll
        for (int i = 0; i < 16; ++i) { A[i] = SA[base + (size_t)i * 768]; H[i] = SH[base + (size_t)i * 768]; }
        float Pp[16], Qq[16]; float pp = 1.f, qq = 0.f;
#pragma unroll
        for (int i = 0; i < 16; ++i) { Pp[i] = pp; Qq[i] = qq; qq = A[i] * qq + H[i]; pp = A[i] * pp; }
        __syncthreads();
        segP[c.tid] = pp; segQ[c.tid] = qq;
        __syncthreads();
        float hin = 0.f;
        for (int s = 0; s < seg; ++s) hin = segP[s * 32 + (c.tid & 31)] * hin + segQ[s * 32 + (c.tid & 31)];
#pragma unroll
        for (int i = 0; i < 16; ++i) CARRY[base + (size_t)i * 768] = Pp[i] * hin + Qq[i];
    }
}
DI void phase_scanC(const Ctx& c0, const PV& P) {
    const Ctx c = relaunder(c0);
    const bf16* LA = (const bf16*)(P.ws + AR_LA); const bf16* UU = (const bf16*)(P.ws + AR_UU); const float* CARRY = (const float*)(P.ws + AR_CARRY);
    const bf16* PROJ = (const bf16*)(P.ws + AR_PROJ); bf16* MIX = (bf16*)(P.ws + AR_MIXL);
    const int gtid = c.blk * 512 + c.tid, nthr = c.G * 512;
    for (int i = gtid; i < 512 * 192; i += nthr) { const int chunk = i / 192, c4 = i % 192;
        const f32x4 h0 = *(const f32x4*)(CARRY + (size_t)chunk * 768 + 4 * c4); float h[4] = {h0.x, h0.y, h0.z, h0.w};
        const size_t base = (size_t)chunk * 64 * 768 + 4 * c4;
#pragma unroll 8
        for (int r = 0; r < 64; ++r) { const size_t row = (size_t)chunk * 64 + r;
            const v2u lw = *(const v2u*)(LA + base + (size_t)r * 768), uw = *(const v2u*)(UU + base + (size_t)r * 768), gw = *(const v2u*)(PROJ + row * 1792 + 768 + 4 * c4);
            const float l4[4] = {bflo(lw.x), bfhi(lw.x), bflo(lw.y), bfhi(lw.y)}, u4[4] = {bflo(uw.x), bfhi(uw.x), bflo(uw.y), bfhi(uw.y)}, g4[4] = {bflo(gw.x), bfhi(gw.x), bflo(gw.y), bfhi(gw.y)};
            float y[4];
#pragma unroll
            for (int j = 0; j < 4; ++j) { h[j] = __expf(l4[j]) * h[j] + u4[j]; y[j] = h[j] * g4[j]; }
            v2u o; o.x = pk2(y[0], y[1]); o.y = pk2(y[2], y[3]); *(v2u*)(MIX + row * 1024 + 4 * c4) = o; }
    }
}

template <int layer> DI void phase_norm_route(const Ctx& c0, const PV& P) {
    const Ctx c = relaunder(c0);
    const float* g = pin(P, I_NORM_FFN) + layer * 1024; bf16* HN = (bf16*)(P.ws + WS_HN); const bf16* WR = (const bf16*)(P.ws + WB_WR);
    int* EID = (int*)(P.ws + AR_EID); float* GATE = (float*)(P.ws + AR_GATE);
    const float* bg = pin(P, I_MOE_B_GROUP) + layer * 4; const float* br = pin(P, I_MOE_B_ROUTER) + layer * 32;
    unsigned* ctl = (unsigned*)(P.ws + WS_CTL);
    constexpr int WRS = 1032, LGS = 52;
    LAS bf16* WRs = (LAS bf16*)c.lds;
    LAS float* lg = (LAS float*)(c.lds + 99328 + c.wave * 3328);
    LAS unsigned* hist = (LAS unsigned*)(c.lds + 99328 + 8 * 3328);
    const int lane = c.lane, l15 = lane & 15, gq = lane >> 4;
    __syncthreads();
    for (int i = c.tid; i < 48 * 128; i += 512) { const int row = i >> 7, ch = i & 127; *(LAS v4u*)(WRs + row * WRS + 8 * ch) = *(const v4u*)(WR + (size_t)row * 1024 + 8 * ch); }
    if (c.tid < 32) hist[c.tid] = 0u;
    __syncthreads();
    for (int tb = c.blk; tb < NTOK / 128; tb += c.G) {
        const int row0 = tb * 128 + c.wave * 16;
#pragma unroll 1
        for (int r = 0; r < 16; r += 2) {
            f32x4 v0[4], v1[4];
            const f32x4* x0 = (const f32x4*)(P.out + (size_t)(row0 + r) * 1024) + lane; const f32x4* x1 = (const f32x4*)(P.out + (size_t)(row0 + r + 1) * 1024) + lane;
#pragma unroll
            for (int j = 0; j < 4; ++j) { v0[j] = x0[64 * j]; v1[j] = x1[64 * j]; }
            rms_finish(v0, g, HN + (size_t)(row0 + r) * 1024, lane); rms_finish(v1, g, HN + (size_t)(row0 + r + 1) * 1024, lane);
        }
        asm volatile("s_waitcnt vmcnt(0)" ::: "memory");
        f32x4 acc[3];
#pragma unroll
        for (int nt = 0; nt < 3; ++nt) acc[nt] = (f32x4){0.f, 0.f, 0.f, 0.f};
        const bf16* ap = HN + (size_t)(row0 + l15) * 1024 + 8 * gq; const LAS bf16* bp = WRs + l15 * WRS + 8 * gq;
#pragma unroll 8
        for (int ks = 0; ks < 32; ++ks) { const bf16x8 A = *(const bf16x8*)(ap + 32 * ks);
#pragma unroll
            for (int nt = 0; nt < 3; ++nt) { const bf16x8 B = *(const LAS bf16x8*)(bp + nt * 16 * WRS + 32 * ks); acc[nt] = mfma16(A, B, acc[nt]); } }
#pragma unroll
        for (int nt = 0; nt < 3; ++nt)
#pragma unroll
            for (int i = 0; i < 4; ++i) lg[(4 * gq + i) * LGS + 16 * nt + l15] = acc[nt][i];
        LDS_WAIT();
        if (lane < 16) { const int t = row0 + lane; const LAS float* L = lg + lane * LGS;
            const float l0 = L[0] + bg[0], l1 = L[1] + bg[1], l2 = L[2] + bg[2], l3 = L[3] + bg[3];
            int gs = 0; float gm = l0;
            if (l1 > gm) { gm = l1; gs = 1; } if (l2 > gm) { gm = l2; gs = 2; } if (l3 > gm) { gm = l3; gs = 3; }
            const float pg = 1.0f / (__expf(l0 - gm) + __expf(l1 - gm) + __expf(l2 - gm) + __expf(l3 - gm));
            float el[8];
#pragma unroll
            for (int j = 0; j < 8; ++j) el[j] = L[4 + 8 * gs + j] + br[8 * gs + j];
            int i1 = 0; float m1 = el[0];
#pragma unroll
            for (int j = 1; j < 8; ++j) if (el[j] > m1) { m1 = el[j]; i1 = j; }
            int i2 = -1; float m2 = -3.0e38f;
#pragma unroll
            for (int j = 0; j < 8; ++j) if (j != i1 && el[j] > m2) { m2 = el[j]; i2 = j; }
            const float e2 = __expf(m2 - m1), inv = pg / (1.0f + e2);
            const int e1id = 8 * gs + i1, e2id = 8 * gs + i2;
            EID[2 * t] = e1id; EID[2 * t + 1] = e2id; GATE[2 * t] = inv; GATE[2 * t + 1] = e2 * inv;
            lds_add(&hist[e1id], 1u); lds_add(&hist[e2id], 1u); }
        LDS_WAIT();
    }
    __syncthreads();
    if (c.tid < 32 && hist[c.tid]) atomicAdd(ctl + CW_CNT + layer * CW_LSTRIDE + c.tid, hist[c.tid]);
}
template <int layer> DI void phase_scatter(const Ctx& c0, const PV& P) {
    const Ctx c = relaunder(c0);
    unsigned* ctl = (unsigned*)(P.ws + WS_CTL);
    const int* EID = (const int*)(P.ws + AR_EID); int* DEST = (int*)(P.ws + AR_DEST);
    const bf16* HN = (const bf16*)(P.ws + WS_HN); bf16* XS = (bf16*)(P.ws + AR_XS);
    LAS int* cnt = (LAS int*)c.lds; LAS int* pstart = cnt + 32; LAS unsigned* hist = (LAS unsigned*)(cnt + 64); LAS unsigned* base = hist + 32; LAS unsigned* lcnt = base + 32; LAS int* dl = (LAS int*)(lcnt + 32);
    __syncthreads();
    if (c.tid < 32) cnt[c.tid] = (int)ctl[CW_CNT + layer * CW_LSTRIDE + c.tid];
    __syncthreads();
    if (c.tid == 0) { int acc = 0; for (int e = 0; e < 32; ++e) { pstart[e] = acc; acc += (cnt[e] + 255) & ~255; }
        if (c.blk == 0) { ctl[CW_NT + layer * CW_LSTRIDE] = (unsigned)(acc >> 8);
            for (int e = 0; e < 32; ++e) { const int t0 = pstart[e] >> 8, t1 = (pstart[e] + ((cnt[e] + 255) & ~255)) >> 8; for (int t = t0; t < t1; ++t) ctl[CW_TE + layer * CW_TE_STRIDE + t] = (unsigned)e; } } }
    __syncthreads();
    for (int tb = c.blk; tb < NTOK / 128; tb += c.G) {
        if (c.tid < 32) { hist[c.tid] = 0u; lcnt[c.tid] = 0u; }
        __syncthreads();
        int e = 0, t = 0;
        if (c.tid < 256) { t = tb * 128 + (c.tid >> 1); e = EID[2 * t + (c.tid & 1)]; lds_add(&hist[e], 1u); }
        __syncthreads();
        if (c.tid < 32) base[c.tid] = hist[c.tid] ? atomicAdd(ctl + CW_CUR + layer * CW_LSTRIDE + c.tid, hist[c.tid]) : 0u;
        __syncthreads();
        if (c.tid < 256) { const unsigned rank = lds_add(&lcnt[e], 1u); const int d = pstart[e] + (int)base[e] + (int)rank; DEST[2 * t + (c.tid & 1)] = d; dl[c.tid] = d; }
        __syncthreads();
        for (int a = c.wave * 32; a < c.wave * 32 + 32; ++a) { const int tt = tb * 128 + (a >> 1), d = dl[a];
            const v4u* s = (const v4u*)(HN + (size_t)tt * 1024) + c.lane; v4u* o = (v4u*)(XS + (size_t)d * 1024) + c.lane;
            const v4u x0 = s[0], x1 = s[64]; o[0] = x0; o[64] = x1; }
        __syncthreads();
    }
    for (int e = 0; e < 32; ++e) { const int npad = ((cnt[e] + 255) & ~255) - cnt[e], r0 = pstart[e] + cnt[e];
        for (int r = c.gw; r < npad; r += c.NGW) { v4u* o = (v4u*)(XS + (size_t)(r0 + r) * 1024) + c.lane; const v4u z = {0u, 0u, 0u, 0u}; o[0] = z; o[64] = z; } }
}
template <bool NEXT> DI void phase_combine(const Ctx& c0, const PV& P) {
    const Ctx c = relaunder(c0);
    if (NEXT) prep_setup<1>(c, P);
    const int* DEST = (const int*)(P.ws + AR_DEST); const float* GATE = (const float*)(P.ws + AR_GATE); const bf16* Y = (const bf16*)(P.ws + AR_XS);
    const float* g = NEXT ? pin(P, I_NORM_MIX) + 1024 : nullptr; bf16* HN = (bf16*)(P.ws + WS_HN); float* WI = (float*)(P.ws + AR_WI);
    const LAS f32x4* wiw = (const LAS f32x4*)(c.lds + 69632);
    for (int t = c.gw; t < NTOK; t += c.NGW) { const int d0 = DEST[2 * t], d1 = DEST[2 * t + 1]; const float g0 = GATE[2 * t], g1 = GATE[2 * t + 1];
        f32x4* op = (f32x4*)(P.out + (size_t)t * 1024) + c.lane; const v2u* y0 = (const v2u*)(Y + (size_t)d0 * 1024) + c.lane; const v2u* y1 = (const v2u*)(Y + (size_t)d1 * 1024) + c.lane;
        f32x4 v[4];
#pragma unroll
        for (int j = 0; j < 4; ++j) { f32x4 o = op[64 * j]; const v2u a = y0[64 * j], b = y1[64 * j];
            o.x += g0 * bflo(a.x) + g1 * bflo(b.x); o.y += g0 * bfhi(a.x) + g1 * bfhi(b.x); o.z += g0 * bflo(a.y) + g1 * bflo(b.y); o.w += g0 * bfhi(a.y) + g1 * bfhi(b.y); op[64 * j] = o; v[j] = o; }
        if (NEXT) { rms_finish(v, g, HN + (size_t)t * 1024, c.lane); wi_row(v, wiw, WI, t, c.lane); }
    }
    if (NEXT) prep_weights<1>(c, P);
}

DI void phase_dsaprep(const Ctx& c0, const PV& P) {
    const Ctx c = relaunder(c0);
    const bf16* PROJ = (const bf16*)(P.ws + AR_PROJ); bf16* KN = (bf16*)(P.ws + AR_KN); bf16* KIN = (bf16*)(P.ws + AR_KIN); bf16* QIW = (bf16*)(P.ws + AR_QIW);
    const float* WI = (const float*)(P.ws + AR_WI); const float* kg = pin(P, I_DSA_K_NORM);
    const int l = c.lane;
    for (int row = c.gw; row < NTOK; row += c.NGW) {
        const int col = l < 8 ? 768 + 8 * l : (l < 16 ? 1216 + 8 * (l - 8) : 960 + 8 * (l - 16));
        float f[8] = {0.f, 0.f, 0.f, 0.f, 0.f, 0.f, 0.f, 0.f};
        if (l < 48) unpack8(*(const v4u*)(PROJ + (size_t)row * 1536 + col), f);
        float ss = 0.f;
#pragma unroll
        for (int j = 0; j < 8; ++j) ss += f[j] * f[j];
        ss += __shfl_xor(ss, 1); ss += __shfl_xor(ss, 2); ss += __shfl_xor(ss, 4);
        const float r = 1.0f / sqrtf(ss * (1.0f / 64.0f) + EPS);
        if (l < 8) {
#pragma unroll
            for (int j = 0; j < 8; ++j) f[j] = f[j] * r * kg[8 * l + j];
            *(v4u*)(KN + (size_t)row * 64 + 8 * l) = pack8(f);
        } else if (l < 16) {
#pragma unroll
            for (int j = 0; j < 8; ++j) f[j] *= r;
            { const int cch = l - 8;
              *(v4u*)(KIN + ((((size_t)(row >> 5) * 4 + (cch >> 1)) * 2 + (cch & 1)) * 32 + (row & 31)) * 8) = pack8(f); }
        } else if (l < 48) {
            const float w = WI[(size_t)row * 4 + ((l - 16) >> 3)] * 0.125f;
#pragma unroll
            for (int j = 0; j < 8; ++j) f[j] *= w;
            *(v4u*)(QIW + (size_t)row * 256 + 8 * (l - 16)) = pack8(f);
        }
    }
}
DI int dpp_scan_add(int v) {
    v += __builtin_amdgcn_update_dpp(0, v, 0x111, 0xf, 0xf, true); v += __builtin_amdgcn_update_dpp(0, v, 0x112, 0xf, 0xf, true);
    v += __builtin_amdgcn_update_dpp(0, v, 0x114, 0xf, 0xf, true); v += __builtin_amdgcn_update_dpp(0, v, 0x118, 0xf, 0xf, true);
    v += __builtin_amdgcn_update_dpp(0, v, 0x142, 0xa, 0xf, false); v += __builtin_amdgcn_update_dpp(0, v, 0x143, 0xc, 0xf, false);
    return v;
}
DI unsigned dpp_scan_max(unsigned v) {
#define DPPMAX_(ctrl, rm, bc) { const unsigned o_ = (unsigned)__builtin_amdgcn_update_dpp(0, (int)v, ctrl, rm, 0xf, bc); v = v > o_ ? v : o_; }
    DPPMAX_(0x111, 0xf, true) DPPMAX_(0x112, 0xf, true) DPPMAX_(0x114, 0xf, true) DPPMAX_(0x118, 0xf, true) DPPMAX_(0x142, 0xa, false) DPPMAX_(0x143, 0xc, false)
#undef DPPMAX_
    return v;
}
DI unsigned idx_compact(LAS unsigned* qb, LAS unsigned* hist, int n, int lane) {
    unsigned e[8];
#pragma unroll
    for (int i = 0; i < 8; ++i) { const int idx = lane + 64 * i; e[i] = idx < n ? qb[idx] : 0u; }
    unsigned prefix = 0u, maskbits = 0u; int want = 256;
#pragma unroll
    for (int pass = 0; pass < 4; ++pass) { const int shift = 24 - 8 * pass;
        *(LAS v4u*)(hist + 4 * lane) = (v4u){0u, 0u, 0u, 0u};
        LDS_WAIT();
#pragma unroll
        for (int i = 0; i < 8; ++i) if (e[i] != 0u && (e[i] & maskbits) == prefix) lds_add(&hist[255u - ((e[i] >> shift) & 255u)], 1u);
        LDS_WAIT();
        const v4u h4 = *(const LAS v4u*)(hist + 4 * lane);
        LDS_WAIT();
        const int s = (int)(h4.x + h4.y + h4.z + h4.w);
        const int c0 = dpp_scan_add(s) - s, c1 = c0 + (int)h4.x, c2 = c1 + (int)h4.y, c3 = c2 + (int)h4.z;
        int fb = -1, fa = 0;
        if (c0 < want && want <= c0 + (int)h4.x) { fb = 0; fa = c0; }
        else if (c1 < want && want <= c1 + (int)h4.y) { fb = 1; fa = c1; }
        else if (c2 < want && want <= c2 + (int)h4.z) { fb = 2; fa = c2; }
        else if (c3 < want && want <= c3 + (int)h4.w) { fb = 3; fa = c3; }
        const unsigned long long m = __ballot(fb >= 0);
        const int src = m ? (int)__builtin_ctzll(m) : 0;
        const int slot = __builtin_amdgcn_readlane(4 * lane + fb, src), ab = __builtin_amdgcn_readlane(fa, src);
        prefix |= (unsigned)(255 - slot) << shift; maskbits |= 0xFFu << shift; want -= ab;
    }
    int base = 0;
#pragma unroll
    for (int i = 0; i < 8; ++i) { const bool pred = e[i] >= prefix && e[i] != 0u; const unsigned long long m = __ballot(pred);
        const int pos = base + (int)__builtin_amdgcn_mbcnt_hi((unsigned)(m >> 32), __builtin_amdgcn_mbcnt_lo((unsigned)m, 0u));
        if (pred) qb[pos] = e[i];
        base += (int)__builtin_popcountll(m); }
    LDS_WAIT();
    return prefix;
}
DI int idx_compact_coarse(LAS unsigned* qb, LAS unsigned* hist, int n, unsigned lo, unsigned& tau, int lane) {
    unsigned e[8]; unsigned mx = 0u;
#pragma unroll
    for (int i = 0; i < 8; ++i) { const int idx = lane + 64 * i; e[i] = idx < n ? qb[idx] : 0u; mx = e[i] > mx ? e[i] : mx; }
    const unsigned hi = (unsigned)__builtin_amdgcn_readlane((int)dpp_scan_max(mx), 63);
    const unsigned range = hi - lo;
    const int sh = range >= 256u ? (24 - (int)__builtin_clz(range)) : 0;
    *(LAS v4u*)(hist + 4 * lane) = (v4u){0u, 0u, 0u, 0u};
    LDS_WAIT();
#pragma unroll
    for (int i = 0; i < 8; ++i) if (e[i] != 0u) lds_add(&hist[255u - ((e[i] - lo) >> sh)], 1u);
    LDS_WAIT();
    const v4u h4 = *(const LAS v4u*)(hist + 4 * lane);
    LDS_WAIT();
    const int s = (int)(h4.x + h4.y + h4.z + h4.w);
    const int c0 = dpp_scan_add(s) - s, c1 = c0 + (int)h4.x, c2 = c1 + (int)h4.y, c3 = c2 + (int)h4.z;
    int fb = -1, fk = 0;
    if (c0 < 256 && 256 <= c0 + (int)h4.x) { fb = 0; fk = c0 + (int)h4.x; }
    else if (c1 < 256 && 256 <= c1 + (int)h4.y) { fb = 1; fk = c1 + (int)h4.y; }
    else if (c2 < 256 && 256 <= c2 + (int)h4.z) { fb = 2; fk = c2 + (int)h4.z; }
    else if (c3 < 256 && 256 <= c3 + (int)h4.w) { fb = 3; fk = c3 + (int)h4.w; }
    const unsigned long long m = __ballot(fb >= 0);
    const int src = m ? (int)__builtin_ctzll(m) : 0;
    const int slot = __builtin_amdgcn_readlane(4 * lane + fb, src), kept = __builtin_amdgcn_readlane(fk, src);
    if (__builtin_expect(kept > 352, 0)) { tau = idx_compact(qb, hist, n, lane); return 256; }
    const unsigned edge = lo + ((unsigned)(255 - slot) << sh);
    int base = 0;
#pragma unroll
    for (int i = 0; i < 8; ++i) { const bool pred = e[i] >= edge && e[i] != 0u; const unsigned long long mm = __ballot(pred);
        const int pos = base + (int)__builtin_amdgcn_mbcnt_hi((unsigned)(mm >> 32), __builtin_amdgcn_mbcnt_lo((unsigned)mm, 0u));
        if (pred) qb[pos] = e[i];
        base += (int)__builtin_popcountll(mm); }
    LDS_WAIT();
    tau = edge - 1u;
    return base;
}
struct IdxState { float lo[4][4], hi[4][4]; unsigned tau[4]; int cnt[4]; int tq[4]; };
DI int sel4(const int (&a)[4], int j) { return j == 0 ? a[0] : (j == 1 ? a[1] : (j == 2 ? a[2] : a[3])); }
DI unsigned sel4u(const unsigned (&a)[4], int j) { return j == 0 ? a[0] : (j == 1 ? a[1] : (j == 2 ? a[2] : a[3])); }
template <int SHADOW> DI void idx_step(const bf16x8 (&A)[4], const bf16x8 (&B)[2][4], IdxState& st, LAS unsigned* buf, LAS unsigned* hist, int step, bool lastst, int lane, int hh, int l31, unsigned ltmask) {
    f32x16 acc[2];
#pragma unroll
    for (int u = 0; u < 2; ++u) {
#pragma unroll
        for (int i = 0; i < 16; ++i) acc[u][i] = 0.f; }
#pragma unroll
    for (int ks = 0; ks < 4; ++ks) {
#pragma unroll
        for (int u = 0; u < 2; ++u) acc[u] = __builtin_amdgcn_mfma_f32_32x32x16_bf16(A[ks], B[u][ks], acc[u], 0, 0, 0); }
    if (SHADOW == 5) {
        f32x16 acc2[2];
#pragma unroll
        for (int u = 0; u < 2; ++u) {
#pragma unroll
            for (int i = 0; i < 16; ++i) acc2[u][i] = 1.f; }
#pragma unroll
        for (int ks = 0; ks < 4; ++ks) {
#pragma unroll
            for (int u = 0; u < 2; ++u) acc2[u] = __builtin_amdgcn_mfma_f32_32x32x16_bf16(A[3 - ks], B[u][ks], acc2[u], 0, 0, 0); }
#pragma unroll
        for (int u = 0; u < 2; ++u) {
#pragma unroll
            for (int i = 0; i < 16; i += 4) acc[u][i] += 1e-30f * acc2[u][i]; }
    }
#pragma unroll
    for (int rep2 = 0; rep2 < (SHADOW == 6 ? 2 : 1); ++rep2)
#pragma unroll
    for (int u = 0; u < 2; ++u) {
        const int s = step * 64 + 32 * u + l31 + rep2;
#pragma unroll
        for (int j = 0; j < 4; ++j) {
            const float sc = (__builtin_amdgcn_fmed3f(acc[u][4 * j], st.lo[j][0], st.hi[j][0]) + __builtin_amdgcn_fmed3f(acc[u][4 * j + 1], st.lo[j][1], st.hi[j][1]))
                           + (__builtin_amdgcn_fmed3f(acc[u][4 * j + 2], st.lo[j][2], st.hi[j][2]) + __builtin_amdgcn_fmed3f(acc[u][4 * j + 3], st.lo[j][3], st.hi[j][3]));
            unsigned uu = __float_as_uint(sc); uu ^= (unsigned)((int)uu >> 31) | 0x80000000u;
            unsigned key = (uu & 0xFFFFC000u) | (unsigned)(16383 - s);
            if (lastst && s > st.tq[j]) key = 0u;
            const bool pred = key > st.tau[j];
            const unsigned long long m = __ballot(pred);
            const unsigned hm = hh ? (unsigned)(m >> 32) : (unsigned)m;
            const int pos = st.cnt[j] + __builtin_popcount(hm & ltmask);
            if (pred) buf[(2 * j + hh) * 512 + pos] = key;
            st.cnt[j] += __builtin_popcount(hm);
        }
    }
    const int cm = max(max(st.cnt[0], st.cnt[1]), max(st.cnt[2], st.cnt[3]));
    unsigned long long need = __ballot(cm > 448);
    if (__builtin_expect(need != 0ull, 0)) {
        unsigned qmask = 0u;
#pragma unroll
        for (int j = 0; j < 4; ++j) { const unsigned long long mm = __ballot(st.cnt[j] > 448); qmask |= ((unsigned)(mm & 1ull) << (2 * j)) | ((unsigned)((mm >> 32) & 1ull) << (2 * j + 1)); }
        LDS_WAIT();
        while (qmask) {
            const int q = __builtin_ctz(qmask); qmask &= qmask - 1u; const int j = q >> 1, h = q & 1;
            const int n = __builtin_amdgcn_readlane(sel4(st.cnt, j), h * 32); const unsigned lo0 = (unsigned)__builtin_amdgcn_readlane((int)sel4u(st.tau, j), h * 32);
            unsigned T; const int k = idx_compact_coarse(buf + q * 512, hist, n, lo0, T, lane);
#pragma unroll
            for (int jj = 0; jj < 4; ++jj) if (jj == j && hh == h) { st.tau[jj] = T; st.cnt[jj] = k; }
        }
    }
}
DI void idx_loadB(bf16x8 (&B)[2][4], const bf16* kbase, int step) {
#pragma unroll
    for (int u = 0; u < 2; ++u)
#pragma unroll
        for (int ks = 0; ks < 4; ++ks) B[u][ks] = *(const bf16x8*)(kbase + ((size_t)(2 * step + u) * 4 + ks) * 512);
}
template <int SHADOW> DI void phase_indexer(const Ctx& c0, const PV& P) {
    const Ctx c = relaunder(c0);
    const bf16* KIN = (const bf16*)(P.ws + AR_KIN); const bf16* QIW = (const bf16*)(P.ws + AR_QIW); const float* WI = (const float*)(P.ws + AR_WI); int* SEL = (int*)(P.ws + (SHADOW ? WS_AR + 272 * MiB : AR_SEL));
    LAS unsigned* buf = (LAS unsigned*)(c.lds + c.wave * 17408);
    LAS unsigned* hist = buf + 4096;
    const int lane = c.lane, hh = lane >> 5, l31 = lane & 31;
    const unsigned ltmask = (1u << l31) - 1u;
    const float INF = __builtin_inff();
    for (int pair = c.blk; pair < 256; pair += c.G) {
        const int b = pair >> 7, jj = pair & 127;
        for (int half = 0; half < 2; ++half) {
            const int unit = half ? (255 - jj) : jj, t0w = unit * 64 + c.wave * 8, rowbase = b * SEQ;
            bf16x8 A[4];
#pragma unroll
            for (int ks = 0; ks < 4; ++ks) A[ks] = *(const bf16x8*)(QIW + (size_t)(rowbase + t0w + (l31 >> 2)) * 256 + (l31 & 3) * 64 + 16 * ks + 8 * hh);
            IdxState st;
#pragma unroll
            for (int j = 0; j < 4; ++j) { st.tq[j] = t0w + 2 * j + hh; st.tau[j] = 0u; st.cnt[j] = 0;
                const f32x4 w = *(const f32x4*)(WI + (size_t)(rowbase + st.tq[j]) * 4);
#pragma unroll
                for (int i = 0; i < 4; ++i) { st.lo[j][i] = w[i] > 0.f ? 0.f : -INF; st.hi[j][i] = w[i] > 0.f ? INF : 0.f; } }
            const int nstep = (SHADOW == 7) ? ((t0w + 7) / 128 + 1) : ((t0w + 7) / 64 + 1);
            const bf16* kbase = KIN + (size_t)(rowbase >> 5) * 2048 + lane * 8;
            bf16x8 R0[2][4], R1[2][4];
            idx_loadB(R0, kbase, 0);
            if (nstep > 1) idx_loadB(R1, kbase, 1); else idx_loadB(R1, kbase, 0);
            for (int step = 0; step < nstep; step += 2) {
                idx_step<SHADOW>(A, R0, st, buf, hist, step, step + 1 >= nstep, lane, hh, l31, ltmask);
                idx_loadB(R0, kbase, min(step + 2, nstep - 1));
                idx_step<SHADOW>(A, R1, st, buf, hist, step + 1, step + 2 >= nstep, lane, hh, l31, ltmask);
                idx_loadB(R1, kbase, min(step + 3, nstep - 1));
            }
            LDS_WAIT();
            for (int q = 0; q < 8; ++q) {
                const int j = q >> 1, h2 = q & 1;
                int n = __builtin_amdgcn_readlane(sel4(st.cnt, j), h2 * 32);
                LAS unsigned* qb = buf + q * 512;
                if (SHADOW == 8) n = n > 256 ? 256 : n;
                if (n > 256) { (void)idx_compact(qb, hist, n, lane); n = 256; }
                int* sp = SEL + (size_t)(rowbase + t0w + q) * 256;
#pragma unroll
                for (int i = 0; i < 4; ++i) { const int idx = lane + 64 * i; sp[idx] = idx < n ? (16383 - (int)(qb[idx] & 0x3FFFu)) : -1; }
            }
            LDS_WAIT();
        }
    }
}
DI int t5_bucket(int d) {
    if (d < 16) return d;
    return 16 + (d >= 19) + (d >= 21) + (d >= 24) + (d >= 27) + (d >= 31) + (d >= 35) + (d >= 40) + (d >= 46) + (d >= 52) + (d >= 59) + (d >= 67) + (d >= 77) + (d >= 87) + (d >= 99) + (d >= 113);
}
typedef short s16x4 __attribute__((ext_vector_type(4)));
DI void phase_sattn(const Ctx& c0, const PV& P) {
    const Ctx c = relaunder(c0);
    const bf16* PROJ = (const bf16*)(P.ws + AR_PROJ); const bf16* KN = (const bf16*)(P.ws + AR_KN); const int* SEL = (const int*)(P.ws + AR_SEL); bf16* MIX = (bf16*)(P.ws + AR_MIXD);
    const float* qg = pin(P, I_DSA_Q_NORM); const float* rb = pin(P, I_REL_BIAS);
    constexpr int WST = 11264, VRS = 144;
    LAS int* bk = (LAS int*)(c.lds + c.wave * WST);
    LAS int* selL = bk + 256;
    LAS bf16* Vs = (LAS bf16*)(selL + 256);
    LAS float* relb = (LAS float*)(c.lds + 8 * WST);
    const int lane = c.lane, l15 = lane & 15, g = lane >> 4;
    __syncthreads();
    relb[c.tid] = (c.tid & 15) < 12 ? rb[(c.tid >> 4) * 12 + (c.tid & 15)] : 0.f;
    __syncthreads();
    float qgv0[8], qgv1[8];
#pragma unroll
    for (int j = 0; j < 8; ++j) { qgv0[j] = qg[8 * g + j]; qgv1[j] = qg[32 + 8 * g + j]; }
    const LAS bf16* trp = Vs + (4 * g + (l15 >> 2)) * VRS + 4 * (l15 & 3);
    int row = c.gw;
    v4i s4n = {0, 0, 0, 0}; v4u qn0 = {0u, 0u, 0u, 0u}, qn1 = {0u, 0u, 0u, 0u};
    if (row < NTOK) { s4n = *(const v4i*)(SEL + (size_t)row * 256 + 4 * lane);
        if (l15 < 12) { const bf16* qp = PROJ + (size_t)row * 1536 + l15 * 64 + 8 * g; qn0 = *(const v4u*)qp; qn1 = *(const v4u*)(qp + 32); } }
#pragma unroll 1
    for (; row < NTOK; row += c.NGW) {
        const int b = row >> 14, t = row & (SEQ - 1), rowbase = b << 14;
        const v4i s4 = s4n; const v4u w0 = qn0, w1 = qn1;
        { const int nrow = row + c.NGW;
          if (nrow < NTOK) { s4n = *(const v4i*)(SEL + (size_t)nrow * 256 + 4 * lane);
              if (l15 < 12) { const bf16* qp = PROJ + (size_t)nrow * 1536 + l15 * 64 + 8 * g; qn0 = *(const v4u*)qp; qn1 = *(const v4u*)(qp + 32); } } }
        const int sv[4] = {s4.x, s4.y, s4.z, s4.w};
        int bv[4], cv[4];
#pragma unroll
        for (int i = 0; i < 4; ++i) { bv[i] = sv[i] >= 0 ? t5_bucket(t - sv[i]) : -1; cv[i] = sv[i] >= 0 ? sv[i] : 0; }
        *(LAS v4i*)(bk + 4 * lane) = (v4i){bv[0], bv[1], bv[2], bv[3]};
        *(LAS v4i*)(selL + 4 * lane) = (v4i){cv[0], cv[1], cv[2], cv[3]};
        float q0[8], q1[8]; unpack8(w0, q0); unpack8(w1, q1);
        float ss = 0.f;
#pragma unroll
        for (int j = 0; j < 8; ++j) ss += q0[j] * q0[j] + q1[j] * q1[j];
        ss += __shfl_xor(ss, 16); ss += __shfl_xor(ss, 32);
        const float r = 0.125f / sqrtf(ss * (1.0f / 64.0f) + EPS);
#pragma unroll
        for (int j = 0; j < 8; ++j) { q0[j] = q0[j] * r * qgv0[j]; q1[j] = q1[j] * r * qgv1[j]; }
        const bf16x8 B0 = __builtin_bit_cast(bf16x8, pack8(q0)), B1 = __builtin_bit_cast(bf16x8, pack8(q1));
        LDS_WAIT();
        v4u vb[2][8];
#pragma unroll
        for (int i = 0; i < 8; ++i) { const int sk = selL[4 * i + g]; vb[0][i] = *(const v4u*)(PROJ + (size_t)(rowbase + sk) * 1536 + 832 + 8 * l15); }
        f32x4 S[16];
#pragma unroll
        for (int hb = 0; hb < 2; ++hb) {
            bf16x8 A0[8], A1[8];
#pragma unroll
            for (int k8 = 0; k8 < 8; ++k8) { const int sk = selL[16 * (8 * hb + k8) + l15]; const bf16* kp = KN + (size_t)(rowbase + sk) * 64 + 8 * g; A0[k8] = *(const bf16x8*)kp; A1[k8] = *(const bf16x8*)(kp + 32); }
#pragma unroll
            for (int k8 = 0; k8 < 8; ++k8) { f32x4 z = {0.f, 0.f, 0.f, 0.f}; z = mfma16(A0[k8], B0, z); S[8 * hb + k8] = mfma16(A1[k8], B1, z); }
            __builtin_amdgcn_sched_barrier(0);
        }
        float mx = -3.0e38f;
#pragma unroll
        for (int kt = 0; kt < 16; ++kt) { const v4i b4 = *(const LAS v4i*)(bk + 16 * kt + 4 * g); const int bb[4] = {b4.x, b4.y, b4.z, b4.w};
#pragma unroll
            for (int i = 0; i < 4; ++i) { const float v = bb[i] >= 0 ? S[kt][i] + relb[bb[i] * 16 + l15] : -3.0e38f; S[kt][i] = v; mx = fmaxf(mx, v); } }
        mx = fmaxf(mx, __shfl_xor(mx, 16)); mx = fmaxf(mx, __shfl_xor(mx, 32));
        float l = 0.f;
#pragma unroll
        for (int kt = 0; kt < 16; ++kt) {
#pragma unroll
            for (int i = 0; i < 4; ++i) { const float p = S[kt][i] > -1.0e38f ? __expf(S[kt][i] - mx) : 0.f; S[kt][i] = p; l += p; } }
        l += __shfl_xor(l, 16); l += __shfl_xor(l, 32);
        f32x4 O[8];
#pragma unroll
        for (int ct = 0; ct < 8; ++ct) O[ct] = (f32x4){0.f, 0.f, 0.f, 0.f};
#pragma unroll
        for (int jb = 0; jb < 8; ++jb) {
            if (jb + 1 < 8) {
#pragma unroll
                for (int i = 0; i < 8; ++i) { const int sk = selL[32 * (jb + 1) + 4 * i + g]; vb[(jb + 1) & 1][i] = *(const v4u*)(PROJ + (size_t)(rowbase + sk) * 1536 + 832 + 8 * l15); } }
#pragma unroll
            for (int i = 0; i < 8; ++i) { const v4u v = vb[jb & 1][i]; LAS v2u* d = (LAS v2u*)(Vs + (4 * i + g) * VRS + 8 * l15); d[0] = (v2u){v.x, v.y}; d[1] = (v2u){v.z, v.w}; }
            v4u pw; pw.x = pk2(S[2 * jb][0], S[2 * jb][1]); pw.y = pk2(S[2 * jb][2], S[2 * jb][3]); pw.z = pk2(S[2 * jb + 1][0], S[2 * jb + 1][1]); pw.w = pk2(S[2 * jb + 1][2], S[2 * jb + 1][3]);
            const bf16x8 Pb = __builtin_bit_cast(bf16x8, pw);
            LDS_WAIT();
#pragma unroll
            for (int ct = 0; ct < 8; ++ct) {
                const s16x4 a = __builtin_amdgcn_ds_read_tr16_b64_v4i16((LAS s16x4*)(trp + 16 * ct));
                const s16x4 bq = __builtin_amdgcn_ds_read_tr16_b64_v4i16((LAS s16x4*)(trp + 16 * VRS + 16 * ct));
                const bf16x8 Af = {a[0], a[1], a[2], a[3], bq[0], bq[1], bq[2], bq[3]};
                O[ct] = mfma16(Af, Pb, O[ct]); }
            LDS_WAIT();
            __builtin_amdgcn_sched_barrier(0);
        }
        if (l15 < 12) { const float il = 1.0f / l; bf16* op = MIX + (size_t)row * 1792 + l15 * 128 + 4 * g;
#pragma unroll
            for (int ct = 0; ct < 8; ++ct) { v2u o; o.x = pk2(O[ct][0] * il, O[ct][1] * il); o.y = pk2(O[ct][2] * il, O[ct][3] * il); *(v2u*)(op + 16 * ct) = o; } }
        LDS_WAIT();
    }
}

#ifndef ONLY
#define ONLY -1
#endif
#define PH(n) (ONLY < 0 || ONLY == (n))
#ifndef REP0
#define REP0 1
#endif
#ifndef REP1
#define REP1 1
#endif
#ifndef REP2
#define REP2 1
#endif
#ifndef REP3
#define REP3 1
#endif
#ifndef REP4
#define REP4 1
#endif
#ifndef REP5
#define REP5 1
#endif
#ifndef REP6
#define REP6 1
#endif
#ifndef REP7
#define REP7 1
#endif
#ifndef REP8
#define REP8 1
#endif
#ifndef REP9
#define REP9 1
#endif
#ifndef REP10
#define REP10 1
#endif
#ifndef REP11
#define REP11 1
#endif
#ifndef REP12
#define REP12 1
#endif
#ifndef REP13
#define REP13 1
#endif
#ifndef REP14
#define REP14 1
#endif
#ifndef REP15
#define REP15 1
#endif
#ifndef REP16
#define REP16 1
#endif
#ifndef REP17
#define REP17 1
#endif
#ifndef REP18
#define REP18 1
#endif
#define RB(n) for (int r_ = 0; r_ < REP##n; ++r_) { if (r_) GRID_BAR();
#define RE }
#define GRID_BAR() xcd_barrier(bar)
template <int layer> DI void layer_body(const Ctx& c, const PV& P, const XcdBarrier& bar) {
    unsigned char* ws = P.ws;
    unsigned* ctl = (unsigned*)(ws + WS_CTL);
    PG8_LAS unsigned char* glds = (PG8_LAS unsigned char*)c.lds;
    const pg8::bf16_t* HN = (const pg8::bf16_t*)(ws + WS_HN);
    if (layer == 0) { RB(0) if (PH(0)) phase_prep0(c, P); RE
    GRID_BAR(); }
    RB(1) if (PH(1)) {
        { pg8::Gemm g{(const pg8::bf16_t*)(ws + WB_MEMN), (const pg8::bf16_t*)(ws + WB_MKV), 1024, 1024, 1024}; pg8::StaticOrder S; S.init(2, 2, c.G, c.G - 1 - c.blk);
          pg8::EpiBf16<false> E{(pg8::bf16_t*)(ws + WB_MKVO), 512, 0, 0};
          pg8::gemm_phase<pg8::EpiBf16<false>, pg8::StaticOrder, true, true>(glds, g, S, E); }
        __syncthreads();
        if (layer == 0) { pg8::Gemm g{HN, (const pg8::bf16_t*)(ws + WB_WIN), 1024, 1024, 1024}; pg8::StaticOrder S; S.init(128, 7, c.G, c.blk);
          pg8::EpiBf16<true> E{(pg8::bf16_t*)(ws + AR_PROJ), 1792, 3, 6};
          pg8::gemm_phase<pg8::EpiBf16<true>, pg8::StaticOrder, true, true>(glds, g, S, E); }
        else { pg8::Gemm g{HN, (const pg8::bf16_t*)(ws + WB_WIN), 1024, 1024, 1024}; pg8::StaticOrder S; S.init(128, 6, c.G, c.blk);
          pg8::EpiBf16<false> E{(pg8::bf16_t*)(ws + AR_PROJ), 1536, 0, 0};
          pg8::gemm_phase<pg8::EpiBf16<false>, pg8::StaticOrder, true, true>(glds, g, S, E); }
    } RE
    GRID_BAR();
    if (layer == 0) {
        RB(2) if (PH(2)) phase_conv(c, P);
        if (PH(2)) phase_xattn<0, 1792, 1536, 1024, 768>(c, P, (const bf16*)(ws + AR_PROJ), (bf16*)(ws + AR_MIXL)); RE
        GRID_BAR();
        RB(3) if (PH(3)) { pg8::Gemm g{(const pg8::bf16_t*)(ws + AR_XSC), (const pg8::bf16_t*)(ws + WB_WGT), 768, 768, 768}; pg8::StaticOrder S; S.init(128, 6, c.G, c.blk);
          pg8::EpiLruGate E{(pg8::bf16_t*)(ws + AR_LA), (pg8::bf16_t*)(ws + AR_UU), (const pg8::bf16_t*)(ws + AR_XSC), 768, pin(P, I_LRU_B_A), pin(P, I_LRU_B_X), pin(P, I_LRU_LAMBDA)};
          pg8::gemm_phase<pg8::EpiLruGate, pg8::StaticOrder, true, true>(glds, g, S, E); } RE
        GRID_BAR();
        RB(4) if (PH(4)) phase_scanA(c, P); RE
        GRID_BAR();
        RB(5) if (PH(5)) phase_scanB(c, P); RE
        GRID_BAR();
        RB(6) if (PH(6)) phase_scanC(c, P); RE
        GRID_BAR();
        RB(7) if (PH(7)) { pg8::Gemm g{(const pg8::bf16_t*)(ws + AR_MIXL), (const pg8::bf16_t*)(ws + WB_WOUT), 1024, 1024, 1024}; pg8::StaticOrder S; S.init(128, 4, c.G, c.blk);
          pg8::EpiResF32 E{P.out, pin(P, I_X), 1024};
          pg8::gemm_phase<pg8::EpiResF32, pg8::StaticOrder, true, true>(glds, g, S, E); } RE
    } else {
        RB(8) if (PH(8)) phase_dsaprep(c, P);
        if (PH(8)) phase_xattn<1, 1536, 1280, 1792, 1536>(c, P, (const bf16*)(ws + AR_PROJ), (bf16*)(ws + AR_MIXD)); RE
        GRID_BAR();
#ifndef IDX_SHADOW
#define IDX_SHADOW 0
#endif
        RB(9) if (PH(9)) { if (r_ + 1 < REP9) phase_indexer<IDX_SHADOW>(c, P); else phase_indexer<0>(c, P); } RE
        GRID_BAR();
        RB(10) if (PH(10)) phase_sattn(c, P); RE
        GRID_BAR();
        RB(11) if (PH(11)) { pg8::Gemm g{(const pg8::bf16_t*)(ws + AR_MIXD), (const pg8::bf16_t*)(ws + WB_WOUT), 1792, 1792, 1792}; pg8::StaticOrder S; S.init(128, 4, c.G, c.blk);
          pg8::EpiResF32 E{(r_ + 1 < REP11) ? (float*)(ws + WS_AR) : P.out, P.out, 1024};
          pg8::gemm_phase<pg8::EpiResF32, pg8::StaticOrder, true, true>(glds, g, S, E); } RE
    }
    GRID_BAR();
    if (PH(12)) phase_norm_route<layer>(c, P);
    GRID_BAR();
    if (PH(15)) phase_scatter<layer>(c, P);
    GRID_BAR();
    RB(16) if (PH(16)) { const int ntile = (int)__hip_atomic_load(ctl + CW_NT + layer * CW_LSTRIDE, RLX_AGENT);
        pg8::Gemm g{(const pg8::bf16_t*)(ws + AR_XS), (const pg8::bf16_t*)(ws + WB_WGU), 1024, 1024, 1024}; pg8::GroupedOrder S; S.init(ntile, 4, c.G, c.blk);
        S.te = (const int*)(ctl + CW_TE + layer * CW_TE_STRIDE); S.estride = (size_t)1024 * 1024 * 2;
        pg8::EpiSwiglu E{(pg8::bf16_t*)(ws + AR_ACT), 512};
        pg8::gemm_phase<pg8::EpiSwiglu, pg8::GroupedOrder, true, true>(glds, g, S, E); } RE
    GRID_BAR();
    RB(17) if (PH(17)) { const int ntile = (int)__hip_atomic_load(ctl + CW_NT + layer * CW_LSTRIDE, RLX_AGENT);
        pg8::Gemm g{(const pg8::bf16_t*)(ws + AR_ACT), (const pg8::bf16_t*)(ws + WB_WD), 512, 512, 512}; pg8::GroupedOrder S; S.init(ntile, 4, c.G, c.blk);
        S.te = (const int*)(ctl + CW_TE + layer * CW_TE_STRIDE); S.estride = (size_t)1024 * 512 * 2;
        pg8::EpiBf16<false> E{(pg8::bf16_t*)(ws + AR_XS), 1024, 0, 0};
        pg8::gemm_phase<pg8::EpiBf16<false>, pg8::GroupedOrder, true, true>(glds, g, S, E); } RE
    GRID_BAR();
#ifdef XBAR
    for (int xb = 0; xb < XBAR; ++xb) GRID_BAR();
#endif
    if (PH(18)) phase_combine<layer == 0>(c, P);
    GRID_BAR();
}
__global__ void __launch_bounds__(512, 2) fwd(const Params P) {
    extern __shared__ __attribute__((aligned(16))) unsigned char lds_raw[];
    Ctx c;
    c.lds = (LAS unsigned char*)lds_raw;
    c.tid = threadIdx.x; c.lane = c.tid & 63; c.wave = __builtin_amdgcn_readfirstlane(c.tid >> 6);
    c.G = gridDim.x; c.blk = blockIdx.x; c.gw = c.blk * 8 + c.wave; c.NGW = c.G * 8;
    volatile LAS unsigned* MISC = (volatile LAS unsigned*)(c.lds + MISC_OFF);
    if (c.tid < 64) MISC[c.tid] = 0u;
    if (c.tid < 29) ((LAS unsigned long long*)(c.lds + MISC_OFF + 512))[c.tid] = (unsigned long long)P.in[c.tid];
    __syncthreads();
    XcdBarrier bar = xcd_barrier_post((unsigned*)(P.ws + WS_CTL) + CW_BAR, MISC + 8);
    PV pv; pv.ws = P.ws; pv.out = P.out; pv.tab = (LAS unsigned long long*)(c.lds + MISC_OFF + 512);
#ifndef ONLY_LAYER
    layer_body<0>(c, pv, bar);
    layer_body<1>(c, pv, bar);
#else
    layer_body<ONLY_LAYER>(c, pv, bar);
#endif
}

extern "C" void kernel_launch(void* const* d_in, const int* in_sizes, int n_in, void* d_out, int out_size, void* d_ws, size_t ws_size, hipStream_t stream) {
    static int grid = 0;
    if (grid == 0) {
        if (n_in != 29 || out_size != NTOK * DM || ws_size < WS_END) { fprintf(stderr, "kernel_launch: unexpected shapes (n_in %d out %d ws %zu need %zu)\n", n_in, out_size, ws_size, (size_t)WS_END); grid = -1; return; }
        int dev = 0, cus = 0, per_cu = 0;
        if (hipGetDevice(&dev) != hipSuccess || hipDeviceGetAttribute(&cus, hipDeviceAttributeMultiprocessorCount, dev) != hipSuccess) { grid = -1; return; }
        if (hipFuncSetAttribute((const void*)fwd, hipFuncAttributeMaxDynamicSharedMemorySize, LDS_BYTES) != hipSuccess) { fprintf(stderr, "kernel_launch: hipFuncSetAttribute failed\n"); grid = -1; return; }
        if (hipOccupancyMaxActiveBlocksPerMultiprocessor(&per_cu, (const void*)fwd, 512, LDS_BYTES) != hipSuccess || per_cu < 1) { fprintf(stderr, "kernel_launch: occupancy query reports %d\n", per_cu); }
        (void)hipGetLastError();
        grid = cus;
    }
    if (grid < 0) return;
    if (hipMemsetAsync((char*)d_ws + WS_CTL, 0, CTL_ZERO_BYTES, stream) != hipSuccess) return;
    Params p{};
    for (int i = 0; i < 29; ++i) p.in[i] = (const float*)d_in[i];
    p.out = (float*)d_out; p.ws = (unsigned char*)d_ws;
    hipLaunchKernelGGL(fwd, dim3(grid), dim3(512), LDS_BYTES, stream, p);
}
```

```cpp
#include <hip/hip_runtime.h>
#include <cstdio>
#include <cstdint>
namespace pg8 {
#define PG8_LAS __attribute__((address_space(3)))
typedef unsigned short bf16_t;
typedef short bf16x8 __attribute__((ext_vector_type(8)));
typedef float f32x4 __attribute__((ext_vector_type(4)));
typedef float f32x2 __attribute__((ext_vector_type(2)));
typedef unsigned u32x4 __attribute__((ext_vector_type(4)));
constexpr int BM = 256, BK = 64, HALF = 128, HTB = HALF * BK * 2  , STAGE_BYTES = 8 * HTB, NXCD = 8, WGM = 8;

__host__ __device__ __forceinline__ int lds_byte(int r, int c) { const int st = (r >> 4) * 2 + (c >> 5), rr = r & 15, cc = c & 31, ob = rr * 64 + cc * 2; return st * 1024 + (ob ^ (((ob >> 9) & 1) << 5)); }
__host__ __device__ __forceinline__ void stage_rc(int b, int& R, int& C) { const int st = b / 1024, sb = b % 1024, swz = sb ^ (((sb >> 9) & 1) << 5); R = (st >> 1) * 16 + swz / 64; C = (st & 1) * 32 + (swz % 64) / 2; }
__host__ __device__ __forceinline__ int perm32(int rho) { const int n = rho >> 4, i = rho & 15; return 8 * (i >> 2) + 4 * n + (i & 3); }

struct Unit { int pm, pn; size_t boff; int koff, nt; int ex, pst, cn; };
struct Gemm { const bf16_t* A; const bf16_t* Bt; int lda, ldb, K; };

struct StaticOrder {
    static constexpr bool GATHER = false; const int* rowtab;
    int nM, nN, nwg, G, c;
    __host__ __device__ void init(int nM_, int nN_, int G_, int c_) { nM = nM_; nN = nN_; nwg = nM * nN; G = G_; c = c_; rowtab = nullptr; }
    __host__ __device__ bool next(int i, Unit& u) const {
        const long L = (long)i * G + c; if (L >= nwg) return false;
        int wgid = (int)L; { const int q = nwg / NXCD, r = nwg % NXCD, xcd = wgid % NXCD, off = wgid / NXCD; wgid = (xcd < r ? xcd * (q + 1) : r * (q + 1) + (xcd - r) * q) + off; }
        const int nig = WGM * nN, gid = wgid / nig, fm = gid * WGM, gsz = (nM - fm) < WGM ? (nM - fm) : WGM;
        u.pm = fm + ((wgid % nig) % gsz); u.pn = (wgid % nig) / gsz; u.boff = 0; u.koff = 0; u.nt = 0; return true;
    }
    __device__ __forceinline__ void a_ready(const Unit&) const {}
    __device__ __forceinline__ void done(const Unit&) const {}
};
struct GateOrder : StaticOrder {
    __device__ bool next(int i, Unit& u) const { if (!StaticOrder::next(i, u)) return false;
        const int k0 = (u.pn == 2) ? 128 : (u.pn >= 5 ? 512 : (u.pn >= 3 ? 384 : 0)); const int kl = (u.pn == 1 || u.pn == 4) ? 384 : 256;
        u.koff = k0 * 2; u.nt = kl / 64; return true; }
};
constexpr int MOE_CAP = 65536;
struct GroupedOrder : StaticOrder {
    const PG8_LAS int* tab; size_t estride;
    __device__ __forceinline__ bool next(int i, Unit& u) const { if (!StaticOrder::next(i, u)) return false;
        const int e = tab[64 + u.pm]; u.ex = e; u.pst = tab[32 + e]; u.cn = tab[e]; u.boff = (size_t)e * estride; return true; }
};

__device__ __forceinline__ unsigned cvt_pk_bf16(float lo, float hi) { unsigned r; asm volatile("v_cvt_pk_bf16_f32 %0, %1, %2" : "=v"(r) : "v"(lo), "v"(hi)); return r; }
__device__ __forceinline__ float bf_lo(unsigned w) { return __uint_as_float(w << 16); }
__device__ __forceinline__ float bf_hi(unsigned w) { return __uint_as_float(w & 0xffff0000u); }
__device__ __forceinline__ float sigmoidf_(float v) { return __builtin_amdgcn_rcpf(1.0f + __expf(-v)); }
__device__ __forceinline__ float gelu_tanh(float v) { const float t = v * v; const float p = __builtin_fmaf(t, -2.3022082f * 0.044715f, -2.3022082f);
    return v * __builtin_amdgcn_rcpf(1.0f + __builtin_amdgcn_exp2f(v * p)); }

struct GatherOrder : GroupedOrder { static constexpr bool GATHER = true; int zrow;
    __device__ __forceinline__ int tok(const Unit& u, int r) const { const int rel = u.pm * BM - u.pst + r; return rel < u.cn ? rowtab[(size_t)u.ex * MOE_CAP + rel] : zrow; } };

template <bool GELU, bool RSCALE = false> struct EpiBf16 {
    static constexpr bool PERM = true, AFTER_DRAIN = false;
    bf16_t* O; int ldc; int gelu_lo, gelu_hi; const float* rs;
    __device__ __forceinline__ void operator()(const f32x4 (&acc)[2][2][4][2], const Unit& u, int wr, int wc, int fr, int fq) const {
        const int row0 = u.pm * BM + wr * 64 + fr, col0 = u.pn * BM + wc * 32 + 8 * fq;
        const bool act = GELU && (u.pn >= gelu_lo && u.pn < gelu_hi);
#pragma unroll
        for (int ai = 0; ai < 2; ++ai)
#pragma unroll
            for (int m = 0; m < 4; ++m) { bf16_t* rowp = O + (size_t)(row0 + ai * HALF + m * 16) * ldc + col0;
#pragma unroll
                for (int bj = 0; bj < 2; ++bj) { f32x4 v0 = acc[ai][bj][m][0], v1 = acc[ai][bj][m][1];
                    if (RSCALE) { const float r = rs[row0 + ai * HALF + m * 16]; v0 = v0 * r; v1 = v1 * r; }
                    if (act) {
#pragma unroll
                        for (int j = 0; j < 4; ++j) { v0[j] = gelu_tanh(v0[j]); v1[j] = gelu_tanh(v1[j]); } }
                    u32x4 w; w.x = cvt_pk_bf16(v0[0], v0[1]); w.y = cvt_pk_bf16(v0[2], v0[3]); w.z = cvt_pk_bf16(v1[0], v1[1]); w.w = cvt_pk_bf16(v1[2], v1[3]);
                    *(u32x4*)(rowp + bj * HALF) = w; } }
    }
};
struct EpiSwiglu {
    static constexpr bool PERM = true, AFTER_DRAIN = false;
    bf16_t* O; int ldc; const float* rs;
    __device__ __forceinline__ void operator()(const f32x4 (&acc)[2][2][4][2], const Unit& u, int wr, int wc, int fr, int fq) const {
        const int row0 = u.pm * BM + wr * 64 + fr, col0 = u.pn * HALF + wc * 32 + 8 * fq;
#pragma unroll
        for (int ai = 0; ai < 2; ++ai)
#pragma unroll
            for (int m = 0; m < 4; ++m) { bf16_t* rowp = O + (size_t)(row0 + ai * HALF + m * 16) * ldc + col0;
                f32x4 v0, v1;
                const float r = rs[((size_t)u.ex * MOE_CAP - u.pst) + row0 + ai * HALF + m * 16];
#pragma unroll
                for (int j = 0; j < 4; ++j) { const float g0 = r * acc[ai][0][m][0][j], g1 = r * acc[ai][0][m][1][j];
                    v0[j] = g0 * sigmoidf_(g0) * (r * acc[ai][1][m][0][j]); v1[j] = g1 * sigmoidf_(g1) * (r * acc[ai][1][m][1][j]); }
                u32x4 w; w.x = cvt_pk_bf16(v0[0], v0[1]); w.y = cvt_pk_bf16(v0[2], v0[3]); w.z = cvt_pk_bf16(v1[0], v1[1]); w.w = cvt_pk_bf16(v1[2], v1[3]);
                *(u32x4*)rowp = w; }
    }
};
struct EpiLruGate {
    static constexpr bool PERM = true, AFTER_DRAIN = false;
    bf16_t* LA; bf16_t* U; const bf16_t* XS; int ldc; const float* b_a; const float* b_x; const float* lam; float* SA; float* SH;
    __device__ __forceinline__ void operator()(const f32x4 (&acc)[2][2][4][2], const Unit& u, int wr, int wc, int fr, int fq) const {
        const int row0 = u.pm * BM + wr * 64 + fr, ch0 = u.pn * HALF + wc * 32 + 8 * fq;
        float ba[8], bx[8], sp8[8];
#pragma unroll
        for (int j = 0; j < 8; ++j) { ba[j] = -1.4426950408889634f * b_a[ch0 + j]; bx[j] = -1.4426950408889634f * b_x[ch0 + j]; const float l = lam[ch0 + j];
            sp8[j] = (8.0f * 1.4426950408889634f) * ((l > 15.f) ? __expf(-l) : __logf(1.0f + __expf(-l))); }
#pragma unroll
        for (int ai = 0; ai < 2; ++ai) {
            float Ac[8], Hc[8];
#pragma unroll
            for (int j = 0; j < 8; ++j) { Ac[j] = 1.f; Hc[j] = 0.f; }
#pragma unroll
            for (int m = 0; m < 4; ++m) { const size_t off = (size_t)(row0 + ai * HALF + m * 16) * ldc + ch0;
                const u32x4 xw = *(const u32x4*)(XS + off);
                float xv[8] = {bf_lo(xw.x), bf_hi(xw.x), bf_lo(xw.y), bf_hi(xw.y), bf_lo(xw.z), bf_hi(xw.z), bf_lo(xw.w), bf_hi(xw.w)};
                float la[8], ig8[8];
#pragma unroll
                for (int j = 0; j < 8; ++j) { const float er = __builtin_amdgcn_exp2f(__builtin_fmaf(acc[ai][0][m][j >> 2][j & 3], -1.4426950408889634f, ba[j])), ei = __builtin_amdgcn_exp2f(__builtin_fmaf(acc[ai][1][m][j >> 2][j & 3], -1.4426950408889634f, bx[j]));
                    la[j] = -sp8[j] * __builtin_amdgcn_rcpf(1.0f + er); ig8[j] = __builtin_amdgcn_rcpf(1.0f + ei); }
                u32x4 w; w.x = cvt_pk_bf16(la[0], la[1]); w.y = cvt_pk_bf16(la[2], la[3]); w.z = cvt_pk_bf16(la[4], la[5]); w.w = cvt_pk_bf16(la[6], la[7]);
                *(u32x4*)(LA + off) = w;
                float A8[8], uu[8];
                { const unsigned lw[4] = {w.x, w.y, w.z, w.w};
#pragma unroll
                  for (int j = 0; j < 8; ++j) { const float lr = (j & 1) ? bf_hi(lw[j >> 1]) : bf_lo(lw[j >> 1]); const float a = __builtin_amdgcn_exp2f(lr); A8[j] = a;
                      const float t = 1.3862943611198906f * lr  ; const float om = (t > -0.002f) ? -t * (1.0f + 0.5f * t) : 1.0f - a * a;
                      uu[j] = __builtin_amdgcn_sqrtf(om) * ig8[j] * xv[j]; } }
                u32x4 w2; w2.x = cvt_pk_bf16(uu[0], uu[1]); w2.y = cvt_pk_bf16(uu[2], uu[3]); w2.z = cvt_pk_bf16(uu[4], uu[5]); w2.w = cvt_pk_bf16(uu[6], uu[7]);
                *(u32x4*)(U + off) = w2;
                { const unsigned uw[4] = {w2.x, w2.y, w2.z, w2.w}; float H8[8];
#pragma unroll
                  for (int j = 0; j < 8; ++j) H8[j] = (j & 1) ? bf_hi(uw[j >> 1]) : bf_lo(uw[j >> 1]);
#define LRU_DPP_STEP(SH) asm( \
                      "s_nop 1\n\tv_fmac_f32_dpp %0, %0, %8 " SH " row_mask:0xf bank_mask:0xf\n\tv_fmac_f32_dpp %1, %1, %9 " SH " row_mask:0xf bank_mask:0xf\n\t" \
                      "v_fmac_f32_dpp %2, %2, %10 " SH " row_mask:0xf bank_mask:0xf\n\tv_fmac_f32_dpp %3, %3, %11 " SH " row_mask:0xf bank_mask:0xf\n\t" \
                      "v_fmac_f32_dpp %4, %4, %12 " SH " row_mask:0xf bank_mask:0xf\n\tv_fmac_f32_dpp %5, %5, %13 " SH " row_mask:0xf bank_mask:0xf\n\t" \
                      "v_fmac_f32_dpp %6, %6, %14 " SH " row_mask:0xf bank_mask:0xf\n\tv_fmac_f32_dpp %7, %7, %15 " SH " row_mask:0xf bank_mask:0xf\n\t" \
                      "v_mul_f32_dpp %8, %8, %8 " SH " row_mask:0xf bank_mask:0xf\n\tv_mul_f32_dpp %9, %9, %9 " SH " row_mask:0xf bank_mask:0xf\n\t" \
                      "v_mul_f32_dpp %10, %10, %10 " SH " row_mask:0xf bank_mask:0xf\n\tv_mul_f32_dpp %11, %11, %11 " SH " row_mask:0xf bank_mask:0xf\n\t" \
                      "v_mul_f32_dpp %12, %12, %12 " SH " row_mask:0xf bank_mask:0xf\n\tv_mul_f32_dpp %13, %13, %13 " SH " row_mask:0xf bank_mask:0xf\n\t" \
                      "v_mul_f32_dpp %14, %14, %14 " SH " row_mask:0xf bank_mask:0xf\n\tv_mul_f32_dpp %15, %15, %15 " SH " row_mask:0xf bank_mask:0xf" \
                      : "+v"(H8[0]), "+v"(H8[1]), "+v"(H8[2]), "+v"(H8[3]), "+v"(H8[4]), "+v"(H8[5]), "+v"(H8[6]), "+v"(H8[7]), \
                        "+v"(A8[0]), "+v"(A8[1]), "+v"(A8[2]), "+v"(A8[3]), "+v"(A8[4]), "+v"(A8[5]), "+v"(A8[6]), "+v"(A8[7]))
                  LRU_DPP_STEP("row_shr:1"); LRU_DPP_STEP("row_shr:2"); LRU_DPP_STEP("row_shr:4"); LRU_DPP_STEP("row_shr:8");
#undef LRU_DPP_STEP
#pragma unroll
                  for (int j = 0; j < 8; ++j) { Hc[j] = A8[j] * Hc[j] + H8[j]; Ac[j] = A8[j] * Ac[j]; } }
                __builtin_amdgcn_sched_barrier(0); }
            if (fr == 15) { float* sa = SA + (size_t)(u.pm * 4 + ai * 2 + wr) * 768 + ch0; float* sh = SH + (size_t)(u.pm * 4 + ai * 2 + wr) * 768 + ch0;
                *(f32x4*)sa = (f32x4){Ac[0], Ac[1], Ac[2], Ac[3]}; *(f32x4*)(sa + 4) = (f32x4){Ac[4], Ac[5], Ac[6], Ac[7]};
                *(f32x4*)sh = (f32x4){Hc[0], Hc[1], Hc[2], Hc[3]}; *(f32x4*)(sh + 4) = (f32x4){Hc[4], Hc[5], Hc[6], Hc[7]}; }
        }
    }
};
struct EpiResF32 {
    static constexpr bool PERM = false, AFTER_DRAIN = false;
    float* C; const float* R; int ldc;
    __device__ __forceinline__ void operator()(const f32x4 (&acc)[2][2][4][2], const Unit& u, int wr, int wc, int fr, int fq) const {
        const int row0 = u.pm * BM + wr * 64 + fr, col0 = u.pn * BM + wc * 32 + 4 * fq;
#pragma unroll
        for (int ai = 0; ai < 2; ++ai)
#pragma unroll
            for (int m = 0; m < 4; ++m) { const size_t ro = (size_t)(row0 + ai * HALF + m * 16) * ldc + col0;
#pragma unroll
                for (int bj = 0; bj < 2; ++bj)
#pragma unroll
                    for (int n = 0; n < 2; ++n) { const f32x4 r = *(const f32x4*)(R + ro + bj * HALF + n * 16); *(f32x4*)(C + ro + bj * HALF + n * 16) = r + acc[ai][bj][m][n]; }  __builtin_amdgcn_sched_barrier(0); }
    }
};
template <bool RBF> struct EpiResBf16 {
    static constexpr bool PERM = true, AFTER_DRAIN = false;
    bf16_t* X; const void* R; int ldc;
    __device__ __forceinline__ void operator()(const f32x4 (&acc)[2][2][4][2], const Unit& u, int wr, int wc, int fr, int fq) const {
        const int row0 = u.pm * BM + wr * 64 + fr, col0 = u.pn * BM + wc * 32 + 8 * fq;
#pragma unroll
        for (int ai = 0; ai < 2; ++ai)
#pragma unroll
            for (int m = 0; m < 4; ++m) { const size_t ro = (size_t)(row0 + ai * HALF + m * 16) * ldc + col0;
#pragma unroll
                for (int bj = 0; bj < 2; ++bj) { f32x4 v0 = acc[ai][bj][m][0], v1 = acc[ai][bj][m][1];
                    if (RBF) { const u32x4 rw = *(const u32x4*)((const bf16_t*)R + ro + bj * HALF);
                        v0[0] += bf_lo(rw.x); v0[1] += bf_hi(rw.x); v0[2] += bf_lo(rw.y); v0[3] += bf_hi(rw.y); v1[0] += bf_lo(rw.z); v1[1] += bf_hi(rw.z); v1[2] += bf_lo(rw.w); v1[3] += bf_hi(rw.w); }
                    else { const f32x4 r0 = *(const f32x4*)((const float*)R + ro + bj * HALF), r1 = *(const f32x4*)((const float*)R + ro + bj * HALF + 4); v0 += r0; v1 += r1; }
                    u32x4 w; w.x = cvt_pk_bf16(v0[0], v0[1]); w.y = cvt_pk_bf16(v0[2], v0[3]); w.z = cvt_pk_bf16(v1[0], v1[1]); w.w = cvt_pk_bf16(v1[2], v1[3]);
                    *(u32x4*)(X + ro + bj * HALF) = w; }
                __builtin_amdgcn_sched_barrier(0); }
    }
};
struct EpiFp8 {
    static constexpr bool PERM = true, AFTER_DRAIN = false;
    unsigned char* O; int ldc;
    __device__ __forceinline__ void operator()(const f32x4 (&acc)[2][2][4][2], const Unit& u, int wr, int wc, int fr, int fq) const {
        const int row0 = u.pm * BM + wr * 64 + fr, col0 = u.pn * BM + wc * 32 + 8 * fq;
#pragma unroll
        for (int ai = 0; ai < 2; ++ai)
#pragma unroll
            for (int m = 0; m < 4; ++m) { unsigned char* rowp = O + (size_t)(row0 + ai * HALF + m * 16) * ldc + col0;
#pragma unroll
                for (int bj = 0; bj < 2; ++bj) { const f32x4 v0 = acc[ai][bj][m][0] * 16.0f, v1 = acc[ai][bj][m][1] * 16.0f;
                    int w0 = 0, w1 = 0;
                    w0 = __builtin_amdgcn_cvt_pk_fp8_f32(v0[0], v0[1], w0, false); w0 = __builtin_amdgcn_cvt_pk_fp8_f32(v0[2], v0[3], w0, true);
                    w1 = __builtin_amdgcn_cvt_pk_fp8_f32(v1[0], v1[1], w1, false); w1 = __builtin_amdgcn_cvt_pk_fp8_f32(v1[2], v1[3], w1, true);
                    typedef int i32x2 __attribute__((ext_vector_type(2)));
                    *(i32x2*)(rowp + bj * HALF) = (i32x2){w0, w1}; } }
    }
};
struct EpiLogits {
    static constexpr bool PERM = false, AFTER_DRAIN = false;
    float* C;
    __device__ __forceinline__ void operator()(const f32x4 (&acc)[2][2][4][2], const Unit& u, int wr, int wc, int fr, int fq) const {
        if (wc >= 2 || u.pn != 0) return;
        const int row0 = u.pm * BM + wr * 64 + fr, col0 = wc * 32 + 4 * fq;
#pragma unroll
        for (int ai = 0; ai < 2; ++ai)
#pragma unroll
            for (int m = 0; m < 4; ++m) { float* rowp = C + (size_t)(row0 + ai * HALF + m * 16) * 64 + col0;
#pragma unroll
                for (int n = 0; n < 2; ++n) *(f32x4*)(rowp + n * 16) = acc[ai][0][m][n]; }
    }
};
template <class Epi, class Sched, bool ALIGN_EPI = false, bool SP2 = false>
__device__ __forceinline__ void gemm_phase(PG8_LAS unsigned char* lds, const Gemm g, const Sched& S, const Epi& E, int wave_id) {
    int lane_; asm volatile("v_mbcnt_lo_u32_b32 %0, -1, 0\n\tv_mbcnt_hi_u32_b32 %0, -1, %0" : "=v"(lane_)); const int tid_ = wave_id * 64 + lane_;
    const int tid = tid_, wid = __builtin_amdgcn_readfirstlane(tid >> 6), lane = tid & 63, wr = wid >> 2, wc = wid & 3, fr = lane & 15, fq = lane >> 4;
    static_assert(SP2, "only the SP2 loop carries the per-lane A offsets");
    const int ntd = g.K / BK;
    constexpr bool GATH = Sched::GATHER;
    unsigned voffA[2], voffB[2]; int Rrow[2], Ccol[2];
#pragma unroll
    for (int i = 0; i < 2; ++i) { int R, C; stage_rc(tid * 16 + i * 8192, R, C); Rrow[i] = R; Ccol[i] = C; const int Rb = Epi::PERM ? ((R & ~31) + perm32(R & 31)) : R;
        voffA[i] = (unsigned)(R * g.lda + C) * 2u; voffB[i] = (unsigned)(Rb * g.ldb + C) * 2u; }
    const size_t kstep = (size_t)(BK * 2);
    const size_t hsA = (size_t)HALF * g.lda * 2, hsB = (size_t)HALF * g.ldb * 2;
    const size_t tsA = 2 * hsA, tsB = 2 * hsB;
    const unsigned ldsw = (unsigned)wid * 1024u;
    const int aoff = lds_byte(wr * 64 + fr, fq * 8), boff = lds_byte(wc * 32 + fr, fq * 8);
#define PG8_SA(b, h) (((b) * 2 + (h)) * HTB)
#define PG8_SB(b, h) ((4 + (b) * 2 + (h)) * HTB)
#define PG8_STAGE(bufoff, gbase, voff) do { _Pragma("unroll") for (int _i = 0; _i < 2; ++_i) \
        __builtin_amdgcn_global_load_lds((const unsigned*)((const char*)(gbase) + (voff)[_i]), (PG8_LAS unsigned*)(lds + (bufoff) + ldsw + _i * 8192), 16, 0, 0); } while (0)
#define PG8_LDA(dst, b, h) do { _Pragma("unroll") for (int m = 0; m < 4; ++m) _Pragma("unroll") for (int k = 0; k < 2; ++k) dst[m][k] = *(const PG8_LAS bf16x8*)(lds + PG8_SA(b, h) + aoff + m * 2048 + k * 1024); } while (0)
#define PG8_LDB(dst, b, h) do { _Pragma("unroll") for (int n = 0; n < 2; ++n) _Pragma("unroll") for (int k = 0; k < 2; ++k) dst[n][k] = *(const PG8_LAS bf16x8*)(lds + PG8_SB(b, h) + boff + n * 2048 + k * 1024); } while (0)
#define PG8_MMA(ai, bj, At, Bt) do { __builtin_amdgcn_s_setprio(1); _Pragma("unroll") for (int m = 0; m < 4; ++m) _Pragma("unroll") for (int n = 0; n < 2; ++n) _Pragma("unroll") for (int k = 0; k < 2; ++k) \
        acc[ai][bj][m][n] = __builtin_amdgcn_mfma_f32_16x16x32_bf16(Bt[n][k], At[m][k], acc[ai][bj][m][n], 0, 0, 0); __builtin_amdgcn_s_setprio(0); } while (0)
#define PG8_WAIT_V(n) asm volatile("s_waitcnt vmcnt(" #n ")" ::: "memory")
#define PG8_WAIT_L(n) asm volatile("s_waitcnt lgkmcnt(" #n ")" ::: "memory")
#define PG8_BAR __builtin_amdgcn_s_barrier()
#define PG8_SCHED __builtin_amdgcn_sched_barrier(0)
    Unit cur, nxt; int ui = 0;
    if (!S.next(0, cur)) return;
    f32x4 acc[2][2][4][2];
#pragma unroll
    for (int a = 0; a < 2; ++a)
#pragma unroll
        for (int b = 0; b < 2; ++b)
#pragma unroll
            for (int m = 0; m < 4; ++m)
#pragma unroll
                for (int n = 0; n < 2; ++n) acc[a][b][m][n] = (f32x4){0.f, 0.f, 0.f, 0.f};
    bf16x8 At[4][2], B0[2][2], B1[2][2];
    const char* cA = (const char*)g.A + (GATH ? (size_t)0 : (size_t)cur.pm * tsA) + cur.koff; const char* cB = (const char*)g.Bt + cur.boff + (size_t)cur.pn * tsB + cur.koff;
    unsigned oc[2][2], on[2][2];
#pragma unroll
    for (int h = 0; h < 2; ++h)
#pragma unroll
        for (int i = 0; i < 2; ++i) { if constexpr (GATH) oc[h][i] = (unsigned)S.tok(cur, h * HALF + Rrow[i]) * (unsigned)(g.lda * 2) + (unsigned)(Ccol[i] * 2); else oc[h][i] = voffA[i] + (unsigned)(h * hsA); on[h][i] = oc[h][i]; }
    S.a_ready(cur);
    if constexpr (SP2) {
        PG8_STAGE(PG8_SB(0, 0), cB, voffB); PG8_STAGE(PG8_SB(0, 1), cB + hsB, voffB); PG8_STAGE(PG8_SA(0, 0), cA, oc[0]); PG8_STAGE(PG8_SA(0, 1), cA, oc[1]);
        if (wr == 1) PG8_BAR;
        PG8_WAIT_V(2); PG8_BAR;
        PG8_STAGE(PG8_SB(1, 0), cB + kstep, voffB); PG8_STAGE(PG8_SA(1, 0), cA + kstep, oc[0]); PG8_STAGE(PG8_SB(1, 1), cB + hsB + kstep, voffB);
        PG8_WAIT_V(6); PG8_BAR;
    } else {
        PG8_STAGE(PG8_SB(0, 0), cB, voffB); PG8_STAGE(PG8_SA(0, 0), cA, voffA); PG8_STAGE(PG8_SB(0, 1), cB + hsB, voffB); PG8_STAGE(PG8_SA(0, 1), cA + hsA, voffA);
        if (wr == 1) PG8_BAR;
        PG8_WAIT_V(4); PG8_BAR;
        PG8_STAGE(PG8_SB(1, 0), cB + kstep, voffB); PG8_STAGE(PG8_SA(1, 0), cA + kstep, voffA); PG8_STAGE(PG8_SB(1, 1), cB + hsB + kstep, voffB);
        PG8_WAIT_V(6); PG8_BAR;
    }
    for (;;) {
        const bool has_next = S.next(ui + 1, nxt);
        if constexpr (GATH) { if (has_next) {
#pragma unroll
            for (int h = 0; h < 2; ++h)
#pragma unroll
                for (int i = 0; i < 2; ++i) on[h][i] = (unsigned)S.tok(nxt, h * HALF + Rrow[i]) * (unsigned)(g.lda * 2) + (unsigned)(Ccol[i] * 2); } }
        const char* nA = has_next ? (const char*)g.A + (GATH ? (size_t)0 : (size_t)nxt.pm * tsA) + nxt.koff : cA; const char* nB = has_next ? (const char*)g.Bt + nxt.boff + (size_t)nxt.pn * tsB + nxt.koff : cB;
        const int nt = cur.nt ? cur.nt : ntd;
        for (int t = 0; t < nt; t += 2) {
            const bool last = (t == nt - 2);
            const char* a1 = cA + (size_t)(t + 1) * kstep;
            const char* a2 = last ? nA : cA + (size_t)(t + 2) * kstep; const char* b2 = last ? nB : cB + (size_t)(t + 2) * kstep;
            const char* a3 = a2 + kstep; const char* b3 = b2 + kstep;
            if (last && has_next) S.a_ready(nxt);
            unsigned s2[2][2];
#pragma unroll
            for (int h = 0; h < 2; ++h)
#pragma unroll
                for (int i = 0; i < 2; ++i) s2[h][i] = (GATH && last) ? on[h][i] : oc[h][i];
            if constexpr (SP2) {
            PG8_LDB(B0, 0, 0); PG8_LDB(B1, 0, 1); PG8_SCHED; PG8_LDA(At, 0, 0); PG8_STAGE(PG8_SA(1, 1), a1, oc[1]);
            PG8_WAIT_V(8); PG8_WAIT_L(0); PG8_BAR; PG8_MMA(0, 0, At, B0); PG8_MMA(0, 1, At, B1); PG8_BAR; PG8_SCHED;
            PG8_LDA(At, 0, 1); PG8_STAGE(PG8_SB(0, 0), b2, voffB); PG8_STAGE(PG8_SB(0, 1), b2 + hsB, voffB); PG8_STAGE(PG8_SA(0, 0), a2, s2[0]);
            PG8_WAIT_V(8); PG8_WAIT_L(0); PG8_BAR; PG8_MMA(1, 0, At, B0); PG8_MMA(1, 1, At, B1); PG8_BAR; PG8_SCHED;
            PG8_LDB(B0, 1, 0); PG8_LDB(B1, 1, 1); PG8_SCHED; PG8_LDA(At, 1, 0); PG8_STAGE(PG8_SA(0, 1), a2, s2[1]);
            PG8_WAIT_V(8); PG8_WAIT_L(0); PG8_BAR; PG8_MMA(0, 0, At, B0); PG8_MMA(0, 1, At, B1); PG8_BAR; PG8_SCHED;
            PG8_LDA(At, 1, 1); PG8_STAGE(PG8_SB(1, 0), b3, voffB); PG8_STAGE(PG8_SB(1, 1), b3 + hsB, voffB); PG8_STAGE(PG8_SA(1, 0), a3, s2[0]);
            PG8_WAIT_V(8); PG8_WAIT_L(0); PG8_BAR; PG8_MMA(1, 0, At, B0); PG8_MMA(1, 1, At, B1); PG8_BAR; PG8_SCHED;
            } else {
            PG8_LDB(B0, 0, 0); PG8_SCHED; PG8_LDA(At, 0, 0); PG8_STAGE(PG8_SA(1, 1), a1 + hsA, voffA);
            PG8_WAIT_L(8); PG8_BAR; PG8_WAIT_L(0); PG8_MMA(0, 0, At, B0); PG8_BAR; PG8_SCHED;
            PG8_LDB(B1, 0, 1); PG8_STAGE(PG8_SB(0, 0), b2, voffB);
            PG8_BAR; PG8_WAIT_L(0); PG8_MMA(0, 1, At, B1); PG8_BAR;
            PG8_LDA(At, 0, 1); PG8_STAGE(PG8_SA(0, 0), a2, voffA);
            PG8_BAR; PG8_WAIT_L(0); PG8_MMA(1, 0, At, B0); PG8_BAR; PG8_SCHED;
            PG8_STAGE(PG8_SB(0, 1), b2 + hsB, voffB);
            PG8_WAIT_V(6); PG8_BAR; PG8_MMA(1, 1, At, B1); PG8_BAR;
            PG8_LDB(B0, 1, 0); PG8_SCHED; PG8_LDA(At, 1, 0); PG8_STAGE(PG8_SA(0, 1), a2 + hsA, voffA);
            PG8_WAIT_L(8); PG8_BAR; PG8_WAIT_L(0); PG8_MMA(0, 0, At, B0); PG8_BAR; PG8_SCHED;
            PG8_LDB(B1, 1, 1); PG8_STAGE(PG8_SB(1, 0), b3, voffB);
            PG8_BAR; PG8_WAIT_L(0); PG8_MMA(0, 1, At, B1); PG8_BAR;
            PG8_LDA(At, 1, 1); PG8_STAGE(PG8_SA(1, 0), a3, voffA);
            PG8_BAR; PG8_WAIT_L(0); PG8_MMA(1, 0, At, B0); PG8_BAR; PG8_SCHED;
            PG8_STAGE(PG8_SB(1, 1), b3 + hsB, voffB);
            PG8_WAIT_V(6); PG8_BAR; PG8_MMA(1, 1, At, B1); PG8_BAR;
            }
        }
        if constexpr (ALIGN_EPI) { if (wr == 0) PG8_BAR; }
        if constexpr (!Epi::AFTER_DRAIN) { E(acc, cur, wr, wc, fr, fq); S.done(cur); }
        if (!has_next) break;
#pragma unroll
        for (int a = 0; a < 2; ++a)
#pragma unroll
            for (int b = 0; b < 2; ++b)
#pragma unroll
                for (int m = 0; m < 4; ++m)
#pragma unroll
                    for (int n = 0; n < 2; ++n) acc[a][b][m][n] = (f32x4){0.f, 0.f, 0.f, 0.f};
        cur = nxt; cA = nA; cB = nB; ++ui;
#pragma unroll
        for (int h = 0; h < 2; ++h)
#pragma unroll
            for (int i = 0; i < 2; ++i) oc[h][i] = on[h][i];
        if constexpr (ALIGN_EPI) { if (wr == 1) PG8_BAR; }
    }
    PG8_WAIT_V(0);
    if constexpr (!ALIGN_EPI) { if (wr == 0) PG8_BAR; }
    PG8_BAR;
    if constexpr (Epi::AFTER_DRAIN) { E.fused(acc, cur, wr, wc, fr, fq, lds, wid, lane); S.done(cur); }
#undef PG8_SA
#undef PG8_SB
#undef PG8_STAGE
#undef PG8_LDA
#undef PG8_LDB
#undef PG8_MMA
#undef PG8_WAIT_V
#undef PG8_WAIT_L
#undef PG8_BAR
#undef PG8_SCHED
}
}

constexpr int NTOK = 32768, SEQ = 16384, DM = 1024;
constexpr float EPS = 1e-6f;
constexpr size_t MiB = 1u << 20;
constexpr size_t WS_CTL = 0, CTL_ZERO_BYTES = 1 * MiB;
constexpr size_t WS_WB = 1 * MiB;
constexpr size_t WB_MKV = WS_WB + 0 * MiB;
constexpr size_t WB_MEMN = WS_WB + 1 * MiB;
constexpr size_t WB_MKVO = WS_WB + 2 * MiB;
constexpr size_t WB_WR = WS_WB + 3 * MiB;
constexpr size_t WB_WIN = WS_WB + 4 * MiB;
constexpr size_t WB_WGT = WS_WB + 8 * MiB;
constexpr size_t WB_WOUT = WS_WB + 11 * MiB;
constexpr size_t WB_WGU = WS_WB + 16 * MiB;
constexpr size_t WB_WD = WS_WB + 80 * MiB;
constexpr size_t WS_HN = WS_WB + 112 * MiB;
constexpr size_t WS_AR = WS_HN + 64 * MiB;
constexpr size_t AR_PROJ = WS_AR;
constexpr size_t AR_XSC = WS_AR + 112 * MiB;
constexpr size_t AR_LA = WS_AR + 160 * MiB;
constexpr size_t AR_UU = WS_AR + 208 * MiB;
constexpr size_t AR_MIXL = WS_AR + 256 * MiB;
constexpr size_t AR_SA = WS_AR + 320 * MiB;
constexpr size_t AR_SH = WS_AR + 322 * MiB;
constexpr size_t AR_CARRY = WS_AR + 324 * MiB;
constexpr size_t AR_KN = WS_AR + 96 * MiB;
constexpr size_t AR_KIN = WS_AR + 100 * MiB;
constexpr size_t AR_QIW = WS_AR + 104 * MiB;
constexpr size_t AR_WI = WS_AR + 264 * MiB;
constexpr size_t AR_SEL = WS_AR + 120 * MiB;
constexpr size_t AR_V8 = WS_HN;
constexpr size_t AR_MIXD = WS_AR + 152 * MiB;
constexpr size_t AR_XS = WS_AR;
constexpr size_t AR_ACT = WS_AR + 144 * MiB;
constexpr size_t AR_LOG = WS_AR + 216 * MiB;
constexpr size_t AR_EID = WS_AR + 224 * MiB;
constexpr size_t AR_GATE = WS_AR + 225 * MiB;
constexpr size_t AR_DEST = WS_AR + 226 * MiB;
constexpr size_t AR_R = WS_AR + 227 * MiB;
constexpr size_t AR_RS = WS_AR + 228 * MiB;
constexpr size_t WB_WGU1 = WS_AR + 265 * MiB;
constexpr size_t WB_WD1 = WS_AR + 329 * MiB;
constexpr size_t WS_END = WB_WD1 + 32 * MiB;
constexpr size_t WS_X2 = WB_WGU;
constexpr int CW_TMO = 0, CW_CODE = 1;
constexpr int CW_CNT = 256, CW_CUR = 320, CW_NT = 384, CW_LSTRIDE = 256;
constexpr int CW_TE = 1024, CW_TE_STRIDE = 512;
constexpr int CW_BAR = 4096;
constexpr int CW_RDY = 65536;
constexpr int LDS_BYTES = 159744, MISC_OFF = 155648;
constexpr int TAB_OFF = 143360;

#define GAS __attribute__((address_space(1)))
#define LAS __attribute__((address_space(3)))
#define DI __device__ __forceinline__
typedef unsigned short bf16;
typedef unsigned v4u __attribute__((ext_vector_type(4)));
typedef unsigned v2u __attribute__((ext_vector_type(2)));
typedef int v4i __attribute__((ext_vector_type(4)));
typedef float f32x4 __attribute__((ext_vector_type(4)));
typedef float f32x16 __attribute__((ext_vector_type(16)));
typedef short bf16x8 __attribute__((ext_vector_type(8)));
typedef GAS unsigned gu32;
#define RLX_AGENT __ATOMIC_RELAXED, __HIP_MEMORY_SCOPE_AGENT
#define LDS_WAIT() asm volatile("s_waitcnt lgkmcnt(0)" ::: "memory")
DI unsigned f2bf(float f) { unsigned u = __builtin_bit_cast(unsigned, f); return (u + 0x7fffu + ((u >> 16) & 1u)) >> 16; }
typedef __bf16 bf2_t __attribute__((ext_vector_type(2)));
typedef float f32x2_t __attribute__((ext_vector_type(2)));
DI unsigned pk2(float lo, float hi) { const bf2_t v = __builtin_convertvector((f32x2_t){lo, hi}, bf2_t); return __builtin_bit_cast(unsigned, v); }
DI float bflo(unsigned w) { return __uint_as_float(w << 16); }
DI float bfhi(unsigned w) { return __uint_as_float(w & 0xffff0000u); }
DI void unpack8(const v4u w, float (&f)[8]) { f[0] = bflo(w.x); f[1] = bfhi(w.x); f[2] = bflo(w.y); f[3] = bfhi(w.y); f[4] = bflo(w.z); f[5] = bfhi(w.z); f[6] = bflo(w.w); f[7] = bfhi(w.w); }
DI v4u pack8(const float (&f)[8]) { v4u w; w.x = pk2(f[0], f[1]); w.y = pk2(f[2], f[3]); w.z = pk2(f[4], f[5]); w.w = pk2(f[6], f[7]); return w; }
DI unsigned lds_add(LAS unsigned* p, unsigned v) { return __hip_atomic_fetch_add(p, v, __ATOMIC_RELAXED, __HIP_MEMORY_SCOPE_WORKGROUP); }
DI float wave_sum(float v) {
#pragma unroll
    for (int o = 1; o < 64; o <<= 1) v += __shfl_xor(v, o);
    return v;
}

#define XB_TMO      128
#define XB_XCNT(j)  (256  + 64 * (j))
#define XB_XSUB(j)  (1280 + 64 * (j))
#define XB_XGEN(j)  (2304 + 64 * (j))
#define XB_TOP      3328
#define XB_TOPGEN   3392
#define XCD_BAR_WORDS 3456
#define XB_SPIN_CAP (1u << 22)
DI unsigned xb_ld(unsigned* p)              { return __hip_atomic_load(p, __ATOMIC_RELAXED, __HIP_MEMORY_SCOPE_AGENT); }
DI unsigned xb_add(unsigned* p, unsigned v) { return __hip_atomic_fetch_add(p, v, __ATOMIC_RELAXED, __HIP_MEMORY_SCOPE_AGENT); }
DI unsigned xb_xcc_id() { return (unsigned)__builtin_amdgcn_s_getreg((3 << 11) | 20) & 0xFu; }
#define XB_SPIN(cond, bar) do { unsigned _sp = 0; while (cond) { __builtin_amdgcn_s_sleep(1); \
    if ((++_sp & 255u) == 0u) { if (xb_ld(&(bar)[XB_TMO])) break; if (_sp > XB_SPIN_CAP) { atomicAdd(&(bar)[XB_TMO], 1u); break; } } } } while (0)
DI int hw_lane() { int l; asm volatile("v_mbcnt_lo_u32_b32 %0, -1, 0\n\tv_mbcnt_hi_u32_b32 %0, -1, %0" : "=v"(l)); return l; }
struct XcdBarrier { unsigned* bar; unsigned x; volatile LAS unsigned* st; int wave; };
DI XcdBarrier xcd_barrier_post(unsigned* bar, volatile LAS unsigned* st, int wave) {
    XcdBarrier b; b.bar = bar; b.x = xb_xcc_id(); b.st = st; b.wave = wave;
    if (wave == 0 && hw_lane() == 0) (void)xb_add(&bar[XB_XCNT(b.x)], 1u);
    return b;
}
DI void xcd_barrier_complete(unsigned* bar, unsigned x, unsigned& nloc, unsigned& nx) {
    const unsigned G = gridDim.x * gridDim.y * gridDim.z;
    unsigned sum, cnt, mine, sp = 0u;
    for (;;) {
        sum = 0u; cnt = 0u; mine = 0u;
#pragma unroll
        for (unsigned j = 0; j < 16; ++j) { const unsigned c = xb_ld(&bar[XB_XCNT(j)]); sum += c; cnt += (c > 0u) ? 1u : 0u; mine = (j == x) ? c : mine; }
        if (sum == G) break;
        __builtin_amdgcn_s_sleep(1);
        if ((++sp & 255u) == 0u) { if (xb_ld(&bar[XB_TMO])) break; if (sp > XB_SPIN_CAP) { atomicAdd(&bar[XB_TMO], 1u); break; } }
    }
    nloc = mine > 0u ? mine : 1u; nx = cnt > 0u ? cnt : 1u;
}
DI void xcd_barrier(const XcdBarrier& b) {
    asm volatile("s_waitcnt vmcnt(0)" ::: "memory");
    __syncthreads();
    if (b.wave == 0 && hw_lane() == 0) {
        unsigned* bar = b.bar;
        __builtin_amdgcn_s_waitcnt(0);
        unsigned nloc = b.st[0], nx = b.st[1];
        if (nloc == 0u) { xcd_barrier_complete(bar, b.x, nloc, nx); b.st[0] = nloc; b.st[1] = nx; }
        const unsigned old = xb_add(&bar[XB_XSUB(b.x)], 1u);
        const unsigned gen = old / nloc;
        if (old + 1u == (gen + 1u) * nloc) {
            __builtin_amdgcn_fence(__ATOMIC_RELEASE, "agent");
            asm volatile("s_waitcnt vmcnt(0)" ::: "memory");
            const unsigned og = xb_add(&bar[XB_TOP], 1u);
            const unsigned tgt = (og / nx + 1u) * nx;
            if (og + 1u != tgt) XB_SPIN(xb_ld(&bar[XB_TOP]) < tgt, bar);
            xb_add(&bar[XB_XGEN(b.x)], 1u);
            __builtin_amdgcn_fence(__ATOMIC_ACQUIRE, "agent");
            asm volatile("s_waitcnt vmcnt(0)" ::: "memory");
        } else {
            XB_SPIN(xb_ld(&bar[XB_XGEN(b.x)]) == gen, bar);
            __builtin_amdgcn_fence(__ATOMIC_ACQUIRE, "agent");
            asm volatile("s_waitcnt vmcnt(0)" ::: "memory");
        }
    }
    __syncthreads();
}

struct Params { const float* in[29]; float* out; unsigned char* ws; };
struct PV { unsigned char* ws; float* out; LAS unsigned long long* tab; };
DI const float* pin(const PV& P, int i) { const unsigned long long v = P.tab[i]; const unsigned lo = __builtin_amdgcn_readfirstlane((unsigned)v), hi = __builtin_amdgcn_readfirstlane((unsigned)(v >> 32)); return (const float*)(const __attribute__((address_space(1))) float*)(((unsigned long long)hi << 32) | lo); }
struct Ctx { LAS unsigned char* lds; int tid, lane, wave, G, blk, gw, NGW; };
DI Ctx relaunder(const Ctx& c0) { Ctx c = c0; int t = c0.wave * 64 + hw_lane(); asm volatile("" : "+v"(t)); c.tid = t; c.lane = t & 63; c.wave = __builtin_amdgcn_readfirstlane(t >> 6); c.gw = c.blk * 8 + c.wave; return c; }
enum { I_X = 0, I_MEM, I_NORM_MIX, I_NORM_FFN, I_MEM_NORM, I_W_MEM_KV, I_XQ_NORM, I_XK_NORM, I_W_OUT, I_LRU_W_IN, I_LRU_CONV_W, I_LRU_CONV_B, I_LRU_W_A, I_LRU_B_A,
       I_LRU_W_X, I_LRU_B_X, I_LRU_LAMBDA, I_DSA_W_IN, I_DSA_Q_NORM, I_DSA_K_NORM, I_DSA_W_UV, I_REL_BIAS, I_MOE_W_GROUP, I_MOE_B_GROUP, I_MOE_W_ROUTER, I_MOE_B_ROUTER,
       I_MOE_W_GATE, I_MOE_W_UP, I_MOE_W_DOWN };

#define GAS __attribute__((address_space(1)))
DI void tr_load(const float* __restrict__ W0, int ldw, f32x4 (&v)[16], int lane) {
    const GAS float* W = (const GAS float*)W0;
    const int m = lane & 15, q = lane >> 4;
#pragma unroll
    for (int i = 0; i < 8; ++i) { const int kk = 8 * i + 2 * q; v[2 * i] = *(const GAS f32x4*)(W + (size_t)kk * ldw + 4 * m); v[2 * i + 1] = *(const GAS f32x4*)(W + (size_t)(kk + 1) * ldw + 4 * m); }
}
DI void tr_store(const f32x4 (&v)[16], bf16* __restrict__ WT0, int ldk, LAS unsigned* scr, int lane, const float* gk0 = nullptr) {
    GAS bf16* WT = (GAS bf16*)WT0; const GAS float* gk = (const GAS float*)gk0;
    const int m = lane & 15, q = lane >> 4;
#pragma unroll
    for (int i = 0; i < 8; ++i) {
        f32x4 v0 = v[2 * i], v1 = v[2 * i + 1];
        if (gk) { v0 = v0 * gk[8 * i + 2 * q]; v1 = v1 * gk[8 * i + 2 * q + 1]; }
        const int sw = 4 * (i ^ (m & 7)) + q;
        scr[(4 * m + 0) * 32 + sw] = pk2(v0.x, v1.x);
        scr[(4 * m + 1) * 32 + sw] = pk2(v0.y, v1.y);
        scr[(4 * m + 2) * 32 + sw] = pk2(v0.z, v1.z);
        scr[(4 * m + 3) * 32 + sw] = pk2(v0.w, v1.w);
    }
    LDS_WAIT();
#pragma unroll
    for (int r = 0; r < 8; ++r) {
        const int n = 8 * r + (lane >> 3), c = lane & 7;
        const v4u o = *(const LAS v4u*)(scr + n * 32 + 4 * (c ^ ((n >> 2) & 7)));
        *(GAS v4u*)(WT + (size_t)n * ldk + 8 * c) = o;
    }
    LDS_WAIT();
}
DI void rms_finish(f32x4 (&v)[4], const float* __restrict__ g, bf16* __restrict__ orow, int lane) {
    float s = 0.f;
#pragma unroll
    for (int j = 0; j < 4; ++j) s += (v[j].x * v[j].x + v[j].y * v[j].y) + (v[j].z * v[j].z + v[j].w * v[j].w);
    const float r = __builtin_amdgcn_rsqf(wave_sum(s) * (1.0f / 1024.0f) + EPS);
    const f32x4* gr = (const f32x4*)g + lane; v2u* o8 = (v2u*)orow + lane;
#pragma unroll
    for (int j = 0; j < 4; ++j) { const f32x4 gg = gr[64 * j]; v[j] = v[j] * r * gg; v2u o; o.x = pk2(v[j].x, v[j].y); o.y = pk2(v[j].z, v[j].w); o8[64 * j] = o; }
}
DI void rms_scale(f32x4 (&v)[4], const float* __restrict__ g, float* __restrict__ R, int row, int lane) {
    float s = 0.f;
#pragma unroll
    for (int j = 0; j < 4; ++j) s += (v[j].x * v[j].x + v[j].y * v[j].y) + (v[j].z * v[j].z + v[j].w * v[j].w);
    const float r = __builtin_amdgcn_rsqf(wave_sum(s) * (1.0f / 1024.0f) + EPS);
    if (lane == 0) R[row] = r;
    const f32x4* gr = (const f32x4*)g + lane;
#pragma unroll
    for (int j = 0; j < 4; ++j) v[j] = v[j] * r * gr[64 * j];
}
DI void rms_row(const float* __restrict__ xrow, const float* __restrict__ g, bf16* __restrict__ orow, int lane, f32x4 (&v)[4]) {
    const f32x4* xr = (const f32x4*)xrow + lane;
#pragma unroll
    for (int j = 0; j < 4; ++j) v[j] = xr[64 * j];
    rms_finish(v, g, orow, lane);
}
DI void wi_row(const f32x4 (&v)[4], const LAS f32x4* wiw, float* WI, int r, int lane) {
    f32x4 a = {0.f, 0.f, 0.f, 0.f};
#pragma unroll
    for (int j = 0; j < 4; ++j) { const int k0 = 4 * (lane + 64 * j); a += v[j].x * wiw[k0] + v[j].y * wiw[k0 + 1] + v[j].z * wiw[k0 + 2] + v[j].w * wiw[k0 + 3]; }
    a.x = wave_sum(a.x); a.y = wave_sum(a.y); a.z = wave_sum(a.z); a.w = wave_sum(a.w);
    if (lane == 0) *(f32x4*)(WI + (size_t)r * 4) = a * 0.5f;
}
struct TrJob { const float* src; bf16* dst; const float* gk; int ldw, ldk, nN, items; };
struct TileDesc { const float* src; bf16* dst; int ldw, ldk; const float* gk; };
template <int layer> DI void prep_setup(const Ctx& c, const PV& P) {
    unsigned char* ws = P.ws;
    LAS TrJob* jobs = (LAS TrJob*)(c.lds + 65536);
    LAS int* njp = (LAS int*)(c.lds + 65536 + 512);
    LAS f32x4* wiw = (LAS f32x4*)(c.lds + 69632);
    __syncthreads();
    if (c.tid == 0) {
        int nj = 0; const float* gjob = nullptr;
#define ADDJOB(S_, D_, K_, N_, LDW_, LDK_) do { jobs[nj].src = (S_); jobs[nj].dst = (D_); jobs[nj].gk = gjob; jobs[nj].ldw = (LDW_); jobs[nj].ldk = (LDK_); jobs[nj].nN = (N_) / 64; jobs[nj].items = ((K_) / 64) * ((N_) / 64); ++nj; } while (0)
        ADDJOB(pin(P, I_W_MEM_KV) + (size_t)layer * 1024 * 512, (bf16*)(ws + WB_MKV), 1024, 512, 512, 1024);
        if (layer == 0) {
            ADDJOB(pin(P, I_LRU_W_IN), (bf16*)(ws + WB_WIN), 1024, 1792, 1792, 1024);
            ADDJOB(pin(P, I_W_OUT), (bf16*)(ws + WB_WOUT), 1024, 1024, 1024, 1024);
        } else {
            gjob = pin(P, I_NORM_MIX) + 1024;
            ADDJOB(pin(P, I_DSA_W_IN), (bf16*)(ws + WB_WIN), 1024, 1280, 1540, 1024);
            ADDJOB(pin(P, I_DSA_W_IN) + 1284, (bf16*)(ws + WB_WIN) + (size_t)1280 * 1024, 1024, 256, 1540, 1024);
            gjob = nullptr;
            ADDJOB(pin(P, I_W_OUT) + (size_t)1024 * 1024 + (size_t)768 * 1024, (bf16*)(ws + WB_WOUT) + 1536, 256, 1024, 1024, 1792);
        }
#undef ADDJOB
        *njp = nj;
    }
    if (layer == 1) { const float* win = pin(P, I_DSA_W_IN); for (int k = c.tid; k < 1024; k += 512) wiw[k] = *(const f32x4*)(win + (size_t)k * 1540 + 1280); }
    __syncthreads();
}
#ifndef PREP_SPLIT
#define PREP_SPLIT 3072
#endif
template <int layer, int PART = 0> DI void prep_weights(const Ctx& c, const PV& P, int vw = 0, int nvw = 1) {
    unsigned char* ws = P.ws;
    LAS unsigned* scr = (LAS unsigned*)(c.lds + c.wave * 8192);
    LAS TrJob* jobs = (LAS TrJob*)(c.lds + 65536);
    LAS int* njp = (LAS int*)(c.lds + 65536 + 512);
    if (PART != 2 && PART != 3 && PART != 6 && PART != 8 && PART != 11 && PART != 12) { const float* gm = pin(P, I_MEM_NORM) + layer * 1024; const float* mem = pin(P, I_MEM); bf16* MEMN = (bf16*)(ws + WB_MEMN);
      for (int r = ((PART == 5 || PART == 7 || PART == 10) ? vw : c.gw); r < 512; r += ((PART == 5 || PART == 7 || PART == 10) ? nvw : c.NGW)) { f32x4 v[4]; rms_row(mem + (size_t)r * 1024, gm, MEMN + (size_t)r * 1024, c.lane, v); } }
    {
        const int nj = *njp; int gen_total = 0;
        for (int j = 0; j < nj; ++j) gen_total += jobs[j].items;
        const int total = gen_total + 3 * 32 * 128;
        const float* wg = pin(P, I_MOE_W_GATE) + (size_t)layer * 32 * 1024 * 512;
        const float* wu = pin(P, I_MOE_W_UP) + (size_t)layer * 32 * 1024 * 512;
        const float* wd = pin(P, I_MOE_W_DOWN) + (size_t)layer * 32 * 512 * 1024;
        const float* gffn = pin(P, I_NORM_FFN) + layer * 1024;
        bf16* WGU = (bf16*)(ws + (layer == 0 ? WB_WGU : WB_WGU1)); bf16* WD = (bf16*)(ws + (layer == 0 ? WB_WD : WB_WD1));
#define TILE_DESC(IT_, D_) do { const int it_ = (IT_); \
            if (it_ < gen_total) { int r = it_, j = 0; while (r >= jobs[j].items) { r -= jobs[j].items; ++j; } \
                const int nN = jobs[j].nN, kb = r / nN, nb = r % nN; D_.ldw = jobs[j].ldw; D_.ldk = jobs[j].ldk; D_.gk = jobs[j].gk ? jobs[j].gk + kb * 64 : nullptr; \
                D_.src = jobs[j].src + (size_t)kb * 64 * D_.ldw + nb * 64; D_.dst = jobs[j].dst + (size_t)nb * 64 * D_.ldk + kb * 64; } \
            else { const int r = it_ - gen_total, type = r >> 12, e = (r >> 7) & 31, ti = r & 127; \
                if (type < 2) { const int kb = ti >> 3, nb = ti & 7; D_.ldw = 512; D_.ldk = 1024; D_.gk = gffn + kb * 64; \
                    D_.src = (type == 0 ? wg : wu) + (size_t)e * 1024 * 512 + (size_t)kb * 64 * 512 + nb * 64; \
                    D_.dst = WGU + (size_t)e * 1024 * 1024 + (size_t)(256 * (nb >> 1) + 64 * (nb & 1) + 128 * type) * 1024 + kb * 64; } \
                else { const int kb = ti >> 4, nb = ti & 15; D_.ldw = 1024; D_.ldk = 512; D_.gk = nullptr; \
                    D_.src = wd + (size_t)e * 512 * 1024 + (size_t)kb * 64 * 1024 + nb * 64; \
                    D_.dst = WD + (size_t)e * 1024 * 512 + (size_t)nb * 64 * 512 + kb * 64; } } } while (0)
        const int split = gen_total + PREP_SPLIT;
        const int nlist = (PART == 10) ? gen_total + 4096 : (PART == 11 || PART == 12) ? 4096 : (PART == 1) ? split : (PART == 3) ? 3072 : (PART == 2) ? total - split : (PART == 5) ? gen_total + 4096 : (PART == 6 || PART == 8) ? 8192 : total;
#define CANON(I_) ((PART == 11) ? gen_total + 4096 + (I_) : (PART == 12) ? gen_total + 8192 + (I_) : (PART == 2) ? split + (I_) : (PART == 5) ? ((I_) < gen_total ? (I_) : (I_) + 8192) : (PART == 3 || PART == 6 || PART == 8) ? gen_total + (I_) : (I_))
        const bool virt = (PART == 2 || PART == 3 || PART == 5 || PART == 7 || PART == 8 || PART == 10 || PART == 11 || PART == 12);
        const int first = virt ? vw : c.gw, stride = virt ? nvw : c.NGW, last = nlist;
        if (first < last) {
            TileDesc d0, d1; f32x4 va[16], vb[16];
            TILE_DESC(CANON(first), d0); tr_load(d0.src, d0.ldw, va, c.lane);
            for (int it = first; it < last; it += 2 * stride) {
                const int it1r = it + stride, it2r = it + 2 * stride; const bool has1 = it1r < last, has2 = it2r < last; const int it1 = CANON(has1 ? it1r : it), it2 = CANON(has2 ? it2r : it);
                TILE_DESC(it1, d1); tr_load(d1.src, d1.ldw, vb, c.lane);
                tr_store(va, d0.dst, d0.ldk, scr, c.lane, d0.gk);
                TILE_DESC(it2, d0); tr_load(d0.src, d0.ldw, va, c.lane);
                if (has1) tr_store(vb, d1.dst, d1.ldk, scr, c.lane, d1.gk);
            }
        }
#undef TILE_DESC
#undef CANON
    }
    if (PART == 2 || PART == 3 || PART == 6 || PART == 8 || PART == 11 || PART == 12) return;
    const int gtid = (PART == 5 || PART == 7 || PART == 10) ? vw * 64 + c.lane : c.blk * 512 + c.tid, nthr = (PART == 5 || PART == 7 || PART == 10) ? nvw * 64 : c.G * 512;
    {
        const float* wgr = pin(P, I_MOE_W_GROUP) + (size_t)layer * 1024 * 4; const float* wrt = pin(P, I_MOE_W_ROUTER) + (size_t)layer * 1024 * 32;
        bf16* WR = (bf16*)(ws + WB_WR); const float* gfr = pin(P, I_NORM_FFN) + layer * 1024;
        for (int i = gtid; i < 256 * 128; i += nthr) { const int row = i >> 7, k8 = i & 127; float f[8];
#pragma unroll
            for (int kk = 0; kk < 8; ++kk) { const int k = 8 * k8 + kk; f[kk] = (row < 4 ? wgr[k * 4 + row] : (row < 36 ? wrt[k * 32 + (row - 4)] : 0.f)) * gfr[k]; }
            *(v4u*)(WR + (size_t)row * 1024 + 8 * k8) = pack8(f); }
    }
    if (layer == 0) {
        bf16* WGT = (bf16*)(ws + WB_WGT); const float* wa = pin(P, I_LRU_W_A); const float* wx = pin(P, I_LRU_W_X);
        for (int i = gtid; i < 1536 * 96; i += nthr) { const int rho = i / 96, k8 = i % 96; const int pn = rho >> 8, bj = (rho >> 7) & 1, j = rho & 127, ch = 128 * pn + j, blkc = ch / 192, cc = ch % 192;
            const float* src = (bj ? wx : wa) + (size_t)blkc * 192 * 192; float f[8];
            const int k0 = 8 * k8; const bool in = (k0 / 192) == blkc;
#pragma unroll
            for (int kk = 0; kk < 8; ++kk) f[kk] = in ? src[((k0 + kk) % 192) * 192 + cc] : 0.f;
            *(v4u*)(WGT + (size_t)rho * 768 + k0) = pack8(f); }
    } else {
        const float* wuv = pin(P, I_DSA_W_UV); const float* wo = pin(P, I_W_OUT) + (size_t)1024 * 1024; bf16* WO = (bf16*)(ws + WB_WOUT);
        for (int i = gtid; i < 1024 * 12 * 16; i += nthr) { const int n = i & 1023, rest = i >> 10, c8 = rest & 15, h = rest >> 4; float a[8] = {0.f, 0.f, 0.f, 0.f, 0.f, 0.f, 0.f, 0.f};
            for (int j = 0; j < 64; ++j) { const float w = wo[(size_t)(64 * h + j) * 1024 + n];
#pragma unroll
                for (int cc = 0; cc < 8; ++cc) a[cc] += wuv[((size_t)h * 128 + 8 * c8 + cc) * 64 + j] * w; }
            *(v4u*)(WO + (size_t)n * 1792 + h * 128 + 8 * c8) = pack8(a); }
    }
}
DI void phase_prep0(const Ctx& c0, const PV& P) {
    const Ctx c = relaunder(c0);
    prep_setup<0>(c, P);
    { const float* xin = pin(P, I_X); const float* g = pin(P, I_NORM_MIX); bf16* HN = (bf16*)(P.ws + WS_HN);
      for (int r = c.gw; r < NTOK; r += 2 * c.NGW) {
          const int r1 = r + c.NGW; const bool has1 = r1 < NTOK; const int rr1 = has1 ? r1 : r;
          f32x4 v0[4], v1[4];
          const f32x4* x0 = (const f32x4*)(xin + (size_t)r * 1024) + c.lane; const f32x4* x1 = (const f32x4*)(xin + (size_t)rr1 * 1024) + c.lane;
#pragma unroll
          for (int j = 0; j < 4; ++j) { v0[j] = x0[64 * j]; v1[j] = x1[64 * j]; }
          rms_finish(v0, g, HN + (size_t)r * 1024, c.lane);
          if (has1) rms_finish(v1, g, HN + (size_t)r1 * 1024, c.lane);
      } }
    prep_weights<0, 1>(c, P);
}
DI void phase_prep0_mid(const Ctx& c0, const PV& P, int firstblk) {
    const Ctx c = relaunder(c0);
    prep_setup<0>(c, P);
    prep_weights<0, 3>(c, P, (c.blk - firstblk) * 8 + c.wave, (c.G - firstblk) * 8);
}
DI void phase_prep1_early(const Ctx& c0, const PV& P, int firstblk) {
    const Ctx c = relaunder(c0);
    prep_setup<1>(c, P);
    prep_weights<1, 10>(c, P, (c.blk - firstblk) * 8 + c.wave, (c.G - firstblk) * 8);
}
DI void phase_prep1_gu(const Ctx& c0, const PV& P, int firstblk) {
    const Ctx c = relaunder(c0);
    prep_setup<1>(c, P);
    prep_weights<1, 11>(c, P, (c.blk - firstblk) * 8 + c.wave, (c.G - firstblk) * 8);
}
DI void phase_prep1_down(const Ctx& c0, const PV& P, int firstblk) {
    const Ctx c = relaunder(c0);
    prep_setup<1>(c, P);
    prep_weights<1, 12>(c, P, (c.blk - firstblk) * 8 + c.wave, (c.G - firstblk) * 8);
}
DI void phase_prep0_tail(const Ctx& c0, const PV& P, int firstblk) {
    const Ctx c = relaunder(c0);
    prep_setup<0>(c, P);
    prep_weights<0, 2>(c, P, (c.blk - firstblk) * 8 + c.wave, (c.G - firstblk) * 8);
}

DI f32x4 mfma16(bf16x8 a, bf16x8 b, f32x4 c) { return __builtin_amdgcn_mfma_f32_16x16x32_bf16(a, b, c, 0, 0, 0); }

template <int layer, int ldp, int xq_off, int ldm, int xo_off, int SHADOW = 0> DI void phase_xattn(const Ctx& c0, const PV& P, const bf16* __restrict__ PROJ, bf16* __restrict__ MIX) {
    const Ctx c = relaunder(c0);
    const bf16* MKVO = (const bf16*)(P.ws + WB_MKVO);
    const float* xqg = pin(P, I_XQ_NORM) + layer * 64; const float* xkg = pin(P, I_XK_NORM) + layer * 64;
    LAS bf16* Ks = (LAS bf16*)c.lds;
    LAS bf16* Vt = (LAS bf16*)(c.lds + 36864);
    const int lane = c.lane, l15 = lane & 15, g = lane >> 4;
    for (int unit = c.blk; unit < 256; unit += c.G) {
        const int b = unit >> 7, h = (unit >> 5) & 3, tr = unit & 31, tok0 = b * SEQ + tr * 512;
        __syncthreads();
        if (SHADOW != 1)
#pragma unroll
        for (int i = 0; i < 4; ++i) { const int p = c.tid + 512 * i, key = p >> 3, ch = p & 7;
            const bf16* src = MKVO + (size_t)(b * 256 + key) * 512 + h * 64 + ch * 8;
            float f[8]; unpack8(*(const v4u*)src, f);
            float ss = 0.f;
#pragma unroll
            for (int j = 0; j < 8; ++j) ss += f[j] * f[j];
            ss += __shfl_xor(ss, 1); ss += __shfl_xor(ss, 2); ss += __shfl_xor(ss, 4);
            const float r = __builtin_amdgcn_rsqf(ss * (1.0f / 64.0f) + EPS);
#pragma unroll
            for (int j = 0; j < 8; ++j) f[j] = f[j] * r * xkg[ch * 8 + j];
            *(LAS v4u*)(Ks + key * 72 + ch * 8) = pack8(f);
            const v4u vw = *(const v4u*)(src + 256);
            const unsigned ww[4] = {vw.x, vw.y, vw.z, vw.w};
#pragma unroll
            for (int j = 0; j < 4; ++j) { Vt[(ch * 8 + 2 * j) * 264 + key] = (bf16)(ww[j] & 0xffffu); Vt[(ch * 8 + 2 * j + 1) * 264 + key] = (bf16)(ww[j] >> 16); }
        }
        __syncthreads();
        v4u qn0, qn1;
        { const bf16* qp = PROJ + (size_t)(tok0 + c.wave * 16 + l15) * ldp + xq_off + h * 64 + 8 * g; qn0 = *(const v4u*)qp; qn1 = *(const v4u*)(qp + 32); }
#pragma unroll 1
        for (int tile = c.wave; tile < (SHADOW == 2 ? 0 : 32); tile += 8) {
            const int row = tok0 + tile * 16 + l15;
            const v4u qc0 = qn0, qc1 = qn1;
            { const int nt = tile + 8 < 32 ? tile + 8 : tile; const bf16* qp = PROJ + (size_t)(tok0 + nt * 16 + l15) * ldp + xq_off + h * 64 + 8 * g; qn0 = *(const v4u*)qp; qn1 = *(const v4u*)(qp + 32); }
            float q0[8], q1[8]; unpack8(qc0, q0); unpack8(qc1, q1);
            float ss = 0.f;
#pragma unroll
            for (int j = 0; j < 8; ++j) ss += q0[j] * q0[j] + q1[j] * q1[j];
            ss += __shfl_xor(ss, 16); ss += __shfl_xor(ss, 32);
            const float r = (0.125f * 1.4426950408889634f) * __builtin_amdgcn_rsqf(ss * (1.0f / 64.0f) + EPS);
#pragma unroll
            for (int j = 0; j < 8; ++j) { q0[j] = q0[j] * r * xqg[8 * g + j]; q1[j] = q1[j] * r * xqg[32 + 8 * g + j]; }
            const bf16x8 B0 = __builtin_bit_cast(bf16x8, pack8(q0)), B1 = __builtin_bit_cast(bf16x8, pack8(q1));
            f32x4 S[16];
#pragma unroll
            for (int kt = 0; kt < 16; ++kt) {
                const bf16x8 A0 = *(const LAS bf16x8*)(Ks + (16 * kt + l15) * 72 + 8 * g), A1 = *(const LAS bf16x8*)(Ks + (16 * kt + l15) * 72 + 32 + 8 * g);
                f32x4 z = {0.f, 0.f, 0.f, 0.f}; z = mfma16(A0, B0, z); S[kt] = mfma16(A1, B1, z);
                if ((kt & 3) == 3) __builtin_amdgcn_sched_barrier(0);
            }
            float mx = -3.0e38f;
#pragma unroll
            for (int kt = 0; kt < 16; ++kt) mx = fmaxf(mx, fmaxf(fmaxf(S[kt][0], S[kt][1]), fmaxf(S[kt][2], S[kt][3])));
            mx = fmaxf(mx, __shfl_xor(mx, 16)); mx = fmaxf(mx, __shfl_xor(mx, 32));
#pragma unroll
            for (int kt = 0; kt < 16; ++kt) {
#pragma unroll
                for (int i = 0; i < 4; ++i) S[kt][i] = __builtin_amdgcn_exp2f(S[kt][i] - mx); }
            f32x4 O[4], Ls = {0.f, 0.f, 0.f, 0.f};
            bf16x8 ones; { v4u ow = {0x3F803F80u, 0x3F803F80u, 0x3F803F80u, 0x3F803F80u}; asm volatile("" : "+v"(ow)); ones = __builtin_bit_cast(bf16x8, ow); }
#pragma unroll
            for (int dt = 0; dt < 4; ++dt) O[dt] = (f32x4){0.f, 0.f, 0.f, 0.f};
#pragma unroll
            for (int jb = 0; jb < 8; ++jb) {
                v4u pw; pw.x = pk2(S[2 * jb][0], S[2 * jb][1]); pw.y = pk2(S[2 * jb][2], S[2 * jb][3]); pw.z = pk2(S[2 * jb + 1][0], S[2 * jb + 1][1]); pw.w = pk2(S[2 * jb + 1][2], S[2 * jb + 1][3]);
                const bf16x8 Pb = __builtin_bit_cast(bf16x8, pw);
#pragma unroll
                for (int dt = 0; dt < 4; ++dt) { const LAS bf16* vp = Vt + (16 * dt + l15) * 264 + 32 * jb + 4 * g;
                    const v2u a0 = *(const LAS v2u*)vp, a1 = *(const LAS v2u*)(vp + 16);
                    v4u aw; aw.x = a0.x; aw.y = a0.y; aw.z = a1.x; aw.w = a1.y;
                    O[dt] = mfma16(__builtin_bit_cast(bf16x8, aw), Pb, O[dt]); }
                Ls = mfma16(ones, Pb, Ls);
                __builtin_amdgcn_sched_barrier(0);
            }
            const float il = __builtin_amdgcn_rcpf(Ls[0]);
            bf16* op = MIX + (size_t)row * ldm + xo_off + h * 64 + 4 * g;
#pragma unroll
            for (int dt = 0; dt < 4; ++dt) { v2u o; o.x = pk2(O[dt][0] * il, O[dt][1] * il); o.y = pk2(O[dt][2] * il, O[dt][3] * il); *(v2u*)(op + 16 * dt) = o; }
        }
    }
}

DI void phase_conv(const Ctx& c0, const PV& P) {
    const Ctx c = relaunder(c0);
    const bf16* PROJ = (const bf16*)(P.ws + AR_PROJ); bf16* XSC = (bf16*)(P.ws + AR_XSC);
    const float* cw = pin(P, I_LRU_CONV_W); const float* cb = pin(P, I_LRU_CONV_B);
    const int gtid = c.blk * 512 + c.tid, nthr = c.G * 512;
    for (int i = gtid; i < (NTOK / 32) * 96; i += nthr) { const int chunk = i / 96, c8 = i % 96, row0 = chunk * 32, t0 = row0 & (SEQ - 1);
        float w[4][8], bias[8];
#pragma unroll
        for (int j = 0; j < 8; ++j) { bias[j] = cb[8 * c8 + j];
#pragma unroll
            for (int k = 0; k < 4; ++k) w[k][j] = cw[k * 768 + 8 * c8 + j]; }
        float p1[8], p2[8], p3[8];
        if (t0 >= 3) { unpack8(*(const v4u*)(PROJ + (size_t)(row0 - 1) * 1792 + 8 * c8), p1); unpack8(*(const v4u*)(PROJ + (size_t)(row0 - 2) * 1792 + 8 * c8), p2); unpack8(*(const v4u*)(PROJ + (size_t)(row0 - 3) * 1792 + 8 * c8), p3); }
        else {
#pragma unroll
            for (int j = 0; j < 8; ++j) { p1[j] = 0.f; p2[j] = 0.f; p3[j] = 0.f; } }
#pragma unroll 1
        for (int rb = 0; rb < 32; rb += 8) {
            v4u xw[8];
#pragma unroll
            for (int r = 0; r < 8; ++r) xw[r] = *(const v4u*)(PROJ + (size_t)(row0 + rb + r) * 1792 + 8 * c8);
#pragma unroll
            for (int r = 0; r < 8; ++r) { float f[8], a[8]; unpack8(xw[r], f);
#pragma unroll
                for (int j = 0; j < 8; ++j) { a[j] = bias[j] + w[0][j] * p3[j] + w[1][j] * p2[j] + w[2][j] * p1[j] + w[3][j] * f[j]; p3[j] = p2[j]; p2[j] = p1[j]; p1[j] = f[j]; }
                *(v4u*)(XSC + (size_t)(row0 + rb + r) * 768 + 8 * c8) = pack8(a); }
        }
    }
}
DI void phase_scanA(const Ctx& c0, const PV& P) {
    const Ctx c = relaunder(c0);
    const bf16* LA = (const bf16*)(P.ws + AR_LA); const bf16* UU = (const bf16*)(P.ws + AR_UU); float* SA = (float*)(P.ws + AR_SA); float* SH = (float*)(P.ws + AR_SH);
    const int gtid = c.blk * 512 + c.tid, nthr = c.G * 512;
    for (int i = gtid; i < 512 * 192; i += nthr) { const int chunk = i / 192, c4 = i % 192; float h[4] = {0.f, 0.f, 0.f, 0.f}, sl[4] = {0.f, 0.f, 0.f, 0.f};
        const size_t base = (size_t)chunk * 64 * 768 + 4 * c4;
#pragma unroll 8
        for (int r = 0; r < 64; ++r) { const v2u lw = *(const v2u*)(LA + base + (size_t)r * 768), uw = *(const v2u*)(UU + base + (size_t)r * 768);
            const float l4[4] = {bflo(lw.x), bfhi(lw.x), bflo(lw.y), bfhi(lw.y)}, u4[4] = {bflo(uw.x), bfhi(uw.x), bflo(uw.y), bfhi(uw.y)};
#pragma unroll
            for (int j = 0; j < 4; ++j) { h[j] = __expf(l4[j]) * h[j] + u4[j]; sl[j] += l4[j]; } }
        *(f32x4*)(SA + (size_t)chunk * 768 + 4 * c4) = (f32x4){__expf(sl[0]), __expf(sl[1]), __expf(sl[2]), __expf(sl[3])};
        *(f32x4*)(SH + (size_t)chunk * 768 + 4 * c4) = (f32x4){h[0], h[1], h[2], h[3]}; }
}
DI void phase_scanB(const Ctx& c0, const PV& P) {
    const Ctx c = relaunder(c0);
    const float* SA = (const float*)(P.ws + AR_SA); const float* SH = (const float*)(P.ws + AR_SH); float* CARRY = (float*)(P.ws + AR_CARRY);
    LAS float* segP = (LAS float*)c.lds; LAS float* segQ = segP + 512;
    for (int u = c.blk; u < 48; u += c.G) { const int b = u / 24, cg = u % 24, seg = c.tid >> 5, ch = 32 * cg + (c.tid & 31);
        const size_t base = (size_t)(b * 256 + seg * 16) * 768 + ch;
        float A[16], H[16];
#pragma unroll
        for (int i = 0; i < 16; ++i) { A[i] = SA[base + (size_t)i * 768]; H[i] = SH[base + (size_t)i * 768]; }
        float Pp[16], Qq[16]; float pp = 1.f, qq = 0.f;
#pragma unroll
        for (int i = 0; i < 16; ++i) { Pp[i] = pp; Qq[i] = qq; qq = A[i] * qq + H[i]; pp = A[i] * pp; }
        __syncthreads();
        segP[c.tid] = pp; segQ[c.tid] = qq;
        __syncthreads();
        float hin = 0.f;
        for (int s = 0; s < seg; ++s) hin = segP[s * 32 + (c.tid & 31)] * hin + segQ[s * 32 + (c.tid & 31)];
#pragma unroll
        for (int i = 0; i < 16; ++i) CARRY[base + (size_t)i * 768] = Pp[i] * hin + Qq[i];
    }
}
DI void phase_scanC(const Ctx& c0, const PV& P) {
    const Ctx c = relaunder(c0);
    const bf16* LA = (const bf16*)(P.ws + AR_LA); const bf16* UU = (const bf16*)(P.ws + AR_UU); const float* CARRY = (const float*)(P.ws + AR_CARRY);
    const bf16* PROJ = (const bf16*)(P.ws + AR_PROJ); bf16* MIX = (bf16*)(P.ws + AR_MIXL);
    const int gtid = c.blk * 512 + c.tid, nthr = c.G * 512;
    for (int i = gtid; i < 512 * 192; i += nthr) { const int chunk = i / 192, c4 = i % 192;
        const f32x4 h0 = *(const f32x4*)(CARRY + (size_t)chunk * 768 + 4 * c4); float h[4] = {h0.x, h0.y, h0.z, h0.w};
        const size_t base = (size_t)chunk * 64 * 768 + 4 * c4;
#pragma unroll 8
        for (int r = 0; r < 64; ++r) { const size_t row = (size_t)chunk * 64 + r;
            const v2u lw = *(const v2u*)(LA + base + (size_t)r * 768), uw = *(const v2u*)(UU + base + (size_t)r * 768), gw = *(const v2u*)(PROJ + row * 1792 + 768 + 4 * c4);
            const float l4[4] = {bflo(lw.x), bfhi(lw.x), bflo(lw.y), bfhi(lw.y)}, u4[4] = {bflo(uw.x), bfhi(uw.x), bflo(uw.y), bfhi(uw.y)}, g4[4] = {bflo(gw.x), bfhi(gw.x), bflo(gw.y), bfhi(gw.y)};
            float y[4];
#pragma unroll
            for (int j = 0; j < 4; ++j) { h[j] = __builtin_amdgcn_exp2f(l4[j]) * h[j] + u4[j]; y[j] = h[j] * g4[j]; }
            v2u o; o.x = pk2(y[0], y[1]); o.y = pk2(y[2], y[3]); *(v2u*)(MIX + row * 1024 + 4 * c4) = o; }
    }
}

template <int layer> DI void phase_norm_route(const Ctx& c0, const PV& P) {
    const Ctx c = relaunder(c0);
    const bf16* WR = (const bf16*)(P.ws + WB_WR); float* R = (float*)(P.ws + AR_R);
    const bf16* XR = (layer == 0) ? (const bf16*)P.out : (const bf16*)(P.ws + WS_X2);
    int* EID = (int*)(P.ws + AR_EID); float* GATE = (float*)(P.ws + AR_GATE); int* DEST = (int*)(P.ws + AR_DEST); int* ROWTAB = (int*)(P.ws + AR_LOG); float* RS = (float*)(P.ws + AR_RS);
    const float* bg = pin(P, I_MOE_B_GROUP) + layer * 4; const float* br = pin(P, I_MOE_B_ROUTER) + layer * 32;
    unsigned* ctl = (unsigned*)(P.ws + WS_CTL);
    constexpr int WRS = 1032, LGS = 52;
    LAS bf16* WRs = (LAS bf16*)c.lds;
    LAS float* lg = (LAS float*)(c.lds + 99328 + c.wave * 3328);
    LAS unsigned* hist = (LAS unsigned*)(c.lds + 99328 + 8 * 3328);
    LAS unsigned* base = hist + 32; LAS unsigned* lcnt = hist + 64;
    const int lane = c.lane, l15 = lane & 15, gq = lane >> 4;
    __syncthreads();
    for (int i = c.tid; i < 48 * 128; i += 512) { const int row = i >> 7, ch = i & 127; *(LAS v4u*)(WRs + row * WRS + 8 * ch) = *(const v4u*)(WR + (size_t)row * 1024 + 8 * ch); }
    if (c.tid < 32) hist[c.tid] = 0u;
    __syncthreads();
    for (int tb = c.blk; tb < NTOK / 128; tb += c.G) {
        const int row0 = tb * 128 + c.wave * 16;
        f32x4 acc[3];
#pragma unroll
        for (int nt = 0; nt < 3; ++nt) acc[nt] = (f32x4){0.f, 0.f, 0.f, 0.f};
        const bf16* ap = XR + (size_t)(row0 + l15) * 1024 + 8 * gq; const LAS bf16* bp = WRs + l15 * WRS + 8 * gq;
        float ss = 0.f;
#pragma unroll 8
        for (int ks = 0; ks < 32; ++ks) { const v4u aw = *(const v4u*)(ap + 32 * ks); const bf16x8 A = __builtin_bit_cast(bf16x8, aw);
            float f[8]; unpack8(aw, f);
#pragma unroll
            for (int j = 0; j < 8; ++j) ss += f[j] * f[j];
#pragma unroll
            for (int nt = 0; nt < 3; ++nt) { const bf16x8 B = *(const LAS bf16x8*)(bp + nt * 16 * WRS + 32 * ks); acc[nt] = mfma16(A, B, acc[nt]); } }
        ss += __shfl_xor(ss, 16); ss += __shfl_xor(ss, 32);
        const float r = __builtin_amdgcn_rsqf(ss * (1.0f / 1024.0f) + EPS);
        if (gq == 0) R[row0 + l15] = r;
#pragma unroll
        for (int i = 0; i < 4; ++i) { const float rt = __shfl(r, 4 * gq + i);
#pragma unroll
            for (int nt = 0; nt < 3; ++nt) lg[(4 * gq + i) * LGS + 16 * nt + l15] = acc[nt][i] * rt; }
        LDS_WAIT();
        int e1id = 0, e2id = 0;
        if (lane < 16) { const int t = row0 + lane; const LAS float* L = lg + lane * LGS;
            const float l0 = L[0] + bg[0], l1 = L[1] + bg[1], l2 = L[2] + bg[2], l3 = L[3] + bg[3];
            int gs = 0; float gm = l0;
            if (l1 > gm) { gm = l1; gs = 1; } if (l2 > gm) { gm = l2; gs = 2; } if (l3 > gm) { gm = l3; gs = 3; }
            const float pg = 1.0f / (__expf(l0 - gm) + __expf(l1 - gm) + __expf(l2 - gm) + __expf(l3 - gm));
            float el[8];
#pragma unroll
            for (int j = 0; j < 8; ++j) el[j] = L[4 + 8 * gs + j] + br[8 * gs + j];
            int i1 = 0; float m1 = el[0];
#pragma unroll
            for (int j = 1; j < 8; ++j) if (el[j] > m1) { m1 = el[j]; i1 = j; }
            int i2 = -1; float m2 = -3.0e38f;
#pragma unroll
            for (int j = 0; j < 8; ++j) if (j != i1 && el[j] > m2) { m2 = el[j]; i2 = j; }
            const float e2 = __expf(m2 - m1), inv = pg / (1.0f + e2);
            e1id = 8 * gs + i1; e2id = 8 * gs + i2;
            EID[2 * t] = e1id; EID[2 * t + 1] = e2id; GATE[2 * t] = inv; GATE[2 * t + 1] = e2 * inv;
            lds_add(&hist[e1id], 1u); lds_add(&hist[e2id], 1u); }
        __syncthreads();
        if (c.tid < 32) { base[c.tid] = hist[c.tid] ? atomicAdd(ctl + CW_CNT + layer * CW_LSTRIDE + c.tid, hist[c.tid]) : 0u; lcnt[c.tid] = 0u; }
        __syncthreads();
        if (lane < 16) { const int t = row0 + lane;
            const int k1 = (int)(base[e1id] + lds_add(&lcnt[e1id], 1u)), k2 = (int)(base[e2id] + lds_add(&lcnt[e2id], 1u));
            *(v2u*)(DEST + 2 * t) = (v2u){(unsigned)((e1id << 20) | k1), (unsigned)((e2id << 20) | k2)};
            ROWTAB[(size_t)e1id * pg8::MOE_CAP + k1] = t; ROWTAB[(size_t)e2id * pg8::MOE_CAP + k2] = t;
            RS[(size_t)e1id * pg8::MOE_CAP + k1] = r; RS[(size_t)e2id * pg8::MOE_CAP + k2] = r; }
        __syncthreads();
        if (c.tid < 32) hist[c.tid] = 0u;
        LDS_WAIT();
    }
    if (c.blk == 0) ((unsigned*)((bf16*)XR + (size_t)NTOK * 1024))[c.tid] = 0u;
}
template <int layer> DI void moe_tables(const Ctx& c0, const PV& P) {
    const Ctx c = relaunder(c0);
    const unsigned* ctl = (const unsigned*)(P.ws + WS_CTL);
    LAS int* T = (LAS int*)(c.lds + TAB_OFF);
    __syncthreads();
    if (c.wave == 0) {
        const int l = hw_lane(); int cn = 0, n = 0;
        if (l < 32) { cn = (int)ctl[CW_CNT + layer * CW_LSTRIDE + l]; n = (cn + 255) & ~255; }
        int x = n;
#pragma unroll
        for (int o = 1; o < 32; o <<= 1) { const int y = __shfl_up(x, o); if (l >= o) x += y; }
        const int ps = x - n;
        if (l < 32) { T[l] = cn; T[32 + l] = ps; for (int t = ps >> 8; t < ((ps + n) >> 8); ++t) T[64 + t] = l; }
        if (l == 31) T[400] = (ps + n) >> 8;
    }
    __syncthreads();
}
template <int layer> DI void phase_scatter(const Ctx& c0, const PV& P) {
    const Ctx c = relaunder(c0);
    unsigned* ctl = (unsigned*)(P.ws + WS_CTL);
    const int* EID = (const int*)(P.ws + AR_EID); int* DEST = (int*)(P.ws + AR_DEST); int* ROWTAB = (int*)(P.ws + AR_LOG);
    bf16* XR = (layer == 0) ? (bf16*)P.out : (bf16*)(P.ws + WS_X2); const float* R = (const float*)(P.ws + AR_R); float* RS = (float*)(P.ws + AR_RS);
    LAS int* cnt = (LAS int*)c.lds; LAS int* pstart = cnt + 32; LAS unsigned* hist = (LAS unsigned*)(cnt + 64); LAS unsigned* base = hist + 32; LAS unsigned* lcnt = base + 32;
    __syncthreads();
    if (c.tid < 32) cnt[c.tid] = (int)ctl[CW_CNT + layer * CW_LSTRIDE + c.tid];
    __syncthreads();
    if (c.tid == 0) { int acc = 0; for (int e = 0; e < 32; ++e) { pstart[e] = acc; acc += (cnt[e] + 255) & ~255; }
        if (c.blk == 0) { ctl[CW_NT + layer * CW_LSTRIDE] = (unsigned)(acc >> 8);
            for (int e = 0; e < 32; ++e) { const int t0 = pstart[e] >> 8, t1 = (pstart[e] + ((cnt[e] + 255) & ~255)) >> 8; for (int t = t0; t < t1; ++t) ctl[CW_TE + layer * CW_TE_STRIDE + t] = (unsigned)e; } } }
    if (c.blk == 0) ((unsigned*)(XR + (size_t)NTOK * 1024))[c.tid] = 0u;
    __syncthreads();
    for (int tb = c.blk; tb < NTOK / 128; tb += c.G) {
        if (c.tid < 32) { hist[c.tid] = 0u; lcnt[c.tid] = 0u; }
        __syncthreads();
        int e = 0, t = 0;
        if (c.tid < 256) { t = tb * 128 + (c.tid >> 1); e = EID[2 * t + (c.tid & 1)]; lds_add(&hist[e], 1u); }
        __syncthreads();
        if (c.tid < 32) base[c.tid] = hist[c.tid] ? atomicAdd(ctl + CW_CUR + layer * CW_LSTRIDE + c.tid, hist[c.tid]) : 0u;
        __syncthreads();
        if (c.tid < 256) { const unsigned rank = lds_add(&lcnt[e], 1u); const int d = pstart[e] + (int)base[e] + (int)rank; DEST[2 * t + (c.tid & 1)] = d; ROWTAB[d] = t; RS[d] = R[t]; }
        __syncthreads();
    }
    const int gtid = c.blk * 512 + c.tid;
    for (int e = 0; e < 32; ++e) { const int npad = ((cnt[e] + 255) & ~255) - cnt[e], r0 = pstart[e] + cnt[e];
        if (gtid < npad) { ROWTAB[r0 + gtid] = NTOK; RS[r0 + gtid] = 0.f; } }
}
template <bool NEXT> DI void phase_combine(const Ctx& c0, const PV& P) {
    const Ctx c = relaunder(c0);
    if (NEXT) prep_setup<1>(c, P);
    const int* DEST = (const int*)(P.ws + AR_DEST); const float* GATE = (const float*)(P.ws + AR_GATE); const unsigned char* Y = (const unsigned char*)(P.ws + AR_XS);
    const float* g = NEXT ? pin(P, I_NORM_MIX) + 1024 : nullptr; bf16* HN = (bf16*)(P.ws + WS_HN); float* WI = (float*)(P.ws + AR_WI);
    float* R1 = (float*)(P.ws + AR_R);
    const bf16* XIN = NEXT ? (const bf16*)P.out : (const bf16*)(P.ws + WS_X2); bf16* X2 = (bf16*)(P.ws + WS_X2);
    const LAS f32x4* wiw = (const LAS f32x4*)(c.lds + 69632);
    const LAS int* TB = (const LAS int*)(c.lds + TAB_OFF);
    typedef int v2i_ __attribute__((ext_vector_type(2))); typedef float v2f_ __attribute__((ext_vector_type(2)));
    const int step2 = 2 * c.NGW;
    int ta = c.gw, tb2 = c.gw + c.NGW;
    v2i_ dA = *(const v2i_*)(DEST + 2 * (ta < NTOK ? ta : 0)), dB = *(const v2i_*)(DEST + 2 * (tb2 < NTOK ? tb2 : 0));
    v2f_ gA = *(const v2f_*)(GATE + 2 * (ta < NTOK ? ta : 0)), gB = *(const v2f_*)(GATE + 2 * (tb2 < NTOK ? tb2 : 0));
    for (; ta < NTOK; ta += step2, tb2 += step2) {
        const bool hasB = tb2 < NTOK; const int tbb = hasB ? tb2 : ta;
        const v2i_ cdA = dA, cdB = hasB ? dB : dA; const v2f_ cgA = gA, cgB = hasB ? gB : gA;
        { const int na = ta + step2, nb = tb2 + step2; const int ia = na < NTOK ? na : 0, ib = nb < NTOK ? nb : 0;
          dA = *(const v2i_*)(DEST + 2 * ia); dB = *(const v2i_*)(DEST + 2 * ib); gA = *(const v2f_*)(GATE + 2 * ia); gB = *(const v2f_*)(GATE + 2 * ib); }
        const v2u* xiA = (const v2u*)(XIN + (size_t)ta * 1024) + c.lane; const v2u* xiB = (const v2u*)(XIN + (size_t)tbb * 1024) + c.lane;
#define SROW(D_) (TB[32 + ((D_) >> 20)] + ((D_) & 0xFFFFF))
        const int* yA0 = (const int*)(Y + (size_t)SROW(cdA.x) * 1024) + c.lane; const int* yA1 = (const int*)(Y + (size_t)SROW(cdA.y) * 1024) + c.lane;
        const int* yB0 = (const int*)(Y + (size_t)SROW(cdB.x) * 1024) + c.lane; const int* yB1 = (const int*)(Y + (size_t)SROW(cdB.y) * 1024) + c.lane;
#undef SROW
        const v2f_ sgA = cgA * (1.0f / 16.0f), sgB = cgB * (1.0f / 16.0f);
        f32x4 vA[4], vB[4]; int a0[4], a1[4], b0[4], b1[4];
#pragma unroll
        for (int j = 0; j < 4; ++j) { const v2u ra = xiA[64 * j], rb = xiB[64 * j]; a0[j] = yA0[64 * j]; a1[j] = yA1[64 * j]; b0[j] = yB0[64 * j]; b1[j] = yB1[64 * j];
            vA[j] = (f32x4){bflo(ra.x), bfhi(ra.x), bflo(ra.y), bfhi(ra.y)}; vB[j] = (f32x4){bflo(rb.x), bfhi(rb.x), bflo(rb.y), bfhi(rb.y)}; }
#pragma unroll
        for (int j = 0; j < 4; ++j) {
            { const v2f_ p0 = __builtin_amdgcn_cvt_pk_f32_fp8(a0[j], false), p1 = __builtin_amdgcn_cvt_pk_f32_fp8(a0[j], true), q0 = __builtin_amdgcn_cvt_pk_f32_fp8(a1[j], false), q1 = __builtin_amdgcn_cvt_pk_f32_fp8(a1[j], true);
              vA[j].x += sgA.x * p0.x + sgA.y * q0.x; vA[j].y += sgA.x * p0.y + sgA.y * q0.y; vA[j].z += sgA.x * p1.x + sgA.y * q1.x; vA[j].w += sgA.x * p1.y + sgA.y * q1.y; }
            { const v2f_ p0 = __builtin_amdgcn_cvt_pk_f32_fp8(b0[j], false), p1 = __builtin_amdgcn_cvt_pk_f32_fp8(b0[j], true), q0 = __builtin_amdgcn_cvt_pk_f32_fp8(b1[j], false), q1 = __builtin_amdgcn_cvt_pk_f32_fp8(b1[j], true);
              vB[j].x += sgB.x * p0.x + sgB.y * q0.x; vB[j].y += sgB.x * p0.y + sgB.y * q0.y; vB[j].z += sgB.x * p1.x + sgB.y * q1.x; vB[j].w += sgB.x * p1.y + sgB.y * q1.y; }
            if (NEXT) { v2u oa; oa.x = pk2(vA[j].x, vA[j].y); oa.y = pk2(vA[j].z, vA[j].w); ((v2u*)(X2 + (size_t)ta * 1024) + c.lane)[64 * j] = oa;
                if (hasB) { v2u ob; ob.x = pk2(vB[j].x, vB[j].y); ob.y = pk2(vB[j].z, vB[j].w); ((v2u*)(X2 + (size_t)tb2 * 1024) + c.lane)[64 * j] = ob; } }
            else { ((f32x4*)(P.out + (size_t)ta * 1024) + c.lane)[64 * j] = vA[j]; if (hasB) ((f32x4*)(P.out + (size_t)tb2 * 1024) + c.lane)[64 * j] = vB[j]; } }
        if (NEXT) { rms_scale(vA, g, R1, ta, c.lane); wi_row(vA, wiw, WI, ta, c.lane);
            if (hasB) { rms_scale(vB, g, R1, tb2, c.lane); wi_row(vB, wiw, WI, tb2, c.lane); } }
    }
}

DI void phase_dsaprep(const Ctx& c0, const PV& P) {
    const Ctx c = relaunder(c0);
    const bf16* PROJ = (const bf16*)(P.ws + AR_PROJ); bf16* KN = (bf16*)(P.ws + AR_KN); bf16* KIN = (bf16*)(P.ws + AR_KIN); bf16* QIW = (bf16*)(P.ws + AR_QIW);
    const float* WI = (const float*)(P.ws + AR_WI); const float* kg = pin(P, I_DSA_K_NORM); unsigned char* V8 = (unsigned char*)(P.ws + AR_V8);
    const int l = c.lane;
    const int col = l < 8 ? 768 + 8 * l : (l < 16 ? 1216 + 8 * (l - 8) : (l < 48 ? 960 + 8 * (l - 16) : 832 + 8 * (l - 48)));
    float kgv[8];
#pragma unroll
    for (int j = 0; j < 8; ++j) kgv[j] = kg[8 * (l & 7) + j];
    for (int row0 = c.gw; row0 < NTOK; row0 += 4 * c.NGW) {
        v4u w[4]; float wv[4]; int rows[4];
#pragma unroll
        for (int u = 0; u < 4; ++u) { const int r = row0 + u * c.NGW; rows[u] = r < NTOK ? r : row0;
            w[u] = *(const v4u*)(PROJ + (size_t)rows[u] * 1536 + col);
            wv[u] = (l >= 16 && l < 48) ? WI[(size_t)rows[u] * 4 + ((l - 16) >> 3)] * 0.125f : 0.f; }
#pragma unroll
        for (int u = 0; u < 4; ++u) { const int row = rows[u]; if (row0 + u * c.NGW >= NTOK) continue;
            if (l >= 48) { float f[8]; unpack8(w[u], f); int w0 = 0, w1 = 0;
                w0 = __builtin_amdgcn_cvt_pk_fp8_f32(f[0], f[1], w0, false); w0 = __builtin_amdgcn_cvt_pk_fp8_f32(f[2], f[3], w0, true);
                w1 = __builtin_amdgcn_cvt_pk_fp8_f32(f[4], f[5], w1, false); w1 = __builtin_amdgcn_cvt_pk_fp8_f32(f[6], f[7], w1, true);
                *(v2u*)(V8 + (size_t)row * 128 + 8 * (l - 48)) = (v2u){(unsigned)w0, (unsigned)w1}; continue; }
            float f[8]; unpack8(w[u], f);
            float ss = 0.f;
#pragma unroll
            for (int j = 0; j < 8; ++j) ss += f[j] * f[j];
            ss += __shfl_xor(ss, 1); ss += __shfl_xor(ss, 2); ss += __shfl_xor(ss, 4);
            const float r = __builtin_amdgcn_rsqf(ss * (1.0f / 64.0f) + EPS);
            if (l < 8) {
#pragma unroll
                for (int j = 0; j < 8; ++j) f[j] = f[j] * r * kgv[j];
                *(v4u*)(KN + (size_t)row * 64 + 8 * l) = pack8(f);
            } else if (l < 16) {
#pragma unroll
                for (int j = 0; j < 8; ++j) f[j] *= r;
                const int cch = l - 8;
                *(v4u*)(KIN + ((((size_t)(row >> 5) * 4 + (cch >> 1)) * 2 + (cch & 1)) * 32 + (row & 31)) * 8) = pack8(f);
            } else {
#pragma unroll
                for (int j = 0; j < 8; ++j) f[j] *= wv[u];
                *(v4u*)(QIW + (size_t)row * 256 + 8 * (l - 16)) = pack8(f);
            }
        }
    }
}
DI int dpp_scan_add(int v) {
    v += __builtin_amdgcn_update_dpp(0, v, 0x111, 0xf, 0xf, true); v += __builtin_amdgcn_update_dpp(0, v, 0x112, 0xf, 0xf, true);
    v += __builtin_amdgcn_update_dpp(0, v, 0x114, 0xf, 0xf, true); v += __builtin_amdgcn_update_dpp(0, v, 0x118, 0xf, 0xf, true);
    v += __builtin_amdgcn_update_dpp(0, v, 0x142, 0xa, 0xf, false); v += __builtin_amdgcn_update_dpp(0, v, 0x143, 0xc, 0xf, false);
    return v;
}
DI unsigned dpp_scan_max(unsigned v) {
#define DPPMAX_(ctrl, rm, bc) { const unsigned o_ = (unsigned)__builtin_amdgcn_update_dpp(0, (int)v, ctrl, rm, 0xf, bc); v = v > o_ ? v : o_; }
    DPPMAX_(0x111, 0xf, true) DPPMAX_(0x112, 0xf, true) DPPMAX_(0x114, 0xf, true) DPPMAX_(0x118, 0xf, true) DPPMAX_(0x142, 0xa, false) DPPMAX_(0x143, 0xc, false)
#undef DPPMAX_
    return v;
}
DI unsigned idx_compact(LAS unsigned* qb, LAS unsigned* hist, int n, int lane) {
    unsigned e[9];
#pragma unroll
    for (int i = 0; i < 9; ++i) { const int idx = lane + 64 * i; e[i] = idx < n ? qb[idx] : 0u; }
    unsigned prefix = 0u, maskbits = 0u; int want = 256;
#pragma unroll
    for (int pass = 0; pass < 4; ++pass) { const int shift = 24 - 8 * pass;
        *(LAS v4u*)(hist + 4 * lane) = (v4u){0u, 0u, 0u, 0u};
        LDS_WAIT();
#pragma unroll
        for (int i = 0; i < 9; ++i) if (e[i] != 0u && (e[i] & maskbits) == prefix) lds_add(&hist[255u - ((e[i] >> shift) & 255u)], 1u);
        LDS_WAIT();
        const v4u h4 = *(const LAS v4u*)(hist + 4 * lane);
        LDS_WAIT();
        const int s = (int)(h4.x + h4.y + h4.z + h4.w);
        const int c0 = dpp_scan_add(s) - s, c1 = c0 + (int)h4.x, c2 = c1 + (int)h4.y, c3 = c2 + (int)h4.z;
        int fb = -1, fa = 0;
        if (c0 < want && want <= c0 + (int)h4.x) { fb = 0; fa = c0; }
        else if (c1 < want && want <= c1 + (int)h4.y) { fb = 1; fa = c1; }
        else if (c2 < want && want <= c2 + (int)h4.z) { fb = 2; fa = c2; }
        else if (c3 < want && want <= c3 + (int)h4.w) { fb = 3; fa = c3; }
        const unsigned long long m = __ballot(fb >= 0);
        const int src = m ? (int)__builtin_ctzll(m) : 0;
        const int slot = __builtin_amdgcn_readlane(4 * lane + fb, src), ab = __builtin_amdgcn_readlane(fa, src);
        prefix |= (unsigned)(255 - slot) << shift; maskbits |= 0xFFu << shift; want -= ab;
    }
    int base = 0;
#pragma unroll
    for (int i = 0; i < 9; ++i) { const bool pred = e[i] >= prefix && e[i] != 0u; const unsigned long long m = __ballot(pred);
        const int pos = base + (int)__builtin_amdgcn_mbcnt_hi((unsigned)(m >> 32), __builtin_amdgcn_mbcnt_lo((unsigned)m, 0u));
        if (pred) qb[pos] = e[i];
        base += (int)__builtin_popcountll(m); }
    LDS_WAIT();
    return prefix;
}
DI void hist_select(LAS unsigned* hist, int lane, int want, int& slot, int& incl, int& above) {
    const v4u h4 = *(const LAS v4u*)(hist + 4 * lane);
    const int s = (int)(h4.x + h4.y + h4.z + h4.w);
    const int c0 = dpp_scan_add(s) - s, c1 = c0 + (int)h4.x, c2 = c1 + (int)h4.y, c3 = c2 + (int)h4.z;
    int fb = -1, fa = 0, fk = 0;
    if (c0 < want && want <= c0 + (int)h4.x) { fb = 0; fa = c0; fk = c0 + (int)h4.x; }
    else if (c1 < want && want <= c1 + (int)h4.y) { fb = 1; fa = c1; fk = c1 + (int)h4.y; }
    else if (c2 < want && want <= c2 + (int)h4.z) { fb = 2; fa = c2; fk = c2 + (int)h4.z; }
    else if (c3 < want && want <= c3 + (int)h4.w) { fb = 3; fa = c3; fk = c3 + (int)h4.w; }
    const unsigned long long m = __ballot(fb >= 0);
    const int src = m ? (int)__builtin_ctzll(m) : 0;
    slot = __builtin_amdgcn_readlane(4 * lane + fb, src); incl = __builtin_amdgcn_readlane(fk, src); above = __builtin_amdgcn_readlane(fa, src);
}
DI int idx_compact_coarse(LAS unsigned* qb, LAS unsigned* hist, int n, unsigned lo, unsigned& tau, int lane) {
    unsigned e[9]; unsigned mx = 0u;
#pragma unroll
    for (int i = 0; i < 9; ++i) { const int idx = lane + 64 * i; e[i] = idx < n ? qb[idx] : 0u; mx = e[i] > mx ? e[i] : mx; }
    *(LAS v4u*)(hist + 4 * lane) = (v4u){0u, 0u, 0u, 0u};
    const unsigned hi = (unsigned)__builtin_amdgcn_readlane((int)dpp_scan_max(mx), 63);
    if (lo == 0u) {
        unsigned mc = 0u;
#pragma unroll
        for (int i = 0; i < 9; ++i) { const unsigned ce = e[i] != 0u ? ~e[i] : 0u; mc = ce > mc ? ce : mc; }
        lo = ~(unsigned)__builtin_amdgcn_readlane((int)dpp_scan_max(mc), 63) - 1u;
    }
    const unsigned range = hi - lo;
    const int sh = range >= 256u ? (24 - (int)__builtin_clz(range)) : 0;
    asm volatile("" ::: "memory");
#pragma unroll
    for (int i = 0; i < 9; ++i) if (e[i] != 0u) lds_add(&hist[255u - ((e[i] - lo) >> sh)], 1u);
    asm volatile("" ::: "memory");
    int slot, kept, above;
    hist_select(hist, lane, 256, slot, kept, above);
    unsigned edge = lo + ((unsigned)(255 - slot) << sh);
    if (__builtin_expect(kept > 352, 0)) {
        if (sh == 0) { tau = idx_compact(qb, hist, n, lane); return 256; }
        const int sh2 = sh > 8 ? sh - 8 : 0;
        *(LAS v4u*)(hist + 4 * lane) = (v4u){0u, 0u, 0u, 0u};
        asm volatile("" ::: "memory");
#pragma unroll
        for (int i = 0; i < 9; ++i) { const unsigned d = e[i] - edge; if (e[i] != 0u && (d >> sh) == 0u) lds_add(&hist[255u - (d >> sh2)], 1u); }
        asm volatile("" ::: "memory");
        int slot2, inc2, ab2;
        hist_select(hist, lane, 256 - above, slot2, inc2, ab2);
        kept = above + inc2;
        if (kept > 352) { tau = idx_compact(qb, hist, n, lane); return 256; }
        edge += (unsigned)(255 - slot2) << sh2;
    }
    int mine = 0;
#pragma unroll
    for (int i = 0; i < 9; ++i) mine += (e[i] >= edge && e[i] != 0u) ? 1 : 0;
    int pos = dpp_scan_add(mine) - mine;
#pragma unroll
    for (int i = 0; i < 9; ++i) { const bool pred = e[i] >= edge && e[i] != 0u; if (pred) qb[pos] = e[i]; pos += pred ? 1 : 0; }
    LDS_WAIT();
    tau = edge - 1u;
    return kept;
}
DI void idx_final(LAS unsigned* qb, LAS unsigned* hist, int n, int lane) {
    unsigned T; const int k = idx_compact_coarse(qb, hist, n, 0u, T, lane);
    const int ex = k - 256;
    if (ex == 0) return;
    if (ex > 12) { (void)idx_compact(qb, hist, k, lane); return; }
    unsigned e[6];
#pragma unroll
    for (int i = 0; i < 6; ++i) { const int idx = lane + 64 * i; e[i] = idx < k ? qb[idx] : 0u; }
    for (int r = 0; r < ex; ++r) {
        unsigned mc = 0u;
#pragma unroll
        for (int i = 0; i < 6; ++i) { const unsigned ce = e[i] != 0u ? ~e[i] : 0u; mc = ce > mc ? ce : mc; }
        const unsigned mn = ~(unsigned)__builtin_amdgcn_readlane((int)dpp_scan_max(mc), 63);
#pragma unroll
        for (int i = 0; i < 6; ++i) e[i] = (e[i] == mn) ? 0u : e[i];
    }
    int base = 0;
#pragma unroll
    for (int i = 0; i < 6; ++i) { const bool pred = e[i] != 0u; const unsigned long long mm = __ballot(pred);
        const int pos = base + (int)__builtin_amdgcn_mbcnt_hi((unsigned)(mm >> 32), __builtin_amdgcn_mbcnt_lo((unsigned)mm, 0u));
        if (pred) qb[pos] = e[i];
        base += (int)__builtin_popcountll(mm); }
    LDS_WAIT();
}
#ifndef CAPTRIG_SUB
#define CAPTRIG_SUB 64
#endif
constexpr int CAPQ = 576, CAPTRIG = CAPQ - CAPTRIG_SUB, IDX_WST = 8 * CAPQ * 4 + 1024;
static_assert(8 * IDX_WST <= MISC_OFF && CAPQ <= 9 * 64, "indexer buffers");
struct IdxState { float lo[4][4], hi[4][4]; unsigned tau[4]; int cnt[4]; int tq[4]; unsigned qa[4]; };
DI int sel4(const int (&a)[4], int j) { return j == 0 ? a[0] : (j == 1 ? a[1] : (j == 2 ? a[2] : a[3])); }
DI unsigned sel4u(const unsigned (&a)[4], int j) { return j == 0 ? a[0] : (j == 1 ? a[1] : (j == 2 ? a[2] : a[3])); }
template <int SHADOW, bool MASKED> DI void idx_step(const bf16x8 (&A)[4], const bf16x8 (&B)[2][4], IdxState& st, LAS unsigned* buf, LAS unsigned* hist, LAS unsigned* dummy, int step, bool lastst, int lane, int hh, int l31, unsigned ltmask) {
    f32x16 acc[2];
#pragma unroll
    for (int u = 0; u < 2; ++u) {
#pragma unroll
        for (int i = 0; i < 16; ++i) acc[u][i] = 0.f; }
#pragma unroll
    for (int ks = 0; ks < 4; ++ks) {
#pragma unroll
        for (int u = 0; u < 2; ++u) acc[u] = __builtin_amdgcn_mfma_f32_32x32x16_bf16(A[ks], B[u][ks], acc[u], 0, 0, 0); }
    if (SHADOW == 5) {
        f32x16 acc2[2];
#pragma unroll
        for (int u = 0; u < 2; ++u) {
#pragma unroll
            for (int i = 0; i < 16; ++i) acc2[u][i] = 1.f; }
#pragma unroll
        for (int ks = 0; ks < 4; ++ks) {
#pragma unroll
            for (int u = 0; u < 2; ++u) acc2[u] = __builtin_amdgcn_mfma_f32_32x32x16_bf16(A[3 - ks], B[u][ks], acc2[u], 0, 0, 0); }
#pragma unroll
        for (int u = 0; u < 2; ++u) {
#pragma unroll
            for (int i = 0; i < 16; i += 4) acc[u][i] += 1e-30f * acc2[u][i]; }
    }
#pragma unroll
    for (int rep2 = 0; rep2 < (SHADOW == 6 ? 2 : 1); ++rep2)
#pragma unroll
    for (int u = 0; u < 2; ++u) {
        const int s = step * 64 + 32 * u + l31 + rep2;
#pragma unroll
        for (int j = 0; j < 4; ++j) {
            const float sc = (__builtin_amdgcn_fmed3f(acc[u][4 * j], st.lo[j][0], st.hi[j][0]) + __builtin_amdgcn_fmed3f(acc[u][4 * j + 1], st.lo[j][1], st.hi[j][1]))
                           + (__builtin_amdgcn_fmed3f(acc[u][4 * j + 2], st.lo[j][2], st.hi[j][2]) + __builtin_amdgcn_fmed3f(acc[u][4 * j + 3], st.lo[j][3], st.hi[j][3]));
            unsigned uu = __float_as_uint(sc); uu ^= (unsigned)((int)uu >> 31) | 0x80000000u;
            const unsigned key = (uu & 0xFFFFC000u) | (unsigned)(16383 - s);
            const bool p1 = (SHADOW == 10) ? (key == 0xFFFFFFFFu) : (key > st.tau[j]), p2 = MASKED ? (s <= st.tq[j]) : true;
            const bool pred = p1 && p2;
            const unsigned long long m = MASKED ? (__builtin_amdgcn_ballot_w64(p1) & __builtin_amdgcn_ballot_w64(p2)) : __builtin_amdgcn_ballot_w64(p1);
            const unsigned hm = hh ? (unsigned)(m >> 32) : (unsigned)m;
            unsigned pos = (unsigned)__builtin_popcount(hm & ltmask) + (unsigned)st.cnt[j];
            asm("" : "+v"(pos));
            LAS unsigned* dst = pred ? (LAS unsigned*)(__UINTPTR_TYPE__)(st.qa[j] + (pos << 2)) : dummy;
            *dst = key;
            st.cnt[j] += __builtin_popcount(hm);
        }
    }
    const int cm = max(max(st.cnt[0], st.cnt[1]), max(st.cnt[2], st.cnt[3]));
    unsigned long long need = __ballot(cm > CAPTRIG);
    if (__builtin_expect(need != 0ull, 0)) {
        unsigned qmask = 0u;
#pragma unroll
        for (int j = 0; j < 4; ++j) { const unsigned long long mm = __ballot(st.cnt[j] > CAPTRIG); qmask |= ((unsigned)(mm & 1ull) << (2 * j)) | ((unsigned)((mm >> 32) & 1ull) << (2 * j + 1)); }
        LDS_WAIT();
        while (qmask) {
            const int q = __builtin_ctz(qmask); qmask &= qmask - 1u; const int j = q >> 1, h = q & 1;
            const int n = __builtin_amdgcn_readlane(sel4(st.cnt, j), h * 32); const unsigned lo0 = (unsigned)__builtin_amdgcn_readlane((int)sel4u(st.tau, j), h * 32);
            unsigned T; int k = idx_compact_coarse(buf + q * CAPQ, hist, n, lo0, T, lane);
            if (SHADOW == 14) { unsigned T2; k = idx_compact_coarse(buf + q * CAPQ, hist, k, T, T2, lane); T = T2; }
#pragma unroll
            for (int jj = 0; jj < 4; ++jj) if (jj == j && hh == h) { st.tau[jj] = T; st.cnt[jj] = k; }
        }
    }
}
template <int SHADOW = 0> DI void idx_loadB(bf16x8 (&B)[2][4], const bf16* kbase, int step) {
#pragma unroll
    for (int u = 0; u < (SHADOW == 9 ? 1 : 2); ++u)
#pragma unroll
        for (int ks = 0; ks < 4; ++ks) B[u][ks] = *(const bf16x8*)(kbase + ((size_t)(2 * step + u) * 4 + ks) * 512);
    if (SHADOW == 9) {
#pragma unroll
        for (int ks = 0; ks < 4; ++ks) B[1][ks] = B[0][ks]; }
}
template <int SHADOW> DI void phase_indexer(const Ctx& c0, const PV& P) {
    const Ctx c = relaunder(c0);
    const bf16* KIN = (const bf16*)(P.ws + AR_KIN); const bf16* QIW = (const bf16*)(P.ws + AR_QIW); const float* WI = (const float*)(P.ws + AR_WI); int* SEL = (int*)(P.ws + AR_SEL);
    LAS unsigned* buf = (LAS unsigned*)(c.lds + c.wave * IDX_WST);
    LAS unsigned* hist = buf + 8 * CAPQ;
    LAS unsigned* dummy = hist + c.lane;
    const int lane = c.lane, hh = lane >> 5, l31 = lane & 31;
    const unsigned ltmask = (1u << l31) - 1u;
    const float INF = __builtin_inff();
    for (int pair = c.blk; pair < 256; pair += c.G) {
        const int b = pair >> 7, jj = pair & 127;
        for (int half = 0; half < 2; ++half) {
            const int unit = half ? (255 - jj) : jj, t0w = unit * 64 + c.wave * 8, rowbase = b * SEQ;
            bf16x8 A[4];
#pragma unroll
            for (int ks = 0; ks < 4; ++ks) A[ks] = *(const bf16x8*)(QIW + (size_t)(rowbase + t0w + (l31 >> 2)) * 256 + (l31 & 3) * 64 + 16 * ks + 8 * hh);
            IdxState st;
#pragma unroll
            for (int j = 0; j < 4; ++j) { st.tq[j] = t0w + 2 * j + hh; st.tau[j] = 0u; st.cnt[j] = 0; st.qa[j] = (unsigned)(__UINTPTR_TYPE__)(buf + (2 * j + hh) * CAPQ); asm volatile("" : "+v"(st.qa[j]));
                const f32x4 w = *(const f32x4*)(WI + (size_t)(rowbase + st.tq[j]) * 4);
#pragma unroll
                for (int i = 0; i < 4; ++i) { st.lo[j][i] = w[i] > 0.f ? 0.f : -INF; st.hi[j][i] = w[i] > 0.f ? INF : 0.f; } }
            const int nstep = (SHADOW == 7) ? ((t0w + 7) / 128 + 1) : ((t0w + 7) / 64 + 1);
            const bf16* kbase = KIN + (size_t)(rowbase >> 5) * 2048 + lane * 8;
            bf16x8 R0[2][4], R1[2][4];
            idx_loadB<SHADOW>(R0, kbase, 0);
            if (nstep > 1) idx_loadB<SHADOW>(R1, kbase, 1); else idx_loadB<SHADOW>(R1, kbase, 0);
            int step = 0;
            for (; step + 2 < nstep; step += 2) {
                idx_step<SHADOW, false>(A, R0, st, buf, hist, dummy, step, false, lane, hh, l31, ltmask);
                idx_loadB<SHADOW>(R0, kbase, min(step + 2, nstep - 1));
                idx_step<SHADOW, false>(A, R1, st, buf, hist, dummy, step + 1, false, lane, hh, l31, ltmask);
                idx_loadB<SHADOW>(R1, kbase, min(step + 3, nstep - 1));
            }
            idx_step<SHADOW, true>(A, R0, st, buf, hist, dummy, step, true, lane, hh, l31, ltmask);
            idx_step<SHADOW, true>(A, R1, st, buf, hist, dummy, step + 1, true, lane, hh, l31, ltmask);
            LDS_WAIT();
            for (int q = 0; q < 8; ++q) {
                const int j = q >> 1, h2 = q & 1;
                int n = __builtin_amdgcn_readlane(sel4(st.cnt, j), h2 * 32);
                LAS unsigned* qb = buf + q * CAPQ;
                if (SHADOW == 8) n = n > 256 ? 256 : n;
                if (SHADOW == 15) n = n > 256 ? 256 : n;
                if (n > 256) { idx_final(qb, hist, n, lane); n = 256; }
                int* sp = SEL + (size_t)(rowbase + t0w + q) * 256;
#pragma unroll
                for (int i = 0; i < 4; ++i) { const int idx = lane + 64 * i; sp[idx] = idx < n ? (16383 - (int)(qb[idx] & 0x3FFFu)) : -1; }
            }
            LDS_WAIT();
        }
    }
}
DI int t5_bucket(int d) {
    if (d < 16) return d;
    return 16 + (d >= 19) + (d >= 21) + (d >= 24) + (d >= 27) + (d >= 31) + (d >= 35) + (d >= 40) + (d >= 46) + (d >= 52) + (d >= 59) + (d >= 67) + (d >= 77) + (d >= 87) + (d >= 99) + (d >= 113);
}
typedef short s16x4 __attribute__((ext_vector_type(4)));
template <int SHADOW = 0> DI void phase_sattn(const Ctx& c0, const PV& P) {
    const Ctx c = relaunder(c0);
    const bf16* PROJ = (const bf16*)(P.ws + AR_PROJ); const bf16* KN = (const bf16*)(P.ws + AR_KN); const int* SEL = (const int*)(P.ws + AR_SEL); bf16* MIX = (bf16*)(P.ws + AR_MIXD);
    const float* qg = pin(P, I_DSA_Q_NORM); const float* rb = pin(P, I_REL_BIAS); const unsigned char* V8 = (const unsigned char*)(P.ws + AR_V8);
    constexpr int WST = 11264, VRS = 144;
    LAS int* bk = (LAS int*)(c.lds + c.wave * WST);
    LAS int* selL = bk + 256;
    LAS bf16* Vs = (LAS bf16*)(selL + 256);
    LAS float* relb = (LAS float*)(c.lds + 8 * WST);
    __syncthreads();
    relb[c.tid] = (c.tid & 15) < 12 ? rb[(c.tid >> 4) * 12 + (c.tid & 15)] * 1.4426950408889634f : 0.f;
    if (c.tid < 16) relb[512 + c.tid] = -3.0e38f;
    if (c.tid < 128) ((LAS int*)(c.lds + 8 * WST + 4096))[c.tid] = t5_bucket(c.tid);
    __syncthreads();
    const int lane0 = hw_lane();
    int row = c.gw;
    v4i s4n = {0, 0, 0, 0}; v4u qn0 = {0u, 0u, 0u, 0u}, qn1 = {0u, 0u, 0u, 0u};
    if (row < NTOK) { s4n = *(const v4i*)((const char*)SEL + ((unsigned)row * 1024u + 16u * (unsigned)lane0));
        if ((lane0 & 15) < 12) { const char* qp = (const char*)PROJ + ((unsigned)row * 3072u + (unsigned)((lane0 & 15) * 128 + 16 * (lane0 >> 4))); qn0 = *(const v4u*)qp; qn1 = *(const v4u*)(qp + 64); } }
#pragma unroll 1
    for (; row < NTOK; row += c.NGW) {
        const int lane = hw_lane();
        const int l15 = lane & 15, g = lane >> 4;
        const LAS bf16* trp = Vs + (4 * g + (l15 >> 2)) * VRS + 4 * (l15 & 3);
        const int b = row >> 14, t = row & (SEQ - 1), rowbase = b << 14;
        const v4i s4 = s4n; const v4u w0 = qn0, w1 = qn1;
        const int sv[4] = {s4.x, s4.y, s4.z, s4.w};
        int bv[4], cv[4];
#pragma unroll
        for (int i = 0; i < 4; ++i) { const int dd = t - sv[i]; const int bq = ((const LAS int*)(c.lds + 8 * WST + 4096))[dd < 127 ? (dd < 0 ? 0 : dd) : 127];
            bv[i] = (sv[i] >= 0 ? bq : 32) * 64; cv[i] = (rowbase + (sv[i] >= 0 ? sv[i] : 0)) * 128; }
        *(LAS v4i*)(bk + 4 * lane) = (v4i){bv[0], bv[1], bv[2], bv[3]};
        *(LAS v4i*)(selL + 4 * lane) = (v4i){cv[0], cv[1], cv[2], cv[3]};
        float q0[8], q1[8]; unpack8(w0, q0); unpack8(w1, q1);
        float ss = 0.f;
#pragma unroll
        for (int j = 0; j < 8; ++j) ss += q0[j] * q0[j] + q1[j] * q1[j];
        ss += __shfl_xor(ss, 16); ss += __shfl_xor(ss, 32);
        const float r = (0.125f * 1.4426950408889634f) * __builtin_amdgcn_rsqf(ss * (1.0f / 64.0f) + EPS);
#pragma unroll
        for (int j = 0; j < 8; ++j) { q0[j] = q0[j] * r * qg[8 * g + j]; q1[j] = q1[j] * r * qg[32 + 8 * g + j]; }
        const bf16x8 B0 = __builtin_bit_cast(bf16x8, pack8(q0)), B1 = __builtin_bit_cast(bf16x8, pack8(q1));
        LDS_WAIT();
        v4u vb[3][4];
        const int kr8 = lane >> 3, kc8 = lane & 7;
#define VLOAD8(JB_, SLOT_) do { const v4i sv_ = *(const LAS v4i*)(selL + 32 * (JB_) + 4 * kr8); const int skv_[4] = {sv_.x, sv_.y, sv_.z, sv_.w}; \
            _Pragma("unroll") for (int i = 0; i < 4; ++i) vb[SLOT_][i] = (SHADOW == 1) ? (v4u){(unsigned)skv_[i], 0u, 0u, 0u} : *(const v4u*)(V8 + ((unsigned)skv_[i] + 16u * (unsigned)kc8)); } while (0)
        f32x4 S[16];
#pragma unroll
        for (int kt = 0; kt < 16; ++kt) { const v4i b4 = *(const LAS v4i*)(bk + 16 * kt + 4 * g); const int bb[4] = {b4.x, b4.y, b4.z, b4.w};
#pragma unroll
            for (int i = 0; i < 4; ++i) S[kt][i] = *(const LAS float*)((const LAS char*)relb + 4 * l15 + bb[i]); }
        {
            LAS bf16* Kst = Vs;
            const int kr = lane >> 3, kc = lane & 7;
            v4u kv[2][4];
#define KLOAD(CH_, SLOT_) do { const v4i sa_ = *(const LAS v4i*)(selL + 32 * (CH_) + 4 * kr); const int sk_[4] = {sa_.x, sa_.y, sa_.z, sa_.w}; \
            _Pragma("unroll") for (int i = 0; i < 4; ++i) kv[SLOT_][i] = *(const v4u*)((const char*)KN + ((unsigned)sk_[i] + 16u * (unsigned)kc)); } while (0)
            KLOAD(0, 0);
#pragma unroll
            for (int ch = 0; ch < 8; ++ch) {
                if (ch + 1 < 8) KLOAD(ch + 1, (ch + 1) & 1);
#pragma unroll
                for (int i = 0; i < 4; ++i) *(LAS v4u*)(Kst + (4 * kr + i) * 72 + 8 * kc) = kv[ch & 1][i];
                asm volatile("" ::: "memory");
#pragma unroll
                for (int k2 = 0; k2 < 2; ++k2) { const LAS bf16* ap = Kst + (16 * k2 + l15) * 72 + 8 * g;
                    const bf16x8 A0 = *(const LAS bf16x8*)ap, A1 = *(const LAS bf16x8*)(ap + 32);
                    const f32x4 z = mfma16(A0, B0, S[2 * ch + k2]); S[2 * ch + k2] = mfma16(A1, B1, z); }
                asm volatile("" ::: "memory");
                __builtin_amdgcn_sched_barrier(0);
            }
#undef KLOAD
        }
        VLOAD8(0, 0); VLOAD8(1, 1);
        float mx = -3.0e38f;
#pragma unroll
        for (int kt = 0; kt < 16; ++kt) mx = fmaxf(mx, fmaxf(fmaxf(S[kt][0], S[kt][1]), fmaxf(S[kt][2], S[kt][3])));
        mx = fmaxf(mx, __shfl_xor(mx, 16)); mx = fmaxf(mx, __shfl_xor(mx, 32));
#pragma unroll
        for (int kt = 0; kt < 16; ++kt) {
#pragma unroll
            for (int i = 0; i < 4; ++i) S[kt][i] = __builtin_amdgcn_exp2f(S[kt][i] - mx); }
        { const int nrow = row + c.NGW;
          if (nrow < NTOK) { s4n = *(const v4i*)((const char*)SEL + ((unsigned)nrow * 1024u + 16u * (unsigned)lane));
              if (l15 < 12) { const char* qp = (const char*)PROJ + ((unsigned)nrow * 3072u + (unsigned)(l15 * 128 + 16 * g)); qn0 = *(const v4u*)qp; qn1 = *(const v4u*)(qp + 64); } } }
        f32x4 O[8];
#pragma unroll
        for (int ct = 0; ct < 8; ++ct) O[ct] = (f32x4){0.f, 0.f, 0.f, 0.f};
        f32x4 Ls = {0.f, 0.f, 0.f, 0.f};
        bf16x8 ones; { v4u ow = {0x3F803F80u, 0x3F803F80u, 0x3F803F80u, 0x3F803F80u}; asm volatile("" : "+v"(ow)); ones = __builtin_bit_cast(bf16x8, ow); }
#pragma unroll
        for (int jb = 0; jb < (SHADOW == 1 ? 0 : 8); ++jb) {
            if (jb + 2 < 8) VLOAD8(jb + 2, (jb + 2) % 3);
#pragma unroll
            for (int i = 0; i < 4; ++i) { const v4u v = vb[jb % 3][i]; const unsigned vw[4] = {v.x, v.y, v.z, v.w}; unsigned o[8];
#pragma unroll
                for (int k = 0; k < 4; ++k) { o[2 * k] = __builtin_bit_cast(unsigned, __builtin_amdgcn_cvt_scalef32_pk_bf16_fp8((int)vw[k], 1.0f, false)); o[2 * k + 1] = __builtin_bit_cast(unsigned, __builtin_amdgcn_cvt_scalef32_pk_bf16_fp8((int)vw[k], 1.0f, true)); }
                LAS v4u* d = (LAS v4u*)(Vs + (4 * kr8 + i) * VRS + 16 * kc8); d[0] = (v4u){o[0], o[1], o[2], o[3]}; d[1] = (v4u){o[4], o[5], o[6], o[7]}; }
            v4u pw; pw.x = pk2(S[2 * jb][0], S[2 * jb][1]); pw.y = pk2(S[2 * jb][2], S[2 * jb][3]); pw.z = pk2(S[2 * jb + 1][0], S[2 * jb + 1][1]); pw.w = pk2(S[2 * jb + 1][2], S[2 * jb + 1][3]);
            const bf16x8 Pb = __builtin_bit_cast(bf16x8, pw);
            asm volatile("" ::: "memory");
#pragma unroll
            for (int ct = 0; ct < 8; ++ct) {
                const s16x4 a = __builtin_amdgcn_ds_read_tr16_b64_v4i16((LAS s16x4*)(trp + 16 * ct));
                const s16x4 bq = __builtin_amdgcn_ds_read_tr16_b64_v4i16((LAS s16x4*)(trp + 16 * VRS + 16 * ct));
                const bf16x8 Af = {a[0], a[1], a[2], a[3], bq[0], bq[1], bq[2], bq[3]};
                O[ct] = mfma16(Af, Pb, O[ct]); }
            Ls = mfma16(ones, Pb, Ls);
            asm volatile("" ::: "memory");
            __builtin_amdgcn_sched_barrier(0);
        }
        if (SHADOW ? (Ls[0] == 1.2345e-30f) : (l15 < 12)) { const float il = __builtin_amdgcn_rcpf(Ls[0]); bf16* op = (bf16*)((char*)MIX + ((unsigned)row * 3584u + (unsigned)(l15 * 256 + 8 * g)));
#pragma unroll
            for (int ct = 0; ct < 8; ++ct) { v2u o; o.x = pk2(O[ct][0] * il, O[ct][1] * il); o.y = pk2(O[ct][2] * il, O[ct][3] * il); *(v2u*)(op + 16 * ct) = o; } }
        LDS_WAIT();
    }
}

#ifndef ONLY
#define ONLY -1
#endif
#define PH(n) (ONLY < 0 || ONLY == (n))
#ifndef REP0
#define REP0 1
#endif
#ifndef REP1
#define REP1 1
#endif
#ifndef REP2
#define REP2 1
#endif
#ifndef REP3
#define REP3 1
#endif
#ifndef REP4
#define REP4 1
#endif
#ifndef REP5
#define REP5 1
#endif
#ifndef REP6
#define REP6 1
#endif
#ifndef REP7
#define REP7 1
#endif
#ifndef REP8
#define REP8 1
#endif
#ifndef REP9
#define REP9 1
#endif
#ifndef REP10
#define REP10 1
#endif
#ifndef REP11
#define REP11 1
#endif
#ifndef REP12
#define REP12 1
#endif
#ifndef REP13
#define REP13 1
#endif
#ifndef REP14
#define REP14 1
#endif
#ifndef REP15
#define REP15 1
#endif
#ifndef REP16
#define REP16 1
#endif
#ifndef REP17
#define REP17 1
#endif
#ifndef REP18
#define REP18 1
#endif
#define RB(n) for (int r_ = 0; r_ < REP##n; ++r_) { if (r_) GRID_BAR();
#define RE }
#ifdef PROBE_A
#define STAMP() do { if (c.blk == 0 && c.tid == 0) { volatile LAS unsigned* M_ = (volatile LAS unsigned*)(c.lds + MISC_OFF); const unsigned k_ = M_[20]; M_[20] = k_ + 1u; ((unsigned long long*)(P.ws + WS_CTL))[4096 + k_] = __builtin_amdgcn_s_memrealtime(); } } while (0)
#else
#define STAMP() do { } while (0)
#endif
#define GRID_BAR() do { xcd_barrier(bar); STAMP(); } while (0)
template <int layer> DI void layer_body(const Ctx& c, const PV& P, const XcdBarrier& bar) {
    unsigned char* ws = P.ws;
    unsigned* ctl = (unsigned*)(ws + WS_CTL);
    PG8_LAS unsigned char* glds = (PG8_LAS unsigned char*)c.lds;
    const pg8::bf16_t* HN = (const pg8::bf16_t*)(ws + WS_HN);
    if (layer == 0) { RB(0) if (PH(0)) phase_prep0(c, P); RE
    GRID_BAR(); }
    RB(1) if (PH(1)) {
        { pg8::Gemm g{(const pg8::bf16_t*)(ws + WB_MEMN), (const pg8::bf16_t*)(ws + WB_MKV), 1024, 1024, 1024}; pg8::StaticOrder S; S.init(2, 2, c.G, c.G - 1 - c.blk);
          pg8::EpiBf16<false> E{(pg8::bf16_t*)(ws + WB_MKVO), 512, 0, 0, nullptr};
          pg8::gemm_phase<pg8::EpiBf16<false>, pg8::StaticOrder, true, true>(glds, g, S, E, c.wave); }
        __syncthreads();
        if (layer == 0) { pg8::Gemm g{HN, (const pg8::bf16_t*)(ws + WB_WIN), 1024, 1024, 1024}; pg8::StaticOrder S; S.init(128, 7, c.G, c.blk);
          pg8::EpiBf16<true> E{(pg8::bf16_t*)(ws + AR_PROJ), 1792, 3, 6, nullptr};
          pg8::gemm_phase<pg8::EpiBf16<true>, pg8::StaticOrder, true, true>(glds, g, S, E, c.wave); }
        if (layer == 0) { const int fb = (128 * 7) % c.G; __syncthreads(); if (c.blk >= fb) phase_prep0_tail(c, P, fb); }
        else { pg8::Gemm g{(const pg8::bf16_t*)(ws + WS_X2), (const pg8::bf16_t*)(ws + WB_WIN), 1024, 1024, 1024}; pg8::StaticOrder S; S.init(128, 6, c.G, c.blk);
          pg8::EpiBf16<false, true> E{(pg8::bf16_t*)(ws + AR_PROJ), 1536, 0, 0, (const float*)(ws + AR_R)};
          pg8::gemm_phase<pg8::EpiBf16<false, true>, pg8::StaticOrder, true, true>(glds, g, S, E, c.wave); }
    } RE
    GRID_BAR();
    if (layer == 0) {
        RB(2) if (PH(2)) phase_conv(c, P); RE
#ifndef REPX
#define REPX 1
#endif
#ifndef XSH
#define XSH 0
#endif
        for (int rx = 0; rx < REPX; ++rx) { if (rx) GRID_BAR(); if (rx + 1 < REPX) phase_xattn<0, 1792, 1536, 1024, 768, XSH>(c, P, (const bf16*)(ws + AR_PROJ), (bf16*)(ws + AR_LA)); else phase_xattn<0, 1792, 1536, 1024, 768>(c, P, (const bf16*)(ws + AR_PROJ), (bf16*)(ws + AR_MIXL)); }
        GRID_BAR();
        RB(3) if (PH(3)) { pg8::Gemm g{(const pg8::bf16_t*)(ws + AR_XSC), (const pg8::bf16_t*)(ws + WB_WGT), 768, 768, 768}; pg8::GateOrder S; S.init(128, 6, c.G, c.blk);
          pg8::EpiLruGate E{(pg8::bf16_t*)(ws + AR_LA), (pg8::bf16_t*)(ws + AR_UU), (const pg8::bf16_t*)(ws + AR_XSC), 768, pin(P, I_LRU_B_A), pin(P, I_LRU_B_X), pin(P, I_LRU_LAMBDA), (float*)(ws + AR_SA), (float*)(ws + AR_SH)};
          pg8::gemm_phase<pg8::EpiLruGate, pg8::GateOrder, true, true>(glds, g, S, E, c.wave); } RE
        GRID_BAR();
        RB(5) if (PH(5)) phase_scanB(c, P); RE
        GRID_BAR();
        RB(6) if (PH(6)) phase_scanC(c, P); RE
        GRID_BAR();
        RB(7) if (PH(7)) { pg8::Gemm g{(const pg8::bf16_t*)(ws + AR_MIXL), (const pg8::bf16_t*)(ws + WB_WOUT), 1024, 1024, 1024}; pg8::StaticOrder S; S.init(128, 4, c.G, c.blk);
          pg8::EpiResBf16<false> E{(pg8::bf16_t*)P.out, (const void*)pin(P, I_X), 1024};
          pg8::gemm_phase<pg8::EpiResBf16<false>, pg8::StaticOrder, true, true>(glds, g, S, E, c.wave); } RE
    } else {
        RB(8) if (PH(8)) phase_dsaprep(c, P);
        if (PH(8)) phase_xattn<1, 1536, 1280, 1792, 1536>(c, P, (const bf16*)(ws + AR_PROJ), (bf16*)(ws + AR_MIXD)); RE
        GRID_BAR();
#ifndef IDX_SHADOW
#define IDX_SHADOW 0
#endif
        RB(9) if (PH(9)) { if (r_ + 1 < REP9) phase_indexer<IDX_SHADOW>(c, P); else phase_indexer<0>(c, P); } RE
        GRID_BAR();
#ifndef SA_SHADOW
#define SA_SHADOW 0
#endif
        RB(10) if (PH(10)) { if (r_ + 1 < REP10) phase_sattn<SA_SHADOW>(c, P); else phase_sattn<0>(c, P); } RE
        GRID_BAR();
        RB(11) if (PH(11)) { pg8::Gemm g{(const pg8::bf16_t*)(ws + AR_MIXD), (const pg8::bf16_t*)(ws + WB_WOUT), 1792, 1792, 1792}; pg8::StaticOrder S; S.init(128, 4, c.G, c.blk);
          pg8::EpiResBf16<true> E{(r_ + 1 < REP11) ? (pg8::bf16_t*)(ws + WS_AR) : (pg8::bf16_t*)(ws + WS_X2), (const void*)(ws + WS_X2), 1024};
          pg8::gemm_phase<pg8::EpiResBf16<true>, pg8::StaticOrder, true, true>(glds, g, S, E, c.wave); } RE
    }
    GRID_BAR();
    if (PH(12)) phase_norm_route<layer>(c, P);
    GRID_BAR();
    moe_tables<layer>(c, P);
    RB(16) if (PH(16)) { const int ntile = ((const LAS int*)(c.lds + TAB_OFF))[400];
        pg8::Gemm g{(layer == 0) ? (const pg8::bf16_t*)P.out : (const pg8::bf16_t*)(ws + WS_X2), (const pg8::bf16_t*)(ws + (layer == 0 ? WB_WGU : WB_WGU1)), 1024, 1024, 1024}; pg8::GatherOrder S; S.init(ntile, 4, c.G, c.blk);
        S.tab = (const PG8_LAS int*)(c.lds + TAB_OFF); S.estride = (size_t)1024 * 1024 * 2; S.rowtab = (const int*)(ws + AR_LOG); S.zrow = NTOK;
        pg8::EpiSwiglu E{(pg8::bf16_t*)(ws + AR_ACT), 512, (const float*)(ws + AR_RS)};
        pg8::gemm_phase<pg8::EpiSwiglu, pg8::GatherOrder, true, true>(glds, g, S, E, c.wave);
        { const int fb = (ntile * 4) % c.G; __syncthreads(); if (c.blk >= fb) { if (layer == 0) phase_prep1_early(c, P, fb); else phase_prep1_down(c, P, fb); } } } RE
    GRID_BAR();
    RB(17) if (PH(17)) { const int ntile = ((const LAS int*)(c.lds + TAB_OFF))[400];
        pg8::Gemm g{(const pg8::bf16_t*)(ws + AR_ACT), (const pg8::bf16_t*)(ws + (layer == 0 ? WB_WD : WB_WD1)), 512, 512, 512}; pg8::GroupedOrder S; S.init(ntile, 4, c.G, c.blk);
        S.tab = (const PG8_LAS int*)(c.lds + TAB_OFF); S.estride = (size_t)1024 * 512 * 2;
        pg8::EpiFp8 E{(unsigned char*)(ws + AR_XS), 1024};
        pg8::gemm_phase<pg8::EpiFp8, pg8::GroupedOrder, true, true>(glds, g, S, E, c.wave);
        if (layer == 0) { const int fb = (ntile * 4) % c.G; __syncthreads(); if (c.blk >= fb) phase_prep1_gu(c, P, fb); } } RE
    GRID_BAR();
#ifdef XBAR
    for (int xb = 0; xb < XBAR; ++xb) GRID_BAR();
#endif
    if (PH(18)) phase_combine<layer == 0>(c, P);
    if (layer == 0) GRID_BAR();
}
__global__ void __launch_bounds__(512, 2) fwd(const Params P) {
    extern __shared__ __attribute__((aligned(16))) unsigned char lds_raw[];
    Ctx c;
    c.lds = (LAS unsigned char*)lds_raw;
    c.tid = threadIdx.x; c.lane = c.tid & 63; c.wave = __builtin_amdgcn_readfirstlane(c.tid >> 6);
    c.G = gridDim.x; c.blk = blockIdx.x; c.gw = c.blk * 8 + c.wave; c.NGW = c.G * 8;
    volatile LAS unsigned* MISC = (volatile LAS unsigned*)(c.lds + MISC_OFF);
    if (c.tid < 64) MISC[c.tid] = 0u;
    if (c.tid < 29) ((LAS unsigned long long*)(c.lds + MISC_OFF + 512))[c.tid] = (unsigned long long)P.in[c.tid];
    __syncthreads();
    XcdBarrier bar = xcd_barrier_post((unsigned*)(P.ws + WS_CTL) + CW_BAR, MISC + 8, c.wave);
    PV pv; pv.ws = P.ws; pv.out = P.out; pv.tab = (LAS unsigned long long*)(c.lds + MISC_OFF + 512);
#ifndef ONLY_LAYER
    { const PV& P = pv; STAMP(); }
    layer_body<0>(c, pv, bar);
    layer_body<1>(c, pv, bar);
#ifdef PROBE_A
    {
        xcd_barrier(bar);
        const unsigned long long* ts = (const unsigned long long*)(pv.ws + WS_CTL) + 4096;
        const float ta = (float)(__hip_atomic_load(ts + PROBE_A + 1, RLX_AGENT) - __hip_atomic_load(ts + PROBE_A, RLX_AGENT)) * 0.01f;
        const float tb = (float)(__hip_atomic_load(ts + PROBE_B + 1, RLX_AGENT) - __hip_atomic_load(ts + PROBE_B, RLX_AGENT)) * 0.01f;
        xcd_barrier(bar);
        for (size_t i = (size_t)c.blk * 512 + c.tid; i < (size_t)NTOK * DM; i += (size_t)c.G * 512) pv.out[i] = (i == 0) ? 100.f * tb : ta;
    }
#endif
#else
    layer_body<ONLY_LAYER>(c, pv, bar);
#endif
}

extern "C" void kernel_launch(void* const* d_in, const int* in_sizes, int n_in, void* d_out, int out_size, void* d_ws, size_t ws_size, hipStream_t stream) {
    static int grid = 0;
    if (grid == 0) {
        if (n_in != 29 || out_size != NTOK * DM || ws_size < WS_END) { fprintf(stderr, "kernel_launch: unexpected shapes (n_in %d out %d ws %zu need %zu)\n", n_in, out_size, ws_size, (size_t)WS_END); grid = -1; return; }
        int dev = 0, cus = 0, per_cu = 0;
        if (hipGetDevice(&dev) != hipSuccess || hipDeviceGetAttribute(&cus, hipDeviceAttributeMultiprocessorCount, dev) != hipSuccess) { grid = -1; return; }
        if (hipFuncSetAttribute((const void*)fwd, hipFuncAttributeMaxDynamicSharedMemorySize, LDS_BYTES) != hipSuccess) { fprintf(stderr, "kernel_launch: hipFuncSetAttribute failed\n"); grid = -1; return; }
        if (hipOccupancyMaxActiveBlocksPerMultiprocessor(&per_cu, (const void*)fwd, 512, LDS_BYTES) != hipSuccess || per_cu < 1) { fprintf(stderr, "kernel_launch: occupancy query reports %d\n", per_cu); }
        (void)hipGetLastError();
        grid = cus;
    }
    if (grid < 0) return;
    if (hipMemsetAsync((char*)d_ws + WS_CTL, 0, CTL_ZERO_BYTES, stream) != hipSuccess) return;
    Params p{};
    for (int i = 0; i < 29; ++i) p.in[i] = (const float*)d_in[i];
    p.out = (float*)d_out; p.ws = (unsigned char*)d_ws;
    hipLaunchKernelGGL(fwd, dim3(grid), dim3(512), LDS_BYTES, stream, p);
}
```

```cpp
#include <hip/hip_runtime.h>
#include <cstdio>
#include <cstdint>
namespace pg8 {
#define PG8_LAS __attribute__((address_space(3)))
typedef unsigned short bf16_t;
typedef short bf16x8 __attribute__((ext_vector_type(8)));
typedef float f32x4 __attribute__((ext_vector_type(4)));
typedef float f32x2 __attribute__((ext_vector_type(2)));
typedef unsigned u32x4 __attribute__((ext_vector_type(4)));
constexpr int BM = 256, BK = 64, HALF = 128, HTB = HALF * BK * 2  , STAGE_BYTES = 8 * HTB, NXCD = 8, WGM = 8;

__host__ __device__ __forceinline__ int lds_byte(int r, int c) { const int st = (r >> 4) * 2 + (c >> 5), rr = r & 15, cc = c & 31, ob = rr * 64 + cc * 2; return st * 1024 + (ob ^ (((ob >> 9) & 1) << 5)); }
__host__ __device__ __forceinline__ void stage_rc(int b, int& R, int& C) { const int st = b / 1024, sb = b % 1024, swz = sb ^ (((sb >> 9) & 1) << 5); R = (st >> 1) * 16 + swz / 64; C = (st & 1) * 32 + (swz % 64) / 2; }
__host__ __device__ __forceinline__ int perm32(int rho) { const int n = rho >> 4, i = rho & 15; return 8 * (i >> 2) + 4 * n + (i & 3); }

struct Unit { int pm, pn; size_t boff; int koff, nt; int ex, pst, cn; };
struct Gemm { const bf16_t* A; const bf16_t* Bt; int lda, ldb, K; };

struct StaticOrder {
    static constexpr bool GATHER = false; const int* rowtab;
    int nM, nN, nwg, G, c;
    __host__ __device__ void init(int nM_, int nN_, int G_, int c_) { nM = nM_; nN = nN_; nwg = nM * nN; G = G_; c = c_; rowtab = nullptr; }
    __host__ __device__ bool next(int i, Unit& u) const {
        const long L = (long)i * G + c; if (L >= nwg) return false;
        int wgid = (int)L; { const int q = nwg / NXCD, r = nwg % NXCD, xcd = wgid % NXCD, off = wgid / NXCD; wgid = (xcd < r ? xcd * (q + 1) : r * (q + 1) + (xcd - r) * q) + off; }
        const int nig = WGM * nN, gid = wgid / nig, fm = gid * WGM, gsz = (nM - fm) < WGM ? (nM - fm) : WGM;
        u.pm = fm + ((wgid % nig) % gsz); u.pn = (wgid % nig) / gsz; u.boff = 0; u.koff = 0; u.nt = 0; return true;
    }
    __device__ __forceinline__ void a_ready(const Unit&) const {}
    __device__ __forceinline__ void done(const Unit&) const {}
};
struct GateOrder : StaticOrder {
    __device__ bool next(int i, Unit& u) const { if (!StaticOrder::next(i, u)) return false;
        const int k0 = (u.pn == 2) ? 128 : (u.pn >= 5 ? 512 : (u.pn >= 3 ? 384 : 0)); const int kl = (u.pn == 1 || u.pn == 4) ? 384 : 256;
        u.koff = k0 * 2; u.nt = kl / 64; return true; }
};
constexpr int MOE_CAP = 65536;
struct GroupedOrder : StaticOrder {
    const PG8_LAS int* tab; size_t estride;
    __device__ __forceinline__ bool next(int i, Unit& u) const { if (!StaticOrder::next(i, u)) return false;
        const int e = tab[64 + u.pm]; u.ex = e; u.pst = tab[32 + e]; u.cn = tab[e]; u.boff = (size_t)e * estride; return true; }
};

__device__ __forceinline__ unsigned cvt_pk_bf16(float lo, float hi) { unsigned r; asm volatile("v_cvt_pk_bf16_f32 %0, %1, %2" : "=v"(r) : "v"(lo), "v"(hi)); return r; }
__device__ __forceinline__ float bf_lo(unsigned w) { return __uint_as_float(w << 16); }
__device__ __forceinline__ float bf_hi(unsigned w) { return __uint_as_float(w & 0xffff0000u); }
__device__ __forceinline__ float sigmoidf_(float v) { return __builtin_amdgcn_rcpf(1.0f + __expf(-v)); }
__device__ __forceinline__ float gelu_tanh(float v) { const float t = v * v; const float p = __builtin_fmaf(t, -2.3022082f * 0.044715f, -2.3022082f);
    return v * __builtin_amdgcn_rcpf(1.0f + __builtin_amdgcn_exp2f(v * p)); }

struct GatherOrder : GroupedOrder { static constexpr bool GATHER = true; int zrow;
    __device__ __forceinline__ int tok(const Unit& u, int r) const { const int rel = u.pm * BM - u.pst + r; return rel < u.cn ? rowtab[(size_t)u.ex * MOE_CAP + rel] : zrow; } };

template <bool GELU, bool RSCALE = false> struct EpiBf16 {
    static constexpr bool PERM = true, AFTER_DRAIN = false;
    bf16_t* O; int ldc; int gelu_lo, gelu_hi; const float* rs;
    __device__ __forceinline__ void operator()(const f32x4 (&acc)[2][2][4][2], const Unit& u, int wr, int wc, int fr, int fq) const {
        const int row0 = u.pm * BM + wr * 64 + fr, col0 = u.pn * BM + wc * 32 + 8 * fq;
        const bool act = GELU && (u.pn >= gelu_lo && u.pn < gelu_hi);
        float rsv[8];
        if (RSCALE) {
#pragma unroll
            for (int i = 0; i < 8; ++i) rsv[i] = rs[row0 + (i >> 2) * HALF + (i & 3) * 16]; }
#pragma unroll
        for (int ai = 0; ai < 2; ++ai)
#pragma unroll
            for (int m = 0; m < 4; ++m) { bf16_t* rowp = O + (size_t)(row0 + ai * HALF + m * 16) * ldc + col0;
#pragma unroll
                for (int bj = 0; bj < 2; ++bj) { f32x4 v0 = acc[ai][bj][m][0], v1 = acc[ai][bj][m][1];
                    if (RSCALE) { const float r = rsv[ai * 4 + m]; v0 = v0 * r; v1 = v1 * r; }
                    if (act) {
#pragma unroll
                        for (int j = 0; j < 4; ++j) { v0[j] = gelu_tanh(v0[j]); v1[j] = gelu_tanh(v1[j]); } }
                    u32x4 w; w.x = cvt_pk_bf16(v0[0], v0[1]); w.y = cvt_pk_bf16(v0[2], v0[3]); w.z = cvt_pk_bf16(v1[0], v1[1]); w.w = cvt_pk_bf16(v1[2], v1[3]);
                    *(u32x4*)(rowp + bj * HALF) = w; } }
    }
};
struct EpiSwiglu {
    static constexpr bool PERM = true, AFTER_DRAIN = false;
    bf16_t* O; int ldc; const float* rs;
    __device__ __forceinline__ void operator()(const f32x4 (&acc)[2][2][4][2], const Unit& u, int wr, int wc, int fr, int fq) const {
        const int row0 = u.pm * BM + wr * 64 + fr, col0 = u.pn * HALF + wc * 32 + 8 * fq;
        float rsv[8];
#pragma unroll
        for (int i = 0; i < 8; ++i) rsv[i] = rs[((size_t)u.ex * MOE_CAP - u.pst) + row0 + (i >> 2) * HALF + (i & 3) * 16];
#pragma unroll
        for (int ai = 0; ai < 2; ++ai)
#pragma unroll
            for (int m = 0; m < 4; ++m) { bf16_t* rowp = O + (size_t)(row0 + ai * HALF + m * 16) * ldc + col0;
                f32x4 v0, v1;
                const float r = rsv[ai * 4 + m];
#pragma unroll
                for (int j = 0; j < 4; ++j) { const float g0 = r * acc[ai][0][m][0][j], g1 = r * acc[ai][0][m][1][j];
                    v0[j] = g0 * sigmoidf_(g0) * (r * acc[ai][1][m][0][j]); v1[j] = g1 * sigmoidf_(g1) * (r * acc[ai][1][m][1][j]); }
                u32x4 w; w.x = cvt_pk_bf16(v0[0], v0[1]); w.y = cvt_pk_bf16(v0[2], v0[3]); w.z = cvt_pk_bf16(v1[0], v1[1]); w.w = cvt_pk_bf16(v1[2], v1[3]);
                *(u32x4*)rowp = w; }
    }
};
struct EpiLruGate {
    static constexpr bool PERM = true, AFTER_DRAIN = false;
    bf16_t* LA; bf16_t* U; const bf16_t* XS; int ldc; const PG8_LAS float* gt; float* SA; float* SH;
    __device__ __forceinline__ void operator()(const f32x4 (&acc)[2][2][4][2], const Unit& u, int wr, int wc, int fr, int fq) const {
        const int row0 = u.pm * BM + wr * 64 + fr, ch0 = u.pn * HALF + wc * 32 + 8 * fq;
        float ba[8], bx[8], sp8[8];
#pragma unroll
        for (int j = 0; j < 8; ++j) { ba[j] = gt[ch0 + j]; bx[j] = gt[768 + ch0 + j]; sp8[j] = gt[1536 + ch0 + j]; }
#pragma unroll
        for (int ai = 0; ai < 2; ++ai) {
            float Ac[8], Hc[8];
#pragma unroll
            for (int j = 0; j < 8; ++j) { Ac[j] = 1.f; Hc[j] = 0.f; }
            u32x4 xwv[4];
#pragma unroll
            for (int m = 0; m < 4; ++m) xwv[m] = *(const u32x4*)(XS + (size_t)(row0 + ai * HALF + m * 16) * ldc + ch0);
#pragma unroll
            for (int m = 0; m < 4; ++m) { const size_t off = (size_t)(row0 + ai * HALF + m * 16) * ldc + ch0;
                const u32x4 xw = xwv[m];
                float xv[8] = {bf_lo(xw.x), bf_hi(xw.x), bf_lo(xw.y), bf_hi(xw.y), bf_lo(xw.z), bf_hi(xw.z), bf_lo(xw.w), bf_hi(xw.w)};
                float la[8], ig8[8];
#pragma unroll
                for (int j = 0; j < 8; ++j) { const float er = __builtin_amdgcn_exp2f(__builtin_fmaf(acc[ai][0][m][j >> 2][j & 3], -1.4426950408889634f, ba[j])), ei = __builtin_amdgcn_exp2f(__builtin_fmaf(acc[ai][1][m][j >> 2][j & 3], -1.4426950408889634f, bx[j]));
                    la[j] = -sp8[j] * __builtin_amdgcn_rcpf(1.0f + er); ig8[j] = __builtin_amdgcn_rcpf(1.0f + ei); }
                u32x4 w; w.x = cvt_pk_bf16(la[0], la[1]); w.y = cvt_pk_bf16(la[2], la[3]); w.z = cvt_pk_bf16(la[4], la[5]); w.w = cvt_pk_bf16(la[6], la[7]);
                *(u32x4*)(LA + off) = w;
                float A8[8], uu[8];
                { const unsigned lw[4] = {w.x, w.y, w.z, w.w};
#pragma unroll
                  for (int j = 0; j < 8; ++j) { const float lr = (j & 1) ? bf_hi(lw[j >> 1]) : bf_lo(lw[j >> 1]); const float a = __builtin_amdgcn_exp2f(lr); A8[j] = a;
                      const float t = 1.3862943611198906f * lr  ; const float om = (t > -0.002f) ? -t * (1.0f + 0.5f * t) : 1.0f - a * a;
                      uu[j] = __builtin_amdgcn_sqrtf(om) * ig8[j] * xv[j]; } }
                u32x4 w2; w2.x = cvt_pk_bf16(uu[0], uu[1]); w2.y = cvt_pk_bf16(uu[2], uu[3]); w2.z = cvt_pk_bf16(uu[4], uu[5]); w2.w = cvt_pk_bf16(uu[6], uu[7]);
                *(u32x4*)(U + off) = w2;
                { const unsigned uw[4] = {w2.x, w2.y, w2.z, w2.w}; float H8[8];
#pragma unroll
                  for (int j = 0; j < 8; ++j) H8[j] = (j & 1) ? bf_hi(uw[j >> 1]) : bf_lo(uw[j >> 1]);
#define LRU_DPP_STEP(SH) asm( \
                      "s_nop 1\n\tv_fmac_f32_dpp %0, %0, %8 " SH " row_mask:0xf bank_mask:0xf\n\tv_fmac_f32_dpp %1, %1, %9 " SH " row_mask:0xf bank_mask:0xf\n\t" \
                      "v_fmac_f32_dpp %2, %2, %10 " SH " row_mask:0xf bank_mask:0xf\n\tv_fmac_f32_dpp %3, %3, %11 " SH " row_mask:0xf bank_mask:0xf\n\t" \
                      "v_fmac_f32_dpp %4, %4, %12 " SH " row_mask:0xf bank_mask:0xf\n\tv_fmac_f32_dpp %5, %5, %13 " SH " row_mask:0xf bank_mask:0xf\n\t" \
                      "v_fmac_f32_dpp %6, %6, %14 " SH " row_mask:0xf bank_mask:0xf\n\tv_fmac_f32_dpp %7, %7, %15 " SH " row_mask:0xf bank_mask:0xf\n\t" \
                      "v_mul_f32_dpp %8, %8, %8 " SH " row_mask:0xf bank_mask:0xf\n\tv_mul_f32_dpp %9, %9, %9 " SH " row_mask:0xf bank_mask:0xf\n\t" \
                      "v_mul_f32_dpp %10, %10, %10 " SH " row_mask:0xf bank_mask:0xf\n\tv_mul_f32_dpp %11, %11, %11 " SH " row_mask:0xf bank_mask:0xf\n\t" \
                      "v_mul_f32_dpp %12, %12, %12 " SH " row_mask:0xf bank_mask:0xf\n\tv_mul_f32_dpp %13, %13, %13 " SH " row_mask:0xf bank_mask:0xf\n\t" \
                      "v_mul_f32_dpp %14, %14, %14 " SH " row_mask:0xf bank_mask:0xf\n\tv_mul_f32_dpp %15, %15, %15 " SH " row_mask:0xf bank_mask:0xf" \
                      : "+v"(H8[0]), "+v"(H8[1]), "+v"(H8[2]), "+v"(H8[3]), "+v"(H8[4]), "+v"(H8[5]), "+v"(H8[6]), "+v"(H8[7]), \
                        "+v"(A8[0]), "+v"(A8[1]), "+v"(A8[2]), "+v"(A8[3]), "+v"(A8[4]), "+v"(A8[5]), "+v"(A8[6]), "+v"(A8[7]))
                  LRU_DPP_STEP("row_shr:1"); LRU_DPP_STEP("row_shr:2"); LRU_DPP_STEP("row_shr:4"); LRU_DPP_STEP("row_shr:8");
#undef LRU_DPP_STEP
#pragma unroll
                  for (int j = 0; j < 8; ++j) { Hc[j] = A8[j] * Hc[j] + H8[j]; Ac[j] = A8[j] * Ac[j]; } }
                __builtin_amdgcn_sched_barrier(0); }
            if (fr == 15) { float* sa = SA + (size_t)(u.pm * 4 + ai * 2 + wr) * 768 + ch0; float* sh = SH + (size_t)(u.pm * 4 + ai * 2 + wr) * 768 + ch0;
                *(f32x4*)sa = (f32x4){Ac[0], Ac[1], Ac[2], Ac[3]}; *(f32x4*)(sa + 4) = (f32x4){Ac[4], Ac[5], Ac[6], Ac[7]};
                *(f32x4*)sh = (f32x4){Hc[0], Hc[1], Hc[2], Hc[3]}; *(f32x4*)(sh + 4) = (f32x4){Hc[4], Hc[5], Hc[6], Hc[7]}; }
        }
    }
};
struct EpiResF32 {
    static constexpr bool PERM = false, AFTER_DRAIN = false;
    float* C; const float* R; int ldc;
    __device__ __forceinline__ void operator()(const f32x4 (&acc)[2][2][4][2], const Unit& u, int wr, int wc, int fr, int fq) const {
        const int row0 = u.pm * BM + wr * 64 + fr, col0 = u.pn * BM + wc * 32 + 4 * fq;
#pragma unroll
        for (int ai = 0; ai < 2; ++ai)
#pragma unroll
            for (int m = 0; m < 4; ++m) { const size_t ro = (size_t)(row0 + ai * HALF + m * 16) * ldc + col0;
#pragma unroll
                for (int bj = 0; bj < 2; ++bj)
#pragma unroll
                    for (int n = 0; n < 2; ++n) { const f32x4 r = *(const f32x4*)(R + ro + bj * HALF + n * 16); *(f32x4*)(C + ro + bj * HALF + n * 16) = r + acc[ai][bj][m][n]; }  __builtin_amdgcn_sched_barrier(0); }
    }
};
template <bool RBF> struct EpiResBf16 {
    static constexpr bool PERM = true, AFTER_DRAIN = false;
    bf16_t* X; const void* R; int ldc;
    __device__ __forceinline__ void operator()(const f32x4 (&acc)[2][2][4][2], const Unit& u, int wr, int wc, int fr, int fq) const {
        const int row0 = u.pm * BM + wr * 64 + fr, col0 = u.pn * BM + wc * 32 + 8 * fq;
        u32x4 rw[2][4]; f32x4 r0[2][4], r1[2][4];
#define RES_LOAD(Q_, S_) do { _Pragma("unroll") for (int m = 0; m < 4; ++m) { const size_t ro = (size_t)(row0 + ((Q_) >> 1) * HALF + m * 16) * ldc + col0 + ((Q_) & 1) * HALF; \
            if (RBF) rw[S_][m] = *(const u32x4*)((const bf16_t*)R + ro); \
            else { r0[S_][m] = *(const f32x4*)((const float*)R + ro); r1[S_][m] = *(const f32x4*)((const float*)R + ro + 4); } } } while (0)
        RES_LOAD(0, 0);
#pragma unroll
        for (int q = 0; q < 4; ++q) { const int ai = q >> 1, bj = q & 1;
            if (q + 1 < 4) RES_LOAD(q + 1, (q + 1) & 1);
#pragma unroll
            for (int m = 0; m < 4; ++m) { const size_t ro = (size_t)(row0 + ai * HALF + m * 16) * ldc + col0 + bj * HALF;
                f32x4 v0 = acc[ai][bj][m][0], v1 = acc[ai][bj][m][1];
                if (RBF) { const u32x4 w4 = rw[q & 1][m]; v0[0] += bf_lo(w4.x); v0[1] += bf_hi(w4.x); v0[2] += bf_lo(w4.y); v0[3] += bf_hi(w4.y); v1[0] += bf_lo(w4.z); v1[1] += bf_hi(w4.z); v1[2] += bf_lo(w4.w); v1[3] += bf_hi(w4.w); }
                else { v0 += r0[q & 1][m]; v1 += r1[q & 1][m]; }
                u32x4 w; w.x = cvt_pk_bf16(v0[0], v0[1]); w.y = cvt_pk_bf16(v0[2], v0[3]); w.z = cvt_pk_bf16(v1[0], v1[1]); w.w = cvt_pk_bf16(v1[2], v1[3]);
                *(u32x4*)(X + ro) = w; }
            __builtin_amdgcn_sched_barrier(0); }
#undef RES_LOAD
    }
};
struct EpiFp8 {
    static constexpr bool PERM = true, AFTER_DRAIN = false;
    unsigned char* O; int ldc;
    __device__ __forceinline__ void operator()(const f32x4 (&acc)[2][2][4][2], const Unit& u, int wr, int wc, int fr, int fq) const {
        const int row0 = u.pm * BM + wr * 64 + fr, col0 = u.pn * BM + wc * 32 + 8 * fq;
#pragma unroll
        for (int ai = 0; ai < 2; ++ai)
#pragma unroll
            for (int m = 0; m < 4; ++m) { unsigned char* rowp = O + (size_t)(row0 + ai * HALF + m * 16) * ldc + col0;
#pragma unroll
                for (int bj = 0; bj < 2; ++bj) { const f32x4 v0 = acc[ai][bj][m][0] * 16.0f, v1 = acc[ai][bj][m][1] * 16.0f;
                    int w0 = 0, w1 = 0;
                    w0 = __builtin_amdgcn_cvt_pk_fp8_f32(v0[0], v0[1], w0, false); w0 = __builtin_amdgcn_cvt_pk_fp8_f32(v0[2], v0[3], w0, true);
                    w1 = __builtin_amdgcn_cvt_pk_fp8_f32(v1[0], v1[1], w1, false); w1 = __builtin_amdgcn_cvt_pk_fp8_f32(v1[2], v1[3], w1, true);
                    typedef int i32x2 __attribute__((ext_vector_type(2)));
                    *(i32x2*)(rowp + bj * HALF) = (i32x2){w0, w1}; } }
    }
};
struct EpiLogits {
    static constexpr bool PERM = false, AFTER_DRAIN = false;
    float* C;
    __device__ __forceinline__ void operator()(const f32x4 (&acc)[2][2][4][2], const Unit& u, int wr, int wc, int fr, int fq) const {
        if (wc >= 2 || u.pn != 0) return;
        const int row0 = u.pm * BM + wr * 64 + fr, col0 = wc * 32 + 4 * fq;
#pragma unroll
        for (int ai = 0; ai < 2; ++ai)
#pragma unroll
            for (int m = 0; m < 4; ++m) { float* rowp = C + (size_t)(row0 + ai * HALF + m * 16) * 64 + col0;
#pragma unroll
                for (int n = 0; n < 2; ++n) *(f32x4*)(rowp + n * 16) = acc[ai][0][m][n]; }
    }
};
template <class Epi, class Sched, bool ALIGN_EPI = false, bool SP2 = false>
__device__ __forceinline__ void gemm_phase(PG8_LAS unsigned char* lds, const Gemm g, const Sched& S, const Epi& E, int wave_id) {
    int lane_; asm volatile("v_mbcnt_lo_u32_b32 %0, -1, 0\n\tv_mbcnt_hi_u32_b32 %0, -1, %0" : "=v"(lane_)); const int tid_ = wave_id * 64 + lane_;
    const int tid = tid_, wid = __builtin_amdgcn_readfirstlane(tid >> 6), lane = tid & 63, wr = wid >> 2, wc = wid & 3, fr = lane & 15, fq = lane >> 4;
    static_assert(SP2, "only the SP2 loop carries the per-lane A offsets");
    const int ntd = g.K / BK;
    constexpr bool GATH = Sched::GATHER;
    unsigned voffA[2], voffB[2]; int Rrow[2], Ccol[2];
#pragma unroll
    for (int i = 0; i < 2; ++i) { int R, C; stage_rc(tid * 16 + i * 8192, R, C); Rrow[i] = R; Ccol[i] = C; const int Rb = Epi::PERM ? ((R & ~31) + perm32(R & 31)) : R;
        voffA[i] = (unsigned)(R * g.lda + C) * 2u; voffB[i] = (unsigned)(Rb * g.ldb + C) * 2u; }
    const size_t kstep = (size_t)(BK * 2);
    const size_t hsA = (size_t)HALF * g.lda * 2, hsB = (size_t)HALF * g.ldb * 2;
    const size_t tsA = 2 * hsA, tsB = 2 * hsB;
    const unsigned ldsw = (unsigned)wid * 1024u;
    const int aoff = lds_byte(wr * 64 + fr, fq * 8), boff = lds_byte(wc * 32 + fr, fq * 8);
#define PG8_SA(b, h) (((b) * 2 + (h)) * HTB)
#define PG8_SB(b, h) ((4 + (b) * 2 + (h)) * HTB)
#define PG8_STAGE(bufoff, gbase, voff) do { _Pragma("unroll") for (int _i = 0; _i < 2; ++_i) \
        __builtin_amdgcn_global_load_lds((const unsigned*)((const char*)(gbase) + (voff)[_i]), (PG8_LAS unsigned*)(lds + (bufoff) + ldsw + _i * 8192), 16, 0, 0); } while (0)
#define PG8_LDA(dst, b, h) do { _Pragma("unroll") for (int m = 0; m < 4; ++m) _Pragma("unroll") for (int k = 0; k < 2; ++k) dst[m][k] = *(const PG8_LAS bf16x8*)(lds + PG8_SA(b, h) + aoff + m * 2048 + k * 1024); } while (0)
#define PG8_LDB(dst, b, h) do { _Pragma("unroll") for (int n = 0; n < 2; ++n) _Pragma("unroll") for (int k = 0; k < 2; ++k) dst[n][k] = *(const PG8_LAS bf16x8*)(lds + PG8_SB(b, h) + boff + n * 2048 + k * 1024); } while (0)
#define PG8_MMA(ai, bj, At, Bt) do { __builtin_amdgcn_s_setprio(1); _Pragma("unroll") for (int m = 0; m < 4; ++m) _Pragma("unroll") for (int n = 0; n < 2; ++n) _Pragma("unroll") for (int k = 0; k < 2; ++k) \
        acc[ai][bj][m][n] = __builtin_amdgcn_mfma_f32_16x16x32_bf16(Bt[n][k], At[m][k], acc[ai][bj][m][n], 0, 0, 0); __builtin_amdgcn_s_setprio(0); } while (0)
#define PG8_WAIT_V(n) asm volatile("s_waitcnt vmcnt(" #n ")" ::: "memory")
#define PG8_WAIT_L(n) asm volatile("s_waitcnt lgkmcnt(" #n ")" ::: "memory")
#define PG8_BAR __builtin_amdgcn_s_barrier()
#define PG8_SCHED __builtin_amdgcn_sched_barrier(0)
    Unit cur, nxt; int ui = 0;
    if (!S.next(0, cur)) return;
    f32x4 acc[2][2][4][2];
#pragma unroll
    for (int a = 0; a < 2; ++a)
#pragma unroll
        for (int b = 0; b < 2; ++b)
#pragma unroll
            for (int m = 0; m < 4; ++m)
#pragma unroll
                for (int n = 0; n < 2; ++n) acc[a][b][m][n] = (f32x4){0.f, 0.f, 0.f, 0.f};
    bf16x8 At[4][2], B0[2][2], B1[2][2];
    const char* cA = (const char*)g.A + (GATH ? (size_t)0 : (size_t)cur.pm * tsA) + cur.koff; const char* cB = (const char*)g.Bt + cur.boff + (size_t)cur.pn * tsB + cur.koff;
    unsigned oc[2][2], on[2][2];
#pragma unroll
    for (int h = 0; h < 2; ++h)
#pragma unroll
        for (int i = 0; i < 2; ++i) { if constexpr (GATH) oc[h][i] = (unsigned)S.tok(cur, h * HALF + Rrow[i]) * (unsigned)(g.lda * 2) + (unsigned)(Ccol[i] * 2); else oc[h][i] = voffA[i] + (unsigned)(h * hsA); on[h][i] = oc[h][i]; }
    S.a_ready(cur);
    if constexpr (SP2) {
        PG8_STAGE(PG8_SB(0, 0), cB, voffB); PG8_STAGE(PG8_SB(0, 1), cB + hsB, voffB); PG8_STAGE(PG8_SA(0, 0), cA, oc[0]); PG8_STAGE(PG8_SA(0, 1), cA, oc[1]);
        if (wr == 1) PG8_BAR;
        PG8_WAIT_V(2); PG8_BAR;
        PG8_STAGE(PG8_SB(1, 0), cB + kstep, voffB); PG8_STAGE(PG8_SA(1, 0), cA + kstep, oc[0]); PG8_STAGE(PG8_SB(1, 1), cB + hsB + kstep, voffB);
        PG8_WAIT_V(6); PG8_BAR;
    } else {
        PG8_STAGE(PG8_SB(0, 0), cB, voffB); PG8_STAGE(PG8_SA(0, 0), cA, voffA); PG8_STAGE(PG8_SB(0, 1), cB + hsB, voffB); PG8_STAGE(PG8_SA(0, 1), cA + hsA, voffA);
        if (wr == 1) PG8_BAR;
        PG8_WAIT_V(4); PG8_BAR;
        PG8_STAGE(PG8_SB(1, 0), cB + kstep, voffB); PG8_STAGE(PG8_SA(1, 0), cA + kstep, voffA); PG8_STAGE(PG8_SB(1, 1), cB + hsB + kstep, voffB);
        PG8_WAIT_V(6); PG8_BAR;
    }
    for (;;) {
        const bool has_next = S.next(ui + 1, nxt);
        if constexpr (GATH) { if (has_next) {
#pragma unroll
            for (int h = 0; h < 2; ++h)
#pragma unroll
                for (int i = 0; i < 2; ++i) on[h][i] = (unsigned)S.tok(nxt, h * HALF + Rrow[i]) * (unsigned)(g.lda * 2) + (unsigned)(Ccol[i] * 2); } }
        const char* nA = has_next ? (const char*)g.A + (GATH ? (size_t)0 : (size_t)nxt.pm * tsA) + nxt.koff : cA; const char* nB = has_next ? (const char*)g.Bt + nxt.boff + (size_t)nxt.pn * tsB + nxt.koff : cB;
        const int nt = cur.nt ? cur.nt : ntd;
        for (int t = 0; t < nt; t += 2) {
            const bool last = (t == nt - 2);
            const char* a1 = cA + (size_t)(t + 1) * kstep;
            const char* a2 = last ? nA : cA + (size_t)(t + 2) * kstep; const char* b2 = last ? nB : cB + (size_t)(t + 2) * kstep;
            const char* a3 = a2 + kstep; const char* b3 = b2 + kstep;
            if (last && has_next) S.a_ready(nxt);
            unsigned s2[2][2];
#pragma unroll
            for (int h = 0; h < 2; ++h)
#pragma unroll
                for (int i = 0; i < 2; ++i) s2[h][i] = (GATH && last) ? on[h][i] : oc[h][i];
            if constexpr (SP2) {
            PG8_LDB(B0, 0, 0); PG8_LDB(B1, 0, 1); PG8_SCHED; PG8_LDA(At, 0, 0); PG8_STAGE(PG8_SA(1, 1), a1, oc[1]);
            PG8_WAIT_V(8); PG8_WAIT_L(0); PG8_BAR; PG8_MMA(0, 0, At, B0); PG8_MMA(0, 1, At, B1); PG8_BAR; PG8_SCHED;
            PG8_LDA(At, 0, 1); PG8_STAGE(PG8_SB(0, 0), b2, voffB); PG8_STAGE(PG8_SB(0, 1), b2 + hsB, voffB); PG8_STAGE(PG8_SA(0, 0), a2, s2[0]);
            PG8_WAIT_V(8); PG8_WAIT_L(0); PG8_BAR; PG8_MMA(1, 0, At, B0); PG8_MMA(1, 1, At, B1); PG8_BAR; PG8_SCHED;
            PG8_LDB(B0, 1, 0); PG8_LDB(B1, 1, 1); PG8_SCHED; PG8_LDA(At, 1, 0); PG8_STAGE(PG8_SA(0, 1), a2, s2[1]);
            PG8_WAIT_V(8); PG8_WAIT_L(0); PG8_BAR; PG8_MMA(0, 0, At, B0); PG8_MMA(0, 1, At, B1); PG8_BAR; PG8_SCHED;
            PG8_LDA(At, 1, 1); PG8_STAGE(PG8_SB(1, 0), b3, voffB); PG8_STAGE(PG8_SB(1, 1), b3 + hsB, voffB); PG8_STAGE(PG8_SA(1, 0), a3, s2[0]);
            PG8_WAIT_V(8); PG8_WAIT_L(0); PG8_BAR; PG8_MMA(1, 0, At, B0); PG8_MMA(1, 1, At, B1); PG8_BAR; PG8_SCHED;
            } else {
            PG8_LDB(B0, 0, 0); PG8_SCHED; PG8_LDA(At, 0, 0); PG8_STAGE(PG8_SA(1, 1), a1 + hsA, voffA);
            PG8_WAIT_L(8); PG8_BAR; PG8_WAIT_L(0); PG8_MMA(0, 0, At, B0); PG8_BAR; PG8_SCHED;
            PG8_LDB(B1, 0, 1); PG8_STAGE(PG8_SB(0, 0), b2, voffB);
            PG8_BAR; PG8_WAIT_L(0); PG8_MMA(0, 1, At, B1); PG8_BAR;
            PG8_LDA(At, 0, 1); PG8_STAGE(PG8_SA(0, 0), a2, voffA);
            PG8_BAR; PG8_WAIT_L(0); PG8_MMA(1, 0, At, B0); PG8_BAR; PG8_SCHED;
            PG8_STAGE(PG8_SB(0, 1), b2 + hsB, voffB);
            PG8_WAIT_V(6); PG8_BAR; PG8_MMA(1, 1, At, B1); PG8_BAR;
            PG8_LDB(B0, 1, 0); PG8_SCHED; PG8_LDA(At, 1, 0); PG8_STAGE(PG8_SA(0, 1), a2 + hsA, voffA);
            PG8_WAIT_L(8); PG8_BAR; PG8_WAIT_L(0); PG8_MMA(0, 0, At, B0); PG8_BAR; PG8_SCHED;
            PG8_LDB(B1, 1, 1); PG8_STAGE(PG8_SB(1, 0), b3, voffB);
            PG8_BAR; PG8_WAIT_L(0); PG8_MMA(0, 1, At, B1); PG8_BAR;
            PG8_LDA(At, 1, 1); PG8_STAGE(PG8_SA(1, 0), a3, voffA);
            PG8_BAR; PG8_WAIT_L(0); PG8_MMA(1, 0, At, B0); PG8_BAR; PG8_SCHED;
            PG8_STAGE(PG8_SB(1, 1), b3 + hsB, voffB);
            PG8_WAIT_V(6); PG8_BAR; PG8_MMA(1, 1, At, B1); PG8_BAR;
            }
        }
        if constexpr (ALIGN_EPI) { if (wr == 0) PG8_BAR; }
        if constexpr (!Epi::AFTER_DRAIN) { E(acc, cur, wr, wc, fr, fq); S.done(cur); }
        if (!has_next) break;
#pragma unroll
        for (int a = 0; a < 2; ++a)
#pragma unroll
            for (int b = 0; b < 2; ++b)
#pragma unroll
                for (int m = 0; m < 4; ++m)
#pragma unroll
                    for (int n = 0; n < 2; ++n) acc[a][b][m][n] = (f32x4){0.f, 0.f, 0.f, 0.f};
        cur = nxt; cA = nA; cB = nB; ++ui;
#pragma unroll
        for (int h = 0; h < 2; ++h)
#pragma unroll
            for (int i = 0; i < 2; ++i) oc[h][i] = on[h][i];
        if constexpr (ALIGN_EPI) { if (wr == 1) PG8_BAR; }
    }
    PG8_WAIT_V(0);
    if constexpr (!ALIGN_EPI) { if (wr == 0) PG8_BAR; }
    PG8_BAR;
    if constexpr (Epi::AFTER_DRAIN) { E.fused(acc, cur, wr, wc, fr, fq, lds, wid, lane); S.done(cur); }
#undef PG8_SA
#undef PG8_SB
#undef PG8_STAGE
#undef PG8_LDA
#undef PG8_LDB
#undef PG8_MMA
#undef PG8_WAIT_V
#undef PG8_WAIT_L
#undef PG8_BAR
#undef PG8_SCHED
}
}

constexpr int NTOK = 32768, SEQ = 16384, DM = 1024;
constexpr float EPS = 1e-6f;
constexpr size_t MiB = 1u << 20;
constexpr size_t WS_CTL = 0, CTL_ZERO_BYTES = 1 * MiB;
constexpr size_t WS_WB = 1 * MiB;
constexpr size_t WB_MKV = WS_WB + 0 * MiB;
constexpr size_t WB_MEMN = WS_WB + 1 * MiB;
constexpr size_t WB_MKVO = WS_WB + 2 * MiB;
constexpr size_t WB_WR = WS_WB + 3 * MiB;
constexpr size_t WB_WIN = WS_WB + 4 * MiB;
constexpr size_t WB_WGT = WS_WB + 8 * MiB;
constexpr size_t WB_WOUT = WS_WB + 11 * MiB;
constexpr size_t WB_WGU = WS_WB + 16 * MiB;
constexpr size_t WB_WD = WS_WB + 80 * MiB;
constexpr size_t WS_HN = WS_WB + 112 * MiB;
constexpr size_t WS_AR = WS_HN + 64 * MiB;
constexpr size_t AR_PROJ = WS_AR;
constexpr size_t AR_XSC = WS_AR + 112 * MiB;
constexpr size_t AR_LA = WS_AR + 160 * MiB;
constexpr size_t AR_UU = WS_AR + 208 * MiB;
constexpr size_t AR_MIXL = WS_AR + 256 * MiB;
constexpr size_t AR_SA = WS_AR + 320 * MiB;
constexpr size_t AR_SH = WS_AR + 322 * MiB;
constexpr size_t AR_CARRY = WS_AR + 324 * MiB;
constexpr size_t AR_KN = WS_AR + 96 * MiB;
constexpr size_t AR_KIN = WS_AR + 100 * MiB;
constexpr size_t AR_QIW = WS_AR + 104 * MiB;
constexpr size_t AR_WI = WS_AR + 264 * MiB;
constexpr size_t AR_SEL = WS_AR + 120 * MiB;
constexpr size_t AR_V8 = WS_HN;
constexpr size_t AR_MIXD = WS_AR + 152 * MiB;
constexpr size_t AR_XS = WS_AR;
constexpr size_t AR_ACT = WS_AR + 144 * MiB;
constexpr size_t AR_LOG = WS_AR + 216 * MiB;
constexpr size_t AR_EID = WS_AR + 224 * MiB;
constexpr size_t AR_GATE = WS_AR + 225 * MiB;
constexpr size_t AR_DEST = WS_AR + 226 * MiB;
constexpr size_t AR_R = WS_AR + 227 * MiB;
constexpr size_t AR_RS = WS_AR + 228 * MiB;
constexpr size_t WB_WGU1 = WS_AR + 265 * MiB;
constexpr size_t WB_WD1 = WS_AR + 329 * MiB;
constexpr size_t WS_END = WB_WD1 + 32 * MiB;
constexpr size_t WS_X2 = WB_WGU;
constexpr int CW_TMO = 0, CW_CODE = 1;
constexpr int CW_CNT = 256, CW_CUR = 320, CW_NT = 384, CW_LSTRIDE = 256;
constexpr int CW_TE = 1024, CW_TE_STRIDE = 512;
constexpr int CW_BAR = 4096;
constexpr int CW_RDY = 65536;
constexpr int LDS_BYTES = 159744, MISC_OFF = 155648;
constexpr int TAB_OFF = 143360;

#define GAS __attribute__((address_space(1)))
#define LAS __attribute__((address_space(3)))
#define DI __device__ __forceinline__
typedef unsigned short bf16;
typedef unsigned v4u __attribute__((ext_vector_type(4)));
typedef unsigned v2u __attribute__((ext_vector_type(2)));
typedef int v4i __attribute__((ext_vector_type(4)));
typedef float f32x4 __attribute__((ext_vector_type(4)));
typedef float f32x16 __attribute__((ext_vector_type(16)));
typedef short bf16x8 __attribute__((ext_vector_type(8)));
typedef GAS unsigned gu32;
#define RLX_AGENT __ATOMIC_RELAXED, __HIP_MEMORY_SCOPE_AGENT
#define LDS_WAIT() asm volatile("s_waitcnt lgkmcnt(0)" ::: "memory")
DI unsigned f2bf(float f) { unsigned u = __builtin_bit_cast(unsigned, f); return (u + 0x7fffu + ((u >> 16) & 1u)) >> 16; }
typedef __bf16 bf2_t __attribute__((ext_vector_type(2)));
typedef float f32x2_t __attribute__((ext_vector_type(2)));
DI unsigned pk2(float lo, float hi) { const bf2_t v = __builtin_convertvector((f32x2_t){lo, hi}, bf2_t); return __builtin_bit_cast(unsigned, v); }
DI float bflo(unsigned w) { return __uint_as_float(w << 16); }
DI float bfhi(unsigned w) { return __uint_as_float(w & 0xffff0000u); }
DI void unpack8(const v4u w, float (&f)[8]) { f[0] = bflo(w.x); f[1] = bfhi(w.x); f[2] = bflo(w.y); f[3] = bfhi(w.y); f[4] = bflo(w.z); f[5] = bfhi(w.z); f[6] = bflo(w.w); f[7] = bfhi(w.w); }
DI v4u pack8(const float (&f)[8]) { v4u w; w.x = pk2(f[0], f[1]); w.y = pk2(f[2], f[3]); w.z = pk2(f[4], f[5]); w.w = pk2(f[6], f[7]); return w; }
DI unsigned lds_add(LAS unsigned* p, unsigned v) { return __hip_atomic_fetch_add(p, v, __ATOMIC_RELAXED, __HIP_MEMORY_SCOPE_WORKGROUP); }
DI float wave_sum(float v) {
#pragma unroll
    for (int o = 1; o < 64; o <<= 1) v += __shfl_xor(v, o);
    return v;
}

#define XB_TMO      128
#define XB_XCNT(j)  (256  + 64 * (j))
#define XB_XSUB(j)  (1280 + 64 * (j))
#define XB_XGEN(j)  (2304 + 64 * (j))
#define XB_TOP      3328
#define XB_TOPGEN   3392
#define XCD_BAR_WORDS 3456
#define XB_SPIN_CAP (1u << 22)
DI unsigned xb_ld(unsigned* p)              { return __hip_atomic_load(p, __ATOMIC_RELAXED, __HIP_MEMORY_SCOPE_AGENT); }
DI unsigned xb_add(unsigned* p, unsigned v) { return __hip_atomic_fetch_add(p, v, __ATOMIC_RELAXED, __HIP_MEMORY_SCOPE_AGENT); }
DI unsigned xb_xcc_id() { return (unsigned)__builtin_amdgcn_s_getreg((3 << 11) | 20) & 0xFu; }
#define XB_SPIN(cond, bar) do { unsigned _sp = 0; while (cond) { __builtin_amdgcn_s_sleep(1); \
    if ((++_sp & 255u) == 0u) { if (xb_ld(&(bar)[XB_TMO])) break; if (_sp > XB_SPIN_CAP) { atomicAdd(&(bar)[XB_TMO], 1u); break; } } } } while (0)
DI int hw_lane() { int l; asm volatile("v_mbcnt_lo_u32_b32 %0, -1, 0\n\tv_mbcnt_hi_u32_b32 %0, -1, %0" : "=v"(l)); return l; }
struct XcdBarrier { unsigned* bar; unsigned x; volatile LAS unsigned* st; int wave; };
DI XcdBarrier xcd_barrier_post(unsigned* bar, volatile LAS unsigned* st, int wave) {
    XcdBarrier b; b.bar = bar; b.x = xb_xcc_id(); b.st = st; b.wave = wave;
    if (wave == 0 && hw_lane() == 0) (void)xb_add(&bar[XB_XCNT(b.x)], 1u);
    return b;
}
DI void xcd_barrier_complete(unsigned* bar, unsigned x, unsigned& nloc, unsigned& nx) {
    const unsigned G = gridDim.x * gridDim.y * gridDim.z;
    unsigned sum, cnt, mine, sp = 0u;
    for (;;) {
        sum = 0u; cnt = 0u; mine = 0u;
#pragma unroll
        for (unsigned j = 0; j < 16; ++j) { const unsigned c = xb_ld(&bar[XB_XCNT(j)]); sum += c; cnt += (c > 0u) ? 1u : 0u; mine = (j == x) ? c : mine; }
        if (sum == G) break;
        __builtin_amdgcn_s_sleep(1);
        if ((++sp & 255u) == 0u) { if (xb_ld(&bar[XB_TMO])) break; if (sp > XB_SPIN_CAP) { atomicAdd(&bar[XB_TMO], 1u); break; } }
    }
    nloc = mine > 0u ? mine : 1u; nx = cnt > 0u ? cnt : 1u;
}
DI void xcd_barrier(const XcdBarrier& b) {
    asm volatile("s_waitcnt vmcnt(0)" ::: "memory");
    __syncthreads();
    if (b.wave == 0 && hw_lane() == 0) {
        unsigned* bar = b.bar;
        __builtin_amdgcn_s_waitcnt(0);
        unsigned nloc = b.st[0], nx = b.st[1];
        if (nloc == 0u) { xcd_barrier_complete(bar, b.x, nloc, nx); b.st[0] = nloc; b.st[1] = nx; }
        const unsigned old = xb_add(&bar[XB_XSUB(b.x)], 1u);
        const unsigned gen = old / nloc;
        if (old + 1u == (gen + 1u) * nloc) {
            __builtin_amdgcn_fence(__ATOMIC_RELEASE, "agent");
            asm volatile("s_waitcnt vmcnt(0)" ::: "memory");
            const unsigned og = xb_add(&bar[XB_TOP], 1u);
            const unsigned tgt = (og / nx + 1u) * nx;
            if (og + 1u != tgt) XB_SPIN(xb_ld(&bar[XB_TOP]) < tgt, bar);
            xb_add(&bar[XB_XGEN(b.x)], 1u);
            __builtin_amdgcn_fence(__ATOMIC_ACQUIRE, "agent");
            asm volatile("s_waitcnt vmcnt(0)" ::: "memory");
        } else {
            XB_SPIN(xb_ld(&bar[XB_XGEN(b.x)]) == gen, bar);
            __builtin_amdgcn_fence(__ATOMIC_ACQUIRE, "agent");
            asm volatile("s_waitcnt vmcnt(0)" ::: "memory");
        }
    }
    __syncthreads();
}

struct Params { const float* in[29]; float* out; unsigned char* ws; };
struct PV { unsigned char* ws; float* out; LAS unsigned long long* tab; };
DI const float* pin(const PV& P, int i) { const unsigned long long v = P.tab[i]; const unsigned lo = __builtin_amdgcn_readfirstlane((unsigned)v), hi = __builtin_amdgcn_readfirstlane((unsigned)(v >> 32)); return (const float*)(const __attribute__((address_space(1))) float*)(((unsigned long long)hi << 32) | lo); }
struct Ctx { LAS unsigned char* lds; int tid, lane, wave, G, blk, gw, NGW; };
DI Ctx relaunder(const Ctx& c0) { Ctx c = c0; int t = c0.wave * 64 + hw_lane(); asm volatile("" : "+v"(t)); c.tid = t; c.lane = t & 63; c.wave = __builtin_amdgcn_readfirstlane(t >> 6); c.gw = c.blk * 8 + c.wave; return c; }
enum { I_X = 0, I_MEM, I_NORM_MIX, I_NORM_FFN, I_MEM_NORM, I_W_MEM_KV, I_XQ_NORM, I_XK_NORM, I_W_OUT, I_LRU_W_IN, I_LRU_CONV_W, I_LRU_CONV_B, I_LRU_W_A, I_LRU_B_A,
       I_LRU_W_X, I_LRU_B_X, I_LRU_LAMBDA, I_DSA_W_IN, I_DSA_Q_NORM, I_DSA_K_NORM, I_DSA_W_UV, I_REL_BIAS, I_MOE_W_GROUP, I_MOE_B_GROUP, I_MOE_W_ROUTER, I_MOE_B_ROUTER,
       I_MOE_W_GATE, I_MOE_W_UP, I_MOE_W_DOWN };

#define GAS __attribute__((address_space(1)))
DI void tr_load(const float* __restrict__ W0, int ldw, f32x4 (&v)[16], int lane) {
    const GAS float* W = (const GAS float*)W0;
    const int m = lane & 15, q = lane >> 4;
#pragma unroll
    for (int i = 0; i < 8; ++i) { const int kk = 8 * i + 2 * q; v[2 * i] = *(const GAS f32x4*)(W + (size_t)kk * ldw + 4 * m); v[2 * i + 1] = *(const GAS f32x4*)(W + (size_t)(kk + 1) * ldw + 4 * m); }
}
DI void tr_loadg(const float* gk0, float (&gq)[16], int lane) {
    const GAS float* gk = (const GAS float*)gk0; const int q = lane >> 4;
#pragma unroll
    for (int i = 0; i < 8; ++i) { gq[2 * i] = gk ? gk[8 * i + 2 * q] : 1.0f; gq[2 * i + 1] = gk ? gk[8 * i + 2 * q + 1] : 1.0f; }
}
DI void tr_store(const f32x4 (&v)[16], bf16* __restrict__ WT0, int ldk, LAS unsigned* scr, int lane, const float (&gq)[16]) {
    GAS bf16* WT = (GAS bf16*)WT0;
    const int m = lane & 15, q = lane >> 4;
#pragma unroll
    for (int i = 0; i < 8; ++i) {
        f32x4 v0 = v[2 * i], v1 = v[2 * i + 1];
        v0 = v0 * gq[2 * i]; v1 = v1 * gq[2 * i + 1];
        const int sw = 4 * (i ^ (m & 7)) + q;
        scr[(4 * m + 0) * 32 + sw] = pk2(v0.x, v1.x);
        scr[(4 * m + 1) * 32 + sw] = pk2(v0.y, v1.y);
        scr[(4 * m + 2) * 32 + sw] = pk2(v0.z, v1.z);
        scr[(4 * m + 3) * 32 + sw] = pk2(v0.w, v1.w);
    }
    LDS_WAIT();
#pragma unroll
    for (int r = 0; r < 8; ++r) {
        const int n = 8 * r + (lane >> 3), c = lane & 7;
        const v4u o = *(const LAS v4u*)(scr + n * 32 + 4 * (c ^ ((n >> 2) & 7)));
        *(GAS v4u*)(WT + (size_t)n * ldk + 8 * c) = o;
    }
    LDS_WAIT();
}
DI void rms_finish_g(f32x4 (&v)[4], const f32x4 (&gv)[4], bf16* __restrict__ orow, int lane) {
    float s = 0.f;
#pragma unroll
    for (int j = 0; j < 4; ++j) s += (v[j].x * v[j].x + v[j].y * v[j].y) + (v[j].z * v[j].z + v[j].w * v[j].w);
    const float r = __builtin_amdgcn_rsqf(wave_sum(s) * (1.0f / 1024.0f) + EPS);
    v2u* o8 = (v2u*)orow + lane;
#pragma unroll
    for (int j = 0; j < 4; ++j) { v[j] = v[j] * r * gv[j]; v2u o; o.x = pk2(v[j].x, v[j].y); o.y = pk2(v[j].z, v[j].w); o8[64 * j] = o; }
}
DI void rms_finish(f32x4 (&v)[4], const float* __restrict__ g, bf16* __restrict__ orow, int lane) {
    float s = 0.f;
#pragma unroll
    for (int j = 0; j < 4; ++j) s += (v[j].x * v[j].x + v[j].y * v[j].y) + (v[j].z * v[j].z + v[j].w * v[j].w);
    const float r = __builtin_amdgcn_rsqf(wave_sum(s) * (1.0f / 1024.0f) + EPS);
    const f32x4* gr = (const f32x4*)g + lane; v2u* o8 = (v2u*)orow + lane;
#pragma unroll
    for (int j = 0; j < 4; ++j) { const f32x4 gg = gr[64 * j]; v[j] = v[j] * r * gg; v2u o; o.x = pk2(v[j].x, v[j].y); o.y = pk2(v[j].z, v[j].w); o8[64 * j] = o; }
}
DI void rms_scale(f32x4 (&v)[4], const float* __restrict__ g, float* __restrict__ R, int row, int lane) {
    float s = 0.f;
#pragma unroll
    for (int j = 0; j < 4; ++j) s += (v[j].x * v[j].x + v[j].y * v[j].y) + (v[j].z * v[j].z + v[j].w * v[j].w);
    const float r = __builtin_amdgcn_rsqf(wave_sum(s) * (1.0f / 1024.0f) + EPS);
    if (lane == 0) R[row] = r;
    const f32x4* gr = (const f32x4*)g + lane;
#pragma unroll
    for (int j = 0; j < 4; ++j) v[j] = v[j] * r * gr[64 * j];
}
DI void rms_scale_g(f32x4 (&v)[4], const f32x4 (&gv)[4], float* __restrict__ R, int row, int lane) {
    float s = 0.f;
#pragma unroll
    for (int j = 0; j < 4; ++j) s += (v[j].x * v[j].x + v[j].y * v[j].y) + (v[j].z * v[j].z + v[j].w * v[j].w);
    const float r = __builtin_amdgcn_rsqf(wave_sum(s) * (1.0f / 1024.0f) + EPS);
    if (lane == 0) R[row] = r;
#pragma unroll
    for (int j = 0; j < 4; ++j) v[j] = v[j] * r * gv[j];
}
DI void rms_row(const float* __restrict__ xrow, const float* __restrict__ g, bf16* __restrict__ orow, int lane, f32x4 (&v)[4]) {
    const f32x4* xr = (const f32x4*)xrow + lane;
#pragma unroll
    for (int j = 0; j < 4; ++j) v[j] = xr[64 * j];
    rms_finish(v, g, orow, lane);
}
DI void wi_row(const f32x4 (&v)[4], const LAS f32x4* wiw, float* WI, int r, int lane) {
    f32x4 a = {0.f, 0.f, 0.f, 0.f};
#pragma unroll
    for (int j = 0; j < 4; ++j) { const int k0 = 4 * (lane + 64 * j); a += v[j].x * wiw[k0] + v[j].y * wiw[k0 + 1] + v[j].z * wiw[k0 + 2] + v[j].w * wiw[k0 + 3]; }
    a.x = wave_sum(a.x); a.y = wave_sum(a.y); a.z = wave_sum(a.z); a.w = wave_sum(a.w);
    if (lane == 0) *(f32x4*)(WI + (size_t)r * 4) = a * 0.5f;
}
struct TrJob { const float* src; bf16* dst; const float* gk; int ldw, ldk, nN, items; };
struct TileDesc { const float* src; bf16* dst; int ldw, ldk; const float* gk; };
template <int layer> DI void prep_setup(const Ctx& c, const PV& P) {
    unsigned char* ws = P.ws;
    LAS TrJob* jobs = (LAS TrJob*)(c.lds + 65536);
    LAS int* njp = (LAS int*)(c.lds + 65536 + 512);
    LAS f32x4* wiw = (LAS f32x4*)(c.lds + 69632);
    __syncthreads();
    if (c.tid == 0) {
        int nj = 0; const float* gjob = nullptr;
#define ADDJOB(S_, D_, K_, N_, LDW_, LDK_) do { jobs[nj].src = (S_); jobs[nj].dst = (D_); jobs[nj].gk = gjob; jobs[nj].ldw = (LDW_); jobs[nj].ldk = (LDK_); jobs[nj].nN = (N_) / 64; jobs[nj].items = ((K_) / 64) * ((N_) / 64); ++nj; } while (0)
        ADDJOB(pin(P, I_W_MEM_KV) + (size_t)layer * 1024 * 512, (bf16*)(ws + WB_MKV), 1024, 512, 512, 1024);
        if (layer == 0) {
            ADDJOB(pin(P, I_LRU_W_IN), (bf16*)(ws + WB_WIN), 1024, 1792, 1792, 1024);
            ADDJOB(pin(P, I_W_OUT), (bf16*)(ws + WB_WOUT), 1024, 1024, 1024, 1024);
        } else {
            gjob = pin(P, I_NORM_MIX) + 1024;
            ADDJOB(pin(P, I_DSA_W_IN), (bf16*)(ws + WB_WIN), 1024, 1280, 1540, 1024);
            ADDJOB(pin(P, I_DSA_W_IN) + 1284, (bf16*)(ws + WB_WIN) + (size_t)1280 * 1024, 1024, 256, 1540, 1024);
            gjob = nullptr;
            ADDJOB(pin(P, I_W_OUT) + (size_t)1024 * 1024 + (size_t)768 * 1024, (bf16*)(ws + WB_WOUT) + 1536, 256, 1024, 1024, 1792);
        }
#undef ADDJOB
        *njp = nj;
    }
    if (layer == 1) { const float* win = pin(P, I_DSA_W_IN); for (int k = c.tid; k < 1024; k += 512) wiw[k] = *(const f32x4*)(win + (size_t)k * 1540 + 1280); }
    __syncthreads();
}
#ifndef PREP_SPLIT
#define PREP_SPLIT 3072
#endif
template <int layer, int PART = 0> DI void prep_weights(const Ctx& c, const PV& P, int vw = 0, int nvw = 1) {
    unsigned char* ws = P.ws;
    LAS unsigned* scr = (LAS unsigned*)(c.lds + c.wave * 8192);
    LAS TrJob* jobs = (LAS TrJob*)(c.lds + 65536);
    LAS int* njp = (LAS int*)(c.lds + 65536 + 512);
    if (PART != 2 && PART != 3 && PART != 6 && PART != 8 && PART != 11 && PART != 12) { const float* gm = pin(P, I_MEM_NORM) + layer * 1024; const float* mem = pin(P, I_MEM); bf16* MEMN = (bf16*)(ws + WB_MEMN);
      for (int r = ((PART == 5 || PART == 7 || PART == 10) ? vw : c.gw); r < 512; r += ((PART == 5 || PART == 7 || PART == 10) ? nvw : c.NGW)) { f32x4 v[4]; rms_row(mem + (size_t)r * 1024, gm, MEMN + (size_t)r * 1024, c.lane, v); } }
    {
        const int nj = *njp; int gen_total = 0;
        for (int j = 0; j < nj; ++j) gen_total += jobs[j].items;
        const int total = gen_total + 3 * 32 * 128;
        const float* wg = pin(P, I_MOE_W_GATE) + (size_t)layer * 32 * 1024 * 512;
        const float* wu = pin(P, I_MOE_W_UP) + (size_t)layer * 32 * 1024 * 512;
        const float* wd = pin(P, I_MOE_W_DOWN) + (size_t)layer * 32 * 512 * 1024;
        const float* gffn = pin(P, I_NORM_FFN) + layer * 1024;
        bf16* WGU = (bf16*)(ws + (layer == 0 ? WB_WGU : WB_WGU1)); bf16* WD = (bf16*)(ws + (layer == 0 ? WB_WD : WB_WD1));
#define TILE_DESC(IT_, D_) do { const int it_ = (IT_); \
            if (it_ < gen_total) { int r = it_, j = 0; while (r >= jobs[j].items) { r -= jobs[j].items; ++j; } \
                const int nN = jobs[j].nN, kb = r / nN, nb = r % nN; D_.ldw = jobs[j].ldw; D_.ldk = jobs[j].ldk; D_.gk = jobs[j].gk ? jobs[j].gk + kb * 64 : nullptr; \
                D_.src = jobs[j].src + (size_t)kb * 64 * D_.ldw + nb * 64; D_.dst = jobs[j].dst + (size_t)nb * 64 * D_.ldk + kb * 64; } \
            else { const int r = it_ - gen_total, type = r >> 12, e = (r >> 7) & 31, ti = r & 127; \
                if (type < 2) { const int kb = ti >> 3, nb = ti & 7; D_.ldw = 512; D_.ldk = 1024; D_.gk = gffn + kb * 64; \
                    D_.src = (type == 0 ? wg : wu) + (size_t)e * 1024 * 512 + (size_t)kb * 64 * 512 + nb * 64; \
                    D_.dst = WGU + (size_t)e * 1024 * 1024 + (size_t)(256 * (nb >> 1) + 64 * (nb & 1) + 128 * type) * 1024 + kb * 64; } \
                else { const int kb = ti >> 4, nb = ti & 15; D_.ldw = 1024; D_.ldk = 512; D_.gk = nullptr; \
                    D_.src = wd + (size_t)e * 512 * 1024 + (size_t)kb * 64 * 1024 + nb * 64; \
                    D_.dst = WD + (size_t)e * 1024 * 512 + (size_t)nb * 64 * 512 + kb * 64; } } } while (0)
        const int split = gen_total + PREP_SPLIT;
        const int nlist = (PART == 10) ? gen_total + 4096 : (PART == 11 || PART == 12) ? 4096 : (PART == 1) ? split : (PART == 3) ? 3072 : (PART == 2) ? total - split : (PART == 5) ? gen_total + 4096 : (PART == 6 || PART == 8) ? 8192 : total;
#define CANON(I_) ((PART == 11) ? gen_total + 4096 + (I_) : (PART == 12) ? gen_total + 8192 + (I_) : (PART == 2) ? split + (I_) : (PART == 5) ? ((I_) < gen_total ? (I_) : (I_) + 8192) : (PART == 3 || PART == 6 || PART == 8) ? gen_total + (I_) : (I_))
        const bool virt = (PART == 2 || PART == 3 || PART == 5 || PART == 7 || PART == 8 || PART == 10 || PART == 11 || PART == 12);
        const int first = virt ? vw : c.gw, stride = virt ? nvw : c.NGW, last = nlist;
        if (first < last) {
            TileDesc d0, d1; f32x4 va[16], vb[16];
            float ga[16], gb[16];
            TILE_DESC(CANON(first), d0); tr_load(d0.src, d0.ldw, va, c.lane); tr_loadg(d0.gk, ga, c.lane);
            for (int it = first; it < last; it += 2 * stride) {
                const int it1r = it + stride, it2r = it + 2 * stride; const bool has1 = it1r < last, has2 = it2r < last; const int it1 = CANON(has1 ? it1r : it), it2 = CANON(has2 ? it2r : it);
                TILE_DESC(it1, d1); tr_load(d1.src, d1.ldw, vb, c.lane); tr_loadg(d1.gk, gb, c.lane);
                tr_store(va, d0.dst, d0.ldk, scr, c.lane, ga);
                TILE_DESC(it2, d0); tr_load(d0.src, d0.ldw, va, c.lane); tr_loadg(d0.gk, ga, c.lane);
                if (has1) tr_store(vb, d1.dst, d1.ldk, scr, c.lane, gb);
            }
        }
#undef TILE_DESC
#undef CANON
    }
    if (PART == 2 || PART == 3 || PART == 6 || PART == 8 || PART == 11 || PART == 12) return;
    const int gtid = (PART == 5 || PART == 7 || PART == 10) ? vw * 64 + c.lane : c.blk * 512 + c.tid, nthr = (PART == 5 || PART == 7 || PART == 10) ? nvw * 64 : c.G * 512;
    {
        const float* wgr = pin(P, I_MOE_W_GROUP) + (size_t)layer * 1024 * 4; const float* wrt = pin(P, I_MOE_W_ROUTER) + (size_t)layer * 1024 * 32;
        bf16* WR = (bf16*)(ws + WB_WR); const float* gfr = pin(P, I_NORM_FFN) + layer * 1024;
        for (int i = gtid; i < 256 * 128; i += nthr) { const int row = i >> 7, k8 = i & 127; float f[8];
#pragma unroll
            for (int kk = 0; kk < 8; ++kk) { const int k = 8 * k8 + kk; f[kk] = (row < 4 ? wgr[k * 4 + row] : (row < 36 ? wrt[k * 32 + (row - 4)] : 0.f)) * gfr[k]; }
            *(v4u*)(WR + (size_t)row * 1024 + 8 * k8) = pack8(f); }
    }
    if (layer == 0) {
        bf16* WGT = (bf16*)(ws + WB_WGT); const float* wa = pin(P, I_LRU_W_A); const float* wx = pin(P, I_LRU_W_X);
        for (int i = gtid; i < 1536 * 96; i += nthr) { const int rho = i / 96, k8 = i % 96; const int pn = rho >> 8, bj = (rho >> 7) & 1, j = rho & 127, ch = 128 * pn + j, blkc = ch / 192, cc = ch % 192;
            const float* src = (bj ? wx : wa) + (size_t)blkc * 192 * 192; float f[8];
            const int k0 = 8 * k8; const bool in = (k0 / 192) == blkc;
#pragma unroll
            for (int kk = 0; kk < 8; ++kk) f[kk] = in ? src[((k0 + kk) % 192) * 192 + cc] : 0.f;
            *(v4u*)(WGT + (size_t)rho * 768 + k0) = pack8(f); }
    } else {
        const float* wuv = pin(P, I_DSA_W_UV); const float* wo = pin(P, I_W_OUT) + (size_t)1024 * 1024; bf16* WO = (bf16*)(ws + WB_WOUT);
        for (int i = gtid; i < 1024 * 12 * 16; i += nthr) { const int n = i & 1023, rest = i >> 10, c8 = rest & 15, h = rest >> 4; float a[8] = {0.f, 0.f, 0.f, 0.f, 0.f, 0.f, 0.f, 0.f};
            for (int j = 0; j < 64; ++j) { const float w = wo[(size_t)(64 * h + j) * 1024 + n];
#pragma unroll
                for (int cc = 0; cc < 8; ++cc) a[cc] += wuv[((size_t)h * 128 + 8 * c8 + cc) * 64 + j] * w; }
            *(v4u*)(WO + (size_t)n * 1792 + h * 128 + 8 * c8) = pack8(a); }
    }
}
DI void phase_prep0(const Ctx& c0, const PV& P) {
    const Ctx c = relaunder(c0);
    prep_setup<0>(c, P);
    { const float* xin = pin(P, I_X); const float* g = pin(P, I_NORM_MIX); bf16* HN = (bf16*)(P.ws + WS_HN);
      f32x4 gv[4];
#pragma unroll
      for (int j = 0; j < 4; ++j) gv[j] = ((const f32x4*)g + c.lane)[64 * j];
      for (int r = c.gw; r < NTOK; r += 2 * c.NGW) {
          const int r1 = r + c.NGW; const bool has1 = r1 < NTOK; const int rr1 = has1 ? r1 : r;
          f32x4 v0[4], v1[4];
          const f32x4* x0 = (const f32x4*)(xin + (size_t)r * 1024) + c.lane; const f32x4* x1 = (const f32x4*)(xin + (size_t)rr1 * 1024) + c.lane;
#pragma unroll
          for (int j = 0; j < 4; ++j) { v0[j] = x0[64 * j]; v1[j] = x1[64 * j]; }
          rms_finish_g(v0, gv, HN + (size_t)r * 1024, c.lane);
          if (has1) rms_finish_g(v1, gv, HN + (size_t)r1 * 1024, c.lane);
      } }
    prep_weights<0, 1>(c, P);
}
DI void phase_prep0_mid(const Ctx& c0, const PV& P, int firstblk) {
    const Ctx c = relaunder(c0);
    prep_setup<0>(c, P);
    prep_weights<0, 3>(c, P, (c.blk - firstblk) * 8 + c.wave, (c.G - firstblk) * 8);
}
DI void phase_prep1_early(const Ctx& c0, const PV& P, int firstblk) {
    const Ctx c = relaunder(c0);
    prep_setup<1>(c, P);
    prep_weights<1, 10>(c, P, (c.blk - firstblk) * 8 + c.wave, (c.G - firstblk) * 8);
}
DI void phase_prep1_gu(const Ctx& c0, const PV& P, int firstblk) {
    const Ctx c = relaunder(c0);
    prep_setup<1>(c, P);
    prep_weights<1, 11>(c, P, (c.blk - firstblk) * 8 + c.wave, (c.G - firstblk) * 8);
}
DI void phase_prep1_down(const Ctx& c0, const PV& P, int firstblk) {
    const Ctx c = relaunder(c0);
    prep_setup<1>(c, P);
    prep_weights<1, 12>(c, P, (c.blk - firstblk) * 8 + c.wave, (c.G - firstblk) * 8);
}
DI void phase_prep0_tail(const Ctx& c0, const PV& P, int firstblk) {
    const Ctx c = relaunder(c0);
    prep_setup<0>(c, P);
    prep_weights<0, 2>(c, P, (c.blk - firstblk) * 8 + c.wave, (c.G - firstblk) * 8);
}

DI f32x4 mfma16(bf16x8 a, bf16x8 b, f32x4 c) { return __builtin_amdgcn_mfma_f32_16x16x32_bf16(a, b, c, 0, 0, 0); }

template <int layer, int ldp, int xq_off, int ldm, int xo_off, int SHADOW = 0> DI void phase_xattn(const Ctx& c0, const PV& P, const bf16* __restrict__ PROJ, bf16* __restrict__ MIX) {
    const Ctx c = relaunder(c0);
    const bf16* MKVO = (const bf16*)(P.ws + WB_MKVO);
    const float* xqg = pin(P, I_XQ_NORM) + layer * 64; const float* xkg = pin(P, I_XK_NORM) + layer * 64;
    LAS bf16* Ks = (LAS bf16*)c.lds;
    LAS bf16* Vt = (LAS bf16*)(c.lds + 36864);
    const int lane = c.lane, l15 = lane & 15, g = lane >> 4;
    for (int unit = c.blk; unit < 256; unit += c.G) {
        const int b = unit >> 7, h = (unit >> 5) & 3, tr = unit & 31, tok0 = b * SEQ + tr * 512;
        __syncthreads();
        if (SHADOW != 1)
#pragma unroll
        for (int i = 0; i < 4; ++i) { const int p = c.tid + 512 * i, key = p >> 3, ch = p & 7;
            const bf16* src = MKVO + (size_t)(b * 256 + key) * 512 + h * 64 + ch * 8;
            float f[8]; unpack8(*(const v4u*)src, f);
            float ss = 0.f;
#pragma unroll
            for (int j = 0; j < 8; ++j) ss += f[j] * f[j];
            ss += __shfl_xor(ss, 1); ss += __shfl_xor(ss, 2); ss += __shfl_xor(ss, 4);
            const float r = __builtin_amdgcn_rsqf(ss * (1.0f / 64.0f) + EPS);
#pragma unroll
            for (int j = 0; j < 8; ++j) f[j] = f[j] * r * xkg[ch * 8 + j];
            *(LAS v4u*)(Ks + key * 72 + ch * 8) = pack8(f);
            const v4u vw = *(const v4u*)(src + 256);
            const unsigned ww[4] = {vw.x, vw.y, vw.z, vw.w};
#pragma unroll
            for (int j = 0; j < 4; ++j) { Vt[(ch * 8 + 2 * j) * 264 + key] = (bf16)(ww[j] & 0xffffu); Vt[(ch * 8 + 2 * j + 1) * 264 + key] = (bf16)(ww[j] >> 16); }
        }
        __syncthreads();
        float xq0[8], xq1[8];
#pragma unroll
        for (int j = 0; j < 8; ++j) { xq0[j] = xqg[8 * g + j]; xq1[j] = xqg[32 + 8 * g + j]; }
        v4u qn0, qn1;
        { const bf16* qp = PROJ + (size_t)(tok0 + c.wave * 16 + l15) * ldp + xq_off + h * 64 + 8 * g; qn0 = *(const v4u*)qp; qn1 = *(const v4u*)(qp + 32); }
#pragma unroll 1
        for (int tile = c.wave; tile < (SHADOW == 2 ? 0 : 32); tile += 8) {
            const int row = tok0 + tile * 16 + l15;
            const v4u qc0 = qn0, qc1 = qn1;
            { const int nt = tile + 8 < 32 ? tile + 8 : tile; const bf16* qp = PROJ + (size_t)(tok0 + nt * 16 + l15) * ldp + xq_off + h * 64 + 8 * g; qn0 = *(const v4u*)qp; qn1 = *(const v4u*)(qp + 32); }
            float q0[8], q1[8]; unpack8(qc0, q0); unpack8(qc1, q1);
            float ss = 0.f;
#pragma unroll
            for (int j = 0; j < 8; ++j) ss += q0[j] * q0[j] + q1[j] * q1[j];
            ss += __shfl_xor(ss, 16); ss += __shfl_xor(ss, 32);
            const float r = (0.125f * 1.4426950408889634f) * __builtin_amdgcn_rsqf(ss * (1.0f / 64.0f) + EPS);
#pragma unroll
            for (int j = 0; j < 8; ++j) { q0[j] = q0[j] * r * xq0[j]; q1[j] = q1[j] * r * xq1[j]; }
            const bf16x8 B0 = __builtin_bit_cast(bf16x8, pack8(q0)), B1 = __builtin_bit_cast(bf16x8, pack8(q1));
            f32x4 S[16];
#pragma unroll
            for (int kt = 0; kt < 16; ++kt) {
                const bf16x8 A0 = *(const LAS bf16x8*)(Ks + (16 * kt + l15) * 72 + 8 * g), A1 = *(const LAS bf16x8*)(Ks + (16 * kt + l15) * 72 + 32 + 8 * g);
                f32x4 z = {0.f, 0.f, 0.f, 0.f}; z = mfma16(A0, B0, z); S[kt] = mfma16(A1, B1, z);
                if ((kt & 3) == 3) __builtin_amdgcn_sched_barrier(0);
            }
            float mx = -3.0e38f;
#pragma unroll
            for (int kt = 0; kt < 16; ++kt) mx = fmaxf(mx, fmaxf(fmaxf(S[kt][0], S[kt][1]), fmaxf(S[kt][2], S[kt][3])));
            mx = fmaxf(mx, __shfl_xor(mx, 16)); mx = fmaxf(mx, __shfl_xor(mx, 32));
#pragma unroll
            for (int kt = 0; kt < 16; ++kt) {
#pragma unroll
                for (int i = 0; i < 4; ++i) S[kt][i] = __builtin_amdgcn_exp2f(S[kt][i] - mx); }
            f32x4 O[4], Ls = {0.f, 0.f, 0.f, 0.f};
            bf16x8 ones; { v4u ow = {0x3F803F80u, 0x3F803F80u, 0x3F803F80u, 0x3F803F80u}; asm volatile("" : "+v"(ow)); ones = __builtin_bit_cast(bf16x8, ow); }
#pragma unroll
            for (int dt = 0; dt < 4; ++dt) O[dt] = (f32x4){0.f, 0.f, 0.f, 0.f};
#pragma unroll
            for (int jb = 0; jb < 8; ++jb) {
                v4u pw; pw.x = pk2(S[2 * jb][0], S[2 * jb][1]); pw.y = pk2(S[2 * jb][2], S[2 * jb][3]); pw.z = pk2(S[2 * jb + 1][0], S[2 * jb + 1][1]); pw.w = pk2(S[2 * jb + 1][2], S[2 * jb + 1][3]);
                const bf16x8 Pb = __builtin_bit_cast(bf16x8, pw);
#pragma unroll
                for (int dt = 0; dt < 4; ++dt) { const LAS bf16* vp = Vt + (16 * dt + l15) * 264 + 32 * jb + 4 * g;
                    const v2u a0 = *(const LAS v2u*)vp, a1 = *(const LAS v2u*)(vp + 16);
                    v4u aw; aw.x = a0.x; aw.y = a0.y; aw.z = a1.x; aw.w = a1.y;
                    O[dt] = mfma16(__builtin_bit_cast(bf16x8, aw), Pb, O[dt]); }
                Ls = mfma16(ones, Pb, Ls);
                __builtin_amdgcn_sched_barrier(0);
            }
            const float il = __builtin_amdgcn_rcpf(Ls[0]);
            bf16* op = MIX + (size_t)row * ldm + xo_off + h * 64 + 4 * g;
#pragma unroll
            for (int dt = 0; dt < 4; ++dt) { v2u o; o.x = pk2(O[dt][0] * il, O[dt][1] * il); o.y = pk2(O[dt][2] * il, O[dt][3] * il); *(v2u*)(op + 16 * dt) = o; }
        }
    }
}

#ifndef CONV_ROWS
#define CONV_ROWS 8
#endif
DI void phase_conv(const Ctx& c0, const PV& P) {
    const Ctx c = relaunder(c0);
    const bf16* PROJ = (const bf16*)(P.ws + AR_PROJ); bf16* XSC = (bf16*)(P.ws + AR_XSC);
    const float* cw = pin(P, I_LRU_CONV_W); const float* cb = pin(P, I_LRU_CONV_B);
    const int gtid = c.blk * 512 + c.tid, nthr = c.G * 512;
    for (int i = gtid; i < (NTOK / CONV_ROWS) * 96; i += nthr) { const int chunk = i / 96, c8 = i % 96, row0 = chunk * CONV_ROWS, t0 = row0 & (SEQ - 1);
        float w[4][8], bias[8];
#pragma unroll
        for (int j = 0; j < 8; ++j) { bias[j] = cb[8 * c8 + j];
#pragma unroll
            for (int k = 0; k < 4; ++k) w[k][j] = cw[k * 768 + 8 * c8 + j]; }
        float p1[8], p2[8], p3[8];
        if (t0 >= 3) { unpack8(*(const v4u*)(PROJ + (size_t)(row0 - 1) * 1792 + 8 * c8), p1); unpack8(*(const v4u*)(PROJ + (size_t)(row0 - 2) * 1792 + 8 * c8), p2); unpack8(*(const v4u*)(PROJ + (size_t)(row0 - 3) * 1792 + 8 * c8), p3); }
        else {
#pragma unroll
            for (int j = 0; j < 8; ++j) { p1[j] = 0.f; p2[j] = 0.f; p3[j] = 0.f; } }
#pragma unroll 1
        for (int rb = 0; rb < CONV_ROWS; rb += 8) {
            v4u xw[8];
#pragma unroll
            for (int r = 0; r < 8; ++r) xw[r] = *(const v4u*)(PROJ + (size_t)(row0 + rb + r) * 1792 + 8 * c8);
#pragma unroll
            for (int r = 0; r < 8; ++r) { float f[8], a[8]; unpack8(xw[r], f);
#pragma unroll
                for (int j = 0; j < 8; ++j) { a[j] = bias[j] + w[0][j] * p3[j] + w[1][j] * p2[j] + w[2][j] * p1[j] + w[3][j] * f[j]; p3[j] = p2[j]; p2[j] = p1[j]; p1[j] = f[j]; }
                *(v4u*)(XSC + (size_t)(row0 + rb + r) * 768 + 8 * c8) = pack8(a); }
        }
    }
}
DI void phase_scanA(const Ctx& c0, const PV& P) {
    const Ctx c = relaunder(c0);
    const bf16* LA = (const bf16*)(P.ws + AR_LA); const bf16* UU = (const bf16*)(P.ws + AR_UU); float* SA = (float*)(P.ws + AR_SA); float* SH = (float*)(P.ws + AR_SH);
    const int gtid = c.blk * 512 + c.tid, nthr = c.G * 512;
    for (int i = gtid; i < 512 * 192; i += nthr) { const int chunk = i / 192, c4 = i % 192; float h[4] = {0.f, 0.f, 0.f, 0.f}, sl[4] = {0.f, 0.f, 0.f, 0.f};
        const size_t base = (size_t)chunk * 64 * 768 + 4 * c4;
#pragma unroll 8
        for (int r = 0; r < 64; ++r) { const v2u lw = *(const v2u*)(LA + base + (size_t)r * 768), uw = *(const v2u*)(UU + base + (size_t)r * 768);
            const float l4[4] = {bflo(lw.x), bfhi(lw.x), bflo(lw.y), bfhi(lw.y)}, u4[4] = {bflo(uw.x), bfhi(uw.x), bflo(uw.y), bfhi(uw.y)};
#pragma unroll
            for (int j = 0; j < 4; ++j) { h[j] = __expf(l4[j]) * h[j] + u4[j]; sl[j] += l4[j]; } }
        *(f32x4*)(SA + (size_t)chunk * 768 + 4 * c4) = (f32x4){__expf(sl[0]), __expf(sl[1]), __expf(sl[2]), __expf(sl[3])};
        *(f32x4*)(SH + (size_t)chunk * 768 + 4 * c4) = (f32x4){h[0], h[1], h[2], h[3]}; }
}
DI void phase_scanB(const Ctx& c0, const PV& P) {
    const Ctx c = relaunder(c0);
    const float* SA = (const float*)(P.ws + AR_SA); const float* SH = (const float*)(P.ws + AR_SH); float* CARRY = (float*)(P.ws + AR_CARRY);
    LAS float* segP = (LAS float*)c.lds; LAS float* segQ = segP + 512;
    for (int u = c.blk; u < 48; u += c.G) { const int b = u / 24, cg = u % 24, seg = c.tid >> 5, ch = 32 * cg + (c.tid & 31);
        const size_t base = (size_t)(b * 256 + seg * 16) * 768 + ch;
        float A[16], H[16];
#pragma unroll
        for (int i = 0; i < 16; ++i) { A[i] = SA[base + (size_t)i * 768]; H[i] = SH[base + (size_t)i * 768]; }
        float Pp[16], Qq[16]; float pp = 1.f, qq = 0.f;
#pragma unroll
        for (int i = 0; i < 16; ++i) { Pp[i] = pp; Qq[i] = qq; qq = A[i] * qq + H[i]; pp = A[i] * pp; }
        __syncthreads();
        segP[c.tid] = pp; segQ[c.tid] = qq;
        __syncthreads();
        float hin = 0.f;
        for (int s = 0; s < seg; ++s) hin = segP[s * 32 + (c.tid & 31)] * hin + segQ[s * 32 + (c.tid & 31)];
#pragma unroll
        for (int i = 0; i < 16; ++i) CARRY[base + (size_t)i * 768] = Pp[i] * hin + Qq[i];
    }
}
DI void phase_scanC(const Ctx& c0, const PV& P) {
    const Ctx c = relaunder(c0);
    const bf16* LA = (const bf16*)(P.ws + AR_LA); const bf16* UU = (const bf16*)(P.ws + AR_UU); const float* CARRY = (const float*)(P.ws + AR_CARRY);
    const bf16* PROJ = (const bf16*)(P.ws + AR_PROJ); bf16* MIX = (bf16*)(P.ws + AR_MIXL);
    const int gtid = c.blk * 512 + c.tid, nthr = c.G * 512;
    for (int i = gtid; i < 512 * 192; i += nthr) { const int chunk = i / 192, c4 = i % 192;
        const f32x4 h0 = *(const f32x4*)(CARRY + (size_t)chunk * 768 + 4 * c4); float h[4] = {h0.x, h0.y, h0.z, h0.w};
        const size_t base = (size_t)chunk * 64 * 768 + 4 * c4;
#pragma unroll 1
        for (int rb = 0; rb < 64; rb += 16) {
            v2u lwv[16], uwv[16], gwv[16];
#pragma unroll
            for (int r = 0; r < 16; ++r) { const size_t row = (size_t)chunk * 64 + rb + r;
                lwv[r] = *(const v2u*)(LA + base + (size_t)(rb + r) * 768); uwv[r] = *(const v2u*)(UU + base + (size_t)(rb + r) * 768); gwv[r] = *(const v2u*)(PROJ + row * 1792 + 768 + 4 * c4); }
#pragma unroll
            for (int r = 0; r < 16; ++r) { const size_t row = (size_t)chunk * 64 + rb + r; const v2u lw = lwv[r], uw = uwv[r], gw = gwv[r];
                const float l4[4] = {bflo(lw.x), bfhi(lw.x), bflo(lw.y), bfhi(lw.y)}, u4[4] = {bflo(uw.x), bfhi(uw.x), bflo(uw.y), bfhi(uw.y)}, g4[4] = {bflo(gw.x), bfhi(gw.x), bflo(gw.y), bfhi(gw.y)};
                float y[4];
#pragma unroll
                for (int j = 0; j < 4; ++j) { h[j] = __builtin_amdgcn_exp2f(l4[j]) * h[j] + u4[j]; y[j] = h[j] * g4[j]; }
                v2u o; o.x = pk2(y[0], y[1]); o.y = pk2(y[2], y[3]); *(v2u*)(MIX + row * 1024 + 4 * c4) = o; }
        }
    }
}

template <int layer> DI void phase_norm_route(const Ctx& c0, const PV& P) {
    const Ctx c = relaunder(c0);
    const bf16* WR = (const bf16*)(P.ws + WB_WR); float* R = (float*)(P.ws + AR_R);
    const bf16* XR = (layer == 0) ? (const bf16*)P.out : (const bf16*)(P.ws + WS_X2);
    int* EID = (int*)(P.ws + AR_EID); float* GATE = (float*)(P.ws + AR_GATE); int* DEST = (int*)(P.ws + AR_DEST); int* ROWTAB = (int*)(P.ws + AR_LOG); float* RS = (float*)(P.ws + AR_RS);
    const float* bg = pin(P, I_MOE_B_GROUP) + layer * 4; const float* br = pin(P, I_MOE_B_ROUTER) + layer * 32;
    unsigned* ctl = (unsigned*)(P.ws + WS_CTL);
    constexpr int WRS = 1032, LGS = 52;
    LAS bf16* WRs = (LAS bf16*)c.lds;
    LAS float* lg = (LAS float*)(c.lds + 99328 + c.wave * 3328);
    LAS unsigned* hist = (LAS unsigned*)(c.lds + 99328 + 8 * 3328);
    LAS unsigned* base = hist + 32; LAS unsigned* lcnt = hist + 64;
    const int lane = c.lane, l15 = lane & 15, gq = lane >> 4;
    __syncthreads();
    for (int i = c.tid; i < 48 * 128; i += 512) { const int row = i >> 7, ch = i & 127; *(LAS v4u*)(WRs + row * WRS + 8 * ch) = *(const v4u*)(WR + (size_t)row * 1024 + 8 * ch); }
    if (c.tid < 32) hist[c.tid] = 0u;
    __syncthreads();
    for (int tb = c.blk; tb < NTOK / 128; tb += c.G) {
        const int row0 = tb * 128 + c.wave * 16;
        f32x4 acc[3];
#pragma unroll
        for (int nt = 0; nt < 3; ++nt) acc[nt] = (f32x4){0.f, 0.f, 0.f, 0.f};
        const bf16* ap = XR + (size_t)(row0 + l15) * 1024 + 8 * gq; const LAS bf16* bp = WRs + l15 * WRS + 8 * gq;
        float ss = 0.f;
#pragma unroll 8
        for (int ks = 0; ks < 32; ++ks) { const v4u aw = *(const v4u*)(ap + 32 * ks); const bf16x8 A = __builtin_bit_cast(bf16x8, aw);
            float f[8]; unpack8(aw, f);
#pragma unroll
            for (int j = 0; j < 8; ++j) ss += f[j] * f[j];
#pragma unroll
            for (int nt = 0; nt < 3; ++nt) { const bf16x8 B = *(const LAS bf16x8*)(bp + nt * 16 * WRS + 32 * ks); acc[nt] = mfma16(A, B, acc[nt]); } }
        ss += __shfl_xor(ss, 16); ss += __shfl_xor(ss, 32);
        const float r = __builtin_amdgcn_rsqf(ss * (1.0f / 1024.0f) + EPS);
        if (gq == 0) R[row0 + l15] = r;
#pragma unroll
        for (int i = 0; i < 4; ++i) { const float rt = __shfl(r, 4 * gq + i);
#pragma unroll
            for (int nt = 0; nt < 3; ++nt) lg[(4 * gq + i) * LGS + 16 * nt + l15] = acc[nt][i] * rt; }
        LDS_WAIT();
        int e1id = 0, e2id = 0;
        if (lane < 16) { const int t = row0 + lane; const LAS float* L = lg + lane * LGS;
            const float l0 = L[0] + bg[0], l1 = L[1] + bg[1], l2 = L[2] + bg[2], l3 = L[3] + bg[3];
            int gs = 0; float gm = l0;
            if (l1 > gm) { gm = l1; gs = 1; } if (l2 > gm) { gm = l2; gs = 2; } if (l3 > gm) { gm = l3; gs = 3; }
            const float pg = 1.0f / (__expf(l0 - gm) + __expf(l1 - gm) + __expf(l2 - gm) + __expf(l3 - gm));
            float el[8];
#pragma unroll
            for (int j = 0; j < 8; ++j) el[j] = L[4 + 8 * gs + j] + br[8 * gs + j];
            int i1 = 0; float m1 = el[0];
#pragma unroll
            for (int j = 1; j < 8; ++j) if (el[j] > m1) { m1 = el[j]; i1 = j; }
            int i2 = -1; float m2 = -3.0e38f;
#pragma unroll
            for (int j = 0; j < 8; ++j) if (j != i1 && el[j] > m2) { m2 = el[j]; i2 = j; }
            const float e2 = __expf(m2 - m1), inv = pg / (1.0f + e2);
            e1id = 8 * gs + i1; e2id = 8 * gs + i2;
            EID[2 * t] = e1id; EID[2 * t + 1] = e2id; GATE[2 * t] = inv; GATE[2 * t + 1] = e2 * inv;
            lds_add(&hist[e1id], 1u); lds_add(&hist[e2id], 1u); }
        __syncthreads();
        if (c.tid < 32) { base[c.tid] = hist[c.tid] ? atomicAdd(ctl + CW_CNT + layer * CW_LSTRIDE + c.tid, hist[c.tid]) : 0u; lcnt[c.tid] = 0u; }
        __syncthreads();
        if (lane < 16) { const int t = row0 + lane;
            const int k1 = (int)(base[e1id] + lds_add(&lcnt[e1id], 1u)), k2 = (int)(base[e2id] + lds_add(&lcnt[e2id], 1u));
            *(v2u*)(DEST + 2 * t) = (v2u){(unsigned)((e1id << 20) | k1), (unsigned)((e2id << 20) | k2)};
            ROWTAB[(size_t)e1id * pg8::MOE_CAP + k1] = t; ROWTAB[(size_t)e2id * pg8::MOE_CAP + k2] = t;
            RS[(size_t)e1id * pg8::MOE_CAP + k1] = r; RS[(size_t)e2id * pg8::MOE_CAP + k2] = r; }
        __syncthreads();
        if (c.tid < 32) hist[c.tid] = 0u;
        LDS_WAIT();
    }
    if (c.blk == 0) ((unsigned*)((bf16*)XR + (size_t)NTOK * 1024))[c.tid] = 0u;
}
template <int layer> DI void moe_tables(const Ctx& c0, const PV& P) {
    const Ctx c = relaunder(c0);
    const unsigned* ctl = (const unsigned*)(P.ws + WS_CTL);
    LAS int* T = (LAS int*)(c.lds + TAB_OFF);
    __syncthreads();
    if (c.wave == 0) {
        const int l = hw_lane(); int cn = 0, n = 0;
        if (l < 32) { cn = (int)ctl[CW_CNT + layer * CW_LSTRIDE + l]; n = (cn + 255) & ~255; }
        int x = n;
#pragma unroll
        for (int o = 1; o < 32; o <<= 1) { const int y = __shfl_up(x, o); if (l >= o) x += y; }
        const int ps = x - n;
        if (l < 32) { T[l] = cn; T[32 + l] = ps; for (int t = ps >> 8; t < ((ps + n) >> 8); ++t) T[64 + t] = l; }
        if (l == 31) T[400] = (ps + n) >> 8;
    }
    __syncthreads();
}
template <int layer> DI void phase_scatter(const Ctx& c0, const PV& P) {
    const Ctx c = relaunder(c0);
    unsigned* ctl = (unsigned*)(P.ws + WS_CTL);
    const int* EID = (const int*)(P.ws + AR_EID); int* DEST = (int*)(P.ws + AR_DEST); int* ROWTAB = (int*)(P.ws + AR_LOG);
    bf16* XR = (layer == 0) ? (bf16*)P.out : (bf16*)(P.ws + WS_X2); const float* R = (const float*)(P.ws + AR_R); float* RS = (float*)(P.ws + AR_RS);
    LAS int* cnt = (LAS int*)c.lds; LAS int* pstart = cnt + 32; LAS unsigned* hist = (LAS unsigned*)(cnt + 64); LAS unsigned* base = hist + 32; LAS unsigned* lcnt = base + 32;
    __syncthreads();
    if (c.tid < 32) cnt[c.tid] = (int)ctl[CW_CNT + layer * CW_LSTRIDE + c.tid];
    __syncthreads();
    if (c.tid == 0) { int acc = 0; for (int e = 0; e < 32; ++e) { pstart[e] = acc; acc += (cnt[e] + 255) & ~255; }
        if (c.blk == 0) { ctl[CW_NT + layer * CW_LSTRIDE] = (unsigned)(acc >> 8);
            for (int e = 0; e < 32; ++e) { const int t0 = pstart[e] >> 8, t1 = (pstart[e] + ((cnt[e] + 255) & ~255)) >> 8; for (int t = t0; t < t1; ++t) ctl[CW_TE + layer * CW_TE_STRIDE + t] = (unsigned)e; } } }
    if (c.blk == 0) ((unsigned*)(XR + (size_t)NTOK * 1024))[c.tid] = 0u;
    __syncthreads();
    for (int tb = c.blk; tb < NTOK / 128; tb += c.G) {
        if (c.tid < 32) { hist[c.tid] = 0u; lcnt[c.tid] = 0u; }
        __syncthreads();
        int e = 0, t = 0;
        if (c.tid < 256) { t = tb * 128 + (c.tid >> 1); e = EID[2 * t + (c.tid & 1)]; lds_add(&hist[e], 1u); }
        __syncthreads();
        if (c.tid < 32) base[c.tid] = hist[c.tid] ? atomicAdd(ctl + CW_CUR + layer * CW_LSTRIDE + c.tid, hist[c.tid]) : 0u;
        __syncthreads();
        if (c.tid < 256) { const unsigned rank = lds_add(&lcnt[e], 1u); const int d = pstart[e] + (int)base[e] + (int)rank; DEST[2 * t + (c.tid & 1)] = d; ROWTAB[d] = t; RS[d] = R[t]; }
        __syncthreads();
    }
    const int gtid = c.blk * 512 + c.tid;
    for (int e = 0; e < 32; ++e) { const int npad = ((cnt[e] + 255) & ~255) - cnt[e], r0 = pstart[e] + cnt[e];
        if (gtid < npad) { ROWTAB[r0 + gtid] = NTOK; RS[r0 + gtid] = 0.f; } }
}
template <bool NEXT> DI void phase_combine(const Ctx& c0, const PV& P) {
    const Ctx c = relaunder(c0);
    if (NEXT) prep_setup<1>(c, P);
    const int* DEST = (const int*)(P.ws + AR_DEST); const float* GATE = (const float*)(P.ws + AR_GATE); const unsigned char* Y = (const unsigned char*)(P.ws + AR_XS);
    const float* g = NEXT ? pin(P, I_NORM_MIX) + 1024 : nullptr; bf16* HN = (bf16*)(P.ws + WS_HN); float* WI = (float*)(P.ws + AR_WI);
    float* R1 = (float*)(P.ws + AR_R);
    const bf16* XIN = NEXT ? (const bf16*)P.out : (const bf16*)(P.ws + WS_X2); bf16* X2 = (bf16*)(P.ws + WS_X2);
    const LAS f32x4* wiw = (const LAS f32x4*)(c.lds + 69632);
    const LAS int* TB = (const LAS int*)(c.lds + TAB_OFF);
    typedef int v2i_ __attribute__((ext_vector_type(2))); typedef float v2f_ __attribute__((ext_vector_type(2)));
    f32x4 gv[4];
#pragma unroll
    for (int j = 0; j < 4; ++j) gv[j] = NEXT ? ((const f32x4*)g + c.lane)[64 * j] : (f32x4){0.f, 0.f, 0.f, 0.f};
    const int step2 = 2 * c.NGW;
    int ta = c.gw, tb2 = c.gw + c.NGW;
    v2i_ dA = *(const v2i_*)(DEST + 2 * (ta < NTOK ? ta : 0)), dB = *(const v2i_*)(DEST + 2 * (tb2 < NTOK ? tb2 : 0));
    v2f_ gA = *(const v2f_*)(GATE + 2 * (ta < NTOK ? ta : 0)), gB = *(const v2f_*)(GATE + 2 * (tb2 < NTOK ? tb2 : 0));
    for (; ta < NTOK; ta += step2, tb2 += step2) {
        const bool hasB = tb2 < NTOK; const int tbb = hasB ? tb2 : ta;
        const v2i_ cdA = dA, cdB = hasB ? dB : dA; const v2f_ cgA = gA, cgB = hasB ? gB : gA;
        { const int na = ta + step2, nb = tb2 + step2; const int ia = na < NTOK ? na : 0, ib = nb < NTOK ? nb : 0;
          dA = *(const v2i_*)(DEST + 2 * ia); dB = *(const v2i_*)(DEST + 2 * ib); gA = *(const v2f_*)(GATE + 2 * ia); gB = *(const v2f_*)(GATE + 2 * ib); }
        const v2u* xiA = (const v2u*)(XIN + (size_t)ta * 1024) + c.lane; const v2u* xiB = (const v2u*)(XIN + (size_t)tbb * 1024) + c.lane;
#define SROW(D_) (TB[32 + ((D_) >> 20)] + ((D_) & 0xFFFFF))
        const int* yA0 = (const int*)(Y + (size_t)SROW(cdA.x) * 1024) + c.lane; const int* yA1 = (const int*)(Y + (size_t)SROW(cdA.y) * 1024) + c.lane;
        const int* yB0 = (const int*)(Y + (size_t)SROW(cdB.x) * 1024) + c.lane; const int* yB1 = (const int*)(Y + (size_t)SROW(cdB.y) * 1024) + c.lane;
#undef SROW
        const v2f_ sgA = cgA * (1.0f / 16.0f), sgB = cgB * (1.0f / 16.0f);
        f32x4 vA[4], vB[4]; int a0[4], a1[4], b0[4], b1[4];
#pragma unroll
        for (int j = 0; j < 4; ++j) { const v2u ra = xiA[64 * j], rb = xiB[64 * j]; a0[j] = yA0[64 * j]; a1[j] = yA1[64 * j]; b0[j] = yB0[64 * j]; b1[j] = yB1[64 * j];
            vA[j] = (f32x4){bflo(ra.x), bfhi(ra.x), bflo(ra.y), bfhi(ra.y)}; vB[j] = (f32x4){bflo(rb.x), bfhi(rb.x), bflo(rb.y), bfhi(rb.y)}; }
#pragma unroll
        for (int j = 0; j < 4; ++j) {
            { const v2f_ p0 = __builtin_amdgcn_cvt_pk_f32_fp8(a0[j], false), p1 = __builtin_amdgcn_cvt_pk_f32_fp8(a0[j], true), q0 = __builtin_amdgcn_cvt_pk_f32_fp8(a1[j], false), q1 = __builtin_amdgcn_cvt_pk_f32_fp8(a1[j], true);
              vA[j].x += sgA.x * p0.x + sgA.y * q0.x; vA[j].y += sgA.x * p0.y + sgA.y * q0.y; vA[j].z += sgA.x * p1.x + sgA.y * q1.x; vA[j].w += sgA.x * p1.y + sgA.y * q1.y; }
            { const v2f_ p0 = __builtin_amdgcn_cvt_pk_f32_fp8(b0[j], false), p1 = __builtin_amdgcn_cvt_pk_f32_fp8(b0[j], true), q0 = __builtin_amdgcn_cvt_pk_f32_fp8(b1[j], false), q1 = __builtin_amdgcn_cvt_pk_f32_fp8(b1[j], true);
              vB[j].x += sgB.x * p0.x + sgB.y * q0.x; vB[j].y += sgB.x * p0.y + sgB.y * q0.y; vB[j].z += sgB.x * p1.x + sgB.y * q1.x; vB[j].w += sgB.x * p1.y + sgB.y * q1.y; }
            if (NEXT) { v2u oa; oa.x = pk2(vA[j].x, vA[j].y); oa.y = pk2(vA[j].z, vA[j].w); ((v2u*)(X2 + (size_t)ta * 1024) + c.lane)[64 * j] = oa;
                if (hasB) { v2u ob; ob.x = pk2(vB[j].x, vB[j].y); ob.y = pk2(vB[j].z, vB[j].w); ((v2u*)(X2 + (size_t)tb2 * 1024) + c.lane)[64 * j] = ob; } }
            else { ((f32x4*)(P.out + (size_t)ta * 1024) + c.lane)[64 * j] = vA[j]; if (hasB) ((f32x4*)(P.out + (size_t)tb2 * 1024) + c.lane)[64 * j] = vB[j]; } }
        if (NEXT) { rms_scale_g(vA, gv, R1, ta, c.lane); wi_row(vA, wiw, WI, ta, c.lane);
            if (hasB) { rms_scale_g(vB, gv, R1, tb2, c.lane); wi_row(vB, wiw, WI, tb2, c.lane); } }
    }
}

DI void phase_dsaprep(const Ctx& c0, const PV& P) {
    const Ctx c = relaunder(c0);
    const bf16* PROJ = (const bf16*)(P.ws + AR_PROJ); bf16* KN = (bf16*)(P.ws + AR_KN); bf16* KIN = (bf16*)(P.ws + AR_KIN); bf16* QIW = (bf16*)(P.ws + AR_QIW);
    const float* WI = (const float*)(P.ws + AR_WI); const float* kg = pin(P, I_DSA_K_NORM); unsigned char* V8 = (unsigned char*)(P.ws + AR_V8);
    const int l = c.lane;
    const int col = l < 8 ? 768 + 8 * l : (l < 16 ? 1216 + 8 * (l - 8) : (l < 48 ? 960 + 8 * (l - 16) : 832 + 8 * (l - 48)));
    float kgv[8];
#pragma unroll
    for (int j = 0; j < 8; ++j) kgv[j] = kg[8 * (l & 7) + j];
    for (int row0 = c.gw; row0 < NTOK; row0 += 4 * c.NGW) {
        v4u w[4]; float wv[4]; int rows[4];
#pragma unroll
        for (int u = 0; u < 4; ++u) { const int r = row0 + u * c.NGW; rows[u] = r < NTOK ? r : row0;
            w[u] = *(const v4u*)(PROJ + (size_t)rows[u] * 1536 + col);
            wv[u] = (l >= 16 && l < 48) ? WI[(size_t)rows[u] * 4 + ((l - 16) >> 3)] * 0.125f : 0.f; }
#pragma unroll
        for (int u = 0; u < 4; ++u) { const int row = rows[u]; if (row0 + u * c.NGW >= NTOK) continue;
            if (l >= 48) { float f[8]; unpack8(w[u], f); int w0 = 0, w1 = 0;
                w0 = __builtin_amdgcn_cvt_pk_fp8_f32(f[0], f[1], w0, false); w0 = __builtin_amdgcn_cvt_pk_fp8_f32(f[2], f[3], w0, true);
                w1 = __builtin_amdgcn_cvt_pk_fp8_f32(f[4], f[5], w1, false); w1 = __builtin_amdgcn_cvt_pk_fp8_f32(f[6], f[7], w1, true);
                *(v2u*)(V8 + (size_t)row * 128 + 8 * (l - 48)) = (v2u){(unsigned)w0, (unsigned)w1}; continue; }
            float f[8]; unpack8(w[u], f);
            float ss = 0.f;
#pragma unroll
            for (int j = 0; j < 8; ++j) ss += f[j] * f[j];
            ss += __shfl_xor(ss, 1); ss += __shfl_xor(ss, 2); ss += __shfl_xor(ss, 4);
            const float r = __builtin_amdgcn_rsqf(ss * (1.0f / 64.0f) + EPS);
            if (l < 8) {
#pragma unroll
                for (int j = 0; j < 8; ++j) f[j] = f[j] * r * kgv[j];
                *(v4u*)(KN + (size_t)row * 64 + 8 * l) = pack8(f);
            } else if (l < 16) {
#pragma unroll
                for (int j = 0; j < 8; ++j) f[j] *= r;
                const int cch = l - 8;
                *(v4u*)(KIN + ((((size_t)(row >> 5) * 4 + (cch >> 1)) * 2 + (cch & 1)) * 32 + (row & 31)) * 8) = pack8(f);
            } else {
#pragma unroll
                for (int j = 0; j < 8; ++j) f[j] *= wv[u];
                *(v4u*)(QIW + (size_t)row * 256 + 8 * (l - 16)) = pack8(f);
            }
        }
    }
}
DI int dpp_scan_add(int v) {
    v += __builtin_amdgcn_update_dpp(0, v, 0x111, 0xf, 0xf, true); v += __builtin_amdgcn_update_dpp(0, v, 0x112, 0xf, 0xf, true);
    v += __builtin_amdgcn_update_dpp(0, v, 0x114, 0xf, 0xf, true); v += __builtin_amdgcn_update_dpp(0, v, 0x118, 0xf, 0xf, true);
    v += __builtin_amdgcn_update_dpp(0, v, 0x142, 0xa, 0xf, false); v += __builtin_amdgcn_update_dpp(0, v, 0x143, 0xc, 0xf, false);
    return v;
}
DI unsigned dpp_scan_max(unsigned v) {
#define DPPMAX_(ctrl, rm, bc) { const unsigned o_ = (unsigned)__builtin_amdgcn_update_dpp(0, (int)v, ctrl, rm, 0xf, bc); v = v > o_ ? v : o_; }
    DPPMAX_(0x111, 0xf, true) DPPMAX_(0x112, 0xf, true) DPPMAX_(0x114, 0xf, true) DPPMAX_(0x118, 0xf, true) DPPMAX_(0x142, 0xa, false) DPPMAX_(0x143, 0xc, false)
#undef DPPMAX_
    return v;
}
DI unsigned idx_compact(LAS unsigned* qb, LAS unsigned* hist, int n, int lane) {
    unsigned e[9];
#pragma unroll
    for (int i = 0; i < 9; ++i) { const int idx = lane + 64 * i; e[i] = idx < n ? qb[idx] : 0u; }
    unsigned prefix = 0u, maskbits = 0u; int want = 256;
#pragma unroll
    for (int pass = 0; pass < 4; ++pass) { const int shift = 24 - 8 * pass;
        *(LAS v4u*)(hist + 4 * lane) = (v4u){0u, 0u, 0u, 0u};
        LDS_WAIT();
#pragma unroll
        for (int i = 0; i < 9; ++i) if (e[i] != 0u && (e[i] & maskbits) == prefix) lds_add(&hist[255u - ((e[i] >> shift) & 255u)], 1u);
        LDS_WAIT();
        const v4u h4 = *(const LAS v4u*)(hist + 4 * lane);
        LDS_WAIT();
        const int s = (int)(h4.x + h4.y + h4.z + h4.w);
        const int c0 = dpp_scan_add(s) - s, c1 = c0 + (int)h4.x, c2 = c1 + (int)h4.y, c3 = c2 + (int)h4.z;
        int fb = -1, fa = 0;
        if (c0 < want && want <= c0 + (int)h4.x) { fb = 0; fa = c0; }
        else if (c1 < want && want <= c1 + (int)h4.y) { fb = 1; fa = c1; }
        else if (c2 < want && want <= c2 + (int)h4.z) { fb = 2; fa = c2; }
        else if (c3 < want && want <= c3 + (int)h4.w) { fb = 3; fa = c3; }
        const unsigned long long m = __ballot(fb >= 0);
        const int src = m ? (int)__builtin_ctzll(m) : 0;
        const int slot = __builtin_amdgcn_readlane(4 * lane + fb, src), ab = __builtin_amdgcn_readlane(fa, src);
        prefix |= (unsigned)(255 - slot) << shift; maskbits |= 0xFFu << shift; want -= ab;
    }
    int base = 0;
#pragma unroll
    for (int i = 0; i < 9; ++i) { const bool pred = e[i] >= prefix && e[i] != 0u; const unsigned long long m = __ballot(pred);
        const int pos = base + (int)__builtin_amdgcn_mbcnt_hi((unsigned)(m >> 32), __builtin_amdgcn_mbcnt_lo((unsigned)m, 0u));
        if (pred) qb[pos] = e[i];
        base += (int)__builtin_popcountll(m); }
    LDS_WAIT();
    return prefix;
}
DI void hist_select(LAS unsigned* hist, int lane, int want, int& slot, int& incl, int& above) {
    const v4u h4 = *(const LAS v4u*)(hist + 4 * lane);
    const int s = (int)(h4.x + h4.y + h4.z + h4.w);
    const int c0 = dpp_scan_add(s) - s, c1 = c0 + (int)h4.x, c2 = c1 + (int)h4.y, c3 = c2 + (int)h4.z;
    int fb = -1, fa = 0, fk = 0;
    if (c0 < want && want <= c0 + (int)h4.x) { fb = 0; fa = c0; fk = c0 + (int)h4.x; }
    else if (c1 < want && want <= c1 + (int)h4.y) { fb = 1; fa = c1; fk = c1 + (int)h4.y; }
    else if (c2 < want && want <= c2 + (int)h4.z) { fb = 2; fa = c2; fk = c2 + (int)h4.z; }
    else if (c3 < want && want <= c3 + (int)h4.w) { fb = 3; fa = c3; fk = c3 + (int)h4.w; }
    const unsigned long long m = __ballot(fb >= 0);
    const int src = m ? (int)__builtin_ctzll(m) : 0;
    slot = __builtin_amdgcn_readlane(4 * lane + fb, src); incl = __builtin_amdgcn_readlane(fk, src); above = __builtin_amdgcn_readlane(fa, src);
}
DI int idx_compact_coarse(LAS unsigned* qb, LAS unsigned* hist, int n, unsigned lo, unsigned& tau, int lane) {
    unsigned e[9]; unsigned mx = 0u;
#pragma unroll
    for (int i = 0; i < 9; ++i) { const int idx = lane + 64 * i; e[i] = idx < n ? qb[idx] : 0u; mx = e[i] > mx ? e[i] : mx; }
    *(LAS v4u*)(hist + 4 * lane) = (v4u){0u, 0u, 0u, 0u};
    const unsigned hi = (unsigned)__builtin_amdgcn_readlane((int)dpp_scan_max(mx), 63);
    if (lo == 0u) {
        unsigned mc = 0u;
#pragma unroll
        for (int i = 0; i < 9; ++i) { const unsigned ce = e[i] != 0u ? ~e[i] : 0u; mc = ce > mc ? ce : mc; }
        lo = ~(unsigned)__builtin_amdgcn_readlane((int)dpp_scan_max(mc), 63) - 1u;
    }
    const unsigned range = hi - lo;
    const int sh = range >= 256u ? (24 - (int)__builtin_clz(range)) : 0;
    asm volatile("" ::: "memory");
#pragma unroll
    for (int i = 0; i < 9; ++i) if (e[i] != 0u) lds_add(&hist[255u - ((e[i] - lo) >> sh)], 1u);
    asm volatile("" ::: "memory");
    int slot, kept, above;
    hist_select(hist, lane, 256, slot, kept, above);
    unsigned edge = lo + ((unsigned)(255 - slot) << sh);
    if (__builtin_expect(kept > 352, 0)) {
        if (sh == 0) { tau = idx_compact(qb, hist, n, lane); return 256; }
        const int sh2 = sh > 8 ? sh - 8 : 0;
        *(LAS v4u*)(hist + 4 * lane) = (v4u){0u, 0u, 0u, 0u};
        asm volatile("" ::: "memory");
#pragma unroll
        for (int i = 0; i < 9; ++i) { const unsigned d = e[i] - edge; if (e[i] != 0u && (d >> sh) == 0u) lds_add(&hist[255u - (d >> sh2)], 1u); }
        asm volatile("" ::: "memory");
        int slot2, inc2, ab2;
        hist_select(hist, lane, 256 - above, slot2, inc2, ab2);
        kept = above + inc2;
        if (kept > 352) { tau = idx_compact(qb, hist, n, lane); return 256; }
        edge += (unsigned)(255 - slot2) << sh2;
    }
    int mine = 0;
#pragma unroll
    for (int i = 0; i < 9; ++i) mine += (e[i] >= edge && e[i] != 0u) ? 1 : 0;
    int pos = dpp_scan_add(mine) - mine;
#pragma unroll
    for (int i = 0; i < 9; ++i) { const bool pred = e[i] >= edge && e[i] != 0u; if (pred) qb[pos] = e[i]; pos += pred ? 1 : 0; }
    LDS_WAIT();
    tau = edge - 1u;
    return kept;
}
DI void idx_final(LAS unsigned* qb, LAS unsigned* hist, int n, int lane) {
    unsigned T; const int k = idx_compact_coarse(qb, hist, n, 0u, T, lane);
    const int ex = k - 256;
    if (ex == 0) return;
    if (ex > 12) { (void)idx_compact(qb, hist, k, lane); return; }
    unsigned e[6];
#pragma unroll
    for (int i = 0; i < 6; ++i) { const int idx = lane + 64 * i; e[i] = idx < k ? qb[idx] : 0u; }
    for (int r = 0; r < ex; ++r) {
        unsigned mc = 0u;
#pragma unroll
        for (int i = 0; i < 6; ++i) { const unsigned ce = e[i] != 0u ? ~e[i] : 0u; mc = ce > mc ? ce : mc; }
        const unsigned mn = ~(unsigned)__builtin_amdgcn_readlane((int)dpp_scan_max(mc), 63);
#pragma unroll
        for (int i = 0; i < 6; ++i) e[i] = (e[i] == mn) ? 0u : e[i];
    }
    int base = 0;
#pragma unroll
    for (int i = 0; i < 6; ++i) { const bool pred = e[i] != 0u; const unsigned long long mm = __ballot(pred);
        const int pos = base + (int)__builtin_amdgcn_mbcnt_hi((unsigned)(mm >> 32), __builtin_amdgcn_mbcnt_lo((unsigned)mm, 0u));
        if (pred) qb[pos] = e[i];
        base += (int)__builtin_popcountll(mm); }
    LDS_WAIT();
}
#ifndef CAPTRIG_SUB
#define CAPTRIG_SUB 64
#endif
constexpr int CAPQ = 576, CAPTRIG = CAPQ - CAPTRIG_SUB, IDX_WST = 8 * CAPQ * 4 + 1024;
static_assert(8 * IDX_WST <= MISC_OFF && CAPQ <= 9 * 64, "indexer buffers");
struct IdxState { float lo[4][4], hi[4][4]; unsigned tau[4]; int cnt[4]; int tq[4]; unsigned qa[4]; };
DI int sel4(const int (&a)[4], int j) { return j == 0 ? a[0] : (j == 1 ? a[1] : (j == 2 ? a[2] : a[3])); }
DI unsigned sel4u(const unsigned (&a)[4], int j) { return j == 0 ? a[0] : (j == 1 ? a[1] : (j == 2 ? a[2] : a[3])); }
template <int SHADOW, bool MASKED> DI void idx_step(const bf16x8 (&A)[4], const bf16x8 (&B)[2][4], IdxState& st, LAS unsigned* buf, LAS unsigned* hist, LAS unsigned* dummy, int step, bool lastst, int lane, int hh, int l31, unsigned ltmask) {
    f32x16 acc[2];
#pragma unroll
    for (int u = 0; u < 2; ++u) {
#pragma unroll
        for (int i = 0; i < 16; ++i) acc[u][i] = 0.f; }
#pragma unroll
    for (int ks = 0; ks < 4; ++ks) {
#pragma unroll
        for (int u = 0; u < 2; ++u) acc[u] = __builtin_amdgcn_mfma_f32_32x32x16_bf16(A[ks], B[u][ks], acc[u], 0, 0, 0); }
    if (SHADOW == 5) {
        f32x16 acc2[2];
#pragma unroll
        for (int u = 0; u < 2; ++u) {
#pragma unroll
            for (int i = 0; i < 16; ++i) acc2[u][i] = 1.f; }
#pragma unroll
        for (int ks = 0; ks < 4; ++ks) {
#pragma unroll
            for (int u = 0; u < 2; ++u) acc2[u] = __builtin_amdgcn_mfma_f32_32x32x16_bf16(A[3 - ks], B[u][ks], acc2[u], 0, 0, 0); }
#pragma unroll
        for (int u = 0; u < 2; ++u) {
#pragma unroll
            for (int i = 0; i < 16; i += 4) acc[u][i] += 1e-30f * acc2[u][i]; }
    }
#pragma unroll
    for (int rep2 = 0; rep2 < (SHADOW == 6 ? 2 : 1); ++rep2)
#pragma unroll
    for (int u = 0; u < 2; ++u) {
        const int s = step * 64 + 32 * u + l31 + rep2;
#pragma unroll
        for (int j = 0; j < 4; ++j) {
            const float sc = (__builtin_amdgcn_fmed3f(acc[u][4 * j], st.lo[j][0], st.hi[j][0]) + __builtin_amdgcn_fmed3f(acc[u][4 * j + 1], st.lo[j][1], st.hi[j][1]))
                           + (__builtin_amdgcn_fmed3f(acc[u][4 * j + 2], st.lo[j][2], st.hi[j][2]) + __builtin_amdgcn_fmed3f(acc[u][4 * j + 3], st.lo[j][3], st.hi[j][3]));
            unsigned uu = __float_as_uint(sc); uu ^= (unsigned)((int)uu >> 31) | 0x80000000u;
            const unsigned key = (uu & 0xFFFFC000u) | (unsigned)(16383 - s);
            const bool p1 = (SHADOW == 10) ? (key == 0xFFFFFFFFu) : (key > st.tau[j]), p2 = MASKED ? (s <= st.tq[j]) : true;
            const bool pred = p1 && p2;
            const unsigned long long m = MASKED ? (__builtin_amdgcn_ballot_w64(p1) & __builtin_amdgcn_ballot_w64(p2)) : __builtin_amdgcn_ballot_w64(p1);
            const unsigned hm = hh ? (unsigned)(m >> 32) : (unsigned)m;
            unsigned pos = (unsigned)__builtin_popcount(hm & ltmask) + (unsigned)st.cnt[j];
            asm("" : "+v"(pos));
            LAS unsigned* dst = pred ? (LAS unsigned*)(__UINTPTR_TYPE__)(st.qa[j] + (pos << 2)) : dummy;
            *dst = key;
            st.cnt[j] += __builtin_popcount(hm);
        }
    }
    const int cm = max(max(st.cnt[0], st.cnt[1]), max(st.cnt[2], st.cnt[3]));
    unsigned long long need = __ballot(cm > CAPTRIG);
    if (__builtin_expect(need != 0ull, 0)) {
        unsigned qmask = 0u;
#pragma unroll
        for (int j = 0; j < 4; ++j) { const unsigned long long mm = __ballot(st.cnt[j] > CAPTRIG); qmask |= ((unsigned)(mm & 1ull) << (2 * j)) | ((unsigned)((mm >> 32) & 1ull) << (2 * j + 1)); }
        LDS_WAIT();
        while (qmask) {
            const int q = __builtin_ctz(qmask); qmask &= qmask - 1u; const int j = q >> 1, h = q & 1;
            const int n = __builtin_amdgcn_readlane(sel4(st.cnt, j), h * 32); const unsigned lo0 = (unsigned)__builtin_amdgcn_readlane((int)sel4u(st.tau, j), h * 32);
            unsigned T; int k = idx_compact_coarse(buf + q * CAPQ, hist, n, lo0, T, lane);
            if (SHADOW == 14) { unsigned T2; k = idx_compact_coarse(buf + q * CAPQ, hist, k, T, T2, lane); T = T2; }
#pragma unroll
            for (int jj = 0; jj < 4; ++jj) if (jj == j && hh == h) { st.tau[jj] = T; st.cnt[jj] = k; }
        }
    }
}
template <int SHADOW = 0> DI void idx_loadB(bf16x8 (&B)[2][4], const bf16* kbase, int step) {
#pragma unroll
    for (int u = 0; u < (SHADOW == 9 ? 1 : 2); ++u)
#pragma unroll
        for (int ks = 0; ks < 4; ++ks) B[u][ks] = *(const bf16x8*)(kbase + ((size_t)(2 * step + u) * 4 + ks) * 512);
    if (SHADOW == 9) {
#pragma unroll
        for (int ks = 0; ks < 4; ++ks) B[1][ks] = B[0][ks]; }
}
template <int SHADOW> DI void phase_indexer(const Ctx& c0, const PV& P) {
    const Ctx c = relaunder(c0);
    const bf16* KIN = (const bf16*)(P.ws + AR_KIN); const bf16* QIW = (const bf16*)(P.ws + AR_QIW); const float* WI = (const float*)(P.ws + AR_WI); int* SEL = (int*)(P.ws + AR_SEL);
    LAS unsigned* buf = (LAS unsigned*)(c.lds + c.wave * IDX_WST);
    LAS unsigned* hist = buf + 8 * CAPQ;
    LAS unsigned* dummy = hist + c.lane;
    const int lane = c.lane, hh = lane >> 5, l31 = lane & 31;
    const unsigned ltmask = (1u << l31) - 1u;
    const float INF = __builtin_inff();
    for (int pair = c.blk; pair < 256; pair += c.G) {
        const int b = pair >> 7, jj = pair & 127;
        for (int half = 0; half < 2; ++half) {
            const int unit = half ? (255 - jj) : jj, t0w = unit * 64 + c.wave * 8, rowbase = b * SEQ;
            bf16x8 A[4];
#pragma unroll
            for (int ks = 0; ks < 4; ++ks) A[ks] = *(const bf16x8*)(QIW + (size_t)(rowbase + t0w + (l31 >> 2)) * 256 + (l31 & 3) * 64 + 16 * ks + 8 * hh);
            IdxState st;
#pragma unroll
            for (int j = 0; j < 4; ++j) { st.tq[j] = t0w + 2 * j + hh; st.tau[j] = 0u; st.cnt[j] = 0; st.qa[j] = (unsigned)(__UINTPTR_TYPE__)(buf + (2 * j + hh) * CAPQ); asm volatile("" : "+v"(st.qa[j]));
                const f32x4 w = *(const f32x4*)(WI + (size_t)(rowbase + st.tq[j]) * 4);
#pragma unroll
                for (int i = 0; i < 4; ++i) { st.lo[j][i] = w[i] > 0.f ? 0.f : -INF; st.hi[j][i] = w[i] > 0.f ? INF : 0.f; } }
            const int nstep = (SHADOW == 7) ? ((t0w + 7) / 128 + 1) : ((t0w + 7) / 64 + 1);
            const bf16* kbase = KIN + (size_t)(rowbase >> 5) * 2048 + lane * 8;
            bf16x8 R0[2][4], R1[2][4];
            idx_loadB<SHADOW>(R0, kbase, 0);
            if (nstep > 1) idx_loadB<SHADOW>(R1, kbase, 1); else idx_loadB<SHADOW>(R1, kbase, 0);
            int step = 0;
            for (; step + 2 < nstep; step += 2) {
                idx_step<SHADOW, false>(A, R0, st, buf, hist, dummy, step, false, lane, hh, l31, ltmask);
                idx_loadB<SHADOW>(R0, kbase, min(step + 2, nstep - 1));
                idx_step<SHADOW, false>(A, R1, st, buf, hist, dummy, step + 1, false, lane, hh, l31, ltmask);
                idx_loadB<SHADOW>(R1, kbase, min(step + 3, nstep - 1));
            }
            idx_step<SHADOW, true>(A, R0, st, buf, hist, dummy, step, true, lane, hh, l31, ltmask);
            idx_step<SHADOW, true>(A, R1, st, buf, hist, dummy, step + 1, true, lane, hh, l31, ltmask);
            LDS_WAIT();
            for (int q = 0; q < 8; ++q) {
                const int j = q >> 1, h2 = q & 1;
                int n = __builtin_amdgcn_readlane(sel4(st.cnt, j), h2 * 32);
                LAS unsigned* qb = buf + q * CAPQ;
                if (SHADOW == 8) n = n > 256 ? 256 : n;
                if (SHADOW == 15) n = n > 256 ? 256 : n;
                if (n > 256) { idx_final(qb, hist, n, lane); n = 256; }
                { const v4u kq = *(const LAS v4u*)(qb + 4 * lane); const unsigned kk[4] = {kq.x, kq.y, kq.z, kq.w}; unsigned e[4];
#pragma unroll
                  for (int i = 0; i < 4; ++i) e[i] = (4 * lane + i < n) ? (16383u - (kk[i] & 0x3FFFu)) : 0xFFFFu;
                  *(v2u*)((char*)SEL + ((unsigned)(rowbase + t0w + q) * 512u + 8u * (unsigned)lane)) = (v2u){e[0] | (e[1] << 16), e[2] | (e[3] << 16)}; }
            }
            LDS_WAIT();
        }
    }
}
DI int t5_bucket(int d) {
    if (d < 16) return d;
    return 16 + (d >= 19) + (d >= 21) + (d >= 24) + (d >= 27) + (d >= 31) + (d >= 35) + (d >= 40) + (d >= 46) + (d >= 52) + (d >= 59) + (d >= 67) + (d >= 77) + (d >= 87) + (d >= 99) + (d >= 113);
}
typedef short s16x4 __attribute__((ext_vector_type(4)));
template <int SHADOW = 0> DI void phase_sattn(const Ctx& c0, const PV& P) {
    const Ctx c = relaunder(c0);
    const bf16* PROJ = (const bf16*)(P.ws + AR_PROJ); const bf16* KN = (const bf16*)(P.ws + AR_KN); const int* SEL = (const int*)(P.ws + AR_SEL); bf16* MIX = (bf16*)(P.ws + AR_MIXD);
    const float* qg = pin(P, I_DSA_Q_NORM); const float* rb = pin(P, I_REL_BIAS); const unsigned char* V8 = (const unsigned char*)(P.ws + AR_V8);
    constexpr int WST = 11264, VRS = 144;
    LAS int* bk = (LAS int*)(c.lds + c.wave * WST);
    LAS int* selL = bk + 256;
    LAS bf16* Vs = (LAS bf16*)(selL + 256);
    LAS float* relb = (LAS float*)(c.lds + 8 * WST);
    __syncthreads();
    relb[c.tid] = (c.tid & 15) < 12 ? rb[(c.tid >> 4) * 12 + (c.tid & 15)] * 1.4426950408889634f : 0.f;
    if (c.tid < 16) relb[512 + c.tid] = -3.0e38f;
    LAS float* qgl = (LAS float*)(c.lds + 8 * WST + 4096 + 512);
    if (c.tid < 64) qgl[c.tid] = qg[c.tid];
    if (c.tid < 128) ((LAS int*)(c.lds + 8 * WST + 4096))[c.tid] = t5_bucket(c.tid);
    __syncthreads();
    const int lane0 = hw_lane();
    int row = c.gw;
    v2u s4n = {0u, 0u}; v4u qn0 = {0u, 0u, 0u, 0u}, qn1 = {0u, 0u, 0u, 0u};
    if (row < NTOK) { s4n = *(const v2u*)((const char*)SEL + ((unsigned)row * 512u + 8u * (unsigned)lane0));
        if ((lane0 & 15) < 12) { const char* qp = (const char*)PROJ + ((unsigned)row * 3072u + (unsigned)((lane0 & 15) * 128 + 16 * (lane0 >> 4))); qn0 = *(const v4u*)qp; qn1 = *(const v4u*)(qp + 64); } }
#pragma unroll 1
    for (; row < NTOK; row += c.NGW) {
        const int lane = hw_lane();
        const int l15 = lane & 15, g = lane >> 4;
        const LAS bf16* trp = Vs + (4 * g + (l15 >> 2)) * VRS + 4 * (l15 & 3);
        const int b = row >> 14, t = row & (SEQ - 1), rowbase = b << 14;
        const v2u s4 = s4n; const v4u w0 = qn0, w1 = qn1;
        int sv[4] = {(int)(s4.x & 0xFFFFu), (int)(s4.x >> 16), (int)(s4.y & 0xFFFFu), (int)(s4.y >> 16)};
#pragma unroll
        for (int i = 0; i < 4; ++i) sv[i] = sv[i] == 0xFFFF ? -1 : sv[i];
        int bv[4], cv[4];
#pragma unroll
        for (int i = 0; i < 4; ++i) { const int dd = t - sv[i]; const int bq = ((const LAS int*)(c.lds + 8 * WST + 4096))[dd < 127 ? (dd < 0 ? 0 : dd) : 127];
            bv[i] = (sv[i] >= 0 ? bq : 32) * 64; cv[i] = (rowbase + (sv[i] >= 0 ? sv[i] : 0)) * 128; }
        *(LAS v4i*)(bk + 4 * lane) = (v4i){bv[0], bv[1], bv[2], bv[3]};
        *(LAS v4i*)(selL + 4 * lane) = (v4i){cv[0], cv[1], cv[2], cv[3]};
        float q0[8], q1[8]; unpack8(w0, q0); unpack8(w1, q1);
        float ss = 0.f;
#pragma unroll
        for (int j = 0; j < 8; ++j) ss += q0[j] * q0[j] + q1[j] * q1[j];
        ss += __shfl_xor(ss, 16); ss += __shfl_xor(ss, 32);
        const float r = (0.125f * 1.4426950408889634f) * __builtin_amdgcn_rsqf(ss * (1.0f / 64.0f) + EPS);
#pragma unroll
        for (int j = 0; j < 8; ++j) { q0[j] = q0[j] * r * qgl[8 * g + j]; q1[j] = q1[j] * r * qgl[32 + 8 * g + j]; }
        const bf16x8 B0 = __builtin_bit_cast(bf16x8, pack8(q0)), B1 = __builtin_bit_cast(bf16x8, pack8(q1));
        LDS_WAIT();
        v4u vb[3][4];
        const int kr8 = lane >> 3, kc8 = lane & 7;
#define VLOAD8(JB_, SLOT_) do { const v4i sv_ = *(const LAS v4i*)(selL + 32 * (JB_) + 4 * kr8); const int skv_[4] = {sv_.x, sv_.y, sv_.z, sv_.w}; \
            _Pragma("unroll") for (int i = 0; i < 4; ++i) vb[SLOT_][i] = (SHADOW == 1) ? (v4u){(unsigned)skv_[i], 0u, 0u, 0u} : *(const v4u*)(V8 + ((unsigned)skv_[i] + 16u * (unsigned)kc8)); } while (0)
        f32x4 S[16];
#pragma unroll
        for (int kt = 0; kt < 16; ++kt) { const v4i b4 = *(const LAS v4i*)(bk + 16 * kt + 4 * g); const int bb[4] = {b4.x, b4.y, b4.z, b4.w};
#pragma unroll
            for (int i = 0; i < 4; ++i) S[kt][i] = *(const LAS float*)((const LAS char*)relb + 4 * l15 + bb[i]); }
        {
            LAS bf16* Kst = Vs;
            const int kr = lane >> 3, kc = lane & 7;
            v4u kv[2][4];
#define KLOAD(CH_, SLOT_) do { const v4i sa_ = *(const LAS v4i*)(selL + 32 * (CH_) + 4 * kr); const int sk_[4] = {sa_.x, sa_.y, sa_.z, sa_.w}; \
            _Pragma("unroll") for (int i = 0; i < 4; ++i) kv[SLOT_][i] = *(const v4u*)((const char*)KN + ((unsigned)sk_[i] + 16u * (unsigned)kc)); } while (0)
            KLOAD(0, 0);
#pragma unroll
            for (int ch = 0; ch < 8; ++ch) {
                if (ch + 1 < 8) KLOAD(ch + 1, (ch + 1) & 1);
#pragma unroll
                for (int i = 0; i < 4; ++i) *(LAS v4u*)(Kst + (4 * kr + i) * 72 + 8 * kc) = kv[ch & 1][i];
                asm volatile("" ::: "memory");
#pragma unroll
                for (int k2 = 0; k2 < 2; ++k2) { const LAS bf16* ap = Kst + (16 * k2 + l15) * 72 + 8 * g;
                    const bf16x8 A0 = *(const LAS bf16x8*)ap, A1 = *(const LAS bf16x8*)(ap + 32);
                    const f32x4 z = mfma16(A0, B0, S[2 * ch + k2]); S[2 * ch + k2] = mfma16(A1, B1, z); }
                asm volatile("" ::: "memory");
                __builtin_amdgcn_sched_barrier(0);
            }
#undef KLOAD
        }
        VLOAD8(0, 0); VLOAD8(1, 1);
        float mx = -3.0e38f;
#pragma unroll
        for (int kt = 0; kt < 16; ++kt) mx = fmaxf(mx, fmaxf(fmaxf(S[kt][0], S[kt][1]), fmaxf(S[kt][2], S[kt][3])));
        mx = fmaxf(mx, __shfl_xor(mx, 16)); mx = fmaxf(mx, __shfl_xor(mx, 32));
#pragma unroll
        for (int kt = 0; kt < 16; ++kt) {
#pragma unroll
            for (int i = 0; i < 4; ++i) S[kt][i] = __builtin_amdgcn_exp2f(S[kt][i] - mx); }
        { const int nrow = row + c.NGW;
          if (nrow < NTOK) { s4n = *(const v2u*)((const char*)SEL + ((unsigned)nrow * 512u + 8u * (unsigned)lane));
              if (l15 < 12) { const char* qp = (const char*)PROJ + ((unsigned)nrow * 3072u + (unsigned)(l15 * 128 + 16 * g)); qn0 = *(const v4u*)qp; qn1 = *(const v4u*)(qp + 64); } } }
        f32x4 O[8];
#pragma unroll
        for (int ct = 0; ct < 8; ++ct) O[ct] = (f32x4){0.f, 0.f, 0.f, 0.f};
        f32x4 Ls = {0.f, 0.f, 0.f, 0.f};
        bf16x8 ones; { v4u ow = {0x3F803F80u, 0x3F803F80u, 0x3F803F80u, 0x3F803F80u}; asm volatile("" : "+v"(ow)); ones = __builtin_bit_cast(bf16x8, ow); }
#pragma unroll
        for (int jb = 0; jb < (SHADOW == 1 ? 0 : 8); ++jb) {
            if (jb + 2 < 8) VLOAD8(jb + 2, (jb + 2) % 3);
#pragma unroll
            for (int i = 0; i < 4; ++i) { const v4u v = vb[jb % 3][i]; const unsigned vw[4] = {v.x, v.y, v.z, v.w}; unsigned o[8];
#pragma unroll
                for (int k = 0; k < 4; ++k) { o[2 * k] = __builtin_bit_cast(unsigned, __builtin_amdgcn_cvt_scalef32_pk_bf16_fp8((int)vw[k], 1.0f, false)); o[2 * k + 1] = __builtin_bit_cast(unsigned, __builtin_amdgcn_cvt_scalef32_pk_bf16_fp8((int)vw[k], 1.0f, true)); }
                LAS v4u* d = (LAS v4u*)(Vs + (4 * kr8 + i) * VRS + 16 * kc8); d[0] = (v4u){o[0], o[1], o[2], o[3]}; d[1] = (v4u){o[4], o[5], o[6], o[7]}; }
            v4u pw; pw.x = pk2(S[2 * jb][0], S[2 * jb][1]); pw.y = pk2(S[2 * jb][2], S[2 * jb][3]); pw.z = pk2(S[2 * jb + 1][0], S[2 * jb + 1][1]); pw.w = pk2(S[2 * jb + 1][2], S[2 * jb + 1][3]);
            const bf16x8 Pb = __builtin_bit_cast(bf16x8, pw);
            asm volatile("" ::: "memory");
#pragma unroll
            for (int ct = 0; ct < 8; ++ct) {
                const s16x4 a = __builtin_amdgcn_ds_read_tr16_b64_v4i16((LAS s16x4*)(trp + 16 * ct));
                const s16x4 bq = __builtin_amdgcn_ds_read_tr16_b64_v4i16((LAS s16x4*)(trp + 16 * VRS + 16 * ct));
                const bf16x8 Af = {a[0], a[1], a[2], a[3], bq[0], bq[1], bq[2], bq[3]};
                O[ct] = mfma16(Af, Pb, O[ct]); }
            Ls = mfma16(ones, Pb, Ls);
            asm volatile("" ::: "memory");
            __builtin_amdgcn_sched_barrier(0);
        }
        if (SHADOW ? (Ls[0] == 1.2345e-30f) : (l15 < 12)) { const float il = __builtin_amdgcn_rcpf(Ls[0]); bf16* op = (bf16*)((char*)MIX + ((unsigned)row * 3584u + (unsigned)(l15 * 256 + 8 * g)));
#pragma unroll
            for (int ct = 0; ct < 8; ++ct) { v2u o; o.x = pk2(O[ct][0] * il, O[ct][1] * il); o.y = pk2(O[ct][2] * il, O[ct][3] * il); *(v2u*)(op + 16 * ct) = o; } }
        LDS_WAIT();
    }
}

#ifndef ONLY
#define ONLY -1
#endif
#define PH(n) (ONLY < 0 || ONLY == (n))
#ifndef REP0
#define REP0 1
#endif
#ifndef REP1
#define REP1 1
#endif
#ifndef REP2
#define REP2 1
#endif
#ifndef REP3
#define REP3 1
#endif
#ifndef REP4
#define REP4 1
#endif
#ifndef REP5
#define REP5 1
#endif
#ifndef REP6
#define REP6 1
#endif
#ifndef REP7
#define REP7 1
#endif
#ifndef REP8
#define REP8 1
#endif
#ifndef REP9
#define REP9 1
#endif
#ifndef REP10
#define REP10 1
#endif
#ifndef REP11
#define REP11 1
#endif
#ifndef REP12
#define REP12 1
#endif
#ifndef REP13
#define REP13 1
#endif
#ifndef REP14
#define REP14 1
#endif
#ifndef REP15
#define REP15 1
#endif
#ifndef REP16
#define REP16 1
#endif
#ifndef REP17
#define REP17 1
#endif
#ifndef REP18
#define REP18 1
#endif
#define RB(n) for (int r_ = 0; r_ < REP##n; ++r_) { if (r_) GRID_BAR();
#define RE }
#ifdef PROBE_A
#define STAMP() do { if (c.blk == 0 && c.tid == 0) { volatile LAS unsigned* M_ = (volatile LAS unsigned*)(c.lds + MISC_OFF); const unsigned k_ = M_[20]; M_[20] = k_ + 1u; ((unsigned long long*)(P.ws + WS_CTL))[4096 + k_] = __builtin_amdgcn_s_memrealtime(); } } while (0)
#else
#define STAMP() do { } while (0)
#endif
#define GRID_BAR() do { xcd_barrier(bar); STAMP(); } while (0)
template <int layer> DI void layer_body(const Ctx& c, const PV& P, const XcdBarrier& bar) {
    unsigned char* ws = P.ws;
    unsigned* ctl = (unsigned*)(ws + WS_CTL);
    PG8_LAS unsigned char* glds = (PG8_LAS unsigned char*)c.lds;
    const pg8::bf16_t* HN = (const pg8::bf16_t*)(ws + WS_HN);
    if (layer == 0) { RB(0) if (PH(0)) phase_prep0(c, P); RE
    GRID_BAR(); }
    RB(1) if (PH(1)) {
        { pg8::Gemm g{(const pg8::bf16_t*)(ws + WB_MEMN), (const pg8::bf16_t*)(ws + WB_MKV), 1024, 1024, 1024}; pg8::StaticOrder S; S.init(2, 2, c.G, c.G - 1 - c.blk);
          pg8::EpiBf16<false> E{(pg8::bf16_t*)(ws + WB_MKVO), 512, 0, 0, nullptr};
          pg8::gemm_phase<pg8::EpiBf16<false>, pg8::StaticOrder, true, true>(glds, g, S, E, c.wave); }
        __syncthreads();
        if (layer == 0) { pg8::Gemm g{HN, (const pg8::bf16_t*)(ws + WB_WIN), 1024, 1024, 1024}; pg8::StaticOrder S; S.init(128, 7, c.G, c.blk);
          pg8::EpiBf16<true> E{(pg8::bf16_t*)(ws + AR_PROJ), 1792, 3, 6, nullptr};
          pg8::gemm_phase<pg8::EpiBf16<true>, pg8::StaticOrder, true, true>(glds, g, S, E, c.wave); }
        if (layer == 0) { const int fb = (128 * 7) % c.G; __syncthreads(); if (c.blk >= fb) phase_prep0_tail(c, P, fb); }
        else { pg8::Gemm g{(const pg8::bf16_t*)(ws + WS_X2), (const pg8::bf16_t*)(ws + WB_WIN), 1024, 1024, 1024}; pg8::StaticOrder S; S.init(128, 6, c.G, c.blk);
          pg8::EpiBf16<false, true> E{(pg8::bf16_t*)(ws + AR_PROJ), 1536, 0, 0, (const float*)(ws + AR_R)};
          pg8::gemm_phase<pg8::EpiBf16<false, true>, pg8::StaticOrder, true, true>(glds, g, S, E, c.wave); }
    } RE
    GRID_BAR();
    if (layer == 0) {
        RB(2) if (PH(2)) phase_conv(c, P); RE
#ifndef REPX
#define REPX 1
#endif
#ifndef XSH
#define XSH 0
#endif
        for (int rx = 0; rx < REPX; ++rx) { if (rx) GRID_BAR(); if (rx + 1 < REPX) phase_xattn<0, 1792, 1536, 1024, 768, XSH>(c, P, (const bf16*)(ws + AR_PROJ), (bf16*)(ws + AR_LA)); else phase_xattn<0, 1792, 1536, 1024, 768>(c, P, (const bf16*)(ws + AR_PROJ), (bf16*)(ws + AR_MIXL)); }
        GRID_BAR();
        RB(3) if (PH(3)) { pg8::Gemm g{(const pg8::bf16_t*)(ws + AR_XSC), (const pg8::bf16_t*)(ws + WB_WGT), 768, 768, 768}; pg8::GateOrder S; S.init(128, 6, c.G, c.blk);
          LAS float* gt = (LAS float*)(c.lds + 132096);
          { const float* ba_ = pin(P, I_LRU_B_A); const float* bx_ = pin(P, I_LRU_B_X); const float* lm_ = pin(P, I_LRU_LAMBDA);
            __syncthreads();
            for (int i = c.wave * 64 + hw_lane(); i < 768; i += 512) { const float l = lm_[i];
                gt[i] = -1.4426950408889634f * ba_[i]; gt[768 + i] = -1.4426950408889634f * bx_[i];
                gt[1536 + i] = (8.0f * 1.4426950408889634f) * ((l > 15.f) ? __expf(-l) : __logf(1.0f + __expf(-l))); }
            __syncthreads(); }
          pg8::EpiLruGate E{(pg8::bf16_t*)(ws + AR_LA), (pg8::bf16_t*)(ws + AR_UU), (const pg8::bf16_t*)(ws + AR_XSC), 768, (const PG8_LAS float*)gt, (float*)(ws + AR_SA), (float*)(ws + AR_SH)};
          pg8::gemm_phase<pg8::EpiLruGate, pg8::GateOrder, true, true>(glds, g, S, E, c.wave); } RE
        GRID_BAR();
        RB(5) if (PH(5)) phase_scanB(c, P); RE
        GRID_BAR();
        RB(6) if (PH(6)) phase_scanC(c, P); RE
        GRID_BAR();
        RB(7) if (PH(7)) { pg8::Gemm g{(const pg8::bf16_t*)(ws + AR_MIXL), (const pg8::bf16_t*)(ws + WB_WOUT), 1024, 1024, 1024}; pg8::StaticOrder S; S.init(128, 4, c.G, c.blk);
          pg8::EpiResBf16<false> E{(pg8::bf16_t*)P.out, (const void*)pin(P, I_X), 1024};
          pg8::gemm_phase<pg8::EpiResBf16<false>, pg8::StaticOrder, true, true>(glds, g, S, E, c.wave); } RE
    } else {
        RB(8) if (PH(8)) phase_dsaprep(c, P);
        if (PH(8)) phase_xattn<1, 1536, 1280, 1792, 1536>(c, P, (const bf16*)(ws + AR_PROJ), (bf16*)(ws + AR_MIXD)); RE
        GRID_BAR();
#ifndef IDX_SHADOW
#define IDX_SHADOW 0
#endif
        RB(9) if (PH(9)) { if (r_ + 1 < REP9) phase_indexer<IDX_SHADOW>(c, P); else phase_indexer<0>(c, P); } RE
        GRID_BAR();
#ifndef SA_SHADOW
#define SA_SHADOW 0
#endif
        RB(10) if (PH(10)) { if (r_ + 1 < REP10) phase_sattn<SA_SHADOW>(c, P); else phase_sattn<0>(c, P); } RE
        GRID_BAR();
        RB(11) if (PH(11)) { pg8::Gemm g{(const pg8::bf16_t*)(ws + AR_MIXD), (const pg8::bf16_t*)(ws + WB_WOUT), 1792, 1792, 1792}; pg8::StaticOrder S; S.init(128, 4, c.G, c.blk);
          pg8::EpiResBf16<true> E{(r_ + 1 < REP11) ? (pg8::bf16_t*)(ws + WS_AR) : (pg8::bf16_t*)(ws + WS_X2), (const void*)(ws + WS_X2), 1024};
          pg8::gemm_phase<pg8::EpiResBf16<true>, pg8::StaticOrder, true, true>(glds, g, S, E, c.wave); } RE
    }
    GRID_BAR();
    if (PH(12)) phase_norm_route<layer>(c, P);
    GRID_BAR();
    moe_tables<layer>(c, P);
    RB(16) if (PH(16)) { const int ntile = ((const LAS int*)(c.lds + TAB_OFF))[400];
        pg8::Gemm g{(layer == 0) ? (const pg8::bf16_t*)P.out : (const pg8::bf16_t*)(ws + WS_X2), (const pg8::bf16_t*)(ws + (layer == 0 ? WB_WGU : WB_WGU1)), 1024, 1024, 1024}; pg8::GatherOrder S; S.init(ntile, 4, c.G, c.blk);
        S.tab = (const PG8_LAS int*)(c.lds + TAB_OFF); S.estride = (size_t)1024 * 1024 * 2; S.rowtab = (const int*)(ws + AR_LOG); S.zrow = NTOK;
        pg8::EpiSwiglu E{(pg8::bf16_t*)(ws + AR_ACT), 512, (const float*)(ws + AR_RS)};
        pg8::gemm_phase<pg8::EpiSwiglu, pg8::GatherOrder, true, true>(glds, g, S, E, c.wave);
        { const int fb = (ntile * 4) % c.G; __syncthreads(); if (c.blk >= fb) { if (layer == 0) phase_prep1_early(c, P, fb); else phase_prep1_down(c, P, fb); } } } RE
    GRID_BAR();
    RB(17) if (PH(17)) { const int ntile = ((const LAS int*)(c.lds + TAB_OFF))[400];
        pg8::Gemm g{(const pg8::bf16_t*)(ws + AR_ACT), (const pg8::bf16_t*)(ws + (layer == 0 ? WB_WD : WB_WD1)), 512, 512, 512}; pg8::GroupedOrder S; S.init(ntile, 4, c.G, c.blk);
        S.tab = (const PG8_LAS int*)(c.lds + TAB_OFF); S.estride = (size_t)1024 * 512 * 2;
        pg8::EpiFp8 E{(unsigned char*)(ws + AR_XS), 1024};
        pg8::gemm_phase<pg8::EpiFp8, pg8::GroupedOrder, true, true>(glds, g, S, E, c.wave);
        if (layer == 0) { const int fb = (ntile * 4) % c.G; __syncthreads(); if (c.blk >= fb) phase_prep1_gu(c, P, fb); } } RE
    GRID_BAR();
#ifdef XBAR
    for (int xb = 0; xb < XBAR; ++xb) GRID_BAR();
#endif
    if (PH(18)) phase_combine<layer == 0>(c, P);
    if (layer == 0) GRID_BAR();
}
__global__ void __launch_bounds__(512, 2) fwd(const Params P) {
    extern __shared__ __attribute__((aligned(16))) unsigned char lds_raw[];
    Ctx c;
    c.lds = (LAS unsigned char*)lds_raw;
    c.tid = threadIdx.x; c.lane = c.tid & 63; c.wave = __builtin_amdgcn_readfirstlane(c.tid >> 6);
    c.G = gridDim.x; c.blk = blockIdx.x; c.gw = c.blk * 8 + c.wave; c.NGW = c.G * 8;
    volatile LAS unsigned* MISC = (volatile LAS unsigned*)(c.lds + MISC_OFF);
    if (c.tid < 64) MISC[c.tid] = 0u;
    if (c.tid < 29) ((LAS unsigned long long*)(c.lds + MISC_OFF + 512))[c.tid] = (unsigned long long)P.in[c.tid];
    __syncthreads();
    XcdBarrier bar = xcd_barrier_post((unsigned*)(P.ws + WS_CTL) + CW_BAR, MISC + 8, c.wave);
    PV pv; pv.ws = P.ws; pv.out = P.out; pv.tab = (LAS unsigned long long*)(c.lds + MISC_OFF + 512);
#ifndef ONLY_LAYER
    { const PV& P = pv; STAMP(); }
    layer_body<0>(c, pv, bar);
    layer_body<1>(c, pv, bar);
#ifdef PROBE_A
    {
        xcd_barrier(bar);
        const unsigned long long* ts = (const unsigned long long*)(pv.ws + WS_CTL) + 4096;
        const float ta = (float)(__hip_atomic_load(ts + PROBE_A + 1, RLX_AGENT) - __hip_atomic_load(ts + PROBE_A, RLX_AGENT)) * 0.01f;
        const float tb = (float)(__hip_atomic_load(ts + PROBE_B + 1, RLX_AGENT) - __hip_atomic_load(ts + PROBE_B, RLX_AGENT)) * 0.01f;
        xcd_barrier(bar);
        for (size_t i = (size_t)c.blk * 512 + c.tid; i < (size_t)NTOK * DM; i += (size_t)c.G * 512) pv.out[i] = (i == 0) ? 100.f * tb : ta;
    }
#endif
#else
    layer_body<ONLY_LAYER>(c, pv, bar);
#endif
}

extern "C" void kernel_launch(void* const* d_in, const int* in_sizes, int n_in, void* d_out, int out_size, void* d_ws, size_t ws_size, hipStream_t stream) {
    static int grid = 0;
    if (grid == 0) {
        if (n_in != 29 || out_size != NTOK * DM || ws_size < WS_END) { fprintf(stderr, "kernel_launch: unexpected shapes (n_in %d out %d ws %zu need %zu)\n", n_in, out_size, ws_size, (size_t)WS_END); grid = -1; return; }
        int dev = 0, cus = 0, per_cu = 0;
        if (hipGetDevice(&dev) != hipSuccess || hipDeviceGetAttribute(&cus, hipDeviceAttributeMultiprocessorCount, dev) != hipSuccess) { grid = -1; return; }
        if (hipFuncSetAttribute((const void*)fwd, hipFuncAttributeMaxDynamicSharedMemorySize, LDS_BYTES) != hipSuccess) { fprintf(stderr, "kernel_launch: hipFuncSetAttribute failed\n"); grid = -1; return; }
        if (hipOccupancyMaxActiveBlocksPerMultiprocessor(&per_cu, (const void*)fwd, 512, LDS_BYTES) != hipSuccess || per_cu < 1) { fprintf(stderr, "kernel_launch: occupancy query reports %d\n", per_cu); }
        (void)hipGetLastError();
        grid = cus;
    }
    if (grid < 0) return;
    if (hipMemsetAsync((char*)d_ws + WS_CTL, 0, CTL_ZERO_BYTES, stream) != hipSuccess) return;
    Params p{};
    for (int i = 0; i < 29; ++i) p.in[i] = (const float*)d_in[i];
    p.out = (float*)d_out; p.ws = (unsigned char*)d_ws;
    hipLaunchKernelGGL(fwd, dim3(grid), dim3(512), LDS_BYTES, stream, p);
}
```
